# Optimizing an MI355X kernel written in HIP

```python
import jax, jax.numpy as jnp
from jax import lax
import numpy as np

D_MODEL = 2048
BATCH = 8
SEQ = 2048
DEPTH = 1

HEAD_DIM = 128
N_Q_HEADS = 8
N_KV_HEADS = 2
Q_GROUP = N_Q_HEADS // N_KV_HEADS
ATTN_WIDTH = N_Q_HEADS * HEAD_DIM
KV_WIDTH = N_KV_HEADS * HEAD_DIM
WINDOW = 128
BLOCK = 128
ROPE_THETA = 10000.0
CONV_WIDTH = D_MODEL // 2
CONV_K = 3
N_BRANCH = 2
N_MEM = 256
MEM_HEADS = 4
MEM_HEAD_DIM = 128
MEM_WIDTH = MEM_HEADS * MEM_HEAD_DIM
D_FF = -(-8 * D_MODEL // (3 * 256)) * 256
RMS_EPS = 1e-6
NEG_INF = -1e30

IN_SIZES = (ATTN_WIDTH, KV_WIDTH, KV_WIDTH, CONV_WIDTH, CONV_WIDTH, CONV_WIDTH, N_BRANCH * D_MODEL)
IN_WIDTH = sum(IN_SIZES)
IN_SPLITS = tuple(int(i) for i in np.cumsum(IN_SIZES)[:-1])

kernel_name = "hybrid_gated_swa_shortconv_encoder"


def rms_norm(t, g):
    tf = t.astype(jnp.float32)
    y = tf * lax.rsqrt(jnp.mean(tf * tf, axis=-1, keepdims=True) + RMS_EPS)
    return (y * g.astype(jnp.float32)).astype(t.dtype)


def rope_tables(s):
    inv = 1.0 / (ROPE_THETA ** (jnp.arange(0, HEAD_DIM, 2, dtype=jnp.float32) / HEAD_DIM))
    ang = jnp.arange(s, dtype=jnp.float32)[:, None] * inv[None, :]
    return jnp.cos(ang), jnp.sin(ang)


def apply_rope(t, cos, sin):
    half = HEAD_DIM // 2
    t1, t2 = t[..., :half], t[..., half:]
    c = cos[None, :, None, :].astype(t.dtype)
    s = sin[None, :, None, :].astype(t.dtype)
    return jnp.concatenate([t1 * c - t2 * s, t2 * c + t1 * s], axis=-1)


def windowed_gqa_sink(q, k, v, sink):
    b, s = q.shape[0], q.shape[1]
    nb = s // BLOCK
    scale = HEAD_DIM ** -0.5
    qb = q.reshape(b, nb, BLOCK, N_KV_HEADS, Q_GROUP, HEAD_DIM)

    def band(t):
        tb = t.reshape(b, nb, BLOCK, N_KV_HEADS, HEAD_DIM)
        tp = jnp.pad(tb, ((0, 0), (1, 1), (0, 0), (0, 0), (0, 0)))
        return jnp.concatenate([tp[:, :-2], tp[:, 1:-1], tp[:, 2:]], axis=2)

    kb, vb = band(k), band(v)
    q_pos = jnp.arange(BLOCK)[:, None]
    k_off = jnp.arange(3 * BLOCK)[None, :] - BLOCK
    in_window = jnp.abs(k_off - q_pos) <= WINDOW
    k_abs = jnp.arange(nb)[:, None] * BLOCK + k_off
    in_range = (k_abs >= 0) & (k_abs < s)
    valid = in_window[None] & in_range[:, None, :]

    scores = jnp.einsum('bnqhgd,bnkhd->bnhgqk', qb, kb).astype(jnp.float32) * scale
    scores = jnp.where(valid[None, :, None, None], scores, NEG_INF)
    sink_col = jnp.broadcast_to(
        sink.astype(jnp.float32).reshape(1, 1, N_KV_HEADS, Q_GROUP, 1, 1),
        scores.shape[:-1] + (1,))
    probs = jax.nn.softmax(jnp.concatenate([scores, sink_col], axis=-1), axis=-1)[..., :-1]
    out = jnp.einsum('bnhgqk,bnkhd->bnqhgd', probs.astype(v.dtype), vb)
    return out.reshape(b, s, ATTN_WIDTH)


def short_conv_centred(u, w):
    up = jnp.pad(u, ((0, 0), (1, 1), (0, 0)))
    return up[:, :-2] * w[0] + up[:, 1:-1] * w[1] + up[:, 2:] * w[2]


def memory_cross_attention(h, mem_n, w_cq, w_ckv, w_co):
    b, s = h.shape[0], h.shape[1]
    m = mem_n.shape[1]
    q = (h @ w_cq).reshape(b, s, MEM_HEADS, MEM_HEAD_DIM)
    k, v = jnp.split(mem_n @ w_ckv, 2, axis=-1)
    k = k.reshape(b, m, MEM_HEADS, MEM_HEAD_DIM)
    v = v.reshape(b, m, MEM_HEADS, MEM_HEAD_DIM)
    scores = jnp.einsum('bshd,bmhd->bhsm', q, k).astype(jnp.float32) * (MEM_HEAD_DIM ** -0.5)
    probs = jax.nn.softmax(scores, axis=-1).astype(v.dtype)
    out = jnp.einsum('bhsm,bmhd->bshd', probs, v).reshape(b, s, MEM_WIDTH)
    return out @ w_co


def setup_inputs(seed: int = 0) -> dict:
    key = jax.random.key(seed)
    ks = jax.random.split(key, 24)
    f32 = jnp.float32

    def w(k, shape, fan_in):
        return jax.random.normal(k, shape, f32) * (fan_in ** -0.5)

    def gain(k, shape):
        return 1.0 + 0.02 * jax.random.normal(k, shape, f32)

    L = DEPTH
    return {
        "x": jax.random.normal(ks[0], (BATCH, SEQ, D_MODEL), f32),
        "mem": jax.random.normal(ks[1], (BATCH, N_MEM, D_MODEL), f32),
        "g_mix": gain(ks[2], (L, D_MODEL)),
        "w_in": w(ks[3], (L, D_MODEL, IN_WIDTH), D_MODEL),
        "sink": 0.5 * jax.random.normal(ks[4], (L, N_Q_HEADS), f32),
        "conv_w": w(ks[5], (L, CONV_K, CONV_WIDTH), CONV_K),
        "b_gate": 0.1 * jax.random.normal(ks[6], (L, N_BRANCH * D_MODEL), f32),
        "w_attn_out": w(ks[7], (L, ATTN_WIDTH, D_MODEL), ATTN_WIDTH),
        "w_conv_out": w(ks[8], (L, CONV_WIDTH, D_MODEL), CONV_WIDTH),
        "w_o": w(ks[9], (L, D_MODEL, D_MODEL), D_MODEL),
        "g_cross": gain(ks[10], (L, D_MODEL)),
        "g_mem": gain(ks[11], (L, D_MODEL)),
        "w_cq": w(ks[12], (L, D_MODEL, MEM_WIDTH), D_MODEL),
        "w_ckv": w(ks[13], (L, D_MODEL, 2 * MEM_WIDTH), D_MODEL),
        "w_co": w(ks[14], (L, MEM_WIDTH, D_MODEL), MEM_WIDTH),
        "g_ffn": gain(ks[15], (L, D_MODEL)),
        "w_gate": w(ks[16], (L, D_MODEL, D_FF), D_MODEL),
        "w_up": w(ks[17], (L, D_MODEL, D_FF), D_MODEL),
        "w_down": w(ks[18], (L, D_FF, D_MODEL), D_FF),
        "g_final": gain(ks[19], (D_MODEL,)),
    }


def reference(x, mem, g_mix, w_in, sink, conv_w, b_gate, w_attn_out, w_conv_out, w_o,
              g_cross, g_mem, w_cq, w_ckv, w_co, g_ffn, w_gate, w_up, w_down, g_final):
    b, s = x.shape[0], x.shape[1]
    cos, sin = rope_tables(s)
    for l in range(DEPTH):
        h = rms_norm(x, g_mix[l])
        z = h @ w_in[l]
        q, k, v, cu, cb, cc, gl = jnp.split(z, IN_SPLITS, axis=-1)

        q = apply_rope(q.reshape(b, s, N_Q_HEADS, HEAD_DIM), cos, sin)
        k = apply_rope(k.reshape(b, s, N_KV_HEADS, HEAD_DIM), cos, sin)
        v = v.reshape(b, s, N_KV_HEADS, HEAD_DIM)
        y_attn = windowed_gqa_sink(q, k, v, sink[l]) @ w_attn_out[l]

        y_conv = (cb * short_conv_centred(cc * cu, conv_w[l])) @ w_conv_out[l]

        g_a, g_c = jnp.split(jax.nn.sigmoid(gl + b_gate[l]), 2, axis=-1)
        x = x + (g_a * y_attn + g_c * y_conv) @ w_o[l]

        x = x + memory_cross_attention(rms_norm(x, g_cross[l]), rms_norm(mem, g_mem[l]),
                                       w_cq[l], w_ckv[l], w_co[l])

        hf = rms_norm(x, g_ffn[l])
        x = x + (jax.nn.silu(hf @ w_gate[l]) * (hf @ w_up[l])) @ w_down[l]
    return rms_norm(x, g_final)
```

```cpp
#include <hip/hip_runtime.h>
#include <hip/hip_cooperative_groups.h>
#include <cstdio>
#include <cstdint>
namespace cg = cooperative_groups;

#ifndef MK_CUT
#define MK_CUT 11
#endif
#ifndef MK_N_LAUNCHES
#define MK_N_LAUNCHES 1
#endif

namespace pg8 {
#define PG8_LAS __attribute__((address_space(3)))
typedef unsigned short bf16_t;
typedef short bf16x8 __attribute__((ext_vector_type(8)));
typedef float f32x4 __attribute__((ext_vector_type(4)));
typedef unsigned u32x4 __attribute__((ext_vector_type(4)));
constexpr int BM = 256, BK = 64, HALF = 128, HTB = HALF * BK * 2, STAGE_BYTES = 8 * HTB, NXCD = 8, WGM = 8;

__host__ __device__ __forceinline__ int lds_byte(int r, int c) { const int st = (r >> 4) * 2 + (c >> 5), rr = r & 15, cc = c & 31, ob = rr * 64 + cc * 2; return st * 1024 + (ob ^ (((ob >> 9) & 1) << 5)); }
__host__ __device__ __forceinline__ void stage_rc(int b, int& R, int& C) { const int st = b / 1024, sb = b % 1024, swz = sb ^ (((sb >> 9) & 1) << 5); R = (st >> 1) * 16 + swz / 64; C = (st & 1) * 32 + (swz % 64) / 2; }
__host__ __device__ __forceinline__ int perm32(int rho) { const int n = rho >> 4, i = rho & 15; return 8 * (i >> 2) + 4 * n + (i & 3); }

struct Unit { int pm, pn, seg; };
struct Gemm { const bf16_t* A0; const bf16_t* B0; const bf16_t* A1; const bf16_t* B1; int M, N, K; };

struct StaticOrder {
    int nM, nN, nwg, G, c, nseg;
    __device__ void init(int M, int N, int G_, int c_, int nseg_ = 1) { nM = M / BM; nN = N / BM; nwg = nM * nN; G = G_; c = c_; nseg = nseg_; }
    __device__ bool next(int i, Unit& u) const {
        const int j = (nseg == 2) ? (i >> 1) : i; u.seg = (nseg == 2) ? (i & 1) : 0;
        const long L = (long)j * G + c; if (L >= nwg) return false;
        int wgid = (int)L; { const int q = nwg / NXCD, r = nwg % NXCD, xcd = wgid % NXCD, off = wgid / NXCD; wgid = (xcd < r ? xcd * (q + 1) : r * (q + 1) + (xcd - r) * q) + off; }
        const int nig = WGM * nN, gid = wgid / nig, fm = gid * WGM, gsz = (nM - fm) < WGM ? (nM - fm) : WGM;
        u.pm = fm + ((wgid % nig) % gsz); u.pn = (wgid % nig) / gsz; return true;
    }
};

typedef __bf16 bf16x2_t __attribute__((ext_vector_type(2)));
typedef float f32x2_t __attribute__((ext_vector_type(2)));
__device__ __forceinline__ unsigned cvt_pk_bf16(float lo, float hi) { const f32x2_t v = {lo, hi}; const bf16x2_t r = __builtin_convertvector(v, bf16x2_t); return __builtin_bit_cast(unsigned, r); }
__device__ __forceinline__ u32x4 pack8(const f32x4 a, const f32x4 b) { u32x4 w; w.x = cvt_pk_bf16(a[0], a[1]); w.y = cvt_pk_bf16(a[2], a[3]); w.z = cvt_pk_bf16(b[0], b[1]); w.w = cvt_pk_bf16(b[2], b[3]); return w; }
__device__ __forceinline__ void unpack8(const u32x4 w, f32x4& a, f32x4& b) {
    a[0] = __uint_as_float(w.x << 16); a[1] = __uint_as_float(w.x & 0xffff0000u); a[2] = __uint_as_float(w.y << 16); a[3] = __uint_as_float(w.y & 0xffff0000u);
    b[0] = __uint_as_float(w.z << 16); b[1] = __uint_as_float(w.z & 0xffff0000u); b[2] = __uint_as_float(w.w << 16); b[3] = __uint_as_float(w.w & 0xffff0000u); }
__device__ __forceinline__ f32x4 sigmoid4(const f32x4 v) { f32x4 o;
#pragma unroll
    for (int i = 0; i < 4; ++i) o[i] = __builtin_amdgcn_rcpf(1.0f + __expf(-v[i]));
    return o; }

typedef f32x4 Acc[2][2][4][2];

struct EpiBf16 {
    static constexpr bool PERM = true, KEEP_ACC = false;
    bf16_t* O; int ldc;
    __device__ __forceinline__ void operator()(Acc& acc, const Unit& u, int wr, int wc, int fr, int fq) const {
        const int row0 = u.pm * BM + wr * 64 + fr, col0 = u.pn * BM + wc * 32 + 8 * fq;
#pragma unroll
        for (int ai = 0; ai < 2; ++ai)
#pragma unroll
            for (int m = 0; m < 4; ++m) { bf16_t* rowp = O + (size_t)(row0 + ai * HALF + m * 16) * ldc + col0;
#pragma unroll
                for (int bj = 0; bj < 2; ++bj) *(u32x4*)(rowp + bj * HALF) = pack8(acc[ai][bj][m][0], acc[ai][bj][m][1]); }
    }
};
struct EpiIn {
    static constexpr bool PERM = true, KEEP_ACC = false;
    bf16_t* ZA; bf16_t* ZG; const float* cosT; const float* sinT; const float* bgate; float qscale;
    __device__ __forceinline__ void operator()(Acc& acc, const Unit& u, int wr, int wc, int fr, int fq) const {
        const int row0 = u.pm * BM + wr * 64 + fr;
        if (u.pn < 5) {
            const int p = wc * 32 + 8 * fq, hb = p >> 6, j0 = p & 63, c1 = u.pn * 256 + hb * 128 + j0;
            const float sc = u.pn < 4 ? qscale : 1.0f;
#pragma unroll
            for (int ai = 0; ai < 2; ++ai)
#pragma unroll
                for (int m = 0; m < 4; ++m) { const int row = row0 + ai * HALF + m * 16, pos = row & 2047;
                    const f32x4 ca = *(const f32x4*)(cosT + pos * 64 + j0), cb = *(const f32x4*)(cosT + pos * 64 + j0 + 4);
                    const f32x4 sa = *(const f32x4*)(sinT + pos * 64 + j0), sb = *(const f32x4*)(sinT + pos * 64 + j0 + 4);
                    const f32x4 t1a = acc[ai][0][m][0], t1b = acc[ai][0][m][1], t2a = acc[ai][1][m][0], t2b = acc[ai][1][m][1];
                    const f32x4 o1a = (t1a * ca - t2a * sa) * sc, o1b = (t1b * cb - t2b * sb) * sc, o2a = (t2a * ca + t1a * sa) * sc, o2b = (t2b * cb + t1b * sb) * sc;
                    bf16_t* rp = ZA + (size_t)row * 4608 + c1;
                    *(u32x4*)rp = pack8(o1a, o1b); *(u32x4*)(rp + 64) = pack8(o2a, o2b); }
        } else if (u.pn < 18) {
            const int col0 = u.pn * BM + wc * 32 + 8 * fq;
#pragma unroll
            for (int ai = 0; ai < 2; ++ai)
#pragma unroll
                for (int m = 0; m < 4; ++m) { bf16_t* rowp = ZA + (size_t)(row0 + ai * HALF + m * 16) * 4608 + col0;
#pragma unroll
                    for (int bj = 0; bj < 2; ++bj) *(u32x4*)(rowp + bj * HALF) = pack8(acc[ai][bj][m][0], acc[ai][bj][m][1]); }
        } else {
            const int col0 = (u.pn - 18) * BM + wc * 32 + 8 * fq;
#pragma unroll
            for (int bj = 0; bj < 2; ++bj) { const f32x4 b0 = *(const f32x4*)(bgate + col0 + bj * HALF), b1 = *(const f32x4*)(bgate + col0 + bj * HALF + 4);
#pragma unroll
                for (int ai = 0; ai < 2; ++ai)
#pragma unroll
                    for (int m = 0; m < 4; ++m) { bf16_t* rowp = ZG + (size_t)(row0 + ai * HALF + m * 16) * 4096 + col0 + bj * HALF;
                        *(u32x4*)rowp = pack8(sigmoid4(acc[ai][bj][m][0] + b0), sigmoid4(acc[ai][bj][m][1] + b1)); } }
        }
    }
};
struct EpiMerge {
    static constexpr bool PERM = true, KEEP_ACC = true;
    const bf16_t* ZG; bf16_t* O;
    __device__ __forceinline__ void operator()(Acc& acc, const Unit& u, int wr, int wc, int fr, int fq) const {
        const int row0 = u.pm * BM + wr * 64 + fr, col0 = u.pn * BM + wc * 32 + 8 * fq;
#pragma unroll
        for (int ai = 0; ai < 2; ++ai)
#pragma unroll
            for (int m = 0; m < 4; ++m) { const int row = row0 + ai * HALF + m * 16;
#pragma unroll
                for (int bj = 0; bj < 2; ++bj) { const bf16_t* gp = ZG + (size_t)row * 4096 + col0 + bj * HALF;
                    f32x4 c0, c1; unpack8(*(const u32x4*)(gp + 2048), c0, c1);
                    if (u.seg == 0) { f32x4 a0, a1; unpack8(*(const u32x4*)gp, a0, a1);
#pragma unroll
                        for (int i = 0; i < 4; ++i) { acc[ai][bj][m][0][i] *= a0[i] * __builtin_amdgcn_rcpf(c0[i]); acc[ai][bj][m][1][i] *= a1[i] * __builtin_amdgcn_rcpf(c1[i]); }
                    } else { *(u32x4*)(O + (size_t)row * 2048 + col0 + bj * HALF) = pack8(acc[ai][bj][m][0] * c0, acc[ai][bj][m][1] * c1); } } }
    }
};
struct EpiRes {
    static constexpr bool PERM = true, KEEP_ACC = false;
    const float* base; float* out; bf16_t* outb; float* part; PG8_LAS float* xch;
    __device__ __forceinline__ void operator()(Acc& acc, const Unit& u, int wr, int wc, int fr, int fq) const {
        const int row0 = u.pm * BM + wr * 64 + fr, col0 = u.pn * BM + wc * 32 + 8 * fq;
#pragma unroll
        for (int ai = 0; ai < 2; ++ai)
#pragma unroll
            for (int m = 0; m < 4; ++m) { const int row = row0 + ai * HALF + m * 16; float ss = 0.f;
#pragma unroll
                for (int bj = 0; bj < 2; ++bj) { const size_t off = (size_t)row * 2048 + col0 + bj * HALF;
                    const f32x4 o0 = *(const f32x4*)(base + off) + acc[ai][bj][m][0], o1 = *(const f32x4*)(base + off + 4) + acc[ai][bj][m][1];
                    *(f32x4*)(out + off) = o0; *(f32x4*)(out + off + 4) = o1;
                    if (outb) *(u32x4*)(outb + off) = pack8(o0, o1);
                    ss += (o0[0] * o0[0] + o0[1] * o0[1]) + (o0[2] * o0[2] + o0[3] * o0[3]) + (o1[0] * o1[0] + o1[1] * o1[1]) + (o1[2] * o1[2] + o1[3] * o1[3]); }
                ss += __shfl_xor(ss, 16); ss += __shfl_xor(ss, 32);
                if (fq == 0) xch[(ai * HALF + wr * 64 + m * 16 + fr) * 4 + wc] = ss; }
        asm volatile("s_waitcnt lgkmcnt(0)" ::: "memory"); __builtin_amdgcn_s_barrier(); asm volatile("" ::: "memory");
        { const int t = threadIdx.x; if (t < 256) { const f32x4 v = *(const PG8_LAS f32x4*)(xch + t * 4); part[(size_t)(u.pm * BM + t) * 8 + u.pn] = (v[0] + v[1]) + (v[2] + v[3]); } }
        asm volatile("s_waitcnt lgkmcnt(0)" ::: "memory"); __builtin_amdgcn_s_barrier(); asm volatile("" ::: "memory");
    }
};
__device__ __forceinline__ float row_rs(const float* part, int row) { const f32x4 a = *(const f32x4*)(part + (size_t)row * 8), b = *(const f32x4*)(part + (size_t)row * 8 + 4);
    return __builtin_amdgcn_rsqf((((a[0] + a[1]) + (a[2] + a[3])) + ((b[0] + b[1]) + (b[2] + b[3]))) * (1.0f / 2048.0f) + 1e-6f); }
struct EpiRowScale {
    static constexpr bool PERM = true, KEEP_ACC = false;
    bf16_t* O; int ldc; const float* ssq; float scale;
    __device__ __forceinline__ void operator()(Acc& acc, const Unit& u, int wr, int wc, int fr, int fq) const {
        const int row0 = u.pm * BM + wr * 64 + fr, col0 = u.pn * BM + wc * 32 + 8 * fq;
#pragma unroll
        for (int ai = 0; ai < 2; ++ai)
#pragma unroll
            for (int m = 0; m < 4; ++m) { const int row = row0 + ai * HALF + m * 16; const float rs = row_rs(ssq, row) * scale;
                bf16_t* rowp = O + (size_t)row * ldc + col0;
#pragma unroll
                for (int bj = 0; bj < 2; ++bj) *(u32x4*)(rowp + bj * HALF) = pack8(acc[ai][bj][m][0] * rs, acc[ai][bj][m][1] * rs); }
    }
};
struct EpiSwiGLU {
    static constexpr bool PERM = true, KEEP_ACC = false;
    bf16_t* O; const float* ssq;
    __device__ __forceinline__ void operator()(Acc& acc, const Unit& u, int wr, int wc, int fr, int fq) const {
        const int row0 = u.pm * BM + wr * 64 + fr, col0 = u.pn * HALF + wc * 32 + 8 * fq;
#pragma unroll
        for (int ai = 0; ai < 2; ++ai)
#pragma unroll
            for (int m = 0; m < 4; ++m) { const int row = row0 + ai * HALF + m * 16; const float rs = row_rs(ssq, row);
                const f32x4 g0 = acc[ai][0][m][0] * rs, g1 = acc[ai][0][m][1] * rs, u0 = acc[ai][1][m][0] * rs, u1 = acc[ai][1][m][1] * rs;
                *(u32x4*)(O + (size_t)row * 5632 + col0) = pack8(g0 * sigmoid4(g0) * u0, g1 * sigmoid4(g1) * u1); }
    }
};

template <class Epi, class Sched, bool ALIGN_EPI = true>
__device__ __forceinline__ void gemm_phase(PG8_LAS unsigned char* lds, const Gemm g, const Sched& S, const Epi& E) {
    const int tid = threadIdx.x, wid = __builtin_amdgcn_readfirstlane(tid >> 6), lane = tid & 63, wr = wid >> 2, wc = wid & 3, fr = lane & 15, fq = lane >> 4;
    const int K = g.K, nt = K / BK;
    unsigned voffA[2], voffB[2];
#pragma unroll
    for (int i = 0; i < 2; ++i) { int R, C; stage_rc(tid * 16 + i * 8192, R, C); const int Rb = Epi::PERM ? ((R & ~31) + perm32(R & 31)) : R;
        voffA[i] = (unsigned)(R * K + C) * 2u; voffB[i] = (unsigned)(Rb * K + C) * 2u; }
    const size_t kstep = (size_t)(BK * 2);
    const size_t hstep = (size_t)HALF * K * 2;
    const size_t tstep = 2 * hstep;
    const unsigned ldsw = (unsigned)wid * 1024u;
    const int aoff = lds_byte(wr * 64 + fr, fq * 8), boff = lds_byte(wc * 32 + fr, fq * 8);
#define PG8_SA(b, h) (((b) * 2 + (h)) * HTB)
#define PG8_SB(b, h) ((4 + (b) * 2 + (h)) * HTB)
#define PG8_STAGE(bufoff, gbase, voff) do { _Pragma("unroll") for (int _i = 0; _i < 2; ++_i) \
        __builtin_amdgcn_global_load_lds((const unsigned*)((const char*)(gbase) + (voff)[_i]), (PG8_LAS unsigned*)(lds + (bufoff) + ldsw + _i * 8192), 16, 0, 0); } while (0)
#define PG8_LDA(dst, b, h) do { _Pragma("unroll") for (int m = 0; m < 4; ++m) _Pragma("unroll") for (int k = 0; k < 2; ++k) dst[m][k] = *(const PG8_LAS bf16x8*)(lds + PG8_SA(b, h) + aoff + m * 2048 + k * 1024); } while (0)
#define PG8_LDB(dst, b, h) do { _Pragma("unroll") for (int n = 0; n < 2; ++n) _Pragma("unroll") for (int k = 0; k < 2; ++k) dst[n][k] = *(const PG8_LAS bf16x8*)(lds + PG8_SB(b, h) + boff + n * 2048 + k * 1024); } while (0)
#define PG8_MMA(ai, bj, At, Bt) do { __builtin_amdgcn_s_setprio(1); _Pragma("unroll") for (int m = 0; m < 4; ++m) _Pragma("unroll") for (int n = 0; n < 2; ++n) _Pragma("unroll") for (int k = 0; k < 2; ++k) \
        acc[ai][bj][m][n] = __builtin_amdgcn_mfma_f32_16x16x32_bf16(Bt[n][k], At[m][k], acc[ai][bj][m][n], 0, 0, 0); __builtin_amdgcn_s_setprio(0); } while (0)
#define PG8_WAIT_V(n) asm volatile("s_waitcnt vmcnt(" #n ")" ::: "memory")
#define PG8_WAIT_L(n) asm volatile("s_waitcnt lgkmcnt(" #n ")" ::: "memory")
#define PG8_BAR __builtin_amdgcn_s_barrier()
#define PG8_SCHED __builtin_amdgcn_sched_barrier(0)
#define PG8_UA(u) ((const char*)((u).seg ? g.A1 : g.A0) + (size_t)(u).pm * tstep)
#define PG8_UB(u) ((const char*)((u).seg ? g.B1 : g.B0) + (size_t)(u).pn * tstep)
    Unit cur, nxt; int ui = 0;
    if (!S.next(0, cur)) return;
    Acc acc;
#pragma unroll
    for (int a = 0; a < 2; ++a)
#pragma unroll
        for (int b = 0; b < 2; ++b)
#pragma unroll
            for (int m = 0; m < 4; ++m)
#pragma unroll
                for (int n = 0; n < 2; ++n) acc[a][b][m][n] = (f32x4){0.f, 0.f, 0.f, 0.f};
    bf16x8 At[4][2], B0[2][2], B1[2][2];
    const char* cA = PG8_UA(cur); const char* cB = PG8_UB(cur);
    PG8_STAGE(PG8_SB(0, 0), cB, voffB); PG8_STAGE(PG8_SB(0, 1), cB + hstep, voffB); PG8_STAGE(PG8_SA(0, 0), cA, voffA); PG8_STAGE(PG8_SA(0, 1), cA + hstep, voffA);
    if (wr == 1) PG8_BAR;
    PG8_WAIT_V(2); PG8_BAR;
    PG8_STAGE(PG8_SB(1, 0), cB + kstep, voffB); PG8_STAGE(PG8_SA(1, 0), cA + kstep, voffA); PG8_STAGE(PG8_SB(1, 1), cB + hstep + kstep, voffB);
    PG8_WAIT_V(6); PG8_BAR;
    for (;;) {
        const bool has_next = S.next(ui + 1, nxt);
        const char* nA = has_next ? PG8_UA(nxt) : cA; const char* nB = has_next ? PG8_UB(nxt) : cB;
        for (int t = 0; t < nt; t += 2) {
            const bool last = (t == nt - 2);
            const char* a1 = cA + (size_t)(t + 1) * kstep;
            const char* a2 = last ? nA : cA + (size_t)(t + 2) * kstep; const char* b2 = last ? nB : cB + (size_t)(t + 2) * kstep;
            const char* a3 = a2 + kstep; const char* b3 = b2 + kstep;
            PG8_LDB(B0, 0, 0); PG8_LDB(B1, 0, 1); PG8_SCHED; PG8_LDA(At, 0, 0); PG8_STAGE(PG8_SA(1, 1), a1 + hstep, voffA);
            PG8_WAIT_V(8); PG8_WAIT_L(0); PG8_BAR; PG8_MMA(0, 0, At, B0); PG8_MMA(0, 1, At, B1); PG8_BAR; PG8_SCHED;
            PG8_LDA(At, 0, 1); PG8_STAGE(PG8_SB(0, 0), b2, voffB); PG8_STAGE(PG8_SB(0, 1), b2 + hstep, voffB); PG8_STAGE(PG8_SA(0, 0), a2, voffA);
            PG8_WAIT_V(8); PG8_WAIT_L(0); PG8_BAR; PG8_MMA(1, 0, At, B0); PG8_MMA(1, 1, At, B1); PG8_BAR; PG8_SCHED;
            PG8_LDB(B0, 1, 0); PG8_LDB(B1, 1, 1); PG8_SCHED; PG8_LDA(At, 1, 0); PG8_STAGE(PG8_SA(0, 1), a2 + hstep, voffA);
            PG8_WAIT_V(8); PG8_WAIT_L(0); PG8_BAR; PG8_MMA(0, 0, At, B0); PG8_MMA(0, 1, At, B1); PG8_BAR; PG8_SCHED;
            PG8_LDA(At, 1, 1); PG8_STAGE(PG8_SB(1, 0), b3, voffB); PG8_STAGE(PG8_SB(1, 1), b3 + hstep, voffB); PG8_STAGE(PG8_SA(1, 0), a3, voffA);
            PG8_WAIT_V(8); PG8_WAIT_L(0); PG8_BAR; PG8_MMA(1, 0, At, B0); PG8_MMA(1, 1, At, B1); PG8_BAR; PG8_SCHED;
        }
        if constexpr (ALIGN_EPI) { if (wr == 0) PG8_BAR; }
        E(acc, cur, wr, wc, fr, fq);
        if (!has_next) break;
        if (!(Epi::KEEP_ACC && cur.seg == 0)) {
#pragma unroll
        for (int a = 0; a < 2; ++a)
#pragma unroll
            for (int b = 0; b < 2; ++b)
#pragma unroll
                for (int m = 0; m < 4; ++m)
#pragma unroll
                    for (int n = 0; n < 2; ++n) acc[a][b][m][n] = (f32x4){0.f, 0.f, 0.f, 0.f};
        }
        cur = nxt; cA = nA; cB = nB; ++ui;
        if constexpr (ALIGN_EPI) { if (wr == 1) PG8_BAR; }
    }
    PG8_WAIT_V(0);
    if constexpr (!ALIGN_EPI) { if (wr == 0) PG8_BAR; }
    PG8_BAR;
#undef PG8_SA
#undef PG8_SB
#undef PG8_STAGE
#undef PG8_LDA
#undef PG8_LDB
#undef PG8_MMA
#undef PG8_WAIT_V
#undef PG8_WAIT_L
#undef PG8_BAR
#undef PG8_SCHED
#undef PG8_UA
#undef PG8_UB
}
}

constexpr int NWAVES = 8, NTHR = NWAVES * 64;
constexpr int DM = 2048, BATCH = 8, SEQ = 2048, M = BATCH * SEQ;
constexpr int INW = 8704, ZAW = 4608, ZGW = 4096;
constexpr int NMEM = 256, MROWS = BATCH * NMEM;
constexpr int DFF = 5632;
constexpr float RMS_EPS = 1e-6f;

constexpr size_t MiB = 1u << 20;
constexpr size_t WS_SSQ = 474 * MiB;
constexpr size_t WS_ROPE = 1 * MiB;
constexpr size_t WS_WIN = 2 * MiB;
constexpr size_t WS_WA = 36 * MiB;
constexpr size_t WS_WC = 40 * MiB;
constexpr size_t WS_WO = 44 * MiB;
constexpr size_t WS_WCQ = 52 * MiB;
constexpr size_t WS_WCKV = 54 * MiB;
constexpr size_t WS_WCO = 58 * MiB;
constexpr size_t WS_WGU = 60 * MiB;
constexpr size_t WS_WDN = 104 * MiB;
constexpr size_t WS_MEMN = 126 * MiB;
constexpr size_t WS_MEMKV = 134 * MiB;
constexpr size_t WS_ZA = 138 * MiB;
constexpr size_t WS_ZG = 282 * MiB;
constexpr size_t WS_AO = 410 * MiB;
constexpr size_t WS_CV = 442 * MiB;
constexpr size_t WS_END = 476 * MiB;
constexpr size_t WS_MG = WS_ZA;
constexpr size_t WS_X1B = WS_AO;
constexpr size_t WS_QC = WS_ZG;
constexpr size_t WS_CO = WS_ZG + 16 * MiB;
constexpr size_t WS_X2B = WS_ZA;
constexpr size_t WS_ACT = WS_ZA + 64 * MiB;
static_assert(WS_ACT + (size_t)M * DFF * 2 <= WS_AO, "ACT overlay");

constexpr int LDS_BYTES = 147456;

#define GAS __attribute__((address_space(1)))
#define LAS __attribute__((address_space(3)))
typedef unsigned short bf16;
typedef unsigned v4u __attribute__((ext_vector_type(4)));
typedef float f32x4 __attribute__((ext_vector_type(4)));
#define LDS_WAIT() asm volatile("s_waitcnt lgkmcnt(0)" ::: "memory")
__device__ __forceinline__ unsigned f2bf(float f) { unsigned u = __builtin_bit_cast(unsigned, f); return (u + 0x7fffu + ((u >> 16) & 1u)) >> 16; }
__device__ __forceinline__ unsigned pk2(float lo, float hi) { return f2bf(lo) | (f2bf(hi) << 16); }
__device__ __forceinline__ float bflo(unsigned w) { return __uint_as_float(w << 16); }
__device__ __forceinline__ float bfhi(unsigned w) { return __uint_as_float(w & 0xffff0000u); }
__device__ __forceinline__ float wave_sum(float v) {
#pragma unroll
    for (int o = 1; o < 64; o <<= 1) v += __shfl_xor(v, o);
    return v;
}
__device__ __forceinline__ float wave_max(float v) {
#pragma unroll
    for (int o = 1; o < 64; o <<= 1) v = fmaxf(v, __shfl_xor(v, o));
    return v;
}

__device__ __forceinline__ int dest_row(int n0, int mode) {
    if (mode == 1) return (n0 >> 7) * 256 + (n0 & 127);
    if (mode == 2) return (n0 >> 7) * 256 + 128 + (n0 & 127);
    if (mode == 3 && n0 < 1280) return (n0 >> 8) * 256 + ((n0 >> 6) & 1) * 128 + ((n0 >> 7) & 1) * 64 + (n0 & 63);
    return n0;
}
__device__ __forceinline__ void p0_transpose_item(const float* W, int K, int N, bf16* WT, int mode, const float* gk, LAS float* scr, int item, int lane) {
    const int nblk = N / 32, kb = item / nblk, nb = item % nblk, k0 = 64 * kb, n0 = 32 * nb;
#pragma unroll 8
    for (int i = 0; i < 32; ++i) { const int kk = 2 * i + (lane >> 5); float v = W[(size_t)(k0 + kk) * N + n0 + (lane & 31)]; if (gk) v *= gk[k0 + kk]; scr[kk * 33 + (lane & 31)] = v; }
    LDS_WAIT(); asm volatile("" ::: "memory");
    const int c = lane & 7, r0 = dest_row(n0, mode);
#pragma unroll
    for (int j = 0; j < 4; ++j) { const int n = (lane >> 3) + 8 * j; const LAS float* s = scr + (8 * c) * 33 + n;
        v4u o; o.x = pk2(s[0 * 33], s[1 * 33]); o.y = pk2(s[2 * 33], s[3 * 33]); o.z = pk2(s[4 * 33], s[5 * 33]); o.w = pk2(s[6 * 33], s[7 * 33]);
        *(v4u*)(WT + (size_t)(r0 + n) * K + k0 + 8 * c) = o; }
    LDS_WAIT(); asm volatile("" ::: "memory");
}
__device__ __forceinline__ void rms_row_to_bf16(const float* xrow, const float* g, bf16* orow, int lane) {
    const f32x4* xr = (const f32x4*)xrow + lane; const f32x4* gr = (const f32x4*)g + lane;
    f32x4 v[8]; float s = 0.f;
#pragma unroll
    for (int j = 0; j < 8; ++j) { v[j] = xr[64 * j]; s += (v[j].x * v[j].x + v[j].y * v[j].y) + (v[j].z * v[j].z + v[j].w * v[j].w); }
    const float rs = 1.0f / sqrtf(wave_sum(s) * (1.0f / DM) + RMS_EPS);
    unsigned long long* o8 = (unsigned long long*)orow + lane;
#pragma unroll
    for (int j = 0; j < 8; ++j) { const f32x4 gg = gr[64 * j];
        o8[64 * j] = (unsigned long long)pk2(v[j].x * rs * gg.x, v[j].y * rs * gg.y) | ((unsigned long long)pk2(v[j].z * rs * gg.z, v[j].w * rs * gg.w) << 32); }
}

template <int MAXI>
__device__ __forceinline__ void attn_naive(const bf16* q, const bf16* kbase, const bf16* vbase, int stride, int nkeys, bool has_sink, float sink, bf16* out, LAS float* buf, int lane) {
    LAS float* pq = buf; LAS float* pp = buf + 128;
    { const unsigned w = *(const unsigned*)(q + 2 * lane); pq[2 * lane] = bflo(w); pq[2 * lane + 1] = bfhi(w); }
    LDS_WAIT(); asm volatile("" ::: "memory");
    float sc[MAXI]; float mx = -1e30f;
#pragma unroll
    for (int i = 0; i < MAXI; ++i) { const int key = lane + 64 * i; float d = -1e30f;
        if (key < nkeys) { d = 0.f; const v4u* kr = (const v4u*)(kbase + (size_t)key * stride);
            for (int c = 0; c < 16; ++c) { const v4u w = kr[c]; const LAS float* qq = pq + 8 * c;
                d += bflo(w.x) * qq[0] + bfhi(w.x) * qq[1] + bflo(w.y) * qq[2] + bfhi(w.y) * qq[3] + bflo(w.z) * qq[4] + bfhi(w.z) * qq[5] + bflo(w.w) * qq[6] + bfhi(w.w) * qq[7]; } }
        sc[i] = d; mx = fmaxf(mx, d); }
    mx = wave_max(mx); if (has_sink) mx = fmaxf(mx, sink);
    float sum = 0.f;
#pragma unroll
    for (int i = 0; i < MAXI; ++i) { const int key = lane + 64 * i; const float p = (key < nkeys) ? __expf(sc[i] - mx) : 0.f; sc[i] = p; sum += p; }
    sum = wave_sum(sum); if (has_sink) sum += __expf(sink - mx);
    const float inv = 1.0f / sum;
#pragma unroll
    for (int i = 0; i < MAXI; ++i) { const int key = lane + 64 * i; if (key < nkeys) pp[key] = sc[i] * inv; }
    LDS_WAIT(); asm volatile("" ::: "memory");
    float o0 = 0.f, o1 = 0.f;
    for (int key = 0; key < nkeys; ++key) { const unsigned w = *(const unsigned*)(vbase + (size_t)key * stride + 2 * lane); const float p = pp[key]; o0 += p * bflo(w); o1 += p * bfhi(w); }
    *(unsigned*)(out + 2 * lane) = pk2(o0, o1);
    LDS_WAIT(); asm volatile("" ::: "memory");
}

struct Args { const float* in[20]; float* out; unsigned char* ws; int ph_lo, ph_hi; };

__global__ void __launch_bounds__(NTHR, 2) mk_fwd(Args args) {
    extern __shared__ __attribute__((aligned(16))) unsigned char lds_raw[];
    LAS unsigned char* lds = (LAS unsigned char*)lds_raw;
    const int tid = threadIdx.x, lane = tid & 63, wave = __builtin_amdgcn_readfirstlane(tid >> 6);
    const int G = gridDim.x, bx = blockIdx.x;
    const int gw = bx * NWAVES + wave, NGW = G * NWAVES;
    unsigned char* ws = args.ws;
    const float* x = args.in[0]; const float* mem = args.in[1]; const float* g_mix = args.in[2]; const float* w_in = args.in[3]; const float* sink = args.in[4];
    const float* conv_w = args.in[5]; const float* b_gate = args.in[6]; const float* w_attn_out = args.in[7]; const float* w_conv_out = args.in[8]; const float* w_o = args.in[9];
    const float* g_cross = args.in[10]; const float* g_mem = args.in[11]; const float* w_cq = args.in[12]; const float* w_ckv = args.in[13]; const float* w_co = args.in[14];
    const float* g_ffn = args.in[15]; const float* w_gate = args.in[16]; const float* w_up = args.in[17]; const float* w_down = args.in[18]; const float* g_final = args.in[19];
    float* out = args.out;
    float* ssq2 = (float*)(ws + WS_SSQ); float* ssq3 = ssq2 + M * 8; float* ssq4 = ssq3 + M * 8;
    PG8_LAS float* xch = (PG8_LAS float*)(lds + pg8::STAGE_BYTES);
    float* cosT = (float*)(ws + WS_ROPE); float* sinT = cosT + SEQ * 64;
    bf16* Wt_in = (bf16*)(ws + WS_WIN); bf16* Wt_a = (bf16*)(ws + WS_WA); bf16* Wt_c = (bf16*)(ws + WS_WC); bf16* Wt_o = (bf16*)(ws + WS_WO);
    bf16* Wt_cq = (bf16*)(ws + WS_WCQ); bf16* Wt_ckv = (bf16*)(ws + WS_WCKV); bf16* Wt_co = (bf16*)(ws + WS_WCO); bf16* Wt_gu = (bf16*)(ws + WS_WGU); bf16* Wt_dn = (bf16*)(ws + WS_WDN);
    bf16* MEMN = (bf16*)(ws + WS_MEMN); bf16* MEMKV = (bf16*)(ws + WS_MEMKV);
    bf16* ZA = (bf16*)(ws + WS_ZA); bf16* ZG = (bf16*)(ws + WS_ZG); bf16* AO = (bf16*)(ws + WS_AO); bf16* CV = (bf16*)(ws + WS_CV);
    bf16* MG = (bf16*)(ws + WS_MG); bf16* X1B = (bf16*)(ws + WS_X1B); bf16* QC = (bf16*)(ws + WS_QC); bf16* CO = (bf16*)(ws + WS_CO);
    bf16* X2B = (bf16*)(ws + WS_X2B); bf16* ACT = (bf16*)(ws + WS_ACT);
    bf16* H = (bf16*)out;
    cg::grid_group grid = cg::this_grid();
    const int lo = args.ph_lo, hi = args.ph_hi;
#define IN(k) (lo <= (k) && (k) < hi)
#define SEAM(k) do { if (IN(k) && IN((k) + 1)) { asm volatile("s_waitcnt vmcnt(0) lgkmcnt(0)" ::: "memory"); __syncthreads(); grid.sync(); } } while (0)

    if (IN(0)) {
        LAS float* scr = (LAS float*)(lds + wave * 16384);
        constexpr int I_IN = (DM / 64) * (INW / 32), I_A = (1024 / 64) * (DM / 32), I_O = (DM / 64) * (DM / 32), I_CQ = (DM / 64) * (512 / 32), I_CKV = (DM / 64) * (1024 / 32),
                      I_CO = (512 / 64) * (DM / 32), I_G = (DM / 64) * (DFF / 32), I_D = (DFF / 64) * (DM / 32);
        constexpr int NITEMS = I_IN + 2 * I_A + I_O + I_CQ + I_CKV + I_CO + 2 * I_G + I_D;
        for (int it = gw; it < NITEMS; it += NGW) {
            int r = it;
            if (r < I_IN) { p0_transpose_item(w_in, DM, INW, Wt_in, 3, nullptr, scr, r, lane); continue; } r -= I_IN;
            if (r < I_A) { p0_transpose_item(w_attn_out, 1024, DM, Wt_a, 0, nullptr, scr, r, lane); continue; } r -= I_A;
            if (r < I_A) { p0_transpose_item(w_conv_out, 1024, DM, Wt_c, 0, nullptr, scr, r, lane); continue; } r -= I_A;
            if (r < I_O) { p0_transpose_item(w_o, DM, DM, Wt_o, 0, nullptr, scr, r, lane); continue; } r -= I_O;
            if (r < I_CQ) { p0_transpose_item(w_cq, DM, 512, Wt_cq, 0, g_cross, scr, r, lane); continue; } r -= I_CQ;
            if (r < I_CKV) { p0_transpose_item(w_ckv, DM, 1024, Wt_ckv, 0, nullptr, scr, r, lane); continue; } r -= I_CKV;
            if (r < I_CO) { p0_transpose_item(w_co, 512, DM, Wt_co, 0, nullptr, scr, r, lane); continue; } r -= I_CO;
            if (r < I_G) { p0_transpose_item(w_gate, DM, DFF, Wt_gu, 1, g_ffn, scr, r, lane); continue; } r -= I_G;
            if (r < I_G) { p0_transpose_item(w_up, DM, DFF, Wt_gu, 2, g_ffn, scr, r, lane); continue; } r -= I_G;
            p0_transpose_item(w_down, DFF, DM, Wt_dn, 0, nullptr, scr, r, lane);
        }
        for (int m = gw; m < M; m += NGW) rms_row_to_bf16(x + (size_t)m * DM, g_mix, H + (size_t)m * DM, lane);
        for (int m = gw; m < MROWS; m += NGW) rms_row_to_bf16(mem + (size_t)m * DM, g_mem, MEMN + (size_t)m * DM, lane);
        for (int i = bx * NTHR + tid; i < SEQ * 64; i += G * NTHR) { const int pos = i >> 6, j = i & 63;
            const float inv = exp2f(-(float)j * (13.287712379549449f / 64.0f)); const float ang = (float)pos * inv;
            cosT[i] = cosf(ang); sinT[i] = sinf(ang); }
    }
    SEAM(0);

    if (IN(1)) {
        { pg8::Gemm g{H, Wt_in, nullptr, nullptr, M, INW, DM}; pg8::StaticOrder S; S.init(M, INW, G, bx);
          pg8::EpiIn E{ZA, ZG, cosT, sinT, b_gate, 0.08838834764831845f};
          pg8::gemm_phase<pg8::EpiIn, pg8::StaticOrder>(lds, g, S, E); }
        { pg8::Gemm g{MEMN, Wt_ckv, nullptr, nullptr, MROWS, 1024, DM}; pg8::StaticOrder S; S.init(MROWS, 1024, G, (bx + G / 2) % G);
          pg8::EpiBf16 E{MEMKV, 1024};
          pg8::gemm_phase<pg8::EpiBf16, pg8::StaticOrder>(lds, g, S, E); }
    }
    SEAM(1);

    if (IN(2)) {
        LAS float* buf = (LAS float*)(lds + wave * 4096);
        for (int it = gw; it < M * 8; it += NGW) { const int t = it >> 3, h = it & 7, s = t & (SEQ - 1), kvh = h >> 2;
            const int k_lo = s - 128 < 0 ? 0 : s - 128, k_hi = s + 128 > SEQ - 1 ? SEQ - 1 : s + 128; const int t0 = t - s + k_lo;
            attn_naive<5>(ZA + (size_t)t * ZAW + h * 128, ZA + (size_t)t0 * ZAW + 1024 + kvh * 128, ZA + (size_t)t0 * ZAW + 1280 + kvh * 128, ZAW, k_hi - k_lo + 1, true, sink[h],
                          AO + (size_t)t * 1024 + h * 128, buf, lane); }
        for (int idx = bx * NTHR + tid; idx < M * 128; idx += G * NTHR) { const int t = idx >> 7, c8 = (idx & 127) * 8, s = t & (SEQ - 1);
            const bf16* zr = ZA + (size_t)t * ZAW + c8;
            f32x4 u0a, u0b, uma = {0.f, 0.f, 0.f, 0.f}, umb = uma, upa = uma, upb = uma, ta, tb, cba, cbb;
            pg8::unpack8(*(const v4u*)(zr + 1536), u0a, u0b); pg8::unpack8(*(const v4u*)(zr + 3584), ta, tb); u0a = u0a * ta; u0b = u0b * tb;
            if (s > 0) { pg8::unpack8(*(const v4u*)(zr - ZAW + 1536), uma, umb); pg8::unpack8(*(const v4u*)(zr - ZAW + 3584), ta, tb); uma = uma * ta; umb = umb * tb; }
            if (s < SEQ - 1) { pg8::unpack8(*(const v4u*)(zr + ZAW + 1536), upa, upb); pg8::unpack8(*(const v4u*)(zr + ZAW + 3584), ta, tb); upa = upa * ta; upb = upb * tb; }
            pg8::unpack8(*(const v4u*)(zr + 2560), cba, cbb);
            const f32x4 w0a = *(const f32x4*)(conv_w + c8), w0b = *(const f32x4*)(conv_w + c8 + 4), w1a = *(const f32x4*)(conv_w + 1024 + c8), w1b = *(const f32x4*)(conv_w + 1024 + c8 + 4),
                        w2a = *(const f32x4*)(conv_w + 2048 + c8), w2b = *(const f32x4*)(conv_w + 2048 + c8 + 4);
            *(v4u*)(CV + (size_t)t * 1024 + c8) = pg8::pack8(cba * (w0a * uma + w1a * u0a + w2a * upa), cbb * (w0b * umb + w1b * u0b + w2b * upb)); }
    }
    SEAM(2);

    if (IN(3)) {
        pg8::Gemm g{AO, Wt_a, CV, Wt_c, M, DM, 1024}; pg8::StaticOrder S; S.init(M, DM, G, bx, 2);
        pg8::EpiMerge E{ZG, MG};
        pg8::gemm_phase<pg8::EpiMerge, pg8::StaticOrder>(lds, g, S, E);
    }
    SEAM(3);

    if (IN(4)) {
        pg8::Gemm g{MG, Wt_o, nullptr, nullptr, M, DM, DM}; pg8::StaticOrder S; S.init(M, DM, G, bx);
        pg8::EpiRes E{x, out, X1B, ssq2, xch};
        pg8::gemm_phase<pg8::EpiRes, pg8::StaticOrder>(lds, g, S, E);
    }
    SEAM(4);

    if (IN(5)) {
        pg8::Gemm g{X1B, Wt_cq, nullptr, nullptr, M, 512, DM}; pg8::StaticOrder S; S.init(M, 512, G, bx);
        pg8::EpiRowScale E{QC, 512, ssq2, 0.08838834764831845f};
        pg8::gemm_phase<pg8::EpiRowScale, pg8::StaticOrder>(lds, g, S, E);
    }
    SEAM(5);

    if (IN(6)) {
        LAS float* buf = (LAS float*)(lds + wave * 4096);
        for (int it = gw; it < M * 4; it += NGW) { const int t = it >> 2, h = it & 3, b = t >> 11;
            attn_naive<4>(QC + (size_t)t * 512 + h * 128, MEMKV + (size_t)(b * NMEM) * 1024 + h * 128, MEMKV + (size_t)(b * NMEM) * 1024 + 512 + h * 128, 1024, NMEM, false, 0.f,
                          CO + (size_t)t * 512 + h * 128, buf, lane); }
    }
    SEAM(6);

    if (IN(7)) {
        pg8::Gemm g{CO, Wt_co, nullptr, nullptr, M, DM, 512}; pg8::StaticOrder S; S.init(M, DM, G, bx);
        pg8::EpiRes E{out, out, X2B, ssq3, xch};
        pg8::gemm_phase<pg8::EpiRes, pg8::StaticOrder>(lds, g, S, E);
    }
    SEAM(7);

    if (IN(8)) {
        pg8::Gemm g{X2B, Wt_gu, nullptr, nullptr, M, 2 * DFF, DM}; pg8::StaticOrder S; S.init(M, 2 * DFF, G, bx);
        pg8::EpiSwiGLU E{ACT, ssq3};
        pg8::gemm_phase<pg8::EpiSwiGLU, pg8::StaticOrder>(lds, g, S, E);
    }
    SEAM(8);

    if (IN(9)) {
        pg8::Gemm g{ACT, Wt_dn, nullptr, nullptr, M, DM, DFF}; pg8::StaticOrder S; S.init(M, DM, G, bx);
        pg8::EpiRes E{out, out, nullptr, ssq4, xch};
        pg8::gemm_phase<pg8::EpiRes, pg8::StaticOrder>(lds, g, S, E);
    }
    SEAM(9);

    if (IN(10)) {
        for (int m = gw; m < M; m += NGW) { f32x4* xr = (f32x4*)(out + (size_t)m * DM) + lane; const f32x4* gr = (const f32x4*)g_final + lane;
            const float rs = pg8::row_rs(ssq4, m);
#pragma unroll
            for (int j = 0; j < 8; ++j) xr[64 * j] = xr[64 * j] * rs * gr[64 * j]; }
    }

#if defined(MK_DUMP_OFF)
    if (hi == MK_CUT && MK_CUT < 11) {
        asm volatile("s_waitcnt vmcnt(0) lgkmcnt(0)" ::: "memory"); __syncthreads(); grid.sync();
        const bf16* src = (const bf16*)(ws + (size_t)(MK_DUMP_OFF));
        for (size_t i = (size_t)bx * NTHR + tid; i < (size_t)M * 2048; i += (size_t)G * NTHR) { const size_t r = i >> 11, c = i & 2047; out[i] = __uint_as_float((unsigned)src[r * (MK_DUMP_LD) + (c % (MK_DUMP_W)) + (c / (MK_DUMP_W)) * (size_t)(MK_DUMP_OFF2)] << 16); }
    }
#endif
#undef IN
#undef SEAM
}

extern "C" void kernel_launch(void* const* d_in, const int* in_sizes, int n_in, void* d_out, int out_size, void* d_ws, size_t ws_size, hipStream_t stream) {
    static int grid = 0;
    if (grid == 0) {
        if (n_in != 20 || in_sizes[0] != M * DM || out_size != M * DM || ws_size < WS_END) { fprintf(stderr, "kernel_launch: unexpected shapes / workspace (n_in %d, ws %zu)\n", n_in, ws_size); grid = -1; return; }
        int dev = 0, cus = 0, per_cu = 0;
        if (hipGetDevice(&dev) != hipSuccess || hipDeviceGetAttribute(&cus, hipDeviceAttributeMultiprocessorCount, dev) != hipSuccess) { grid = -1; return; }
        if (hipFuncSetAttribute((const void*)mk_fwd, hipFuncAttributeMaxDynamicSharedMemorySize, LDS_BYTES) != hipSuccess) { fprintf(stderr, "kernel_launch: hipFuncSetAttribute failed\n"); grid = -1; return; }
        if (hipOccupancyMaxActiveBlocksPerMultiprocessor(&per_cu, (const void*)mk_fwd, NTHR, LDS_BYTES) != hipSuccess || per_cu < 1) { fprintf(stderr, "kernel_launch: occupancy query says %d\n", per_cu); (void)hipGetLastError(); grid = -1; return; }
        grid = cus;
    }
    if (grid < 0) return;
    Args a{};
    for (int i = 0; i < 20; ++i) a.in[i] = (const float*)d_in[i];
    a.out = (float*)d_out; a.ws = (unsigned char*)d_ws;
#if MK_N_LAUNCHES == 1
    a.ph_lo = 0; a.ph_hi = MK_CUT;
    void* kargs[] = {&a};
    hipError_t e = hipLaunchCooperativeKernel((const void*)mk_fwd, dim3(grid), dim3(NTHR), kargs, LDS_BYTES, stream);
    if (e != hipSuccess) fprintf(stderr, "kernel_launch: cooperative launch failed: %s (grid %d)\n", hipGetErrorString(e), grid);
#else
    for (int p = 0; p < 11; ++p) { a.ph_lo = p; a.ph_hi = p + 1; hipLaunchKernelGGL(mk_fwd, dim3(grid), dim3(NTHR), LDS_BYTES, stream, a); }
#endif
}
```

```cpp
#include <hip/hip_runtime.h>
#include <hip/hip_cooperative_groups.h>
#include <cstdio>
#include <cstdint>
namespace cg = cooperative_groups;

#ifndef MK_CUT
#define MK_CUT 11
#endif
#ifndef MK_N_LAUNCHES
#define MK_N_LAUNCHES 1
#endif

namespace pg8 {
#define PG8_LAS __attribute__((address_space(3)))
typedef unsigned short bf16_t;
typedef short bf16x8 __attribute__((ext_vector_type(8)));
typedef float f32x4 __attribute__((ext_vector_type(4)));
typedef unsigned u32x4 __attribute__((ext_vector_type(4)));
constexpr int BM = 256, BK = 64, HALF = 128, HTB = HALF * BK * 2, STAGE_BYTES = 8 * HTB, NXCD = 8, WGM = 8;

__host__ __device__ __forceinline__ int lds_byte(int r, int c) { const int st = (r >> 4) * 2 + (c >> 5), rr = r & 15, cc = c & 31, ob = rr * 64 + cc * 2; return st * 1024 + (ob ^ (((ob >> 9) & 1) << 5)); }
__host__ __device__ __forceinline__ void stage_rc(int b, int& R, int& C) { const int st = b / 1024, sb = b % 1024, swz = sb ^ (((sb >> 9) & 1) << 5); R = (st >> 1) * 16 + swz / 64; C = (st & 1) * 32 + (swz % 64) / 2; }
__host__ __device__ __forceinline__ int perm32(int rho) { const int n = rho >> 4, i = rho & 15; return 8 * (i >> 2) + 4 * n + (i & 3); }

struct Unit { int pm, pn, seg; };
struct Gemm { const bf16_t* A0; const bf16_t* B0; const bf16_t* A1; const bf16_t* B1; int M, N, K; };

struct StaticOrder {
    int nM, nN, nwg, G, c, nseg;
    __device__ void init(int M, int N, int G_, int c_, int nseg_ = 1) { nM = M / BM; nN = N / BM; nwg = nM * nN; G = G_; c = c_; nseg = nseg_; }
    __device__ bool next(int i, Unit& u) const {
        const int j = (nseg == 2) ? (i >> 1) : i; u.seg = (nseg == 2) ? (i & 1) : 0;
        const long L = (long)j * G + c; if (L >= nwg) return false;
        int wgid = (int)L; { const int q = nwg / NXCD, r = nwg % NXCD, xcd = wgid % NXCD, off = wgid / NXCD; wgid = (xcd < r ? xcd * (q + 1) : r * (q + 1) + (xcd - r) * q) + off; }
        const int nig = WGM * nN, gid = wgid / nig, fm = gid * WGM, gsz = (nM - fm) < WGM ? (nM - fm) : WGM;
        u.pm = fm + ((wgid % nig) % gsz); u.pn = (wgid % nig) / gsz; return true;
    }
};

typedef __bf16 bf16x2_t __attribute__((ext_vector_type(2)));
typedef float f32x2_t __attribute__((ext_vector_type(2)));
__device__ __forceinline__ unsigned cvt_pk_bf16(float lo, float hi) { const f32x2_t v = {lo, hi}; const bf16x2_t r = __builtin_convertvector(v, bf16x2_t); return __builtin_bit_cast(unsigned, r); }
__device__ __forceinline__ u32x4 pack8(const f32x4 a, const f32x4 b) { u32x4 w; w.x = cvt_pk_bf16(a[0], a[1]); w.y = cvt_pk_bf16(a[2], a[3]); w.z = cvt_pk_bf16(b[0], b[1]); w.w = cvt_pk_bf16(b[2], b[3]); return w; }
__device__ __forceinline__ void unpack8(const u32x4 w, f32x4& a, f32x4& b) {
    a[0] = __uint_as_float(w.x << 16); a[1] = __uint_as_float(w.x & 0xffff0000u); a[2] = __uint_as_float(w.y << 16); a[3] = __uint_as_float(w.y & 0xffff0000u);
    b[0] = __uint_as_float(w.z << 16); b[1] = __uint_as_float(w.z & 0xffff0000u); b[2] = __uint_as_float(w.w << 16); b[3] = __uint_as_float(w.w & 0xffff0000u); }
__device__ __forceinline__ f32x4 sigmoid4(const f32x4 v) { f32x4 o;
#pragma unroll
    for (int i = 0; i < 4; ++i) o[i] = __builtin_amdgcn_rcpf(1.0f + __expf(-v[i]));
    return o; }

typedef f32x4 Acc[2][2][4][2];

struct EpiBf16 {
    static constexpr bool PERM = true, KEEP_ACC = false;
    bf16_t* O; int ldc;
    __device__ __forceinline__ void operator()(Acc& acc, const Unit& u, int wr, int wc, int fr, int fq) const {
        const int row0 = u.pm * BM + wr * 64 + fr, col0 = u.pn * BM + wc * 32 + 8 * fq;
#pragma unroll
        for (int ai = 0; ai < 2; ++ai)
#pragma unroll
            for (int m = 0; m < 4; ++m) { bf16_t* rowp = O + (size_t)(row0 + ai * HALF + m * 16) * ldc + col0;
#pragma unroll
                for (int bj = 0; bj < 2; ++bj) *(u32x4*)(rowp + bj * HALF) = pack8(acc[ai][bj][m][0], acc[ai][bj][m][1]); }
    }
};
struct EpiIn {
    static constexpr bool PERM = true, KEEP_ACC = false;
    bf16_t* ZA; bf16_t* ZG; const float* cosT; const float* sinT; const float* bgate; float qscale;
    __device__ __forceinline__ void operator()(Acc& acc, const Unit& u, int wr, int wc, int fr, int fq) const {
        const int row0 = u.pm * BM + wr * 64 + fr;
        if (u.pn < 5) {
            const int p = wc * 32 + 8 * fq, hb = p >> 6, j0 = p & 63, c1 = u.pn * 256 + hb * 128 + j0;
            const float sc = u.pn < 4 ? qscale : 1.0f;
#pragma unroll
            for (int ai = 0; ai < 2; ++ai)
#pragma unroll
                for (int m = 0; m < 4; ++m) { const int row = row0 + ai * HALF + m * 16, pos = row & 2047;
                    const f32x4 ca = *(const f32x4*)(cosT + pos * 64 + j0), cb = *(const f32x4*)(cosT + pos * 64 + j0 + 4);
                    const f32x4 sa = *(const f32x4*)(sinT + pos * 64 + j0), sb = *(const f32x4*)(sinT + pos * 64 + j0 + 4);
                    const f32x4 t1a = acc[ai][0][m][0], t1b = acc[ai][0][m][1], t2a = acc[ai][1][m][0], t2b = acc[ai][1][m][1];
                    const f32x4 o1a = (t1a * ca - t2a * sa) * sc, o1b = (t1b * cb - t2b * sb) * sc, o2a = (t2a * ca + t1a * sa) * sc, o2b = (t2b * cb + t1b * sb) * sc;
                    bf16_t* rp = ZA + (size_t)row * 4608 + c1;
                    *(u32x4*)rp = pack8(o1a, o1b); *(u32x4*)(rp + 64) = pack8(o2a, o2b); }
        } else if (u.pn < 18) {
            const int col0 = u.pn * BM + wc * 32 + 8 * fq;
#pragma unroll
            for (int ai = 0; ai < 2; ++ai)
#pragma unroll
                for (int m = 0; m < 4; ++m) { bf16_t* rowp = ZA + (size_t)(row0 + ai * HALF + m * 16) * 4608 + col0;
#pragma unroll
                    for (int bj = 0; bj < 2; ++bj) *(u32x4*)(rowp + bj * HALF) = pack8(acc[ai][bj][m][0], acc[ai][bj][m][1]); }
        } else {
            const int col0 = (u.pn - 18) * BM + wc * 32 + 8 * fq;
#pragma unroll
            for (int bj = 0; bj < 2; ++bj) { const f32x4 b0 = *(const f32x4*)(bgate + col0 + bj * HALF), b1 = *(const f32x4*)(bgate + col0 + bj * HALF + 4);
#pragma unroll
                for (int ai = 0; ai < 2; ++ai)
#pragma unroll
                    for (int m = 0; m < 4; ++m) { bf16_t* rowp = ZG + (size_t)(row0 + ai * HALF + m * 16) * 4096 + col0 + bj * HALF;
                        *(u32x4*)rowp = pack8(sigmoid4(acc[ai][bj][m][0] + b0), sigmoid4(acc[ai][bj][m][1] + b1)); } }
        }
    }
};
struct EpiMerge {
    static constexpr bool PERM = true, KEEP_ACC = true;
    const bf16_t* ZG; bf16_t* O;
    __device__ __forceinline__ void operator()(Acc& acc, const Unit& u, int wr, int wc, int fr, int fq) const {
        const int row0 = u.pm * BM + wr * 64 + fr, col0 = u.pn * BM + wc * 32 + 8 * fq;
#pragma unroll
        for (int ai = 0; ai < 2; ++ai)
#pragma unroll
            for (int m = 0; m < 4; ++m) { const int row = row0 + ai * HALF + m * 16;
#pragma unroll
                for (int bj = 0; bj < 2; ++bj) { const bf16_t* gp = ZG + (size_t)row * 4096 + col0 + bj * HALF;
                    f32x4 c0, c1; unpack8(*(const u32x4*)(gp + 2048), c0, c1);
                    if (u.seg == 0) { f32x4 a0, a1; unpack8(*(const u32x4*)gp, a0, a1);
#pragma unroll
                        for (int i = 0; i < 4; ++i) { acc[ai][bj][m][0][i] *= a0[i] * __builtin_amdgcn_rcpf(c0[i]); acc[ai][bj][m][1][i] *= a1[i] * __builtin_amdgcn_rcpf(c1[i]); }
                    } else { *(u32x4*)(O + (size_t)row * 2048 + col0 + bj * HALF) = pack8(acc[ai][bj][m][0] * c0, acc[ai][bj][m][1] * c1); } } }
    }
};
struct EpiRes {
    static constexpr bool PERM = true, KEEP_ACC = false;
    const float* base; float* out; bf16_t* outb; float* part; PG8_LAS float* xch;
    __device__ __forceinline__ void operator()(Acc& acc, const Unit& u, int wr, int wc, int fr, int fq) const {
        const int row0 = u.pm * BM + wr * 64 + fr, col0 = u.pn * BM + wc * 32 + 8 * fq;
#pragma unroll
        for (int ai = 0; ai < 2; ++ai)
#pragma unroll
            for (int m = 0; m < 4; ++m) { const int row = row0 + ai * HALF + m * 16; float ss = 0.f;
#pragma unroll
                for (int bj = 0; bj < 2; ++bj) { const size_t off = (size_t)row * 2048 + col0 + bj * HALF;
                    const f32x4 o0 = *(const f32x4*)(base + off) + acc[ai][bj][m][0], o1 = *(const f32x4*)(base + off + 4) + acc[ai][bj][m][1];
                    *(f32x4*)(out + off) = o0; *(f32x4*)(out + off + 4) = o1;
                    if (outb) *(u32x4*)(outb + off) = pack8(o0, o1);
                    ss += (o0[0] * o0[0] + o0[1] * o0[1]) + (o0[2] * o0[2] + o0[3] * o0[3]) + (o1[0] * o1[0] + o1[1] * o1[1]) + (o1[2] * o1[2] + o1[3] * o1[3]); }
                ss += __shfl_xor(ss, 16); ss += __shfl_xor(ss, 32);
                if (fq == 0) xch[(ai * HALF + wr * 64 + m * 16 + fr) * 4 + wc] = ss; }
        asm volatile("s_waitcnt lgkmcnt(0)" ::: "memory"); __builtin_amdgcn_s_barrier(); asm volatile("" ::: "memory");
        { const int t = threadIdx.x; if (t < 256) { const f32x4 v = *(const PG8_LAS f32x4*)(xch + t * 4); part[(size_t)(u.pm * BM + t) * 8 + u.pn] = (v[0] + v[1]) + (v[2] + v[3]); } }
        asm volatile("s_waitcnt lgkmcnt(0)" ::: "memory"); __builtin_amdgcn_s_barrier(); asm volatile("" ::: "memory");
    }
};
__device__ __forceinline__ float row_rs(const float* part, int row) { const f32x4 a = *(const f32x4*)(part + (size_t)row * 8), b = *(const f32x4*)(part + (size_t)row * 8 + 4);
    return __builtin_amdgcn_rsqf((((a[0] + a[1]) + (a[2] + a[3])) + ((b[0] + b[1]) + (b[2] + b[3]))) * (1.0f / 2048.0f) + 1e-6f); }
struct EpiRowScale {
    static constexpr bool PERM = true, KEEP_ACC = false;
    bf16_t* O; int ldc; const float* ssq; float scale;
    __device__ __forceinline__ void operator()(Acc& acc, const Unit& u, int wr, int wc, int fr, int fq) const {
        const int row0 = u.pm * BM + wr * 64 + fr, col0 = u.pn * BM + wc * 32 + 8 * fq;
#pragma unroll
        for (int ai = 0; ai < 2; ++ai)
#pragma unroll
            for (int m = 0; m < 4; ++m) { const int row = row0 + ai * HALF + m * 16; const float rs = row_rs(ssq, row) * scale;
                bf16_t* rowp = O + (size_t)row * ldc + col0;
#pragma unroll
                for (int bj = 0; bj < 2; ++bj) *(u32x4*)(rowp + bj * HALF) = pack8(acc[ai][bj][m][0] * rs, acc[ai][bj][m][1] * rs); }
    }
};
struct EpiSwiGLU {
    static constexpr bool PERM = true, KEEP_ACC = false;
    bf16_t* O; const float* ssq;
    __device__ __forceinline__ void operator()(Acc& acc, const Unit& u, int wr, int wc, int fr, int fq) const {
        const int row0 = u.pm * BM + wr * 64 + fr, col0 = u.pn * HALF + wc * 32 + 8 * fq;
#pragma unroll
        for (int ai = 0; ai < 2; ++ai)
#pragma unroll
            for (int m = 0; m < 4; ++m) { const int row = row0 + ai * HALF + m * 16; const float rs = row_rs(ssq, row);
                const f32x4 g0 = acc[ai][0][m][0] * rs, g1 = acc[ai][0][m][1] * rs, u0 = acc[ai][1][m][0] * rs, u1 = acc[ai][1][m][1] * rs;
                *(u32x4*)(O + (size_t)row * 5632 + col0) = pack8(g0 * sigmoid4(g0) * u0, g1 * sigmoid4(g1) * u1); }
    }
};

template <class Epi, class Sched, bool ALIGN_EPI = true>
__device__ __forceinline__ void gemm_phase(PG8_LAS unsigned char* lds, const Gemm g, const Sched& S, const Epi& E) {
    const int tid = threadIdx.x, wid = __builtin_amdgcn_readfirstlane(tid >> 6), lane = tid & 63, wr = wid >> 2, wc = wid & 3, fr = lane & 15, fq = lane >> 4;
    const int K = g.K, nt = K / BK;
    unsigned voffA[2], voffB[2];
#pragma unroll
    for (int i = 0; i < 2; ++i) { int R, C; stage_rc(tid * 16 + i * 8192, R, C); const int Rb = Epi::PERM ? ((R & ~31) + perm32(R & 31)) : R;
        voffA[i] = (unsigned)(R * K + C) * 2u; voffB[i] = (unsigned)(Rb * K + C) * 2u; }
    const size_t kstep = (size_t)(BK * 2);
    const size_t hstep = (size_t)HALF * K * 2;
    const size_t tstep = 2 * hstep;
    const unsigned ldsw = (unsigned)wid * 1024u;
    const int aoff = lds_byte(wr * 64 + fr, fq * 8), boff = lds_byte(wc * 32 + fr, fq * 8);
#define PG8_SA(b, h) (((b) * 2 + (h)) * HTB)
#define PG8_SB(b, h) ((4 + (b) * 2 + (h)) * HTB)
#define PG8_STAGE(bufoff, gbase, voff) do { _Pragma("unroll") for (int _i = 0; _i < 2; ++_i) \
        __builtin_amdgcn_global_load_lds((const unsigned*)((const char*)(gbase) + (voff)[_i]), (PG8_LAS unsigned*)(lds + (bufoff) + ldsw + _i * 8192), 16, 0, 0); } while (0)
#define PG8_LDA(dst, b, h) do { _Pragma("unroll") for (int m = 0; m < 4; ++m) _Pragma("unroll") for (int k = 0; k < 2; ++k) dst[m][k] = *(const PG8_LAS bf16x8*)(lds + PG8_SA(b, h) + aoff + m * 2048 + k * 1024); } while (0)
#define PG8_LDB(dst, b, h) do { _Pragma("unroll") for (int n = 0; n < 2; ++n) _Pragma("unroll") for (int k = 0; k < 2; ++k) dst[n][k] = *(const PG8_LAS bf16x8*)(lds + PG8_SB(b, h) + boff + n * 2048 + k * 1024); } while (0)
#define PG8_MMA(ai, bj, At, Bt) do { __builtin_amdgcn_s_setprio(1); _Pragma("unroll") for (int m = 0; m < 4; ++m) _Pragma("unroll") for (int n = 0; n < 2; ++n) _Pragma("unroll") for (int k = 0; k < 2; ++k) \
        acc[ai][bj][m][n] = __builtin_amdgcn_mfma_f32_16x16x32_bf16(Bt[n][k], At[m][k], acc[ai][bj][m][n], 0, 0, 0); __builtin_amdgcn_s_setprio(0); } while (0)
#define PG8_WAIT_V(n) asm volatile("s_waitcnt vmcnt(" #n ")" ::: "memory")
#define PG8_WAIT_L(n) asm volatile("s_waitcnt lgkmcnt(" #n ")" ::: "memory")
#define PG8_BAR __builtin_amdgcn_s_barrier()
#define PG8_SCHED __builtin_amdgcn_sched_barrier(0)
#define PG8_UA(u) ((const char*)((u).seg ? g.A1 : g.A0) + (size_t)(u).pm * tstep)
#define PG8_UB(u) ((const char*)((u).seg ? g.B1 : g.B0) + (size_t)(u).pn * tstep)
    Unit cur, nxt; int ui = 0;
    if (!S.next(0, cur)) return;
    Acc acc;
#pragma unroll
    for (int a = 0; a < 2; ++a)
#pragma unroll
        for (int b = 0; b < 2; ++b)
#pragma unroll
            for (int m = 0; m < 4; ++m)
#pragma unroll
                for (int n = 0; n < 2; ++n) acc[a][b][m][n] = (f32x4){0.f, 0.f, 0.f, 0.f};
    bf16x8 At[4][2], B0[2][2], B1[2][2];
    const char* cA = PG8_UA(cur); const char* cB = PG8_UB(cur);
    PG8_STAGE(PG8_SB(0, 0), cB, voffB); PG8_STAGE(PG8_SB(0, 1), cB + hstep, voffB); PG8_STAGE(PG8_SA(0, 0), cA, voffA); PG8_STAGE(PG8_SA(0, 1), cA + hstep, voffA);
    if (wr == 1) PG8_BAR;
    PG8_WAIT_V(2); PG8_BAR;
    PG8_STAGE(PG8_SB(1, 0), cB + kstep, voffB); PG8_STAGE(PG8_SA(1, 0), cA + kstep, voffA); PG8_STAGE(PG8_SB(1, 1), cB + hstep + kstep, voffB);
    PG8_WAIT_V(6); PG8_BAR;
    for (;;) {
        const bool has_next = S.next(ui + 1, nxt);
        const char* nA = has_next ? PG8_UA(nxt) : cA; const char* nB = has_next ? PG8_UB(nxt) : cB;
        for (int t = 0; t < nt; t += 2) {
            const bool last = (t == nt - 2);
            const char* a1 = cA + (size_t)(t + 1) * kstep;
            const char* a2 = last ? nA : cA + (size_t)(t + 2) * kstep; const char* b2 = last ? nB : cB + (size_t)(t + 2) * kstep;
            const char* a3 = a2 + kstep; const char* b3 = b2 + kstep;
            PG8_LDB(B0, 0, 0); PG8_LDB(B1, 0, 1); PG8_SCHED; PG8_LDA(At, 0, 0); PG8_STAGE(PG8_SA(1, 1), a1 + hstep, voffA);
            PG8_WAIT_V(8); PG8_WAIT_L(0); PG8_BAR; PG8_MMA(0, 0, At, B0); PG8_MMA(0, 1, At, B1); PG8_BAR; PG8_SCHED;
            PG8_LDA(At, 0, 1); PG8_STAGE(PG8_SB(0, 0), b2, voffB); PG8_STAGE(PG8_SB(0, 1), b2 + hstep, voffB); PG8_STAGE(PG8_SA(0, 0), a2, voffA);
            PG8_WAIT_V(8); PG8_WAIT_L(0); PG8_BAR; PG8_MMA(1, 0, At, B0); PG8_MMA(1, 1, At, B1); PG8_BAR; PG8_SCHED;
            PG8_LDB(B0, 1, 0); PG8_LDB(B1, 1, 1); PG8_SCHED; PG8_LDA(At, 1, 0); PG8_STAGE(PG8_SA(0, 1), a2 + hstep, voffA);
            PG8_WAIT_V(8); PG8_WAIT_L(0); PG8_BAR; PG8_MMA(0, 0, At, B0); PG8_MMA(0, 1, At, B1); PG8_BAR; PG8_SCHED;
            PG8_LDA(At, 1, 1); PG8_STAGE(PG8_SB(1, 0), b3, voffB); PG8_STAGE(PG8_SB(1, 1), b3 + hstep, voffB); PG8_STAGE(PG8_SA(1, 0), a3, voffA);
            PG8_WAIT_V(8); PG8_WAIT_L(0); PG8_BAR; PG8_MMA(1, 0, At, B0); PG8_MMA(1, 1, At, B1); PG8_BAR; PG8_SCHED;
        }
        if constexpr (ALIGN_EPI) { if (wr == 0) PG8_BAR; }
        E(acc, cur, wr, wc, fr, fq);
        if (!has_next) break;
        if (!(Epi::KEEP_ACC && cur.seg == 0)) {
#pragma unroll
        for (int a = 0; a < 2; ++a)
#pragma unroll
            for (int b = 0; b < 2; ++b)
#pragma unroll
                for (int m = 0; m < 4; ++m)
#pragma unroll
                    for (int n = 0; n < 2; ++n) acc[a][b][m][n] = (f32x4){0.f, 0.f, 0.f, 0.f};
        }
        cur = nxt; cA = nA; cB = nB; ++ui;
        if constexpr (ALIGN_EPI) { if (wr == 1) PG8_BAR; }
    }
    PG8_WAIT_V(0);
    if constexpr (!ALIGN_EPI) { if (wr == 0) PG8_BAR; }
    PG8_BAR;
#undef PG8_SA
#undef PG8_SB
#undef PG8_STAGE
#undef PG8_LDA
#undef PG8_LDB
#undef PG8_MMA
#undef PG8_WAIT_V
#undef PG8_WAIT_L
#undef PG8_BAR
#undef PG8_SCHED
#undef PG8_UA
#undef PG8_UB
}
}

constexpr int NWAVES = 8, NTHR = NWAVES * 64;
constexpr int DM = 2048, BATCH = 8, SEQ = 2048, M = BATCH * SEQ;
constexpr int INW = 8704, ZAW = 4608, ZGW = 4096;
constexpr int NMEM = 256, MROWS = BATCH * NMEM;
constexpr int DFF = 5632;
constexpr float RMS_EPS = 1e-6f;

constexpr size_t MiB = 1u << 20;
constexpr size_t WS_SSQ = 474 * MiB;
constexpr size_t WS_ROPE = 1 * MiB;
constexpr size_t WS_WIN = 2 * MiB;
constexpr size_t WS_WA = 36 * MiB;
constexpr size_t WS_WC = 40 * MiB;
constexpr size_t WS_WO = 44 * MiB;
constexpr size_t WS_WCQ = 52 * MiB;
constexpr size_t WS_WCKV = 54 * MiB;
constexpr size_t WS_WCO = 58 * MiB;
constexpr size_t WS_WGU = 60 * MiB;
constexpr size_t WS_WDN = 104 * MiB;
constexpr size_t WS_MEMN = 126 * MiB;
constexpr size_t WS_MEMKV = 134 * MiB;
constexpr size_t WS_ZA = 138 * MiB;
constexpr size_t WS_ZG = 282 * MiB;
constexpr size_t WS_AO = 410 * MiB;
constexpr size_t WS_CV = 442 * MiB;
constexpr size_t WS_END = 476 * MiB;
constexpr size_t WS_MG = WS_ZA;
constexpr size_t WS_X1B = WS_AO;
constexpr size_t WS_QC = WS_ZG;
constexpr size_t WS_CO = WS_ZG + 16 * MiB;
constexpr size_t WS_X2B = WS_ZA;
constexpr size_t WS_ACT = WS_ZA + 64 * MiB;
static_assert(WS_ACT + (size_t)M * DFF * 2 <= WS_AO, "ACT overlay");

constexpr int LDS_BYTES = 147456;

#define GAS __attribute__((address_space(1)))
#define LAS __attribute__((address_space(3)))
typedef unsigned short bf16;
typedef unsigned v4u __attribute__((ext_vector_type(4)));
typedef float f32x4 __attribute__((ext_vector_type(4)));
#define LDS_WAIT() asm volatile("s_waitcnt lgkmcnt(0)" ::: "memory")
__device__ __forceinline__ unsigned f2bf(float f) { unsigned u = __builtin_bit_cast(unsigned, f); return (u + 0x7fffu + ((u >> 16) & 1u)) >> 16; }
__device__ __forceinline__ unsigned pk2(float lo, float hi) { return f2bf(lo) | (f2bf(hi) << 16); }
__device__ __forceinline__ float bflo(unsigned w) { return __uint_as_float(w << 16); }
__device__ __forceinline__ float bfhi(unsigned w) { return __uint_as_float(w & 0xffff0000u); }
__device__ __forceinline__ float wave_sum(float v) {
#pragma unroll
    for (int o = 1; o < 64; o <<= 1) v += __shfl_xor(v, o);
    return v;
}
__device__ __forceinline__ float wave_max(float v) {
#pragma unroll
    for (int o = 1; o < 64; o <<= 1) v = fmaxf(v, __shfl_xor(v, o));
    return v;
}

__device__ __forceinline__ int dest_row(int n0, int mode) {
    if (mode == 1) return (n0 >> 7) * 256 + (n0 & 127);
    if (mode == 2) return (n0 >> 7) * 256 + 128 + (n0 & 127);
    if (mode == 3 && n0 < 1280) return (n0 >> 8) * 256 + ((n0 >> 6) & 1) * 128 + ((n0 >> 7) & 1) * 64 + (n0 & 63);
    return n0;
}
__device__ __forceinline__ void p0_transpose_item(const float* W, int K, int N, bf16* WT, int mode, const float* gk, LAS float* scr, int item, int lane) {
    const int nblk = N / 32, kb = item / nblk, nb = item % nblk, k0 = 64 * kb, n0 = 32 * nb;
#pragma unroll 8
    for (int i = 0; i < 32; ++i) { const int kk = 2 * i + (lane >> 5); float v = W[(size_t)(k0 + kk) * N + n0 + (lane & 31)]; if (gk) v *= gk[k0 + kk]; scr[kk * 33 + (lane & 31)] = v; }
    LDS_WAIT(); asm volatile("" ::: "memory");
    const int c = lane & 7, r0 = dest_row(n0, mode);
#pragma unroll
    for (int j = 0; j < 4; ++j) { const int n = (lane >> 3) + 8 * j; const LAS float* s = scr + (8 * c) * 33 + n;
        v4u o; o.x = pk2(s[0 * 33], s[1 * 33]); o.y = pk2(s[2 * 33], s[3 * 33]); o.z = pk2(s[4 * 33], s[5 * 33]); o.w = pk2(s[6 * 33], s[7 * 33]);
        *(v4u*)(WT + (size_t)(r0 + n) * K + k0 + 8 * c) = o; }
    LDS_WAIT(); asm volatile("" ::: "memory");
}
__device__ __forceinline__ void rms_row_to_bf16(const float* xrow, const float* g, bf16* orow, int lane) {
    const f32x4* xr = (const f32x4*)xrow + lane; const f32x4* gr = (const f32x4*)g + lane;
    f32x4 v[8]; float s = 0.f;
#pragma unroll
    for (int j = 0; j < 8; ++j) { v[j] = xr[64 * j]; s += (v[j].x * v[j].x + v[j].y * v[j].y) + (v[j].z * v[j].z + v[j].w * v[j].w); }
    const float rs = 1.0f / sqrtf(wave_sum(s) * (1.0f / DM) + RMS_EPS);
    unsigned long long* o8 = (unsigned long long*)orow + lane;
#pragma unroll
    for (int j = 0; j < 8; ++j) { const f32x4 gg = gr[64 * j];
        o8[64 * j] = (unsigned long long)pk2(v[j].x * rs * gg.x, v[j].y * rs * gg.y) | ((unsigned long long)pk2(v[j].z * rs * gg.z, v[j].w * rs * gg.w) << 32); }
}

typedef float f32x16 __attribute__((ext_vector_type(16)));
typedef short s16x8 __attribute__((ext_vector_type(8)));
typedef short s16x4 __attribute__((ext_vector_type(4)));
constexpr int ATT_KP = 272, ATT_VP = 264, ATT_V_OFF = 128 * ATT_KP, ATT_LDS = ATT_V_OFF + 128 * ATT_VP;
constexpr float LOG2E = 1.4426950408889634f;
template <bool WINDOW>
__device__ __forceinline__ void attn_unit(LAS unsigned char* lds, const bf16* qw, int qpitch, const bf16* kg, const bf16* vg, int kvpitch, int nblk,
                                          int qpos, int kpos, float m_init, float l_init, bf16* ow, int opitch, int tid, int lane) {
    const int r = lane & 31, h = lane >> 5;
    s16x8 qf[8];
#pragma unroll
    for (int kk = 0; kk < 8; ++kk) qf[kk] = *(const s16x8*)(qw + (size_t)r * qpitch + 16 * kk + 8 * h);
    f32x16 o[4];
#pragma unroll
    for (int dt = 0; dt < 4; ++dt)
#pragma unroll
        for (int i = 0; i < 16; ++i) o[dt][i] = 0.f;
    float m = m_init, l = (h == 0) ? l_init : 0.f;
    const int kkey = tid >> 4, kc = tid & 15, vkey = tid & 127, vcg = tid >> 7;
    for (int blk = 0; blk < nblk; ++blk) {
        v4u kreg[4], vreg[4];
#pragma unroll
        for (int it = 0; it < 4; ++it) { kreg[it] = *(const v4u*)(kg + (size_t)(blk * 128 + kkey + 32 * it) * kvpitch + kc * 8); vreg[it] = *(const v4u*)(vg + (size_t)(blk * 128 + vkey) * kvpitch + (vcg * 4 + it) * 8); }
        __syncthreads();
#pragma unroll
        for (int it = 0; it < 4; ++it) { *(LAS v4u*)(lds + (kkey + 32 * it) * ATT_KP + kc * 16) = kreg[it];
            LAS unsigned short* vt = (LAS unsigned short*)(lds + ATT_V_OFF) + (size_t)((vcg * 4 + it) * 8) * (ATT_VP / 2) + vkey;
            const v4u w = vreg[it];
            vt[0 * (ATT_VP / 2)] = (unsigned short)(w.x & 0xffffu); vt[1 * (ATT_VP / 2)] = (unsigned short)(w.x >> 16); vt[2 * (ATT_VP / 2)] = (unsigned short)(w.y & 0xffffu); vt[3 * (ATT_VP / 2)] = (unsigned short)(w.y >> 16);
            vt[4 * (ATT_VP / 2)] = (unsigned short)(w.z & 0xffffu); vt[5 * (ATT_VP / 2)] = (unsigned short)(w.z >> 16); vt[6 * (ATT_VP / 2)] = (unsigned short)(w.w & 0xffffu); vt[7 * (ATT_VP / 2)] = (unsigned short)(w.w >> 16); }
        __syncthreads();
#pragma unroll 1
        for (int hf = 0; hf < 2; ++hf) {
        f32x16 sc[2];
#pragma unroll
        for (int kt = 0; kt < 2; ++kt) {
#pragma unroll
            for (int i = 0; i < 16; ++i) sc[kt][i] = 0.f;
#pragma unroll
            for (int kk = 0; kk < 8; ++kk) { const s16x8 kf = *(const LAS s16x8*)(lds + (64 * hf + 32 * kt + r) * ATT_KP + (16 * kk + 8 * h) * 2); sc[kt] = __builtin_amdgcn_mfma_f32_32x32x16_bf16(kf, qf[kk], sc[kt], 0, 0, 0); }
        }
        float mb = -1e30f;
#pragma unroll
        for (int kt = 0; kt < 2; ++kt)
#pragma unroll
            for (int i = 0; i < 16; ++i) {
                if (WINDOW) { const int d = (kpos + blk * 128 + 64 * hf + 32 * kt + (i & 3) + 8 * (i >> 2) + 4 * h) - (qpos + r); if (d > 128 || d < -128) sc[kt][i] = -1e30f; }
                mb = fmaxf(mb, sc[kt][i]); }
        mb = fmaxf(mb, __shfl_xor(mb, 32));
        const float mn = fmaxf(m, mb), alpha = __builtin_amdgcn_exp2f((m - mn) * LOG2E), mo = mn * LOG2E;
        m = mn; l *= alpha;
#pragma unroll
        for (int dt = 0; dt < 4; ++dt) o[dt] = o[dt] * alpha;
        float ls = 0.f;
#pragma unroll
        for (int kt = 0; kt < 2; ++kt)
#pragma unroll
            for (int i = 0; i < 16; ++i) { const float p = __builtin_amdgcn_exp2f(sc[kt][i] * LOG2E - mo); sc[kt][i] = p; ls += p; }
        l += ls;
#pragma unroll
        for (int kt = 0; kt < 2; ++kt)
#pragma unroll
            for (int st = 0; st < 2; ++st) {
                v4u pw; pw.x = pg8::cvt_pk_bf16(sc[kt][8 * st + 0], sc[kt][8 * st + 1]); pw.y = pg8::cvt_pk_bf16(sc[kt][8 * st + 2], sc[kt][8 * st + 3]);
                pw.z = pg8::cvt_pk_bf16(sc[kt][8 * st + 4], sc[kt][8 * st + 5]); pw.w = pg8::cvt_pk_bf16(sc[kt][8 * st + 6], sc[kt][8 * st + 7]);
                const s16x8 pf = __builtin_bit_cast(s16x8, pw);
#pragma unroll
                for (int dt = 0; dt < 4; ++dt) { const LAS unsigned char* vp = lds + ATT_V_OFF + (32 * dt + r) * ATT_VP + (64 * hf + 32 * kt + 16 * st + 4 * h) * 2;
                    const s16x4 lo = *(const LAS s16x4*)vp, hi = *(const LAS s16x4*)(vp + 16);
                    const s16x8 vf = __builtin_shufflevector(lo, hi, 0, 1, 2, 3, 4, 5, 6, 7);
                    o[dt] = __builtin_amdgcn_mfma_f32_32x32x16_bf16(vf, pf, o[dt], 0, 0, 0); }
            }
        }
    }
    l += __shfl_xor(l, 32);
    const float inv = 1.0f / l;
    bf16* orow = ow + (size_t)r * opitch + 4 * h;
#pragma unroll
    for (int dt = 0; dt < 4; ++dt)
#pragma unroll
        for (int g = 0; g < 4; ++g) { unsigned long long w = (unsigned long long)pg8::cvt_pk_bf16(o[dt][4 * g] * inv, o[dt][4 * g + 1] * inv) | ((unsigned long long)pg8::cvt_pk_bf16(o[dt][4 * g + 2] * inv, o[dt][4 * g + 3] * inv) << 32);
            *(unsigned long long*)(orow + 32 * dt + 8 * g) = w; }
}

struct Args { const float* in[20]; float* out; unsigned char* ws; int ph_lo, ph_hi; };

__global__ void __launch_bounds__(NTHR, 2) mk_fwd(Args args) {
    extern __shared__ __attribute__((aligned(16))) unsigned char lds_raw[];
    LAS unsigned char* lds = (LAS unsigned char*)lds_raw;
    const int tid = threadIdx.x, lane = tid & 63, wave = __builtin_amdgcn_readfirstlane(tid >> 6);
    const int G = gridDim.x, bx = blockIdx.x;
    const int gw = bx * NWAVES + wave, NGW = G * NWAVES;
    unsigned char* ws = args.ws;
    const float* x = args.in[0]; const float* mem = args.in[1]; const float* g_mix = args.in[2]; const float* w_in = args.in[3]; const float* sink = args.in[4];
    const float* conv_w = args.in[5]; const float* b_gate = args.in[6]; const float* w_attn_out = args.in[7]; const float* w_conv_out = args.in[8]; const float* w_o = args.in[9];
    const float* g_cross = args.in[10]; const float* g_mem = args.in[11]; const float* w_cq = args.in[12]; const float* w_ckv = args.in[13]; const float* w_co = args.in[14];
    const float* g_ffn = args.in[15]; const float* w_gate = args.in[16]; const float* w_up = args.in[17]; const float* w_down = args.in[18]; const float* g_final = args.in[19];
    float* out = args.out;
    float* ssq2 = (float*)(ws + WS_SSQ); float* ssq3 = ssq2 + M * 8; float* ssq4 = ssq3 + M * 8;
    PG8_LAS float* xch = (PG8_LAS float*)(lds + pg8::STAGE_BYTES);
    float* cosT = (float*)(ws + WS_ROPE); float* sinT = cosT + SEQ * 64;
    bf16* Wt_in = (bf16*)(ws + WS_WIN); bf16* Wt_a = (bf16*)(ws + WS_WA); bf16* Wt_c = (bf16*)(ws + WS_WC); bf16* Wt_o = (bf16*)(ws + WS_WO);
    bf16* Wt_cq = (bf16*)(ws + WS_WCQ); bf16* Wt_ckv = (bf16*)(ws + WS_WCKV); bf16* Wt_co = (bf16*)(ws + WS_WCO); bf16* Wt_gu = (bf16*)(ws + WS_WGU); bf16* Wt_dn = (bf16*)(ws + WS_WDN);
    bf16* MEMN = (bf16*)(ws + WS_MEMN); bf16* MEMKV = (bf16*)(ws + WS_MEMKV);
    bf16* ZA = (bf16*)(ws + WS_ZA); bf16* ZG = (bf16*)(ws + WS_ZG); bf16* AO = (bf16*)(ws + WS_AO); bf16* CV = (bf16*)(ws + WS_CV);
    bf16* MG = (bf16*)(ws + WS_MG); bf16* X1B = (bf16*)(ws + WS_X1B); bf16* QC = (bf16*)(ws + WS_QC); bf16* CO = (bf16*)(ws + WS_CO);
    bf16* X2B = (bf16*)(ws + WS_X2B); bf16* ACT = (bf16*)(ws + WS_ACT);
    bf16* H = (bf16*)out;
    cg::grid_group grid = cg::this_grid();
    const int lo = args.ph_lo, hi = args.ph_hi;
#define IN(k) (lo <= (k) && (k) < hi)
#define SEAM(k) do { if (IN(k) && IN((k) + 1)) { asm volatile("s_waitcnt vmcnt(0) lgkmcnt(0)" ::: "memory"); __syncthreads(); grid.sync(); } } while (0)

    if (IN(0)) {
        LAS float* scr = (LAS float*)(lds + wave * 16384);
        constexpr int I_IN = (DM / 64) * (INW / 32), I_A = (1024 / 64) * (DM / 32), I_O = (DM / 64) * (DM / 32), I_CQ = (DM / 64) * (512 / 32), I_CKV = (DM / 64) * (1024 / 32),
                      I_CO = (512 / 64) * (DM / 32), I_G = (DM / 64) * (DFF / 32), I_D = (DFF / 64) * (DM / 32);
        constexpr int NITEMS = I_IN + 2 * I_A + I_O + I_CQ + I_CKV + I_CO + 2 * I_G + I_D;
        for (int it = gw; it < NITEMS; it += NGW) {
            int r = it;
            if (r < I_IN) { p0_transpose_item(w_in, DM, INW, Wt_in, 3, nullptr, scr, r, lane); continue; } r -= I_IN;
            if (r < I_A) { p0_transpose_item(w_attn_out, 1024, DM, Wt_a, 0, nullptr, scr, r, lane); continue; } r -= I_A;
            if (r < I_A) { p0_transpose_item(w_conv_out, 1024, DM, Wt_c, 0, nullptr, scr, r, lane); continue; } r -= I_A;
            if (r < I_O) { p0_transpose_item(w_o, DM, DM, Wt_o, 0, nullptr, scr, r, lane); continue; } r -= I_O;
            if (r < I_CQ) { p0_transpose_item(w_cq, DM, 512, Wt_cq, 0, g_cross, scr, r, lane); continue; } r -= I_CQ;
            if (r < I_CKV) { p0_transpose_item(w_ckv, DM, 1024, Wt_ckv, 0, nullptr, scr, r, lane); continue; } r -= I_CKV;
            if (r < I_CO) { p0_transpose_item(w_co, 512, DM, Wt_co, 0, nullptr, scr, r, lane); continue; } r -= I_CO;
            if (r < I_G) { p0_transpose_item(w_gate, DM, DFF, Wt_gu, 1, g_ffn, scr, r, lane); continue; } r -= I_G;
            if (r < I_G) { p0_transpose_item(w_up, DM, DFF, Wt_gu, 2, g_ffn, scr, r, lane); continue; } r -= I_G;
            p0_transpose_item(w_down, DFF, DM, Wt_dn, 0, nullptr, scr, r, lane);
        }
        for (int m = gw; m < M; m += NGW) rms_row_to_bf16(x + (size_t)m * DM, g_mix, H + (size_t)m * DM, lane);
        for (int m = gw; m < MROWS; m += NGW) rms_row_to_bf16(mem + (size_t)m * DM, g_mem, MEMN + (size_t)m * DM, lane);
        for (int i = bx * NTHR + tid; i < SEQ * 64; i += G * NTHR) { const int pos = i >> 6, j = i & 63;
            const float inv = exp2f(-(float)j * (13.287712379549449f / 64.0f)); const float ang = (float)pos * inv;
            cosT[i] = cosf(ang); sinT[i] = sinf(ang); }
    }
    SEAM(0);

    if (IN(1)) {
        { pg8::Gemm g{H, Wt_in, nullptr, nullptr, M, INW, DM}; pg8::StaticOrder S; S.init(M, INW, G, bx);
          pg8::EpiIn E{ZA, ZG, cosT, sinT, b_gate, 0.08838834764831845f};
          pg8::gemm_phase<pg8::EpiIn, pg8::StaticOrder>(lds, g, S, E); }
        { pg8::Gemm g{MEMN, Wt_ckv, nullptr, nullptr, MROWS, 1024, DM}; pg8::StaticOrder S; S.init(MROWS, 1024, G, (bx + G / 2) % G);
          pg8::EpiBf16 E{MEMKV, 1024};
          pg8::gemm_phase<pg8::EpiBf16, pg8::StaticOrder>(lds, g, S, E); }
    }
    SEAM(1);

    if (IN(2)) {
        for (int it = 2 * bx; it < 512; it += 2 * G)
            for (int hp = 0; hp < 2; ++hp) { const int kvh = it >> 1 & 1, nb = (it >> 2) & 15, b = it >> 6;
                const int hq = kvh * 4 + hp * 2 + (wave >> 2), t0 = b * SEQ + nb * 128 + (wave & 3) * 32;
                const int kb0 = nb > 0 ? nb - 1 : 0, kb1 = nb < 15 ? nb + 1 : 15; const size_t kt0 = (size_t)b * SEQ + kb0 * 128;
                attn_unit<true>(lds, ZA + (size_t)t0 * ZAW + hq * 128, ZAW, ZA + kt0 * ZAW + 1024 + kvh * 128, ZA + kt0 * ZAW + 1280 + kvh * 128, ZAW, kb1 - kb0 + 1,
                                nb * 128 + (wave & 3) * 32, kb0 * 128, sink[hq], 1.0f, AO + (size_t)t0 * 1024 + hq * 128, 1024, tid, lane); }
        __syncthreads();
        for (int idx = bx * NTHR + tid; idx < M * 128; idx += G * NTHR) { const int t = idx >> 7, c8 = (idx & 127) * 8, s = t & (SEQ - 1);
            const bf16* zr = ZA + (size_t)t * ZAW + c8;
            f32x4 u0a, u0b, uma = {0.f, 0.f, 0.f, 0.f}, umb = uma, upa = uma, upb = uma, ta, tb, cba, cbb;
            pg8::unpack8(*(const v4u*)(zr + 1536), u0a, u0b); pg8::unpack8(*(const v4u*)(zr + 3584), ta, tb); u0a = u0a * ta; u0b = u0b * tb;
            if (s > 0) { pg8::unpack8(*(const v4u*)(zr - ZAW + 1536), uma, umb); pg8::unpack8(*(const v4u*)(zr - ZAW + 3584), ta, tb); uma = uma * ta; umb = umb * tb; }
            if (s < SEQ - 1) { pg8::unpack8(*(const v4u*)(zr + ZAW + 1536), upa, upb); pg8::unpack8(*(const v4u*)(zr + ZAW + 3584), ta, tb); upa = upa * ta; upb = upb * tb; }
            pg8::unpack8(*(const v4u*)(zr + 2560), cba, cbb);
            const f32x4 w0a = *(const f32x4*)(conv_w + c8), w0b = *(const f32x4*)(conv_w + c8 + 4), w1a = *(const f32x4*)(conv_w + 1024 + c8), w1b = *(const f32x4*)(conv_w + 1024 + c8 + 4),
                        w2a = *(const f32x4*)(conv_w + 2048 + c8), w2b = *(const f32x4*)(conv_w + 2048 + c8 + 4);
            *(v4u*)(CV + (size_t)t * 1024 + c8) = pg8::pack8(cba * (w0a * uma + w1a * u0a + w2a * upa), cbb * (w0b * umb + w1b * u0b + w2b * upb)); }
    }
    SEAM(2);

    if (IN(3)) {
        pg8::Gemm g{AO, Wt_a, CV, Wt_c, M, DM, 1024}; pg8::StaticOrder S; S.init(M, DM, G, bx, 2);
        pg8::EpiMerge E{ZG, MG};
        pg8::gemm_phase<pg8::EpiMerge, pg8::StaticOrder>(lds, g, S, E);
    }
    SEAM(3);

    if (IN(4)) {
        pg8::Gemm g{MG, Wt_o, nullptr, nullptr, M, DM, DM}; pg8::StaticOrder S; S.init(M, DM, G, bx);
        pg8::EpiRes E{x, out, X1B, ssq2, xch};
        pg8::gemm_phase<pg8::EpiRes, pg8::StaticOrder>(lds, g, S, E);
    }
    SEAM(4);

    if (IN(5)) {
        pg8::Gemm g{X1B, Wt_cq, nullptr, nullptr, M, 512, DM}; pg8::StaticOrder S; S.init(M, 512, G, bx);
        pg8::EpiRowScale E{QC, 512, ssq2, 0.08838834764831845f};
        pg8::gemm_phase<pg8::EpiRowScale, pg8::StaticOrder>(lds, g, S, E);
    }
    SEAM(5);

    if (IN(6)) {
        for (int it = bx; it < 256; it += G) { const int rb = it & 7, hh = (it >> 3) & 3, b = it >> 5; const int t0 = b * SEQ + rb * 256 + wave * 32;
            attn_unit<false>(lds, QC + (size_t)t0 * 512 + hh * 128, 512, MEMKV + (size_t)(b * NMEM) * 1024 + hh * 128, MEMKV + (size_t)(b * NMEM) * 1024 + 512 + hh * 128, 1024, 2,
                             0, 0, -1e30f, 0.0f, CO + (size_t)t0 * 512 + hh * 128, 512, tid, lane); }
    }
    SEAM(6);

    if (IN(7)) {
        pg8::Gemm g{CO, Wt_co, nullptr, nullptr, M, DM, 512}; pg8::StaticOrder S; S.init(M, DM, G, bx);
        pg8::EpiRes E{out, out, X2B, ssq3, xch};
        pg8::gemm_phase<pg8::EpiRes, pg8::StaticOrder>(lds, g, S, E);
    }
    SEAM(7);

    if (IN(8)) {
        pg8::Gemm g{X2B, Wt_gu, nullptr, nullptr, M, 2 * DFF, DM}; pg8::StaticOrder S; S.init(M, 2 * DFF, G, bx);
        pg8::EpiSwiGLU E{ACT, ssq3};
        pg8::gemm_phase<pg8::EpiSwiGLU, pg8::StaticOrder>(lds, g, S, E);
    }
    SEAM(8);

    if (IN(9)) {
        pg8::Gemm g{ACT, Wt_dn, nullptr, nullptr, M, DM, DFF}; pg8::StaticOrder S; S.init(M, DM, G, bx);
        pg8::EpiRes E{out, out, nullptr, ssq4, xch};
        pg8::gemm_phase<pg8::EpiRes, pg8::StaticOrder>(lds, g, S, E);
    }
    SEAM(9);

    if (IN(10)) {
        for (int m = gw; m < M; m += NGW) { f32x4* xr = (f32x4*)(out + (size_t)m * DM) + lane; const f32x4* gr = (const f32x4*)g_final + lane;
            const float rs = pg8::row_rs(ssq4, m);
#pragma unroll
            for (int j = 0; j < 8; ++j) xr[64 * j] = xr[64 * j] * rs * gr[64 * j]; }
    }

#if defined(MK_DUMP_OFF)
    if (hi == MK_CUT && MK_CUT < 11) {
        asm volatile("s_waitcnt vmcnt(0) lgkmcnt(0)" ::: "memory"); __syncthreads(); grid.sync();
        const bf16* src = (const bf16*)(ws + (size_t)(MK_DUMP_OFF));
        for (size_t i = (size_t)bx * NTHR + tid; i < (size_t)M * 2048; i += (size_t)G * NTHR) { const size_t r = i >> 11, c = i & 2047; out[i] = __uint_as_float((unsigned)src[r * (MK_DUMP_LD) + (c % (MK_DUMP_W)) + (c / (MK_DUMP_W)) * (size_t)(MK_DUMP_OFF2)] << 16); }
    }
#endif
#undef IN
#undef SEAM
}

extern "C" void kernel_launch(void* const* d_in, const int* in_sizes, int n_in, void* d_out, int out_size, void* d_ws, size_t ws_size, hipStream_t stream) {
    static int grid = 0;
    if (grid == 0) {
        if (n_in != 20 || in_sizes[0] != M * DM || out_size != M * DM || ws_size < WS_END) { fprintf(stderr, "kernel_launch: unexpected shapes / workspace (n_in %d, ws %zu)\n", n_in, ws_size); grid = -1; return; }
        int dev = 0, cus = 0, per_cu = 0;
        if (hipGetDevice(&dev) != hipSuccess || hipDeviceGetAttribute(&cus, hipDeviceAttributeMultiprocessorCount, dev) != hipSuccess) { grid = -1; return; }
        if (hipFuncSetAttribute((const void*)mk_fwd, hipFuncAttributeMaxDynamicSharedMemorySize, LDS_BYTES) != hipSuccess) { fprintf(stderr, "kernel_launch: hipFuncSetAttribute failed\n"); grid = -1; return; }
        if (hipOccupancyMaxActiveBlocksPerMultiprocessor(&per_cu, (const void*)mk_fwd, NTHR, LDS_BYTES) != hipSuccess || per_cu < 1) { fprintf(stderr, "kernel_launch: occupancy query says %d\n", per_cu); (void)hipGetLastError(); grid = -1; return; }
        grid = cus;
    }
    if (grid < 0) return;
    Args a{};
    for (int i = 0; i < 20; ++i) a.in[i] = (const float*)d_in[i];
    a.out = (float*)d_out; a.ws = (unsigned char*)d_ws;
#if MK_N_LAUNCHES == 1
    a.ph_lo = 0; a.ph_hi = MK_CUT;
    void* kargs[] = {&a};
    hipError_t e = hipLaunchCooperativeKernel((const void*)mk_fwd, dim3(grid), dim3(NTHR), kargs, LDS_BYTES, stream);
    if (e != hipSuccess) fprintf(stderr, "kernel_launch: cooperative launch failed: %s (grid %d)\n", hipGetErrorString(e), grid);
#else
    for (int p = 0; p < 11; ++p) { a.ph_lo = p; a.ph_hi = p + 1; hipLaunchKernelGGL(mk_fwd, dim3(grid), dim3(NTHR), LDS_BYTES, stream, a); }
#endif
}
```

```cpp
#include <hip/hip_runtime.h>
#include <hip/hip_cooperative_groups.h>
#include <cstdio>
#include <cstdint>
namespace cg = cooperative_groups;

#ifndef MK_CUT
#define MK_CUT 11
#endif
#ifndef MK_N_LAUNCHES
#define MK_N_LAUNCHES 1
#endif

namespace pg8 {
#define PG8_LAS __attribute__((address_space(3)))
typedef unsigned short bf16_t;
typedef short bf16x8 __attribute__((ext_vector_type(8)));
typedef float f32x4 __attribute__((ext_vector_type(4)));
typedef unsigned u32x4 __attribute__((ext_vector_type(4)));
constexpr int BM = 256, BK = 64, HALF = 128, HTB = HALF * BK * 2, STAGE_BYTES = 8 * HTB, NXCD = 8, WGM = 8;

__host__ __device__ __forceinline__ int lds_byte(int r, int c) { const int st = (r >> 4) * 2 + (c >> 5), rr = r & 15, cc = c & 31, ob = rr * 64 + cc * 2; return st * 1024 + (ob ^ (((ob >> 9) & 1) << 5)); }
__host__ __device__ __forceinline__ void stage_rc(int b, int& R, int& C) { const int st = b / 1024, sb = b % 1024, swz = sb ^ (((sb >> 9) & 1) << 5); R = (st >> 1) * 16 + swz / 64; C = (st & 1) * 32 + (swz % 64) / 2; }
__host__ __device__ __forceinline__ int perm32(int rho) { const int n = rho >> 4, i = rho & 15; return 8 * (i >> 2) + 4 * n + (i & 3); }

struct Unit { int pm, pn, seg; };
struct Gemm { const bf16_t* A0; const bf16_t* B0; const bf16_t* A1; const bf16_t* B1; int M, N, K; };

struct StaticOrder {
    int nM, nN, nwg, G, c, nseg;
    __device__ void init(int M, int N, int G_, int c_, int nseg_ = 1) { nM = M / BM; nN = N / BM; nwg = nM * nN; G = G_; c = c_; nseg = nseg_; }
    __device__ bool next(int i, Unit& u) const {
        const int j = (nseg == 2) ? (i >> 1) : i; u.seg = (nseg == 2) ? (i & 1) : 0;
        const long L = (long)j * G + c; if (L >= nwg) return false;
        int wgid = (int)L; { const int q = nwg / NXCD, r = nwg % NXCD, xcd = wgid % NXCD, off = wgid / NXCD; wgid = (xcd < r ? xcd * (q + 1) : r * (q + 1) + (xcd - r) * q) + off; }
        const int nig = WGM * nN, gid = wgid / nig, fm = gid * WGM, gsz = (nM - fm) < WGM ? (nM - fm) : WGM;
        u.pm = fm + ((wgid % nig) % gsz); u.pn = (wgid % nig) / gsz; return true;
    }
};

typedef __bf16 bf16x2_t __attribute__((ext_vector_type(2)));
typedef float f32x2_t __attribute__((ext_vector_type(2)));
__device__ __forceinline__ unsigned cvt_pk_bf16(float lo, float hi) { const f32x2_t v = {lo, hi}; const bf16x2_t r = __builtin_convertvector(v, bf16x2_t); return __builtin_bit_cast(unsigned, r); }
__device__ __forceinline__ u32x4 pack8(const f32x4 a, const f32x4 b) { u32x4 w; w.x = cvt_pk_bf16(a[0], a[1]); w.y = cvt_pk_bf16(a[2], a[3]); w.z = cvt_pk_bf16(b[0], b[1]); w.w = cvt_pk_bf16(b[2], b[3]); return w; }
__device__ __forceinline__ void unpack8(const u32x4 w, f32x4& a, f32x4& b) {
    a[0] = __uint_as_float(w.x << 16); a[1] = __uint_as_float(w.x & 0xffff0000u); a[2] = __uint_as_float(w.y << 16); a[3] = __uint_as_float(w.y & 0xffff0000u);
    b[0] = __uint_as_float(w.z << 16); b[1] = __uint_as_float(w.z & 0xffff0000u); b[2] = __uint_as_float(w.w << 16); b[3] = __uint_as_float(w.w & 0xffff0000u); }
__device__ __forceinline__ f32x4 sigmoid4(const f32x4 v) { f32x4 o;
#pragma unroll
    for (int i = 0; i < 4; ++i) o[i] = __builtin_amdgcn_rcpf(1.0f + __expf(-v[i]));
    return o; }

typedef f32x4 Acc[2][2][4][2];

struct EpiBf16 {
    static constexpr bool PERM = true, KEEP_ACC = false;
    bf16_t* O; int ldc;
    __device__ __forceinline__ void operator()(Acc& acc, const Unit& u, int wr, int wc, int fr, int fq) const {
        const int row0 = u.pm * BM + wr * 64 + fr, col0 = u.pn * BM + wc * 32 + 8 * fq;
#pragma unroll
        for (int ai = 0; ai < 2; ++ai)
#pragma unroll
            for (int m = 0; m < 4; ++m) { bf16_t* rowp = O + (size_t)(row0 + ai * HALF + m * 16) * ldc + col0;
#pragma unroll
                for (int bj = 0; bj < 2; ++bj) *(u32x4*)(rowp + bj * HALF) = pack8(acc[ai][bj][m][0], acc[ai][bj][m][1]); }
    }
};
struct EpiIn {
    static constexpr bool PERM = true, KEEP_ACC = false;
    bf16_t* ZA; bf16_t* ZG; const float* cosT; const float* sinT; const float* bgate; float qscale;
    __device__ __forceinline__ void operator()(Acc& acc, const Unit& u, int wr, int wc, int fr, int fq) const {
        const int row0 = u.pm * BM + wr * 64 + fr;
        if (u.pn < 5) {
            const int p = wc * 32 + 8 * fq, hb = p >> 6, j0 = p & 63, c1 = u.pn * 256 + hb * 128 + j0;
            const float sc = u.pn < 4 ? qscale : 1.0f;
#pragma unroll
            for (int ai = 0; ai < 2; ++ai)
#pragma unroll
                for (int m = 0; m < 4; ++m) { const int row = row0 + ai * HALF + m * 16, pos = row & 2047;
                    const f32x4 ca = *(const f32x4*)(cosT + pos * 64 + j0), cb = *(const f32x4*)(cosT + pos * 64 + j0 + 4);
                    const f32x4 sa = *(const f32x4*)(sinT + pos * 64 + j0), sb = *(const f32x4*)(sinT + pos * 64 + j0 + 4);
                    const f32x4 t1a = acc[ai][0][m][0], t1b = acc[ai][0][m][1], t2a = acc[ai][1][m][0], t2b = acc[ai][1][m][1];
                    const f32x4 o1a = (t1a * ca - t2a * sa) * sc, o1b = (t1b * cb - t2b * sb) * sc, o2a = (t2a * ca + t1a * sa) * sc, o2b = (t2b * cb + t1b * sb) * sc;
                    bf16_t* rp = ZA + (size_t)row * 4608 + c1;
                    *(u32x4*)rp = pack8(o1a, o1b); *(u32x4*)(rp + 64) = pack8(o2a, o2b); }
        } else if (u.pn < 18) {
            const int col0 = u.pn * BM + wc * 32 + 8 * fq;
#pragma unroll
            for (int ai = 0; ai < 2; ++ai)
#pragma unroll
                for (int m = 0; m < 4; ++m) { bf16_t* rowp = ZA + (size_t)(row0 + ai * HALF + m * 16) * 4608 + col0;
#pragma unroll
                    for (int bj = 0; bj < 2; ++bj) *(u32x4*)(rowp + bj * HALF) = pack8(acc[ai][bj][m][0], acc[ai][bj][m][1]); }
        } else {
            const int col0 = (u.pn - 18) * BM + wc * 32 + 8 * fq;
#pragma unroll
            for (int bj = 0; bj < 2; ++bj) { const f32x4 b0 = *(const f32x4*)(bgate + col0 + bj * HALF), b1 = *(const f32x4*)(bgate + col0 + bj * HALF + 4);
#pragma unroll
                for (int ai = 0; ai < 2; ++ai)
#pragma unroll
                    for (int m = 0; m < 4; ++m) { bf16_t* rowp = ZG + (size_t)(row0 + ai * HALF + m * 16) * 4096 + col0 + bj * HALF;
                        *(u32x4*)rowp = pack8(sigmoid4(acc[ai][bj][m][0] + b0), sigmoid4(acc[ai][bj][m][1] + b1)); } }
        }
    }
};
struct EpiMerge {
    static constexpr bool PERM = true, KEEP_ACC = true;
    const bf16_t* ZG; bf16_t* O;
    __device__ __forceinline__ void operator()(Acc& acc, const Unit& u, int wr, int wc, int fr, int fq) const {
        const int row0 = u.pm * BM + wr * 64 + fr, col0 = u.pn * BM + wc * 32 + 8 * fq;
#pragma unroll
        for (int ai = 0; ai < 2; ++ai)
#pragma unroll
            for (int m = 0; m < 4; ++m) { const int row = row0 + ai * HALF + m * 16;
#pragma unroll
                for (int bj = 0; bj < 2; ++bj) { const bf16_t* gp = ZG + (size_t)row * 4096 + col0 + bj * HALF;
                    f32x4 c0, c1; unpack8(*(const u32x4*)(gp + 2048), c0, c1);
                    if (u.seg == 0) { f32x4 a0, a1; unpack8(*(const u32x4*)gp, a0, a1);
#pragma unroll
                        for (int i = 0; i < 4; ++i) { acc[ai][bj][m][0][i] *= a0[i] * __builtin_amdgcn_rcpf(c0[i]); acc[ai][bj][m][1][i] *= a1[i] * __builtin_amdgcn_rcpf(c1[i]); }
                    } else { *(u32x4*)(O + (size_t)row * 2048 + col0 + bj * HALF) = pack8(acc[ai][bj][m][0] * c0, acc[ai][bj][m][1] * c1); } } }
    }
};
struct EpiRes {
    static constexpr bool PERM = true, KEEP_ACC = false;
    const float* base; float* out; bf16_t* outb; float* part; PG8_LAS float* xch;
    __device__ __forceinline__ void operator()(Acc& acc, const Unit& u, int wr, int wc, int fr, int fq) const {
        const int row0 = u.pm * BM + wr * 64 + fr, col0 = u.pn * BM + wc * 32 + 8 * fq;
#pragma unroll
        for (int ai = 0; ai < 2; ++ai)
#pragma unroll
            for (int m = 0; m < 4; ++m) { const int row = row0 + ai * HALF + m * 16; float ss = 0.f;
#pragma unroll
                for (int bj = 0; bj < 2; ++bj) { const size_t off = (size_t)row * 2048 + col0 + bj * HALF;
                    const f32x4 o0 = *(const f32x4*)(base + off) + acc[ai][bj][m][0], o1 = *(const f32x4*)(base + off + 4) + acc[ai][bj][m][1];
                    *(f32x4*)(out + off) = o0; *(f32x4*)(out + off + 4) = o1;
                    if (outb) *(u32x4*)(outb + off) = pack8(o0, o1);
                    ss += (o0[0] * o0[0] + o0[1] * o0[1]) + (o0[2] * o0[2] + o0[3] * o0[3]) + (o1[0] * o1[0] + o1[1] * o1[1]) + (o1[2] * o1[2] + o1[3] * o1[3]); }
                ss += __shfl_xor(ss, 16); ss += __shfl_xor(ss, 32);
                if (fq == 0) xch[(ai * HALF + wr * 64 + m * 16 + fr) * 4 + wc] = ss; }
        asm volatile("s_waitcnt lgkmcnt(0)" ::: "memory"); __builtin_amdgcn_s_barrier(); asm volatile("" ::: "memory");
        { const int t = threadIdx.x; if (t < 256) { const f32x4 v = *(const PG8_LAS f32x4*)(xch + t * 4); part[(size_t)(u.pm * BM + t) * 8 + u.pn] = (v[0] + v[1]) + (v[2] + v[3]); } }
        asm volatile("s_waitcnt lgkmcnt(0)" ::: "memory"); __builtin_amdgcn_s_barrier(); asm volatile("" ::: "memory");
    }
};
__device__ __forceinline__ float row_rs(const float* part, int row) { const f32x4 a = *(const f32x4*)(part + (size_t)row * 8), b = *(const f32x4*)(part + (size_t)row * 8 + 4);
    return __builtin_amdgcn_rsqf((((a[0] + a[1]) + (a[2] + a[3])) + ((b[0] + b[1]) + (b[2] + b[3]))) * (1.0f / 2048.0f) + 1e-6f); }
struct EpiRowScale {
    static constexpr bool PERM = true, KEEP_ACC = false;
    bf16_t* O; int ldc; const float* ssq; float scale;
    __device__ __forceinline__ void operator()(Acc& acc, const Unit& u, int wr, int wc, int fr, int fq) const {
        const int row0 = u.pm * BM + wr * 64 + fr, col0 = u.pn * BM + wc * 32 + 8 * fq;
#pragma unroll
        for (int ai = 0; ai < 2; ++ai)
#pragma unroll
            for (int m = 0; m < 4; ++m) { const int row = row0 + ai * HALF + m * 16; const float rs = row_rs(ssq, row) * scale;
                bf16_t* rowp = O + (size_t)row * ldc + col0;
#pragma unroll
                for (int bj = 0; bj < 2; ++bj) *(u32x4*)(rowp + bj * HALF) = pack8(acc[ai][bj][m][0] * rs, acc[ai][bj][m][1] * rs); }
    }
};
struct EpiSwiGLU {
    static constexpr bool PERM = true, KEEP_ACC = false;
    bf16_t* O; const float* ssq;
    __device__ __forceinline__ void operator()(Acc& acc, const Unit& u, int wr, int wc, int fr, int fq) const {
        const int row0 = u.pm * BM + wr * 64 + fr, col0 = u.pn * HALF + wc * 32 + 8 * fq;
#pragma unroll
        for (int ai = 0; ai < 2; ++ai)
#pragma unroll
            for (int m = 0; m < 4; ++m) { const int row = row0 + ai * HALF + m * 16; const float rs = row_rs(ssq, row);
                const f32x4 g0 = acc[ai][0][m][0] * rs, g1 = acc[ai][0][m][1] * rs, u0 = acc[ai][1][m][0] * rs, u1 = acc[ai][1][m][1] * rs;
                *(u32x4*)(O + (size_t)row * 5632 + col0) = pack8(g0 * sigmoid4(g0) * u0, g1 * sigmoid4(g1) * u1); }
    }
};

template <class Epi, class Sched, bool ALIGN_EPI = true>
__device__ __forceinline__ void gemm_phase(PG8_LAS unsigned char* lds, const Gemm g, const Sched& S, const Epi& E) {
    const int tid = threadIdx.x, wid = __builtin_amdgcn_readfirstlane(tid >> 6), lane = tid & 63, wr = wid >> 2, wc = wid & 3, fr = lane & 15, fq = lane >> 4;
    const int K = g.K, nt = K / BK;
    unsigned voffA[2], voffB[2];
#pragma unroll
    for (int i = 0; i < 2; ++i) { int R, C; stage_rc(tid * 16 + i * 8192, R, C); const int Rb = Epi::PERM ? ((R & ~31) + perm32(R & 31)) : R;
        voffA[i] = (unsigned)(R * K + C) * 2u; voffB[i] = (unsigned)(Rb * K + C) * 2u; }
    const size_t kstep = (size_t)(BK * 2);
    const size_t hstep = (size_t)HALF * K * 2;
    const size_t tstep = 2 * hstep;
    const unsigned ldsw = (unsigned)wid * 1024u;
    const int aoff = lds_byte(wr * 64 + fr, fq * 8), boff = lds_byte(wc * 32 + fr, fq * 8);
#define PG8_SA(b, h) (((b) * 2 + (h)) * HTB)
#define PG8_SB(b, h) ((4 + (b) * 2 + (h)) * HTB)
#define PG8_STAGE(bufoff, gbase, voff) do { _Pragma("unroll") for (int _i = 0; _i < 2; ++_i) \
        __builtin_amdgcn_global_load_lds((const unsigned*)((const char*)(gbase) + (voff)[_i]), (PG8_LAS unsigned*)(lds + (bufoff) + ldsw + _i * 8192), 16, 0, 0); } while (0)
#define PG8_LDA(dst, b, h) do { _Pragma("unroll") for (int m = 0; m < 4; ++m) _Pragma("unroll") for (int k = 0; k < 2; ++k) dst[m][k] = *(const PG8_LAS bf16x8*)(lds + PG8_SA(b, h) + aoff + m * 2048 + k * 1024); } while (0)
#define PG8_LDB(dst, b, h) do { _Pragma("unroll") for (int n = 0; n < 2; ++n) _Pragma("unroll") for (int k = 0; k < 2; ++k) dst[n][k] = *(const PG8_LAS bf16x8*)(lds + PG8_SB(b, h) + boff + n * 2048 + k * 1024); } while (0)
#define PG8_MMA(ai, bj, At, Bt) do { __builtin_amdgcn_s_setprio(1); _Pragma("unroll") for (int m = 0; m < 4; ++m) _Pragma("unroll") for (int n = 0; n < 2; ++n) _Pragma("unroll") for (int k = 0; k < 2; ++k) \
        acc[ai][bj][m][n] = __builtin_amdgcn_mfma_f32_16x16x32_bf16(Bt[n][k], At[m][k], acc[ai][bj][m][n], 0, 0, 0); __builtin_amdgcn_s_setprio(0); } while (0)
#define PG8_WAIT_V(n) asm volatile("s_waitcnt vmcnt(" #n ")" ::: "memory")
#define PG8_WAIT_L(n) asm volatile("s_waitcnt lgkmcnt(" #n ")" ::: "memory")
#define PG8_BAR __builtin_amdgcn_s_barrier()
#define PG8_SCHED __builtin_amdgcn_sched_barrier(0)
#define PG8_UA(u) ((const char*)((u).seg ? g.A1 : g.A0) + (size_t)(u).pm * tstep)
#define PG8_UB(u) ((const char*)((u).seg ? g.B1 : g.B0) + (size_t)(u).pn * tstep)
    Unit cur, nxt; int ui = 0;
    if (!S.next(0, cur)) return;
    Acc acc;
#pragma unroll
    for (int a = 0; a < 2; ++a)
#pragma unroll
        for (int b = 0; b < 2; ++b)
#pragma unroll
            for (int m = 0; m < 4; ++m)
#pragma unroll
                for (int n = 0; n < 2; ++n) acc[a][b][m][n] = (f32x4){0.f, 0.f, 0.f, 0.f};
    bf16x8 At[4][2], B0[2][2], B1[2][2];
    const char* cA = PG8_UA(cur); const char* cB = PG8_UB(cur);
    PG8_STAGE(PG8_SB(0, 0), cB, voffB); PG8_STAGE(PG8_SB(0, 1), cB + hstep, voffB); PG8_STAGE(PG8_SA(0, 0), cA, voffA); PG8_STAGE(PG8_SA(0, 1), cA + hstep, voffA);
    if (wr == 1) PG8_BAR;
    PG8_WAIT_V(2); PG8_BAR;
    PG8_STAGE(PG8_SB(1, 0), cB + kstep, voffB); PG8_STAGE(PG8_SA(1, 0), cA + kstep, voffA); PG8_STAGE(PG8_SB(1, 1), cB + hstep + kstep, voffB);
    PG8_WAIT_V(6); PG8_BAR;
    for (;;) {
        const bool has_next = S.next(ui + 1, nxt);
        const char* nA = has_next ? PG8_UA(nxt) : cA; const char* nB = has_next ? PG8_UB(nxt) : cB;
        for (int t = 0; t < nt; t += 2) {
            const bool last = (t == nt - 2);
            const char* a1 = cA + (size_t)(t + 1) * kstep;
            const char* a2 = last ? nA : cA + (size_t)(t + 2) * kstep; const char* b2 = last ? nB : cB + (size_t)(t + 2) * kstep;
            const char* a3 = a2 + kstep; const char* b3 = b2 + kstep;
            PG8_LDB(B0, 0, 0); PG8_LDB(B1, 0, 1); PG8_SCHED; PG8_LDA(At, 0, 0); PG8_STAGE(PG8_SA(1, 1), a1 + hstep, voffA);
            PG8_WAIT_V(8); PG8_WAIT_L(0); PG8_BAR; PG8_MMA(0, 0, At, B0); PG8_MMA(0, 1, At, B1); PG8_BAR; PG8_SCHED;
            PG8_LDA(At, 0, 1); PG8_STAGE(PG8_SB(0, 0), b2, voffB); PG8_STAGE(PG8_SB(0, 1), b2 + hstep, voffB); PG8_STAGE(PG8_SA(0, 0), a2, voffA);
            PG8_WAIT_V(8); PG8_WAIT_L(0); PG8_BAR; PG8_MMA(1, 0, At, B0); PG8_MMA(1, 1, At, B1); PG8_BAR; PG8_SCHED;
            PG8_LDB(B0, 1, 0); PG8_LDB(B1, 1, 1); PG8_SCHED; PG8_LDA(At, 1, 0); PG8_STAGE(PG8_SA(0, 1), a2 + hstep, voffA);
            PG8_WAIT_V(8); PG8_WAIT_L(0); PG8_BAR; PG8_MMA(0, 0, At, B0); PG8_MMA(0, 1, At, B1); PG8_BAR; PG8_SCHED;
            PG8_LDA(At, 1, 1); PG8_STAGE(PG8_SB(1, 0), b3, voffB); PG8_STAGE(PG8_SB(1, 1), b3 + hstep, voffB); PG8_STAGE(PG8_SA(1, 0), a3, voffA);
            PG8_WAIT_V(8); PG8_WAIT_L(0); PG8_BAR; PG8_MMA(1, 0, At, B0); PG8_MMA(1, 1, At, B1); PG8_BAR; PG8_SCHED;
        }
        if constexpr (ALIGN_EPI) { if (wr == 0) PG8_BAR; }
        E(acc, cur, wr, wc, fr, fq);
        if (!has_next) break;
        if (!(Epi::KEEP_ACC && cur.seg == 0)) {
#pragma unroll
        for (int a = 0; a < 2; ++a)
#pragma unroll
            for (int b = 0; b < 2; ++b)
#pragma unroll
                for (int m = 0; m < 4; ++m)
#pragma unroll
                    for (int n = 0; n < 2; ++n) acc[a][b][m][n] = (f32x4){0.f, 0.f, 0.f, 0.f};
        }
        cur = nxt; cA = nA; cB = nB; ++ui;
        if constexpr (ALIGN_EPI) { if (wr == 1) PG8_BAR; }
    }
    PG8_WAIT_V(0);
    if constexpr (!ALIGN_EPI) { if (wr == 0) PG8_BAR; }
    PG8_BAR;
#undef PG8_SA
#undef PG8_SB
#undef PG8_STAGE
#undef PG8_LDA
#undef PG8_LDB
#undef PG8_MMA
#undef PG8_WAIT_V
#undef PG8_WAIT_L
#undef PG8_BAR
#undef PG8_SCHED
#undef PG8_UA
#undef PG8_UB
}
}

constexpr int NWAVES = 8, NTHR = NWAVES * 64;
constexpr int DM = 2048, BATCH = 8, SEQ = 2048, M = BATCH * SEQ;
constexpr int INW = 8704, ZAW = 4608, ZGW = 4096;
constexpr int NMEM = 256, MROWS = BATCH * NMEM;
constexpr int DFF = 5632;
constexpr float RMS_EPS = 1e-6f;

constexpr size_t MiB = 1u << 20;
constexpr size_t WS_SSQ = 474 * MiB;
constexpr size_t WS_ROPE = 1 * MiB;
constexpr size_t WS_WIN = 2 * MiB;
constexpr size_t WS_WA = 36 * MiB;
constexpr size_t WS_WC = 40 * MiB;
constexpr size_t WS_WO = 44 * MiB;
constexpr size_t WS_WCQ = 52 * MiB;
constexpr size_t WS_WCKV = 54 * MiB;
constexpr size_t WS_WCO = 58 * MiB;
constexpr size_t WS_WGU = 60 * MiB;
constexpr size_t WS_WDN = 104 * MiB;
constexpr size_t WS_MEMN = 126 * MiB;
constexpr size_t WS_MEMKV = 134 * MiB;
constexpr size_t WS_ZA = 138 * MiB;
constexpr size_t WS_ZG = 282 * MiB;
constexpr size_t WS_AO = 410 * MiB;
constexpr size_t WS_CV = 442 * MiB;
constexpr size_t WS_END = 476 * MiB;
constexpr size_t WS_MG = WS_ZA;
constexpr size_t WS_X1B = WS_AO;
constexpr size_t WS_QC = WS_ZG;
constexpr size_t WS_CO = WS_ZG + 16 * MiB;
constexpr size_t WS_X2B = WS_ZA;
constexpr size_t WS_ACT = WS_ZA + 64 * MiB;
static_assert(WS_ACT + (size_t)M * DFF * 2 <= WS_AO, "ACT overlay");

constexpr int LDS_BYTES = 147456;

#define GAS __attribute__((address_space(1)))
#define LAS __attribute__((address_space(3)))
typedef unsigned short bf16;
typedef unsigned v4u __attribute__((ext_vector_type(4)));
typedef float f32x4 __attribute__((ext_vector_type(4)));
#define LDS_WAIT() asm volatile("s_waitcnt lgkmcnt(0)" ::: "memory")
__device__ __forceinline__ unsigned f2bf(float f) { unsigned u = __builtin_bit_cast(unsigned, f); return (u + 0x7fffu + ((u >> 16) & 1u)) >> 16; }
__device__ __forceinline__ unsigned pk2(float lo, float hi) { return f2bf(lo) | (f2bf(hi) << 16); }
__device__ __forceinline__ float bflo(unsigned w) { return __uint_as_float(w << 16); }
__device__ __forceinline__ float bfhi(unsigned w) { return __uint_as_float(w & 0xffff0000u); }
__device__ __forceinline__ float wave_sum(float v) {
#pragma unroll
    for (int o = 1; o < 64; o <<= 1) v += __shfl_xor(v, o);
    return v;
}
__device__ __forceinline__ float wave_max(float v) {
#pragma unroll
    for (int o = 1; o < 64; o <<= 1) v = fmaxf(v, __shfl_xor(v, o));
    return v;
}

__device__ __forceinline__ int dest_row(int n0, int mode) {
    if (mode == 1) return (n0 >> 7) * 256 + (n0 & 127);
    if (mode == 2) return (n0 >> 7) * 256 + 128 + (n0 & 127);
    if (mode == 3 && n0 < 1280) return (n0 >> 8) * 256 + ((n0 >> 6) & 1) * 128 + ((n0 >> 7) & 1) * 64 + (n0 & 63);
    return n0;
}
__device__ __forceinline__ void p0_transpose_item(const float* W, int K, int N, bf16* WT, int mode, const float* gk, LAS float* scr, int item, int lane) {
    const int nblk = N / 32, kb = item / nblk, nb = item % nblk, k0 = 64 * kb, n0 = 32 * nb;
    const int kr = lane >> 3, nq = lane & 7;
    f32x4 v[8];
#pragma unroll
    for (int i = 0; i < 8; ++i) v[i] = *(const f32x4*)(W + (size_t)(k0 + 8 * i + kr) * N + n0 + 4 * nq);
#pragma unroll
    for (int i = 0; i < 8; ++i) { const float g = gk ? gk[k0 + 8 * i + kr] : 1.0f; LAS float* p = scr + (8 * i + kr) * 33 + 4 * nq;
        p[0] = v[i].x * g; p[1] = v[i].y * g; p[2] = v[i].z * g; p[3] = v[i].w * g; }
    LDS_WAIT(); asm volatile("" ::: "memory");
    const int c = lane & 7, r0 = dest_row(n0, mode);
#pragma unroll
    for (int j = 0; j < 4; ++j) { const int n = (lane >> 3) + 8 * j; const LAS float* s = scr + (8 * c) * 33 + n;
        v4u o; o.x = pk2(s[0 * 33], s[1 * 33]); o.y = pk2(s[2 * 33], s[3 * 33]); o.z = pk2(s[4 * 33], s[5 * 33]); o.w = pk2(s[6 * 33], s[7 * 33]);
        *(v4u*)(WT + (size_t)(r0 + n) * K + k0 + 8 * c) = o; }
    LDS_WAIT(); asm volatile("" ::: "memory");
}
__device__ __forceinline__ void rms_row_to_bf16(const float* xrow, const float* g, bf16* orow, int lane) {
    const f32x4* xr = (const f32x4*)xrow + lane; const f32x4* gr = (const f32x4*)g + lane;
    f32x4 v[8]; float s = 0.f;
#pragma unroll
    for (int j = 0; j < 8; ++j) { v[j] = xr[64 * j]; s += (v[j].x * v[j].x + v[j].y * v[j].y) + (v[j].z * v[j].z + v[j].w * v[j].w); }
    const float rs = 1.0f / sqrtf(wave_sum(s) * (1.0f / DM) + RMS_EPS);
    unsigned long long* o8 = (unsigned long long*)orow + lane;
#pragma unroll
    for (int j = 0; j < 8; ++j) { const f32x4 gg = gr[64 * j];
        o8[64 * j] = (unsigned long long)pk2(v[j].x * rs * gg.x, v[j].y * rs * gg.y) | ((unsigned long long)pk2(v[j].z * rs * gg.z, v[j].w * rs * gg.w) << 32); }
}

typedef float f32x16 __attribute__((ext_vector_type(16)));
typedef short s16x8 __attribute__((ext_vector_type(8)));
typedef short s16x4 __attribute__((ext_vector_type(4)));
constexpr int ATT_KP = 272, ATT_VP = 264, ATT_V_OFF = 128 * ATT_KP, ATT_LDS = ATT_V_OFF + 128 * ATT_VP;
constexpr float LOG2E = 1.4426950408889634f;
template <bool WINDOW>
__device__ __forceinline__ void attn_unit(LAS unsigned char* lds, const bf16* qw, int qpitch, const bf16* kg, const bf16* vg, int kvpitch, int nblk,
                                          int qpos, int kpos, float m_init, float l_init, bf16* ow, int opitch, int tid, int lane) {
    const int r = lane & 31, h = lane >> 5;
    s16x8 qf[8];
#pragma unroll
    for (int kk = 0; kk < 8; ++kk) qf[kk] = *(const s16x8*)(qw + (size_t)r * qpitch + 16 * kk + 8 * h);
    f32x16 o[4];
#pragma unroll
    for (int dt = 0; dt < 4; ++dt)
#pragma unroll
        for (int i = 0; i < 16; ++i) o[dt][i] = 0.f;
    float m = m_init, l = (h == 0) ? l_init : 0.f;
    const int kkey = tid >> 4, kc = tid & 15, vkey = tid & 127, vcg = tid >> 7;
    for (int blk = 0; blk < nblk; ++blk) {
        v4u kreg[4], vreg[4];
#pragma unroll
        for (int it = 0; it < 4; ++it) { kreg[it] = *(const v4u*)(kg + (size_t)(blk * 128 + kkey + 32 * it) * kvpitch + kc * 8); vreg[it] = *(const v4u*)(vg + (size_t)(blk * 128 + vkey) * kvpitch + (vcg * 4 + it) * 8); }
        __syncthreads();
#pragma unroll
        for (int it = 0; it < 4; ++it) { *(LAS v4u*)(lds + (kkey + 32 * it) * ATT_KP + kc * 16) = kreg[it];
            LAS unsigned short* vt = (LAS unsigned short*)(lds + ATT_V_OFF) + (size_t)((vcg * 4 + it) * 8) * (ATT_VP / 2) + vkey;
            const v4u w = vreg[it];
            vt[0 * (ATT_VP / 2)] = (unsigned short)(w.x & 0xffffu); vt[1 * (ATT_VP / 2)] = (unsigned short)(w.x >> 16); vt[2 * (ATT_VP / 2)] = (unsigned short)(w.y & 0xffffu); vt[3 * (ATT_VP / 2)] = (unsigned short)(w.y >> 16);
            vt[4 * (ATT_VP / 2)] = (unsigned short)(w.z & 0xffffu); vt[5 * (ATT_VP / 2)] = (unsigned short)(w.z >> 16); vt[6 * (ATT_VP / 2)] = (unsigned short)(w.w & 0xffffu); vt[7 * (ATT_VP / 2)] = (unsigned short)(w.w >> 16); }
        __syncthreads();
#pragma unroll 1
        for (int hf = 0; hf < 2; ++hf) {
        f32x16 sc[2];
#pragma unroll
        for (int kt = 0; kt < 2; ++kt) {
#pragma unroll
            for (int i = 0; i < 16; ++i) sc[kt][i] = 0.f;
#pragma unroll
            for (int kk = 0; kk < 8; ++kk) { const s16x8 kf = *(const LAS s16x8*)(lds + (64 * hf + 32 * kt + r) * ATT_KP + (16 * kk + 8 * h) * 2); sc[kt] = __builtin_amdgcn_mfma_f32_32x32x16_bf16(kf, qf[kk], sc[kt], 0, 0, 0); }
        }
        float mb = -1e30f;
#pragma unroll
        for (int kt = 0; kt < 2; ++kt)
#pragma unroll
            for (int i = 0; i < 16; ++i) {
                if (WINDOW) { const int d = (kpos + blk * 128 + 64 * hf + 32 * kt + (i & 3) + 8 * (i >> 2) + 4 * h) - (qpos + r); if (d > 128 || d < -128) sc[kt][i] = -1e30f; }
                mb = fmaxf(mb, sc[kt][i]); }
        mb = fmaxf(mb, __shfl_xor(mb, 32));
        const float mn = fmaxf(m, mb), alpha = __builtin_amdgcn_exp2f((m - mn) * LOG2E), mo = mn * LOG2E;
        m = mn; l *= alpha;
#pragma unroll
        for (int dt = 0; dt < 4; ++dt) o[dt] = o[dt] * alpha;
        float ls = 0.f;
#pragma unroll
        for (int kt = 0; kt < 2; ++kt)
#pragma unroll
            for (int i = 0; i < 16; ++i) { const float p = __builtin_amdgcn_exp2f(sc[kt][i] * LOG2E - mo); sc[kt][i] = p; ls += p; }
        l += ls;
#pragma unroll
        for (int kt = 0; kt < 2; ++kt)
#pragma unroll
            for (int st = 0; st < 2; ++st) {
                v4u pw; pw.x = pg8::cvt_pk_bf16(sc[kt][8 * st + 0], sc[kt][8 * st + 1]); pw.y = pg8::cvt_pk_bf16(sc[kt][8 * st + 2], sc[kt][8 * st + 3]);
                pw.z = pg8::cvt_pk_bf16(sc[kt][8 * st + 4], sc[kt][8 * st + 5]); pw.w = pg8::cvt_pk_bf16(sc[kt][8 * st + 6], sc[kt][8 * st + 7]);
                const s16x8 pf = __builtin_bit_cast(s16x8, pw);
#pragma unroll
                for (int dt = 0; dt < 4; ++dt) { const LAS unsigned char* vp = lds + ATT_V_OFF + (32 * dt + r) * ATT_VP + (64 * hf + 32 * kt + 16 * st + 4 * h) * 2;
                    const s16x4 lo = *(const LAS s16x4*)vp, hi = *(const LAS s16x4*)(vp + 16);
                    const s16x8 vf = __builtin_shufflevector(lo, hi, 0, 1, 2, 3, 4, 5, 6, 7);
                    o[dt] = __builtin_amdgcn_mfma_f32_32x32x16_bf16(vf, pf, o[dt], 0, 0, 0); }
            }
        }
    }
    l += __shfl_xor(l, 32);
    const float inv = 1.0f / l;
    bf16* orow = ow + (size_t)r * opitch + 4 * h;
#pragma unroll
    for (int dt = 0; dt < 4; ++dt)
#pragma unroll
        for (int g = 0; g < 4; ++g) { unsigned long long w = (unsigned long long)pg8::cvt_pk_bf16(o[dt][4 * g] * inv, o[dt][4 * g + 1] * inv) | ((unsigned long long)pg8::cvt_pk_bf16(o[dt][4 * g + 2] * inv, o[dt][4 * g + 3] * inv) << 32);
            *(unsigned long long*)(orow + 32 * dt + 8 * g) = w; }
}

struct Args { const float* in[20]; float* out; unsigned char* ws; int ph_lo, ph_hi; };

__global__ void __launch_bounds__(NTHR, 2) mk_fwd(Args args) {
    extern __shared__ __attribute__((aligned(16))) unsigned char lds_raw[];
    LAS unsigned char* lds = (LAS unsigned char*)lds_raw;
    const int tid = threadIdx.x, lane = tid & 63, wave = __builtin_amdgcn_readfirstlane(tid >> 6);
    const int G = gridDim.x, bx = blockIdx.x;
    const int gw = bx * NWAVES + wave, NGW = G * NWAVES;
    unsigned char* ws = args.ws;
    const float* x = args.in[0]; const float* mem = args.in[1]; const float* g_mix = args.in[2]; const float* w_in = args.in[3]; const float* sink = args.in[4];
    const float* conv_w = args.in[5]; const float* b_gate = args.in[6]; const float* w_attn_out = args.in[7]; const float* w_conv_out = args.in[8]; const float* w_o = args.in[9];
    const float* g_cross = args.in[10]; const float* g_mem = args.in[11]; const float* w_cq = args.in[12]; const float* w_ckv = args.in[13]; const float* w_co = args.in[14];
    const float* g_ffn = args.in[15]; const float* w_gate = args.in[16]; const float* w_up = args.in[17]; const float* w_down = args.in[18]; const float* g_final = args.in[19];
    float* out = args.out;
    float* ssq2 = (float*)(ws + WS_SSQ); float* ssq3 = ssq2 + M * 8; float* ssq4 = ssq3 + M * 8;
    PG8_LAS float* xch = (PG8_LAS float*)(lds + pg8::STAGE_BYTES);
    float* cosT = (float*)(ws + WS_ROPE); float* sinT = cosT + SEQ * 64;
    bf16* Wt_in = (bf16*)(ws + WS_WIN); bf16* Wt_a = (bf16*)(ws + WS_WA); bf16* Wt_c = (bf16*)(ws + WS_WC); bf16* Wt_o = (bf16*)(ws + WS_WO);
    bf16* Wt_cq = (bf16*)(ws + WS_WCQ); bf16* Wt_ckv = (bf16*)(ws + WS_WCKV); bf16* Wt_co = (bf16*)(ws + WS_WCO); bf16* Wt_gu = (bf16*)(ws + WS_WGU); bf16* Wt_dn = (bf16*)(ws + WS_WDN);
    bf16* MEMN = (bf16*)(ws + WS_MEMN); bf16* MEMKV = (bf16*)(ws + WS_MEMKV);
    bf16* ZA = (bf16*)(ws + WS_ZA); bf16* ZG = (bf16*)(ws + WS_ZG); bf16* AO = (bf16*)(ws + WS_AO); bf16* CV = (bf16*)(ws + WS_CV);
    bf16* MG = (bf16*)(ws + WS_MG); bf16* X1B = (bf16*)(ws + WS_X1B); bf16* QC = (bf16*)(ws + WS_QC); bf16* CO = (bf16*)(ws + WS_CO);
    bf16* X2B = (bf16*)(ws + WS_X2B); bf16* ACT = (bf16*)(ws + WS_ACT);
    bf16* H = (bf16*)out;
    cg::grid_group grid = cg::this_grid();
    const int lo = args.ph_lo, hi = args.ph_hi;
#define IN(k) (lo <= (k) && (k) < hi)
#define SEAM(k) do { if (IN(k) && IN((k) + 1)) { asm volatile("s_waitcnt vmcnt(0) lgkmcnt(0)" ::: "memory"); __syncthreads(); grid.sync(); } } while (0)

    if (IN(0)) {
        LAS float* scr = (LAS float*)(lds + wave * 16384);
        constexpr int I_IN = (DM / 64) * (INW / 32), I_A = (1024 / 64) * (DM / 32), I_O = (DM / 64) * (DM / 32), I_CQ = (DM / 64) * (512 / 32), I_CKV = (DM / 64) * (1024 / 32),
                      I_CO = (512 / 64) * (DM / 32), I_G = (DM / 64) * (DFF / 32), I_D = (DFF / 64) * (DM / 32);
        constexpr int NITEMS = I_IN + 2 * I_A + I_O + I_CQ + I_CKV + I_CO + 2 * I_G + I_D;
        for (int it = gw; it < NITEMS; it += NGW) {
            int r = it;
            if (r < I_IN) { p0_transpose_item(w_in, DM, INW, Wt_in, 3, nullptr, scr, r, lane); continue; } r -= I_IN;
            if (r < I_A) { p0_transpose_item(w_attn_out, 1024, DM, Wt_a, 0, nullptr, scr, r, lane); continue; } r -= I_A;
            if (r < I_A) { p0_transpose_item(w_conv_out, 1024, DM, Wt_c, 0, nullptr, scr, r, lane); continue; } r -= I_A;
            if (r < I_O) { p0_transpose_item(w_o, DM, DM, Wt_o, 0, nullptr, scr, r, lane); continue; } r -= I_O;
            if (r < I_CQ) { p0_transpose_item(w_cq, DM, 512, Wt_cq, 0, g_cross, scr, r, lane); continue; } r -= I_CQ;
            if (r < I_CKV) { p0_transpose_item(w_ckv, DM, 1024, Wt_ckv, 0, nullptr, scr, r, lane); continue; } r -= I_CKV;
            if (r < I_CO) { p0_transpose_item(w_co, 512, DM, Wt_co, 0, nullptr, scr, r, lane); continue; } r -= I_CO;
            if (r < I_G) { p0_transpose_item(w_gate, DM, DFF, Wt_gu, 1, g_ffn, scr, r, lane); continue; } r -= I_G;
            if (r < I_G) { p0_transpose_item(w_up, DM, DFF, Wt_gu, 2, g_ffn, scr, r, lane); continue; } r -= I_G;
            p0_transpose_item(w_down, DFF, DM, Wt_dn, 0, nullptr, scr, r, lane);
        }
        for (int m = gw; m < M; m += NGW) rms_row_to_bf16(x + (size_t)m * DM, g_mix, H + (size_t)m * DM, lane);
        for (int m = gw; m < MROWS; m += NGW) rms_row_to_bf16(mem + (size_t)m * DM, g_mem, MEMN + (size_t)m * DM, lane);
        for (int i = bx * NTHR + tid; i < SEQ * 64; i += G * NTHR) { const int pos = i >> 6, j = i & 63;
            const float inv = exp2f(-(float)j * (13.287712379549449f / 64.0f)); const float ang = (float)pos * inv;
            cosT[i] = cosf(ang); sinT[i] = sinf(ang); }
    }
    SEAM(0);

    if (IN(1)) {
        { pg8::Gemm g{H, Wt_in, nullptr, nullptr, M, INW, DM}; pg8::StaticOrder S; S.init(M, INW, G, bx);
          pg8::EpiIn E{ZA, ZG, cosT, sinT, b_gate, 0.08838834764831845f};
          pg8::gemm_phase<pg8::EpiIn, pg8::StaticOrder>(lds, g, S, E); }
        { pg8::Gemm g{MEMN, Wt_ckv, nullptr, nullptr, MROWS, 1024, DM}; pg8::StaticOrder S; S.init(MROWS, 1024, G, (bx + G / 2) % G);
          pg8::EpiBf16 E{MEMKV, 1024};
          pg8::gemm_phase<pg8::EpiBf16, pg8::StaticOrder>(lds, g, S, E); }
    }
    SEAM(1);

    if (IN(2)) {
        for (int it = 2 * bx; it < 512; it += 2 * G)
            for (int hp = 0; hp < 2; ++hp) { const int kvh = it >> 1 & 1, nb = (it >> 2) & 15, b = it >> 6;
                const int hq = kvh * 4 + hp * 2 + (wave >> 2), t0 = b * SEQ + nb * 128 + (wave & 3) * 32;
                const int kb0 = nb > 0 ? nb - 1 : 0, kb1 = nb < 15 ? nb + 1 : 15; const size_t kt0 = (size_t)b * SEQ + kb0 * 128;
                attn_unit<true>(lds, ZA + (size_t)t0 * ZAW + hq * 128, ZAW, ZA + kt0 * ZAW + 1024 + kvh * 128, ZA + kt0 * ZAW + 1280 + kvh * 128, ZAW, kb1 - kb0 + 1,
                                nb * 128 + (wave & 3) * 32, kb0 * 128, sink[hq], 1.0f, AO + (size_t)t0 * 1024 + hq * 128, 1024, tid, lane); }
        __syncthreads();
        for (int idx = bx * NTHR + tid; idx < (M / 16) * 128; idx += G * NTHR) { const int run = idx >> 7, c8 = (idx & 127) * 8, t0 = run * 16, s0 = t0 & (SEQ - 1);
            const f32x4 w0a = *(const f32x4*)(conv_w + c8), w0b = *(const f32x4*)(conv_w + c8 + 4), w1a = *(const f32x4*)(conv_w + 1024 + c8), w1b = *(const f32x4*)(conv_w + 1024 + c8 + 4),
                        w2a = *(const f32x4*)(conv_w + 2048 + c8), w2b = *(const f32x4*)(conv_w + 2048 + c8 + 4);
            const bf16* zr = ZA + (size_t)t0 * ZAW + c8;
            f32x4 pa = {0.f, 0.f, 0.f, 0.f}, pb = pa, ca, cb, ta, tb;
            if (s0 > 0) { pg8::unpack8(*(const v4u*)(zr - ZAW + 1536), pa, pb); pg8::unpack8(*(const v4u*)(zr - ZAW + 3584), ta, tb); pa = pa * ta; pb = pb * tb; }
            pg8::unpack8(*(const v4u*)(zr + 1536), ca, cb); pg8::unpack8(*(const v4u*)(zr + 3584), ta, tb); ca = ca * ta; cb = cb * tb;
#pragma unroll
            for (int i = 0; i < 16; ++i) { f32x4 na = {0.f, 0.f, 0.f, 0.f}, nbv = na, ga, gb;
                if (i < 15 || s0 + 16 < SEQ) { pg8::unpack8(*(const v4u*)(zr + (size_t)(i + 1) * ZAW + 1536), na, nbv); pg8::unpack8(*(const v4u*)(zr + (size_t)(i + 1) * ZAW + 3584), ta, tb); na = na * ta; nbv = nbv * tb; }
                pg8::unpack8(*(const v4u*)(zr + (size_t)i * ZAW + 2560), ga, gb);
                *(v4u*)(CV + (size_t)(t0 + i) * 1024 + c8) = pg8::pack8(ga * (w0a * pa + w1a * ca + w2a * na), gb * (w0b * pb + w1b * cb + w2b * nbv));
                pa = ca; pb = cb; ca = na; cb = nbv; }
        }
    }
    SEAM(2);

    if (IN(3)) {
        pg8::Gemm g{AO, Wt_a, CV, Wt_c, M, DM, 1024}; pg8::StaticOrder S; S.init(M, DM, G, bx, 2);
        pg8::EpiMerge E{ZG, MG};
        pg8::gemm_phase<pg8::EpiMerge, pg8::StaticOrder>(lds, g, S, E);
    }
    SEAM(3);

    if (IN(4)) {
        pg8::Gemm g{MG, Wt_o, nullptr, nullptr, M, DM, DM}; pg8::StaticOrder S; S.init(M, DM, G, bx);
        pg8::EpiRes E{x, out, X1B, ssq2, xch};
        pg8::gemm_phase<pg8::EpiRes, pg8::StaticOrder>(lds, g, S, E);
    }
    SEAM(4);

    if (IN(5)) {
        pg8::Gemm g{X1B, Wt_cq, nullptr, nullptr, M, 512, DM}; pg8::StaticOrder S; S.init(M, 512, G, bx);
        pg8::EpiRowScale E{QC, 512, ssq2, 0.08838834764831845f};
        pg8::gemm_phase<pg8::EpiRowScale, pg8::StaticOrder>(lds, g, S, E);
    }
    SEAM(5);

    if (IN(6)) {
        for (int it = bx; it < 256; it += G) { const int rb = it & 7, hh = (it >> 3) & 3, b = it >> 5; const int t0 = b * SEQ + rb * 256 + wave * 32;
            attn_unit<false>(lds, QC + (size_t)t0 * 512 + hh * 128, 512, MEMKV + (size_t)(b * NMEM) * 1024 + hh * 128, MEMKV + (size_t)(b * NMEM) * 1024 + 512 + hh * 128, 1024, 2,
                             0, 0, -1e30f, 0.0f, CO + (size_t)t0 * 512 + hh * 128, 512, tid, lane); }
    }
    SEAM(6);

    if (IN(7)) {
        pg8::Gemm g{CO, Wt_co, nullptr, nullptr, M, DM, 512}; pg8::StaticOrder S; S.init(M, DM, G, bx);
        pg8::EpiRes E{out, out, X2B, ssq3, xch};
        pg8::gemm_phase<pg8::EpiRes, pg8::StaticOrder>(lds, g, S, E);
    }
    SEAM(7);

    if (IN(8)) {
        pg8::Gemm g{X2B, Wt_gu, nullptr, nullptr, M, 2 * DFF, DM}; pg8::StaticOrder S; S.init(M, 2 * DFF, G, bx);
        pg8::EpiSwiGLU E{ACT, ssq3};
        pg8::gemm_phase<pg8::EpiSwiGLU, pg8::StaticOrder>(lds, g, S, E);
    }
    SEAM(8);

    if (IN(9)) {
        pg8::Gemm g{ACT, Wt_dn, nullptr, nullptr, M, DM, DFF}; pg8::StaticOrder S; S.init(M, DM, G, bx);
        pg8::EpiRes E{out, out, nullptr, ssq4, xch};
        pg8::gemm_phase<pg8::EpiRes, pg8::StaticOrder>(lds, g, S, E);
    }
    SEAM(9);

    if (IN(10)) {
        for (int m = gw; m < M; m += NGW) { f32x4* xr = (f32x4*)(out + (size_t)m * DM) + lane; const f32x4* gr = (const f32x4*)g_final + lane;
            const float rs = pg8::row_rs(ssq4, m);
#pragma unroll
            for (int j = 0; j < 8; ++j) xr[64 * j] = xr[64 * j] * rs * gr[64 * j]; }
    }

#if defined(MK_DUMP_OFF)
    if (hi == MK_CUT && MK_CUT < 11) {
        asm volatile("s_waitcnt vmcnt(0) lgkmcnt(0)" ::: "memory"); __syncthreads(); grid.sync();
        const bf16* src = (const bf16*)(ws + (size_t)(MK_DUMP_OFF));
        for (size_t i = (size_t)bx * NTHR + tid; i < (size_t)M * 2048; i += (size_t)G * NTHR) { const size_t r = i >> 11, c = i & 2047; out[i] = __uint_as_float((unsigned)src[r * (MK_DUMP_LD) + (c % (MK_DUMP_W)) + (c / (MK_DUMP_W)) * (size_t)(MK_DUMP_OFF2)] << 16); }
    }
#endif
#undef IN
#undef SEAM
}

extern "C" void kernel_launch(void* const* d_in, const int* in_sizes, int n_in, void* d_out, int out_size, void* d_ws, size_t ws_size, hipStream_t stream) {
    static int grid = 0;
    if (grid == 0) {
        if (n_in != 20 || in_sizes[0] != M * DM || out_size != M * DM || ws_size < WS_END) { fprintf(stderr, "kernel_launch: unexpected shapes / workspace (n_in %d, ws %zu)\n", n_in, ws_size); grid = -1; return; }
        int dev = 0, cus = 0, per_cu = 0;
        if (hipGetDevice(&dev) != hipSuccess || hipDeviceGetAttribute(&cus, hipDeviceAttributeMultiprocessorCount, dev) != hipSuccess) { grid = -1; return; }
        if (hipFuncSetAttribute((const void*)mk_fwd, hipFuncAttributeMaxDynamicSharedMemorySize, LDS_BYTES) != hipSuccess) { fprintf(stderr, "kernel_launch: hipFuncSetAttribute failed\n"); grid = -1; return; }
        if (hipOccupancyMaxActiveBlocksPerMultiprocessor(&per_cu, (const void*)mk_fwd, NTHR, LDS_BYTES) != hipSuccess || per_cu < 1) { fprintf(stderr, "kernel_launch: occupancy query says %d\n", per_cu); (void)hipGetLastError(); grid = -1; return; }
        grid = cus;
    }
    if (grid < 0) return;
    Args a{};
    for (int i = 0; i < 20; ++i) a.in[i] = (const float*)d_in[i];
    a.out = (float*)d_out; a.ws = (unsigned char*)d_ws;
#if MK_N_LAUNCHES == 1
    a.ph_lo = 0; a.ph_hi = MK_CUT;
    void* kargs[] = {&a};
    hipError_t e = hipLaunchCooperativeKernel((const void*)mk_fwd, dim3(grid), dim3(NTHR), kargs, LDS_BYTES, stream);
    if (e != hipSuccess) fprintf(stderr, "kernel_launch: cooperative launch failed: %s (grid %d)\n", hipGetErrorString(e), grid);
#else
    for (int p = 0; p < 11; ++p) { a.ph_lo = p; a.ph_hi = p + 1; hipLaunchKernelGGL(mk_fwd, dim3(grid), dim3(NTHR), LDS_BYTES, stream, a); }
#endif
}
```

```cpp
#include <hip/hip_runtime.h>
#include <hip/hip_cooperative_groups.h>
#include <cstdio>
#include <cstdint>
namespace cg = cooperative_groups;

#ifndef MK_CUT
#define MK_CUT 11
#endif
#ifndef MK_N_LAUNCHES
#define MK_N_LAUNCHES 1
#endif

namespace pg8 {
#define PG8_LAS __attribute__((address_space(3)))
typedef unsigned short bf16_t;
typedef short bf16x8 __attribute__((ext_vector_type(8)));
typedef float f32x4 __attribute__((ext_vector_type(4)));
typedef unsigned u32x4 __attribute__((ext_vector_type(4)));
constexpr int BM = 256, BK = 64, HALF = 128, HTB = HALF * BK * 2, STAGE_BYTES = 8 * HTB, NXCD = 8, WGM = 8;

__host__ __device__ __forceinline__ int lds_byte(int r, int c) { const int st = (r >> 4) * 2 + (c >> 5), rr = r & 15, cc = c & 31, ob = rr * 64 + cc * 2; return st * 1024 + (ob ^ (((ob >> 9) & 1) << 5)); }
__host__ __device__ __forceinline__ void stage_rc(int b, int& R, int& C) { const int st = b / 1024, sb = b % 1024, swz = sb ^ (((sb >> 9) & 1) << 5); R = (st >> 1) * 16 + swz / 64; C = (st & 1) * 32 + (swz % 64) / 2; }
__host__ __device__ __forceinline__ int perm32(int rho) { const int n = rho >> 4, i = rho & 15; return 8 * (i >> 2) + 4 * n + (i & 3); }

struct Unit { int pm, pn, seg; };
struct Gemm { const bf16_t* A0; const bf16_t* B0; const bf16_t* A1; const bf16_t* B1; int M, N, K; };

struct StaticOrder {
    int nM, nN, nwg, G, c, nseg;
    __device__ void init(int M, int N, int G_, int c_, int nseg_ = 1) { nM = M / BM; nN = N / BM; nwg = nM * nN; G = G_; c = c_; nseg = nseg_; }
    __device__ bool next(int i, Unit& u) const {
        const int j = (nseg == 2) ? (i >> 1) : i; u.seg = (nseg == 2) ? (i & 1) : 0;
        const long L = (long)j * G + c; if (L >= nwg) return false;
        int wgid = (int)L; { const int q = nwg / NXCD, r = nwg % NXCD, xcd = wgid % NXCD, off = wgid / NXCD; wgid = (xcd < r ? xcd * (q + 1) : r * (q + 1) + (xcd - r) * q) + off; }
        const int nig = WGM * nN, gid = wgid / nig, fm = gid * WGM, gsz = (nM - fm) < WGM ? (nM - fm) : WGM;
        u.pm = fm + ((wgid % nig) % gsz); u.pn = (wgid % nig) / gsz; return true;
    }
};

typedef __bf16 bf16x2_t __attribute__((ext_vector_type(2)));
typedef float f32x2_t __attribute__((ext_vector_type(2)));
struct ListOrder {
    int first, count, nN, nseg;
    __device__ bool next(int i, Unit& u) const { const int j = (nseg == 2) ? (i >> 1) : i; u.seg = (nseg == 2) ? (i & 1) : 0; if (j >= count) return false; const int L = first + j; u.pm = L / nN; u.pn = L % nN; return true; }
};
__device__ __forceinline__ unsigned cvt_pk_bf16(float lo, float hi) { const f32x2_t v = {lo, hi}; const bf16x2_t r = __builtin_convertvector(v, bf16x2_t); return __builtin_bit_cast(unsigned, r); }
__device__ __forceinline__ u32x4 pack8(const f32x4 a, const f32x4 b) { u32x4 w; w.x = cvt_pk_bf16(a[0], a[1]); w.y = cvt_pk_bf16(a[2], a[3]); w.z = cvt_pk_bf16(b[0], b[1]); w.w = cvt_pk_bf16(b[2], b[3]); return w; }
__device__ __forceinline__ void unpack8(const u32x4 w, f32x4& a, f32x4& b) {
    a[0] = __uint_as_float(w.x << 16); a[1] = __uint_as_float(w.x & 0xffff0000u); a[2] = __uint_as_float(w.y << 16); a[3] = __uint_as_float(w.y & 0xffff0000u);
    b[0] = __uint_as_float(w.z << 16); b[1] = __uint_as_float(w.z & 0xffff0000u); b[2] = __uint_as_float(w.w << 16); b[3] = __uint_as_float(w.w & 0xffff0000u); }
__device__ __forceinline__ f32x4 sigmoid4(const f32x4 v) { f32x4 o;
#pragma unroll
    for (int i = 0; i < 4; ++i) o[i] = __builtin_amdgcn_rcpf(1.0f + __expf(-v[i]));
    return o; }

typedef f32x4 Acc[2][2][4][2];

struct EpiBf16 {
    static constexpr bool PERM = true, KEEP_ACC = false;
    bf16_t* O; int ldc;
    __device__ __forceinline__ void operator()(Acc& acc, const Unit& u, int wr, int wc, int fr, int fq) const {
        const int row0 = u.pm * BM + wr * 64 + fr, col0 = u.pn * BM + wc * 32 + 8 * fq;
#pragma unroll
        for (int ai = 0; ai < 2; ++ai)
#pragma unroll
            for (int m = 0; m < 4; ++m) { bf16_t* rowp = O + (size_t)(row0 + ai * HALF + m * 16) * ldc + col0;
#pragma unroll
                for (int bj = 0; bj < 2; ++bj) *(u32x4*)(rowp + bj * HALF) = pack8(acc[ai][bj][m][0], acc[ai][bj][m][1]); }
    }
};
struct EpiIn {
    static constexpr bool PERM = true, KEEP_ACC = false;
    bf16_t* ZA; bf16_t* ZG; const float* cosT; const float* sinT; const float* bgate; float qscale; const float* rs1;
    __device__ __forceinline__ void operator()(Acc& acc, const Unit& u, int wr, int wc, int fr, int fq) const {
        const int row0 = u.pm * BM + wr * 64 + fr;
#pragma unroll
        for (int ai = 0; ai < 2; ++ai)
#pragma unroll
            for (int m = 0; m < 4; ++m) { const float rs = rs1[row0 + ai * HALF + m * 16];
#pragma unroll
                for (int bj = 0; bj < 2; ++bj) { acc[ai][bj][m][0] = acc[ai][bj][m][0] * rs; acc[ai][bj][m][1] = acc[ai][bj][m][1] * rs; } }
        if (u.pn < 5) {
            const int p = wc * 32 + 8 * fq, hb = p >> 6, j0 = p & 63, c1 = u.pn * 256 + hb * 128 + j0;
            const float sc = u.pn < 4 ? qscale : 1.0f;
#pragma unroll
            for (int ai = 0; ai < 2; ++ai)
#pragma unroll
                for (int m = 0; m < 4; ++m) { const int row = row0 + ai * HALF + m * 16, pos = row & 2047;
                    const f32x4 ca = *(const f32x4*)(cosT + pos * 64 + j0), cb = *(const f32x4*)(cosT + pos * 64 + j0 + 4);
                    const f32x4 sa = *(const f32x4*)(sinT + pos * 64 + j0), sb = *(const f32x4*)(sinT + pos * 64 + j0 + 4);
                    const f32x4 t1a = acc[ai][0][m][0], t1b = acc[ai][0][m][1], t2a = acc[ai][1][m][0], t2b = acc[ai][1][m][1];
                    const f32x4 o1a = (t1a * ca - t2a * sa) * sc, o1b = (t1b * cb - t2b * sb) * sc, o2a = (t2a * ca + t1a * sa) * sc, o2b = (t2b * cb + t1b * sb) * sc;
                    bf16_t* rp = ZA + (size_t)row * 4608 + c1;
                    *(u32x4*)rp = pack8(o1a, o1b); *(u32x4*)(rp + 64) = pack8(o2a, o2b); }
        } else if (u.pn < 18) {
            const int col0 = u.pn * BM + wc * 32 + 8 * fq;
#pragma unroll
            for (int ai = 0; ai < 2; ++ai)
#pragma unroll
                for (int m = 0; m < 4; ++m) { bf16_t* rowp = ZA + (size_t)(row0 + ai * HALF + m * 16) * 4608 + col0;
#pragma unroll
                    for (int bj = 0; bj < 2; ++bj) *(u32x4*)(rowp + bj * HALF) = pack8(acc[ai][bj][m][0], acc[ai][bj][m][1]); }
        } else {
            const int col0 = (u.pn - 18) * BM + wc * 32 + 8 * fq;
#pragma unroll
            for (int bj = 0; bj < 2; ++bj) { const f32x4 b0 = *(const f32x4*)(bgate + col0 + bj * HALF), b1 = *(const f32x4*)(bgate + col0 + bj * HALF + 4);
#pragma unroll
                for (int ai = 0; ai < 2; ++ai)
#pragma unroll
                    for (int m = 0; m < 4; ++m) { bf16_t* rowp = ZG + (size_t)(row0 + ai * HALF + m * 16) * 4096 + col0 + bj * HALF;
                        *(u32x4*)rowp = pack8(sigmoid4(acc[ai][bj][m][0] + b0), sigmoid4(acc[ai][bj][m][1] + b1)); } }
        }
    }
};
struct EpiAcc2 {
    static constexpr bool PERM = true, KEEP_ACC = true;
    bf16_t* O; int ldc;
    __device__ __forceinline__ void operator()(Acc& acc, const Unit& u, int wr, int wc, int fr, int fq) const {
        if (u.seg == 0) return;
        const int row0 = u.pm * BM + wr * 64 + fr, col0 = u.pn * BM + wc * 32 + 8 * fq;
#pragma unroll
        for (int ai = 0; ai < 2; ++ai)
#pragma unroll
            for (int m = 0; m < 4; ++m) { bf16_t* rowp = O + (size_t)(row0 + ai * HALF + m * 16) * ldc + col0;
#pragma unroll
                for (int bj = 0; bj < 2; ++bj) *(u32x4*)(rowp + bj * HALF) = pack8(acc[ai][bj][m][0], acc[ai][bj][m][1]); }
    }
};
struct EpiMerge {
    static constexpr bool PERM = true, KEEP_ACC = true;
    const bf16_t* ZG; bf16_t* O;
    __device__ __forceinline__ void operator()(Acc& acc, const Unit& u, int wr, int wc, int fr, int fq) const {
        const int row0 = u.pm * BM + wr * 64 + fr, col0 = u.pn * BM + wc * 32 + 8 * fq;
#pragma unroll
        for (int ai = 0; ai < 2; ++ai)
#pragma unroll
            for (int m = 0; m < 4; ++m) { const int row = row0 + ai * HALF + m * 16;
#pragma unroll
                for (int bj = 0; bj < 2; ++bj) { const bf16_t* gp = ZG + (size_t)row * 4096 + col0 + bj * HALF;
                    f32x4 c0, c1; unpack8(*(const u32x4*)(gp + 2048), c0, c1);
                    if (u.seg == 0) { f32x4 a0, a1; unpack8(*(const u32x4*)gp, a0, a1);
#pragma unroll
                        for (int i = 0; i < 4; ++i) { acc[ai][bj][m][0][i] *= a0[i] * __builtin_amdgcn_rcpf(c0[i]); acc[ai][bj][m][1][i] *= a1[i] * __builtin_amdgcn_rcpf(c1[i]); }
                    } else { *(u32x4*)(O + (size_t)row * 2048 + col0 + bj * HALF) = pack8(acc[ai][bj][m][0] * c0, acc[ai][bj][m][1] * c1); } } }
    }
};
struct EpiRes {
    static constexpr bool PERM = true, KEEP_ACC = false;
    const float* base; float* out; bf16_t* outb; float* part; PG8_LAS float* xch;
    __device__ __forceinline__ void operator()(Acc& acc, const Unit& u, int wr, int wc, int fr, int fq) const {
        const int row0 = u.pm * BM + wr * 64 + fr, col0 = u.pn * BM + wc * 32 + 8 * fq;
#pragma unroll
        for (int ai = 0; ai < 2; ++ai)
#pragma unroll
            for (int m = 0; m < 4; ++m) { const int row = row0 + ai * HALF + m * 16; float ss = 0.f;
#pragma unroll
                for (int bj = 0; bj < 2; ++bj) { const size_t off = (size_t)row * 2048 + col0 + bj * HALF;
                    const f32x4 o0 = *(const f32x4*)(base + off) + acc[ai][bj][m][0], o1 = *(const f32x4*)(base + off + 4) + acc[ai][bj][m][1];
                    *(f32x4*)(out + off) = o0; *(f32x4*)(out + off + 4) = o1;
                    if (outb) *(u32x4*)(outb + off) = pack8(o0, o1);
                    ss += (o0[0] * o0[0] + o0[1] * o0[1]) + (o0[2] * o0[2] + o0[3] * o0[3]) + (o1[0] * o1[0] + o1[1] * o1[1]) + (o1[2] * o1[2] + o1[3] * o1[3]); }
                ss += __shfl_xor(ss, 16); ss += __shfl_xor(ss, 32);
                if (fq == 0) xch[(ai * HALF + wr * 64 + m * 16 + fr) * 4 + wc] = ss; }
        asm volatile("s_waitcnt lgkmcnt(0)" ::: "memory"); __builtin_amdgcn_s_barrier(); asm volatile("" ::: "memory");
        { const int t = threadIdx.x; if (t < 256) { const f32x4 v = *(const PG8_LAS f32x4*)(xch + t * 4); part[(size_t)(u.pm * BM + t) * 8 + u.pn] = (v[0] + v[1]) + (v[2] + v[3]); } }
        asm volatile("s_waitcnt lgkmcnt(0)" ::: "memory"); __builtin_amdgcn_s_barrier(); asm volatile("" ::: "memory");
    }
};
__device__ __forceinline__ float row_rs(const float* part, int row) { const f32x4 a = *(const f32x4*)(part + (size_t)row * 8), b = *(const f32x4*)(part + (size_t)row * 8 + 4);
    return __builtin_amdgcn_rsqf((((a[0] + a[1]) + (a[2] + a[3])) + ((b[0] + b[1]) + (b[2] + b[3]))) * (1.0f / 2048.0f) + 1e-6f); }
struct EpiRowScale {
    static constexpr bool PERM = true, KEEP_ACC = false;
    bf16_t* O; int ldc; const float* ssq; float scale;
    __device__ __forceinline__ void operator()(Acc& acc, const Unit& u, int wr, int wc, int fr, int fq) const {
        const int row0 = u.pm * BM + wr * 64 + fr, col0 = u.pn * BM + wc * 32 + 8 * fq;
#pragma unroll
        for (int ai = 0; ai < 2; ++ai)
#pragma unroll
            for (int m = 0; m < 4; ++m) { const int row = row0 + ai * HALF + m * 16; const float rs = row_rs(ssq, row) * scale;
                bf16_t* rowp = O + (size_t)row * ldc + col0;
#pragma unroll
                for (int bj = 0; bj < 2; ++bj) *(u32x4*)(rowp + bj * HALF) = pack8(acc[ai][bj][m][0] * rs, acc[ai][bj][m][1] * rs); }
    }
};
struct EpiSwiGLU {
    static constexpr bool PERM = true, KEEP_ACC = false;
    bf16_t* O; const float* ssq;
    __device__ __forceinline__ void operator()(Acc& acc, const Unit& u, int wr, int wc, int fr, int fq) const {
        const int row0 = u.pm * BM + wr * 64 + fr, col0 = u.pn * HALF + wc * 32 + 8 * fq;
#pragma unroll
        for (int ai = 0; ai < 2; ++ai)
#pragma unroll
            for (int m = 0; m < 4; ++m) { const int row = row0 + ai * HALF + m * 16; const float rs = row_rs(ssq, row);
                const f32x4 g0 = acc[ai][0][m][0] * rs, g1 = acc[ai][0][m][1] * rs, u0 = acc[ai][1][m][0] * rs, u1 = acc[ai][1][m][1] * rs;
                *(u32x4*)(O + (size_t)row * 5632 + col0) = pack8(g0 * sigmoid4(g0) * u0, g1 * sigmoid4(g1) * u1); }
    }
};

template <class Epi, class Sched, bool ALIGN_EPI = true>
__device__ __forceinline__ void gemm_phase(PG8_LAS unsigned char* lds, const Gemm g, const Sched& S, const Epi& E) {
    const int tid = threadIdx.x, wid = __builtin_amdgcn_readfirstlane(tid >> 6), lane = tid & 63, wr = wid >> 2, wc = wid & 3, fr = lane & 15, fq = lane >> 4;
    const int K = g.K, nt = K / BK;
    unsigned voffA[2], voffB[2];
#pragma unroll
    for (int i = 0; i < 2; ++i) { int R, C; stage_rc(tid * 16 + i * 8192, R, C); const int Rb = Epi::PERM ? ((R & ~31) + perm32(R & 31)) : R;
        voffA[i] = (unsigned)(R * K + C) * 2u; voffB[i] = (unsigned)(Rb * K + C) * 2u; }
    const size_t kstep = (size_t)(BK * 2);
    const size_t hstep = (size_t)HALF * K * 2;
    const size_t tstep = 2 * hstep;
    const unsigned ldsw = (unsigned)wid * 1024u;
    const int aoff = lds_byte(wr * 64 + fr, fq * 8), boff = lds_byte(wc * 32 + fr, fq * 8);
#define PG8_SA(b, h) (((b) * 2 + (h)) * HTB)
#define PG8_SB(b, h) ((4 + (b) * 2 + (h)) * HTB)
#define PG8_STAGE(bufoff, gbase, voff) do { _Pragma("unroll") for (int _i = 0; _i < 2; ++_i) \
        __builtin_amdgcn_global_load_lds((const unsigned*)((const char*)(gbase) + (voff)[_i]), (PG8_LAS unsigned*)(lds + (bufoff) + ldsw + _i * 8192), 16, 0, 0); } while (0)
#define PG8_LDA(dst, b, h) do { _Pragma("unroll") for (int m = 0; m < 4; ++m) _Pragma("unroll") for (int k = 0; k < 2; ++k) dst[m][k] = *(const PG8_LAS bf16x8*)(lds + PG8_SA(b, h) + aoff + m * 2048 + k * 1024); } while (0)
#define PG8_LDB(dst, b, h) do { _Pragma("unroll") for (int n = 0; n < 2; ++n) _Pragma("unroll") for (int k = 0; k < 2; ++k) dst[n][k] = *(const PG8_LAS bf16x8*)(lds + PG8_SB(b, h) + boff + n * 2048 + k * 1024); } while (0)
#define PG8_MMA(ai, bj, At, Bt) do { __builtin_amdgcn_s_setprio(1); _Pragma("unroll") for (int m = 0; m < 4; ++m) _Pragma("unroll") for (int n = 0; n < 2; ++n) _Pragma("unroll") for (int k = 0; k < 2; ++k) \
        acc[ai][bj][m][n] = __builtin_amdgcn_mfma_f32_16x16x32_bf16(Bt[n][k], At[m][k], acc[ai][bj][m][n], 0, 0, 0); __builtin_amdgcn_s_setprio(0); } while (0)
#define PG8_WAIT_V(n) asm volatile("s_waitcnt vmcnt(" #n ")" ::: "memory")
#define PG8_WAIT_L(n) asm volatile("s_waitcnt lgkmcnt(" #n ")" ::: "memory")
#define PG8_BAR __builtin_amdgcn_s_barrier()
#define PG8_SCHED __builtin_amdgcn_sched_barrier(0)
#define PG8_UA(u) ((const char*)((u).seg ? g.A1 : g.A0) + (size_t)(u).pm * tstep)
#define PG8_UB(u) ((const char*)((u).seg ? g.B1 : g.B0) + (size_t)(u).pn * tstep)
    Unit cur, nxt; int ui = 0;
    if (!S.next(0, cur)) return;
    Acc acc;
#pragma unroll
    for (int a = 0; a < 2; ++a)
#pragma unroll
        for (int b = 0; b < 2; ++b)
#pragma unroll
            for (int m = 0; m < 4; ++m)
#pragma unroll
                for (int n = 0; n < 2; ++n) acc[a][b][m][n] = (f32x4){0.f, 0.f, 0.f, 0.f};
    bf16x8 At[4][2], B0[2][2], B1[2][2];
    const char* cA = PG8_UA(cur); const char* cB = PG8_UB(cur);
    PG8_STAGE(PG8_SB(0, 0), cB, voffB); PG8_STAGE(PG8_SB(0, 1), cB + hstep, voffB); PG8_STAGE(PG8_SA(0, 0), cA, voffA); PG8_STAGE(PG8_SA(0, 1), cA + hstep, voffA);
    if (wr == 1) PG8_BAR;
    PG8_WAIT_V(2); PG8_BAR;
    PG8_STAGE(PG8_SB(1, 0), cB + kstep, voffB); PG8_STAGE(PG8_SA(1, 0), cA + kstep, voffA); PG8_STAGE(PG8_SB(1, 1), cB + hstep + kstep, voffB);
    PG8_WAIT_V(6); PG8_BAR;
    for (;;) {
        const bool has_next = S.next(ui + 1, nxt);
        const char* nA = has_next ? PG8_UA(nxt) : cA; const char* nB = has_next ? PG8_UB(nxt) : cB;
        for (int t = 0; t < nt; t += 2) {
            const bool last = (t == nt - 2);
            const char* a1 = cA + (size_t)(t + 1) * kstep;
            const char* a2 = last ? nA : cA + (size_t)(t + 2) * kstep; const char* b2 = last ? nB : cB + (size_t)(t + 2) * kstep;
            const char* a3 = a2 + kstep; const char* b3 = b2 + kstep;
            PG8_LDB(B0, 0, 0); PG8_LDB(B1, 0, 1); PG8_SCHED; PG8_LDA(At, 0, 0); PG8_STAGE(PG8_SA(1, 1), a1 + hstep, voffA);
            PG8_WAIT_V(8); PG8_WAIT_L(0); PG8_BAR; PG8_MMA(0, 0, At, B0); PG8_MMA(0, 1, At, B1); PG8_BAR; PG8_SCHED;
            PG8_LDA(At, 0, 1); PG8_STAGE(PG8_SB(0, 0), b2, voffB); PG8_STAGE(PG8_SB(0, 1), b2 + hstep, voffB); PG8_STAGE(PG8_SA(0, 0), a2, voffA);
            PG8_WAIT_V(8); PG8_WAIT_L(0); PG8_BAR; PG8_MMA(1, 0, At, B0); PG8_MMA(1, 1, At, B1); PG8_BAR; PG8_SCHED;
            PG8_LDB(B0, 1, 0); PG8_LDB(B1, 1, 1); PG8_SCHED; PG8_LDA(At, 1, 0); PG8_STAGE(PG8_SA(0, 1), a2 + hstep, voffA);
            PG8_WAIT_V(8); PG8_WAIT_L(0); PG8_BAR; PG8_MMA(0, 0, At, B0); PG8_MMA(0, 1, At, B1); PG8_BAR; PG8_SCHED;
            PG8_LDA(At, 1, 1); PG8_STAGE(PG8_SB(1, 0), b3, voffB); PG8_STAGE(PG8_SB(1, 1), b3 + hstep, voffB); PG8_STAGE(PG8_SA(1, 0), a3, voffA);
            PG8_WAIT_V(8); PG8_WAIT_L(0); PG8_BAR; PG8_MMA(1, 0, At, B0); PG8_MMA(1, 1, At, B1); PG8_BAR; PG8_SCHED;
        }
        if constexpr (ALIGN_EPI) { if (wr == 0) PG8_BAR; }
        E(acc, cur, wr, wc, fr, fq);
        if (!has_next) break;
        if (!(Epi::KEEP_ACC && cur.seg == 0)) {
#pragma unroll
        for (int a = 0; a < 2; ++a)
#pragma unroll
            for (int b = 0; b < 2; ++b)
#pragma unroll
                for (int m = 0; m < 4; ++m)
#pragma unroll
                    for (int n = 0; n < 2; ++n) acc[a][b][m][n] = (f32x4){0.f, 0.f, 0.f, 0.f};
        }
        cur = nxt; cA = nA; cB = nB; ++ui;
        if constexpr (ALIGN_EPI) { if (wr == 1) PG8_BAR; }
    }
    PG8_WAIT_V(0);
    if constexpr (!ALIGN_EPI) { if (wr == 0) PG8_BAR; }
    PG8_BAR;
#undef PG8_SA
#undef PG8_SB
#undef PG8_STAGE
#undef PG8_LDA
#undef PG8_LDB
#undef PG8_MMA
#undef PG8_WAIT_V
#undef PG8_WAIT_L
#undef PG8_BAR
#undef PG8_SCHED
#undef PG8_UA
#undef PG8_UB
}
}

constexpr int NWAVES = 8, NTHR = NWAVES * 64;
constexpr int DM = 2048, BATCH = 8, SEQ = 2048, M = BATCH * SEQ;
constexpr int INW = 8704, ZAW = 4608, ZGW = 4096;
constexpr int NMEM = 256, MROWS = BATCH * NMEM;
constexpr int DFF = 5632;
constexpr float RMS_EPS = 1e-6f;

constexpr size_t MiB = 1u << 20;
constexpr size_t WS_RS1 = 0;
constexpr size_t WS_SSQ = 506 * MiB;
constexpr size_t WS_ROPE = 1 * MiB;
constexpr size_t WS_WIN = 2 * MiB;
constexpr size_t WS_WA = 36 * MiB;
constexpr size_t WS_WC = 40 * MiB;
constexpr size_t WS_WO = 44 * MiB;
constexpr size_t WS_WCQ = 52 * MiB;
constexpr size_t WS_WCKV = 54 * MiB;
constexpr size_t WS_WCO = 58 * MiB;
constexpr size_t WS_WGU = 60 * MiB;
constexpr size_t WS_WDN = 104 * MiB;
constexpr size_t WS_MEMN = 126 * MiB;
constexpr size_t WS_MEMKV = 134 * MiB;
constexpr size_t WS_ZA = 138 * MiB;
constexpr size_t WS_ZG = 282 * MiB;
constexpr size_t WS_AO = 2 * MiB;
constexpr size_t WS_CV = 410 * MiB;
constexpr size_t WS_WOB = 410 * MiB;
constexpr size_t WS_XB = 442 * MiB;
constexpr size_t WS_WOQ = 508 * MiB;
constexpr size_t WS_END = 510 * MiB;
constexpr size_t WS_MG = WS_ZA;
constexpr size_t WS_QC = WS_ZG;
constexpr size_t WS_CO = WS_ZG + 16 * MiB;
constexpr size_t WS_X2B = WS_ZA;
constexpr size_t WS_ACT = WS_ZA + 64 * MiB;
static_assert(WS_ACT + (size_t)M * DFF * 2 <= WS_CV, "ACT overlay");

constexpr int LDS_BYTES = 147456;

#define GAS __attribute__((address_space(1)))
#define LAS __attribute__((address_space(3)))
typedef unsigned short bf16;
typedef unsigned v4u __attribute__((ext_vector_type(4)));
typedef float f32x4 __attribute__((ext_vector_type(4)));
#define LDS_WAIT() asm volatile("s_waitcnt lgkmcnt(0)" ::: "memory")
__device__ __forceinline__ unsigned f2bf(float f) { unsigned u = __builtin_bit_cast(unsigned, f); return (u + 0x7fffu + ((u >> 16) & 1u)) >> 16; }
__device__ __forceinline__ unsigned pk2(float lo, float hi) { return f2bf(lo) | (f2bf(hi) << 16); }
__device__ __forceinline__ float bflo(unsigned w) { return __uint_as_float(w << 16); }
__device__ __forceinline__ float bfhi(unsigned w) { return __uint_as_float(w & 0xffff0000u); }
__device__ __forceinline__ float wave_sum(float v) {
#pragma unroll
    for (int o = 1; o < 64; o <<= 1) v += __shfl_xor(v, o);
    return v;
}
__device__ __forceinline__ float wave_max(float v) {
#pragma unroll
    for (int o = 1; o < 64; o <<= 1) v = fmaxf(v, __shfl_xor(v, o));
    return v;
}

__device__ __forceinline__ int dest_row(int n0, int mode) {
    if (mode == 1) return (n0 >> 7) * 256 + (n0 & 127);
    if (mode == 2) return (n0 >> 7) * 256 + 128 + (n0 & 127);
    if (mode == 3 && n0 < 1280) return (n0 >> 8) * 256 + ((n0 >> 6) & 1) * 128 + ((n0 >> 7) & 1) * 64 + (n0 & 63);
    return n0;
}
__device__ __forceinline__ void p0_transpose_item(const float* W, int K, int N, bf16* WT, int mode, const float* gk, LAS float* scr, int item, int lane) {
    const int nblk = N / 32, kb = item / nblk, nb = item % nblk, k0 = 64 * kb, n0 = 32 * nb;
    const int kr = lane >> 3, nq = lane & 7;
    f32x4 v[8];
#pragma unroll
    for (int i = 0; i < 8; ++i) v[i] = *(const f32x4*)(W + (size_t)(k0 + 8 * i + kr) * N + n0 + 4 * nq);
#pragma unroll
    for (int i = 0; i < 8; ++i) { const float g = gk ? gk[k0 + 8 * i + kr] : 1.0f; LAS float* p = scr + (8 * i + kr) * 33 + 4 * nq;
        p[0] = v[i].x * g; p[1] = v[i].y * g; p[2] = v[i].z * g; p[3] = v[i].w * g; }
    LDS_WAIT(); asm volatile("" ::: "memory");
    const int c = lane & 7, r0 = dest_row(n0, mode);
#pragma unroll
    for (int j = 0; j < 4; ++j) { const int n = (lane >> 3) + 8 * j; const LAS float* s = scr + (8 * c) * 33 + n;
        v4u o; o.x = pk2(s[0 * 33], s[1 * 33]); o.y = pk2(s[2 * 33], s[3 * 33]); o.z = pk2(s[4 * 33], s[5 * 33]); o.w = pk2(s[6 * 33], s[7 * 33]);
        *(v4u*)(WT + (size_t)(r0 + n) * K + k0 + 8 * c) = o; }
    LDS_WAIT(); asm volatile("" ::: "memory");
}
__device__ __forceinline__ void row_to_bf16_rs(const float* xrow, bf16* orow, float* rs_out, int lane) {
    const f32x4* xr = (const f32x4*)xrow + lane;
    f32x4 v[8]; float s = 0.f;
#pragma unroll
    for (int j = 0; j < 8; ++j) { v[j] = xr[64 * j]; s += (v[j].x * v[j].x + v[j].y * v[j].y) + (v[j].z * v[j].z + v[j].w * v[j].w); }
    const float rs = 1.0f / sqrtf(wave_sum(s) * (1.0f / DM) + RMS_EPS);
    if (lane == 0) *rs_out = rs;
    unsigned long long* o8 = (unsigned long long*)orow + lane;
#pragma unroll
    for (int j = 0; j < 8; ++j) o8[64 * j] = (unsigned long long)pk2(v[j].x, v[j].y) | ((unsigned long long)pk2(v[j].z, v[j].w) << 32);
}
__device__ __forceinline__ void rms_row_to_bf16(const float* xrow, const float* g, bf16* orow, int lane) {
    const f32x4* xr = (const f32x4*)xrow + lane; const f32x4* gr = (const f32x4*)g + lane;
    f32x4 v[8]; float s = 0.f;
#pragma unroll
    for (int j = 0; j < 8; ++j) { v[j] = xr[64 * j]; s += (v[j].x * v[j].x + v[j].y * v[j].y) + (v[j].z * v[j].z + v[j].w * v[j].w); }
    const float rs = 1.0f / sqrtf(wave_sum(s) * (1.0f / DM) + RMS_EPS);
    unsigned long long* o8 = (unsigned long long*)orow + lane;
#pragma unroll
    for (int j = 0; j < 8; ++j) { const f32x4 gg = gr[64 * j];
        o8[64 * j] = (unsigned long long)pk2(v[j].x * rs * gg.x, v[j].y * rs * gg.y) | ((unsigned long long)pk2(v[j].z * rs * gg.z, v[j].w * rs * gg.w) << 32); }
}

typedef float f32x16 __attribute__((ext_vector_type(16)));
typedef short s16x8 __attribute__((ext_vector_type(8)));
typedef short s16x4 __attribute__((ext_vector_type(4)));
constexpr int ATT_KP = 272, ATT_VP = 264, ATT_V_OFF = 128 * ATT_KP, ATT_LDS = ATT_V_OFF + 128 * ATT_VP;
constexpr float LOG2E = 1.4426950408889634f;
template <bool WINDOW>
__device__ __forceinline__ void attn_unit(LAS unsigned char* lds, const bf16* qw, int qpitch, const bf16* kg, const bf16* vg, int kvpitch, int nblk,
                                          int qpos, int kpos, float m_init, float l_init, float qs, bf16* ow, int opitch, int tid, int lane) {
    const int r = lane & 31, h = lane >> 5;
    s16x8 qf[8];
#pragma unroll
    for (int kk = 0; kk < 8; ++kk) qf[kk] = *(const s16x8*)(qw + (size_t)r * qpitch + 16 * kk + 8 * h);
    f32x16 o[4];
#pragma unroll
    for (int dt = 0; dt < 4; ++dt)
#pragma unroll
        for (int i = 0; i < 16; ++i) o[dt][i] = 0.f;
    float m = m_init, l = (h == 0) ? l_init : 0.f;
    const int kkey = tid >> 4, kc = tid & 15, vkey = tid & 127, vcg = tid >> 7;
    for (int blk = 0; blk < nblk; ++blk) {
        v4u kreg[4], vreg[4];
#pragma unroll
        for (int it = 0; it < 4; ++it) { kreg[it] = *(const v4u*)(kg + (size_t)(blk * 128 + kkey + 32 * it) * kvpitch + kc * 8); vreg[it] = *(const v4u*)(vg + (size_t)(blk * 128 + vkey) * kvpitch + (vcg * 4 + it) * 8); }
        __syncthreads();
#pragma unroll
        for (int it = 0; it < 4; ++it) { *(LAS v4u*)(lds + (kkey + 32 * it) * ATT_KP + kc * 16) = kreg[it];
            LAS unsigned short* vt = (LAS unsigned short*)(lds + ATT_V_OFF) + (size_t)((vcg * 4 + it) * 8) * (ATT_VP / 2) + vkey;
            const v4u w = vreg[it];
            vt[0 * (ATT_VP / 2)] = (unsigned short)(w.x & 0xffffu); vt[1 * (ATT_VP / 2)] = (unsigned short)(w.x >> 16); vt[2 * (ATT_VP / 2)] = (unsigned short)(w.y & 0xffffu); vt[3 * (ATT_VP / 2)] = (unsigned short)(w.y >> 16);
            vt[4 * (ATT_VP / 2)] = (unsigned short)(w.z & 0xffffu); vt[5 * (ATT_VP / 2)] = (unsigned short)(w.z >> 16); vt[6 * (ATT_VP / 2)] = (unsigned short)(w.w & 0xffffu); vt[7 * (ATT_VP / 2)] = (unsigned short)(w.w >> 16); }
        __syncthreads();
#pragma unroll 1
        for (int hf = 0; hf < 2; ++hf) {
        f32x16 sc[2];
#pragma unroll
        for (int kt = 0; kt < 2; ++kt) {
#pragma unroll
            for (int i = 0; i < 16; ++i) sc[kt][i] = 0.f;
#pragma unroll
            for (int kk = 0; kk < 8; ++kk) { const s16x8 kf = *(const LAS s16x8*)(lds + (64 * hf + 32 * kt + r) * ATT_KP + (16 * kk + 8 * h) * 2); sc[kt] = __builtin_amdgcn_mfma_f32_32x32x16_bf16(kf, qf[kk], sc[kt], 0, 0, 0); }
        }
        float mb = -1e30f;
#pragma unroll
        for (int kt = 0; kt < 2; ++kt)
#pragma unroll
            for (int i = 0; i < 16; ++i) {
                if (!WINDOW) sc[kt][i] *= qs;
                if (WINDOW) { const int d = (kpos + blk * 128 + 64 * hf + 32 * kt + (i & 3) + 8 * (i >> 2) + 4 * h) - (qpos + r); if (d > 128 || d < -128) sc[kt][i] = -1e30f; }
                mb = fmaxf(mb, sc[kt][i]); }
        mb = fmaxf(mb, __shfl_xor(mb, 32));
        const float mn = fmaxf(m, mb), alpha = __builtin_amdgcn_exp2f((m - mn) * LOG2E), mo = mn * LOG2E;
        m = mn; l *= alpha;
#pragma unroll
        for (int dt = 0; dt < 4; ++dt) o[dt] = o[dt] * alpha;
        float ls = 0.f;
#pragma unroll
        for (int kt = 0; kt < 2; ++kt)
#pragma unroll
            for (int i = 0; i < 16; ++i) { const float p = __builtin_amdgcn_exp2f(sc[kt][i] * LOG2E - mo); sc[kt][i] = p; ls += p; }
        l += ls;
#pragma unroll
        for (int kt = 0; kt < 2; ++kt)
#pragma unroll
            for (int st = 0; st < 2; ++st) {
                v4u pw; pw.x = pg8::cvt_pk_bf16(sc[kt][8 * st + 0], sc[kt][8 * st + 1]); pw.y = pg8::cvt_pk_bf16(sc[kt][8 * st + 2], sc[kt][8 * st + 3]);
                pw.z = pg8::cvt_pk_bf16(sc[kt][8 * st + 4], sc[kt][8 * st + 5]); pw.w = pg8::cvt_pk_bf16(sc[kt][8 * st + 6], sc[kt][8 * st + 7]);
                const s16x8 pf = __builtin_bit_cast(s16x8, pw);
#pragma unroll
                for (int dt = 0; dt < 4; ++dt) { const LAS unsigned char* vp = lds + ATT_V_OFF + (32 * dt + r) * ATT_VP + (64 * hf + 32 * kt + 16 * st + 4 * h) * 2;
                    const s16x4 lo = *(const LAS s16x4*)vp, hi = *(const LAS s16x4*)(vp + 16);
                    const s16x8 vf = __builtin_shufflevector(lo, hi, 0, 1, 2, 3, 4, 5, 6, 7);
                    o[dt] = __builtin_amdgcn_mfma_f32_32x32x16_bf16(vf, pf, o[dt], 0, 0, 0); }
            }
        }
    }
    l += __shfl_xor(l, 32);
    const float inv = 1.0f / l;
    bf16* orow = ow + (size_t)r * opitch + 4 * h;
#pragma unroll
    for (int dt = 0; dt < 4; ++dt)
#pragma unroll
        for (int g = 0; g < 4; ++g) { unsigned long long w = (unsigned long long)pg8::cvt_pk_bf16(o[dt][4 * g] * inv, o[dt][4 * g + 1] * inv) | ((unsigned long long)pg8::cvt_pk_bf16(o[dt][4 * g + 2] * inv, o[dt][4 * g + 3] * inv) << 32);
            *(unsigned long long*)(orow + 32 * dt + 8 * g) = w; }
}

struct Args { const float* in[20]; float* out; unsigned char* ws; int ph_lo, ph_hi; };

__global__ void __launch_bounds__(NTHR, 2) mk_fwd(Args args) {
    extern __shared__ __attribute__((aligned(16))) unsigned char lds_raw[];
    LAS unsigned char* lds = (LAS unsigned char*)lds_raw;
    const int tid = threadIdx.x, lane = tid & 63, wave = __builtin_amdgcn_readfirstlane(tid >> 6);
    const int G = gridDim.x, bx = blockIdx.x;
    const int gw = bx * NWAVES + wave, NGW = G * NWAVES;
    unsigned char* ws = args.ws;
    const float* x = args.in[0]; const float* mem = args.in[1]; const float* g_mix = args.in[2]; const float* w_in = args.in[3]; const float* sink = args.in[4];
    const float* conv_w = args.in[5]; const float* b_gate = args.in[6]; const float* w_attn_out = args.in[7]; const float* w_conv_out = args.in[8]; const float* w_o = args.in[9];
    const float* g_cross = args.in[10]; const float* g_mem = args.in[11]; const float* w_cq = args.in[12]; const float* w_ckv = args.in[13]; const float* w_co = args.in[14];
    const float* g_ffn = args.in[15]; const float* w_gate = args.in[16]; const float* w_up = args.in[17]; const float* w_down = args.in[18]; const float* g_final = args.in[19];
    float* out = args.out;
    float* ssq2 = (float*)(ws + WS_SSQ); float* ssq3 = ssq2 + M * 8; float* ssq4 = ssq3 + M * 8;
    PG8_LAS float* xch = (PG8_LAS float*)(lds + pg8::STAGE_BYTES);
    float* cosT = (float*)(ws + WS_ROPE); float* sinT = cosT + SEQ * 64;
    bf16* Wt_in = (bf16*)(ws + WS_WIN); bf16* Wt_a = (bf16*)(ws + WS_WA); bf16* Wt_c = (bf16*)(ws + WS_WC); bf16* Wt_o = (bf16*)(ws + WS_WO);
    bf16* Wt_cq = (bf16*)(ws + WS_WCQ); bf16* Wt_ckv = (bf16*)(ws + WS_WCKV); bf16* Wt_co = (bf16*)(ws + WS_WCO); bf16* Wt_gu = (bf16*)(ws + WS_WGU); bf16* Wt_dn = (bf16*)(ws + WS_WDN);
    bf16* MEMN = (bf16*)(ws + WS_MEMN); bf16* MEMKV = (bf16*)(ws + WS_MEMKV);
    bf16* ZA = (bf16*)(ws + WS_ZA); bf16* ZG = (bf16*)(ws + WS_ZG); bf16* AO = (bf16*)(ws + WS_AO); bf16* CV = (bf16*)(ws + WS_CV);
    bf16* MG = (bf16*)(ws + WS_MG); bf16* XB = (bf16*)(ws + WS_XB); bf16* WOB = (bf16*)(ws + WS_WOB); bf16* WOQ = (bf16*)(ws + WS_WOQ); float* rs1 = (float*)(ws + WS_RS1); bf16* QC = (bf16*)(ws + WS_QC); bf16* CO = (bf16*)(ws + WS_CO);
    bf16* X2B = (bf16*)(ws + WS_X2B); bf16* ACT = (bf16*)(ws + WS_ACT);
    cg::grid_group grid = cg::this_grid();
    const int lo = args.ph_lo, hi = args.ph_hi;
#define IN(k) (lo <= (k) && (k) < hi)
#define SEAM(k) do { if (IN(k) && IN((k) + 1)) { asm volatile("s_waitcnt vmcnt(0) lgkmcnt(0)" ::: "memory"); __syncthreads(); grid.sync(); } } while (0)

    if (IN(0)) {
        LAS float* scr = (LAS float*)(lds + wave * 16384);
        constexpr int I_IN = (DM / 64) * (INW / 32), I_A = (1024 / 64) * (DM / 32), I_O = (DM / 64) * (DM / 32), I_CQ = (DM / 64) * (512 / 32), I_CKV = (DM / 64) * (1024 / 32),
                      I_CO = (512 / 64) * (DM / 32), I_G = (DM / 64) * (DFF / 32), I_D = (DFF / 64) * (DM / 32);
        constexpr int NITEMS = I_IN + 2 * I_A + I_O + I_CQ + I_CKV + I_CO + 2 * I_G + I_D;
        for (int it = gw; it < NITEMS; it += NGW) {
            int r = it;
            if (r < I_IN) { p0_transpose_item(w_in, DM, INW, Wt_in, 3, g_mix, scr, r, lane); continue; } r -= I_IN;
            if (r < I_A) { p0_transpose_item(w_attn_out, 1024, DM, Wt_a, 0, nullptr, scr, r, lane); continue; } r -= I_A;
            if (r < I_A) { p0_transpose_item(w_conv_out, 1024, DM, Wt_c, 0, nullptr, scr, r, lane); continue; } r -= I_A;
            if (r < I_O) { p0_transpose_item(w_o, DM, DM, Wt_o, 0, nullptr, scr, r, lane); continue; } r -= I_O;
            if (r < I_CQ) { p0_transpose_item(w_cq, DM, 512, Wt_cq, 0, g_cross, scr, r, lane); continue; } r -= I_CQ;
            if (r < I_CKV) { p0_transpose_item(w_ckv, DM, 1024, Wt_ckv, 0, nullptr, scr, r, lane); continue; } r -= I_CKV;
            if (r < I_CO) { p0_transpose_item(w_co, 512, DM, Wt_co, 0, nullptr, scr, r, lane); continue; } r -= I_CO;
            if (r < I_G) { p0_transpose_item(w_gate, DM, DFF, Wt_gu, 1, g_ffn, scr, r, lane); continue; } r -= I_G;
            if (r < I_G) { p0_transpose_item(w_up, DM, DFF, Wt_gu, 2, g_ffn, scr, r, lane); continue; } r -= I_G;
            p0_transpose_item(w_down, DFF, DM, Wt_dn, 0, nullptr, scr, r, lane);
        }
        for (int m = gw; m < M; m += NGW) row_to_bf16_rs(x + (size_t)m * DM, XB + (size_t)m * DM, rs1 + m, lane);
        for (int i = bx * NTHR + tid; i < DM * DM / 8; i += G * NTHR) { const f32x4 a = *(const f32x4*)(w_o + (size_t)i * 8), b = *(const f32x4*)(w_o + (size_t)i * 8 + 4); *(v4u*)(WOB + (size_t)i * 8) = pg8::pack8(a, b); }
        for (int m = gw; m < MROWS; m += NGW) rms_row_to_bf16(mem + (size_t)m * DM, g_mem, MEMN + (size_t)m * DM, lane);
        for (int i = bx * NTHR + tid; i < SEQ * 64; i += G * NTHR) { const int pos = i >> 6, j = i & 63;
            const float inv = exp2f(-(float)j * (13.287712379549449f / 64.0f)); const float ang = (float)pos * inv;
            cosT[i] = cosf(ang); sinT[i] = sinf(ang); }
    }
    SEAM(0);

    if (IN(1)) {
        { pg8::Gemm g{XB, Wt_in, nullptr, nullptr, M, INW, DM}; pg8::StaticOrder S; S.init(M, INW, G, bx);
          pg8::EpiIn E{ZA, ZG, cosT, sinT, b_gate, 0.08838834764831845f, rs1};
          pg8::gemm_phase<pg8::EpiIn, pg8::StaticOrder>(lds, g, S, E); }
        { pg8::Gemm g{MEMN, Wt_ckv, nullptr, nullptr, MROWS, 1024, DM}; pg8::StaticOrder S; S.init(MROWS, 1024, G, (bx + G / 2) % G);
          pg8::EpiBf16 E{MEMKV, 1024};
          pg8::gemm_phase<pg8::EpiBf16, pg8::StaticOrder>(lds, g, S, E); }
        { pg8::Gemm g{Wt_cq, WOB, nullptr, nullptr, 512, DM, DM}; pg8::StaticOrder S; S.init(512, DM, G, (bx + G / 2 - 32 + G) % G);
          pg8::EpiBf16 E{WOQ, DM};
          pg8::gemm_phase<pg8::EpiBf16, pg8::StaticOrder>(lds, g, S, E); }
    }
    SEAM(1);

    if (IN(2)) {
        for (int it = 2 * bx; it < 512; it += 2 * G)
            for (int hp = 0; hp < 2; ++hp) { const int kvh = it >> 1 & 1, nb = (it >> 2) & 15, b = it >> 6;
                const int hq = kvh * 4 + hp * 2 + (wave >> 2), t0 = b * SEQ + nb * 128 + (wave & 3) * 32;
                const int kb0 = nb > 0 ? nb - 1 : 0, kb1 = nb < 15 ? nb + 1 : 15; const size_t kt0 = (size_t)b * SEQ + kb0 * 128;
                attn_unit<true>(lds, ZA + (size_t)t0 * ZAW + hq * 128, ZAW, ZA + kt0 * ZAW + 1024 + kvh * 128, ZA + kt0 * ZAW + 1280 + kvh * 128, ZAW, kb1 - kb0 + 1,
                                nb * 128 + (wave & 3) * 32, kb0 * 128, sink[hq], 1.0f, 1.0f, AO + (size_t)t0 * 1024 + hq * 128, 1024, tid, lane); }
        __syncthreads();
        for (int idx = bx * NTHR + tid; idx < (M / 16) * 128; idx += G * NTHR) { const int run = idx >> 7, c8 = (idx & 127) * 8, t0 = run * 16, s0 = t0 & (SEQ - 1);
            const f32x4 w0a = *(const f32x4*)(conv_w + c8), w0b = *(const f32x4*)(conv_w + c8 + 4), w1a = *(const f32x4*)(conv_w + 1024 + c8), w1b = *(const f32x4*)(conv_w + 1024 + c8 + 4),
                        w2a = *(const f32x4*)(conv_w + 2048 + c8), w2b = *(const f32x4*)(conv_w + 2048 + c8 + 4);
            const bf16* zr = ZA + (size_t)t0 * ZAW + c8;
            f32x4 pa = {0.f, 0.f, 0.f, 0.f}, pb = pa, ca, cb, ta, tb;
            if (s0 > 0) { pg8::unpack8(*(const v4u*)(zr - ZAW + 1536), pa, pb); pg8::unpack8(*(const v4u*)(zr - ZAW + 3584), ta, tb); pa = pa * ta; pb = pb * tb; }
            pg8::unpack8(*(const v4u*)(zr + 1536), ca, cb); pg8::unpack8(*(const v4u*)(zr + 3584), ta, tb); ca = ca * ta; cb = cb * tb;
#pragma unroll
            for (int i = 0; i < 16; ++i) { f32x4 na = {0.f, 0.f, 0.f, 0.f}, nbv = na, ga, gb;
                if (i < 15 || s0 + 16 < SEQ) { pg8::unpack8(*(const v4u*)(zr + (size_t)(i + 1) * ZAW + 1536), na, nbv); pg8::unpack8(*(const v4u*)(zr + (size_t)(i + 1) * ZAW + 3584), ta, tb); na = na * ta; nbv = nbv * tb; }
                pg8::unpack8(*(const v4u*)(zr + (size_t)i * ZAW + 2560), ga, gb);
                *(v4u*)(CV + (size_t)(t0 + i) * 1024 + c8) = pg8::pack8(ga * (w0a * pa + w1a * ca + w2a * na), gb * (w0b * pb + w1b * cb + w2b * nbv));
                pa = ca; pb = cb; ca = na; cb = nbv; }
        }
    }
    SEAM(2);

    if (IN(3)) {
        pg8::Gemm g{AO, Wt_a, CV, Wt_c, M, DM, 1024}; pg8::StaticOrder S; S.init(M, DM, G, bx, 2);
        pg8::EpiMerge E{ZG, MG};
        pg8::gemm_phase<pg8::EpiMerge, pg8::StaticOrder>(lds, g, S, E);
    }
    SEAM(3);

    if (IN(4)) {
        { pg8::Gemm g{XB, Wt_cq, MG, WOQ, M, 512, DM}; pg8::ListOrder S{bx, bx < 128 ? 1 : 0, 2, 2};
          pg8::EpiAcc2 E{QC, 512};
          pg8::gemm_phase<pg8::EpiAcc2, pg8::ListOrder>(lds, g, S, E); }
        { pg8::Gemm g{MG, Wt_o, nullptr, nullptr, M, DM, DM}; pg8::ListOrder S{bx < 128 ? bx : 128 + (bx - 128) * 3, bx < 128 ? 1 : 3, 8, 1};
          pg8::EpiRes E{x, out, nullptr, ssq2, xch};
          pg8::gemm_phase<pg8::EpiRes, pg8::ListOrder>(lds, g, S, E); }
    }
    SEAM(4);

    if (IN(6)) {
        for (int it = bx; it < 256; it += G) { const int rb = it & 7, hh = (it >> 3) & 3, b = it >> 5; const int t0 = b * SEQ + rb * 256 + wave * 32;
            attn_unit<false>(lds, QC + (size_t)t0 * 512 + hh * 128, 512, MEMKV + (size_t)(b * NMEM) * 1024 + hh * 128, MEMKV + (size_t)(b * NMEM) * 1024 + 512 + hh * 128, 1024, 2,
                             0, 0, -1e30f, 0.0f, pg8::row_rs(ssq2, t0 + (lane & 31)) * 0.08838834764831845f, CO + (size_t)t0 * 512 + hh * 128, 512, tid, lane); }
    }
    SEAM(6);

    if (IN(7)) {
        pg8::Gemm g{CO, Wt_co, nullptr, nullptr, M, DM, 512}; pg8::StaticOrder S; S.init(M, DM, G, bx);
        pg8::EpiRes E{out, out, X2B, ssq3, xch};
        pg8::gemm_phase<pg8::EpiRes, pg8::StaticOrder>(lds, g, S, E);
    }
    SEAM(7);

    if (IN(8)) {
        pg8::Gemm g{X2B, Wt_gu, nullptr, nullptr, M, 2 * DFF, DM}; pg8::StaticOrder S; S.init(M, 2 * DFF, G, bx);
        pg8::EpiSwiGLU E{ACT, ssq3};
        pg8::gemm_phase<pg8::EpiSwiGLU, pg8::StaticOrder>(lds, g, S, E);
    }
    SEAM(8);

    if (IN(9)) {
        pg8::Gemm g{ACT, Wt_dn, nullptr, nullptr, M, DM, DFF}; pg8::StaticOrder S; S.init(M, DM, G, bx);
        pg8::EpiRes E{out, out, nullptr, ssq4, xch};
        pg8::gemm_phase<pg8::EpiRes, pg8::StaticOrder>(lds, g, S, E);
    }
    SEAM(9);

    if (IN(10)) {
        for (int m = gw; m < M; m += NGW) { f32x4* xr = (f32x4*)(out + (size_t)m * DM) + lane; const f32x4* gr = (const f32x4*)g_final + lane;
            const float rs = pg8::row_rs(ssq4, m);
#pragma unroll
            for (int j = 0; j < 8; ++j) xr[64 * j] = xr[64 * j] * rs * gr[64 * j]; }
    }

#if defined(MK_DUMP_OFF)
    if (hi == MK_CUT && MK_CUT < 11) {
        asm volatile("s_waitcnt vmcnt(0) lgkmcnt(0)" ::: "memory"); __syncthreads(); grid.sync();
        const bf16* src = (const bf16*)(ws + (size_t)(MK_DUMP_OFF));
        for (size_t i = (size_t)bx * NTHR + tid; i < (size_t)M * 2048; i += (size_t)G * NTHR) { const size_t r = i >> 11, c = i & 2047; out[i] = __uint_as_float((unsigned)src[r * (MK_DUMP_LD) + (c % (MK_DUMP_W)) + (c / (MK_DUMP_W)) * (size_t)(MK_DUMP_OFF2)] << 16); }
    }
#endif
#undef IN
#undef SEAM
}

extern "C" void kernel_launch(void* const* d_in, const int* in_sizes, int n_in, void* d_out, int out_size, void* d_ws, size_t ws_size, hipStream_t stream) {
    static int grid = 0;
    if (grid == 0) {
        if (n_in != 20 || in_sizes[0] != M * DM || out_size != M * DM || ws_size < WS_END) { fprintf(stderr, "kernel_launch: unexpected shapes / workspace (n_in %d, ws %zu)\n", n_in, ws_size); grid = -1; return; }
        int dev = 0, cus = 0, per_cu = 0;
        if (hipGetDevice(&dev) != hipSuccess || hipDeviceGetAttribute(&cus, hipDeviceAttributeMultiprocessorCount, dev) != hipSuccess) { grid = -1; return; }
        if (hipFuncSetAttribute((const void*)mk_fwd, hipFuncAttributeMaxDynamicSharedMemorySize, LDS_BYTES) != hipSuccess) { fprintf(stderr, "kernel_launch: hipFuncSetAttribute failed\n"); grid = -1; return; }
        if (hipOccupancyMaxActiveBlocksPerMultiprocessor(&per_cu, (const void*)mk_fwd, NTHR, LDS_BYTES) != hipSuccess || per_cu < 1) { fprintf(stderr, "kernel_launch: occupancy query says %d\n", per_cu); (void)hipGetLastError(); grid = -1; return; }
        grid = cus;
    }
    if (grid < 0) return;
    Args a{};
    for (int i = 0; i < 20; ++i) a.in[i] = (const float*)d_in[i];
    a.out = (float*)d_out; a.ws = (unsigned char*)d_ws;
#if MK_N_LAUNCHES == 1
    a.ph_lo = 0; a.ph_hi = MK_CUT;
    void* kargs[] = {&a};
    hipError_t e = hipLaunchCooperativeKernel((const void*)mk_fwd, dim3(grid), dim3(NTHR), kargs, LDS_BYTES, stream);
    if (e != hipSuccess) fprintf(stderr, "kernel_launch: cooperative launch failed: %s (grid %d)\n", hipGetErrorString(e), grid);
#else
    for (int p = 0; p < 11; ++p) { a.ph_lo = p; a.ph_hi = p + 1; hipLaunchKernelGGL(mk_fwd, dim3(grid), dim3(NTHR), LDS_BYTES, stream, a); }
#endif
}
```

```cpp
#include <hip/hip_runtime.h>
#include <hip/hip_cooperative_groups.h>
#include <cstdio>
#include <cstdint>
namespace cg = cooperative_groups;

#ifndef MK_CUT
#define MK_CUT 11
#endif
#ifndef MK_N_LAUNCHES
#define MK_N_LAUNCHES 1
#endif

namespace pg8 {
#define PG8_LAS __attribute__((address_space(3)))
typedef unsigned short bf16_t;
typedef short bf16x8 __attribute__((ext_vector_type(8)));
typedef float f32x4 __attribute__((ext_vector_type(4)));
typedef unsigned u32x4 __attribute__((ext_vector_type(4)));
constexpr int BM = 256, BK = 64, HALF = 128, HTB = HALF * BK * 2, STAGE_BYTES = 8 * HTB, NXCD = 8, WGM = 8;

__host__ __device__ __forceinline__ int lds_byte(int r, int c) { const int st = (r >> 4) * 2 + (c >> 5), rr = r & 15, cc = c & 31, ob = rr * 64 + cc * 2; return st * 1024 + (ob ^ (((ob >> 9) & 1) << 5)); }
__host__ __device__ __forceinline__ void stage_rc(int b, int& R, int& C) { const int st = b / 1024, sb = b % 1024, swz = sb ^ (((sb >> 9) & 1) << 5); R = (st >> 1) * 16 + swz / 64; C = (st & 1) * 32 + (swz % 64) / 2; }
__host__ __device__ __forceinline__ int perm32(int rho) { const int n = rho >> 4, i = rho & 15; return 8 * (i >> 2) + 4 * n + (i & 3); }

struct Unit { int pm, pn, seg; };
struct Gemm { const bf16_t* A0; const bf16_t* B0; const bf16_t* A1; const bf16_t* B1; int M, N, K; };

struct StaticOrder {
    int nM, nN, nwg, G, c, nseg;
    __device__ void init(int M, int N, int G_, int c_, int nseg_ = 1) { nM = M / BM; nN = N / BM; nwg = nM * nN; G = G_; c = c_; nseg = nseg_; }
    __device__ bool next(int i, Unit& u) const {
        const int j = (nseg == 2) ? (i >> 1) : i; u.seg = (nseg == 2) ? (i & 1) : 0;
        const long L = (long)j * G + c; if (L >= nwg) return false;
        int wgid = (int)L; { const int q = nwg / NXCD, r = nwg % NXCD, xcd = wgid % NXCD, off = wgid / NXCD; wgid = (xcd < r ? xcd * (q + 1) : r * (q + 1) + (xcd - r) * q) + off; }
        const int nig = WGM * nN, gid = wgid / nig, fm = gid * WGM, gsz = (nM - fm) < WGM ? (nM - fm) : WGM;
        u.pm = fm + ((wgid % nig) % gsz); u.pn = (wgid % nig) / gsz; return true;
    }
};

typedef __bf16 bf16x2_t __attribute__((ext_vector_type(2)));
typedef float f32x2_t __attribute__((ext_vector_type(2)));
struct ListOrder {
    int first, count, nN, nseg;
    __device__ bool next(int i, Unit& u) const { const int j = (nseg == 2) ? (i >> 1) : i; u.seg = (nseg == 2) ? (i & 1) : 0; if (j >= count) return false; const int L = first + j; u.pm = L / nN; u.pn = L % nN; return true; }
};
__device__ __forceinline__ unsigned cvt_pk_bf16(float lo, float hi) { const f32x2_t v = {lo, hi}; const bf16x2_t r = __builtin_convertvector(v, bf16x2_t); return __builtin_bit_cast(unsigned, r); }
__device__ __forceinline__ u32x4 pack8(const f32x4 a, const f32x4 b) { u32x4 w; w.x = cvt_pk_bf16(a[0], a[1]); w.y = cvt_pk_bf16(a[2], a[3]); w.z = cvt_pk_bf16(b[0], b[1]); w.w = cvt_pk_bf16(b[2], b[3]); return w; }
__device__ __forceinline__ void unpack8(const u32x4 w, f32x4& a, f32x4& b) {
    a[0] = __uint_as_float(w.x << 16); a[1] = __uint_as_float(w.x & 0xffff0000u); a[2] = __uint_as_float(w.y << 16); a[3] = __uint_as_float(w.y & 0xffff0000u);
    b[0] = __uint_as_float(w.z << 16); b[1] = __uint_as_float(w.z & 0xffff0000u); b[2] = __uint_as_float(w.w << 16); b[3] = __uint_as_float(w.w & 0xffff0000u); }
__device__ __forceinline__ f32x4 sigmoid4(const f32x4 v) { f32x4 o;
#pragma unroll
    for (int i = 0; i < 4; ++i) o[i] = __builtin_amdgcn_rcpf(1.0f + __expf(-v[i]));
    return o; }

typedef f32x4 Acc[2][2][4][2];

struct EpiBf16 {
    static constexpr bool PERM = true, KEEP_ACC = false;
    bf16_t* O; int ldc;
    __device__ __forceinline__ void operator()(Acc& acc, const Unit& u, int wr, int wc, int fr, int fq) const {
        const int row0 = u.pm * BM + wr * 64 + fr, col0 = u.pn * BM + wc * 32 + 8 * fq;
#pragma unroll
        for (int ai = 0; ai < 2; ++ai)
#pragma unroll
            for (int m = 0; m < 4; ++m) { bf16_t* rowp = O + (size_t)(row0 + ai * HALF + m * 16) * ldc + col0;
#pragma unroll
                for (int bj = 0; bj < 2; ++bj) *(u32x4*)(rowp + bj * HALF) = pack8(acc[ai][bj][m][0], acc[ai][bj][m][1]); }
    }
};
struct EpiIn {
    static constexpr bool PERM = true, KEEP_ACC = false;
    bf16_t* ZA; bf16_t* ZG; const float* cosT; const float* sinT; const float* bgate; float qscale; const float* rs1;
    __device__ __forceinline__ void operator()(Acc& acc, const Unit& u, int wr, int wc, int fr, int fq) const {
        const int row0 = u.pm * BM + wr * 64 + fr;
#pragma unroll
        for (int ai = 0; ai < 2; ++ai)
#pragma unroll
            for (int m = 0; m < 4; ++m) { const float rs = rs1[row0 + ai * HALF + m * 16];
#pragma unroll
                for (int bj = 0; bj < 2; ++bj) { acc[ai][bj][m][0] = acc[ai][bj][m][0] * rs; acc[ai][bj][m][1] = acc[ai][bj][m][1] * rs; } }
        if (u.pn < 5) {
            const int p = wc * 32 + 8 * fq, hb = p >> 6, j0 = p & 63, c1 = u.pn * 256 + hb * 128 + j0;
            const float sc = u.pn < 4 ? qscale : 1.0f;
#pragma unroll
            for (int ai = 0; ai < 2; ++ai)
#pragma unroll
                for (int m = 0; m < 4; ++m) { const int row = row0 + ai * HALF + m * 16, pos = row & 2047;
                    const f32x4 ca = *(const f32x4*)(cosT + pos * 64 + j0), cb = *(const f32x4*)(cosT + pos * 64 + j0 + 4);
                    const f32x4 sa = *(const f32x4*)(sinT + pos * 64 + j0), sb = *(const f32x4*)(sinT + pos * 64 + j0 + 4);
                    const f32x4 t1a = acc[ai][0][m][0], t1b = acc[ai][0][m][1], t2a = acc[ai][1][m][0], t2b = acc[ai][1][m][1];
                    const f32x4 o1a = (t1a * ca - t2a * sa) * sc, o1b = (t1b * cb - t2b * sb) * sc, o2a = (t2a * ca + t1a * sa) * sc, o2b = (t2b * cb + t1b * sb) * sc;
                    bf16_t* rp = ZA + (size_t)row * 4608 + c1;
                    *(u32x4*)rp = pack8(o1a, o1b); *(u32x4*)(rp + 64) = pack8(o2a, o2b); }
        } else if (u.pn < 18) {
            const int col0 = u.pn * BM + wc * 32 + 8 * fq;
#pragma unroll
            for (int ai = 0; ai < 2; ++ai)
#pragma unroll
                for (int m = 0; m < 4; ++m) { bf16_t* rowp = ZA + (size_t)(row0 + ai * HALF + m * 16) * 4608 + col0;
#pragma unroll
                    for (int bj = 0; bj < 2; ++bj) *(u32x4*)(rowp + bj * HALF) = pack8(acc[ai][bj][m][0], acc[ai][bj][m][1]); }
        } else {
            const int col0 = (u.pn - 18) * BM + wc * 32 + 8 * fq;
#pragma unroll
            for (int bj = 0; bj < 2; ++bj) { const f32x4 b0 = *(const f32x4*)(bgate + col0 + bj * HALF), b1 = *(const f32x4*)(bgate + col0 + bj * HALF + 4);
#pragma unroll
                for (int ai = 0; ai < 2; ++ai)
#pragma unroll
                    for (int m = 0; m < 4; ++m) { bf16_t* rowp = ZG + (size_t)(row0 + ai * HALF + m * 16) * 4096 + col0 + bj * HALF;
                        *(u32x4*)rowp = pack8(sigmoid4(acc[ai][bj][m][0] + b0), sigmoid4(acc[ai][bj][m][1] + b1)); } }
        }
    }
};
struct EpiAcc2 {
    static constexpr bool PERM = true, KEEP_ACC = true;
    bf16_t* O; int ldc;
    __device__ __forceinline__ void operator()(Acc& acc, const Unit& u, int wr, int wc, int fr, int fq) const {
        if (u.seg == 0) return;
        const int row0 = u.pm * BM + wr * 64 + fr, col0 = u.pn * BM + wc * 32 + 8 * fq;
#pragma unroll
        for (int ai = 0; ai < 2; ++ai)
#pragma unroll
            for (int m = 0; m < 4; ++m) { bf16_t* rowp = O + (size_t)(row0 + ai * HALF + m * 16) * ldc + col0;
#pragma unroll
                for (int bj = 0; bj < 2; ++bj) *(u32x4*)(rowp + bj * HALF) = pack8(acc[ai][bj][m][0], acc[ai][bj][m][1]); }
    }
};
struct EpiMerge {
    static constexpr bool PERM = true, KEEP_ACC = true;
    const bf16_t* ZG; bf16_t* O;
    __device__ __forceinline__ void operator()(Acc& acc, const Unit& u, int wr, int wc, int fr, int fq) const {
        const int row0 = u.pm * BM + wr * 64 + fr, col0 = u.pn * BM + wc * 32 + 8 * fq;
#pragma unroll
        for (int ai = 0; ai < 2; ++ai)
#pragma unroll
            for (int m = 0; m < 4; ++m) { const int row = row0 + ai * HALF + m * 16;
#pragma unroll
                for (int bj = 0; bj < 2; ++bj) { const bf16_t* gp = ZG + (size_t)row * 4096 + col0 + bj * HALF;
                    f32x4 c0, c1; unpack8(*(const u32x4*)(gp + 2048), c0, c1);
                    if (u.seg == 0) { f32x4 a0, a1; unpack8(*(const u32x4*)gp, a0, a1);
#pragma unroll
                        for (int i = 0; i < 4; ++i) { acc[ai][bj][m][0][i] *= a0[i] * __builtin_amdgcn_rcpf(c0[i]); acc[ai][bj][m][1][i] *= a1[i] * __builtin_amdgcn_rcpf(c1[i]); }
                    } else { *(u32x4*)(O + (size_t)row * 2048 + col0 + bj * HALF) = pack8(acc[ai][bj][m][0] * c0, acc[ai][bj][m][1] * c1); } } }
    }
};
struct EpiRes {
    static constexpr bool PERM = true, KEEP_ACC = false;
    const float* base; float* out; bf16_t* outb; float* part; PG8_LAS float* xch;
    __device__ __forceinline__ void operator()(Acc& acc, const Unit& u, int wr, int wc, int fr, int fq) const {
        const int row0 = u.pm * BM + wr * 64 + fr, col0 = u.pn * BM + wc * 32 + 8 * fq;
#pragma unroll
        for (int ai = 0; ai < 2; ++ai)
#pragma unroll
            for (int m = 0; m < 4; ++m) { const int row = row0 + ai * HALF + m * 16; float ss = 0.f;
#pragma unroll
                for (int bj = 0; bj < 2; ++bj) { const size_t off = (size_t)row * 2048 + col0 + bj * HALF;
                    const f32x4 o0 = *(const f32x4*)(base + off) + acc[ai][bj][m][0], o1 = *(const f32x4*)(base + off + 4) + acc[ai][bj][m][1];
                    *(f32x4*)(out + off) = o0; *(f32x4*)(out + off + 4) = o1;
                    if (outb) *(u32x4*)(outb + off) = pack8(o0, o1);
                    ss += (o0[0] * o0[0] + o0[1] * o0[1]) + (o0[2] * o0[2] + o0[3] * o0[3]) + (o1[0] * o1[0] + o1[1] * o1[1]) + (o1[2] * o1[2] + o1[3] * o1[3]); }
                ss += __shfl_xor(ss, 16); ss += __shfl_xor(ss, 32);
                if (fq == 0) xch[(ai * HALF + wr * 64 + m * 16 + fr) * 4 + wc] = ss; }
        asm volatile("s_waitcnt lgkmcnt(0)" ::: "memory"); __builtin_amdgcn_s_barrier(); asm volatile("" ::: "memory");
        { const int t = threadIdx.x; if (t < 256) { const f32x4 v = *(const PG8_LAS f32x4*)(xch + t * 4); part[(size_t)(u.pm * BM + t) * 8 + u.pn] = (v[0] + v[1]) + (v[2] + v[3]); } }
        asm volatile("s_waitcnt lgkmcnt(0)" ::: "memory"); __builtin_amdgcn_s_barrier(); asm volatile("" ::: "memory");
    }
};
struct EpiResB {
    static constexpr bool PERM = true, KEEP_ACC = false;
    const bf16_t* base; bf16_t* outb; float* part; PG8_LAS float* xch;
    __device__ __forceinline__ void operator()(Acc& acc, const Unit& u, int wr, int wc, int fr, int fq) const {
        const int row0 = u.pm * BM + wr * 64 + fr, col0 = u.pn * BM + wc * 32 + 8 * fq;
#pragma unroll
        for (int ai = 0; ai < 2; ++ai)
#pragma unroll
            for (int m = 0; m < 4; ++m) { const int row = row0 + ai * HALF + m * 16; float ss = 0.f;
#pragma unroll
                for (int bj = 0; bj < 2; ++bj) { const size_t off = (size_t)row * 2048 + col0 + bj * HALF;
                    f32x4 b0, b1; unpack8(*(const u32x4*)(base + off), b0, b1);
                    const f32x4 o0 = b0 + acc[ai][bj][m][0], o1 = b1 + acc[ai][bj][m][1];
                    *(u32x4*)(outb + off) = pack8(o0, o1);
                    ss += (o0[0] * o0[0] + o0[1] * o0[1]) + (o0[2] * o0[2] + o0[3] * o0[3]) + (o1[0] * o1[0] + o1[1] * o1[1]) + (o1[2] * o1[2] + o1[3] * o1[3]); }
                ss += __shfl_xor(ss, 16); ss += __shfl_xor(ss, 32);
                if (fq == 0) xch[(ai * HALF + wr * 64 + m * 16 + fr) * 4 + wc] = ss; }
        asm volatile("s_waitcnt lgkmcnt(0)" ::: "memory"); __builtin_amdgcn_s_barrier(); asm volatile("" ::: "memory");
        { const int t = threadIdx.x; if (t < 256) { const f32x4 v = *(const PG8_LAS f32x4*)(xch + t * 4); part[(size_t)(u.pm * BM + t) * 8 + u.pn] = (v[0] + v[1]) + (v[2] + v[3]); } }
        asm volatile("s_waitcnt lgkmcnt(0)" ::: "memory"); __builtin_amdgcn_s_barrier(); asm volatile("" ::: "memory");
    }
};
__device__ __forceinline__ float row_rs(const float* part, int row) { const f32x4 a = *(const f32x4*)(part + (size_t)row * 8), b = *(const f32x4*)(part + (size_t)row * 8 + 4);
    return __builtin_amdgcn_rsqf((((a[0] + a[1]) + (a[2] + a[3])) + ((b[0] + b[1]) + (b[2] + b[3]))) * (1.0f / 2048.0f) + 1e-6f); }
struct EpiRowScale {
    static constexpr bool PERM = true, KEEP_ACC = false;
    bf16_t* O; int ldc; const float* ssq; float scale;
    __device__ __forceinline__ void operator()(Acc& acc, const Unit& u, int wr, int wc, int fr, int fq) const {
        const int row0 = u.pm * BM + wr * 64 + fr, col0 = u.pn * BM + wc * 32 + 8 * fq;
#pragma unroll
        for (int ai = 0; ai < 2; ++ai)
#pragma unroll
            for (int m = 0; m < 4; ++m) { const int row = row0 + ai * HALF + m * 16; const float rs = row_rs(ssq, row) * scale;
                bf16_t* rowp = O + (size_t)row * ldc + col0;
#pragma unroll
                for (int bj = 0; bj < 2; ++bj) *(u32x4*)(rowp + bj * HALF) = pack8(acc[ai][bj][m][0] * rs, acc[ai][bj][m][1] * rs); }
    }
};
struct EpiSwiGLU {
    static constexpr bool PERM = true, KEEP_ACC = false;
    bf16_t* O; const float* ssq;
    __device__ __forceinline__ void operator()(Acc& acc, const Unit& u, int wr, int wc, int fr, int fq) const {
        const int row0 = u.pm * BM + wr * 64 + fr, col0 = u.pn * HALF + wc * 32 + 8 * fq;
#pragma unroll
        for (int ai = 0; ai < 2; ++ai)
#pragma unroll
            for (int m = 0; m < 4; ++m) { const int row = row0 + ai * HALF + m * 16; const float rs = row_rs(ssq, row);
                const f32x4 g0 = acc[ai][0][m][0] * rs, g1 = acc[ai][0][m][1] * rs, u0 = acc[ai][1][m][0] * rs, u1 = acc[ai][1][m][1] * rs;
                *(u32x4*)(O + (size_t)row * 5632 + col0) = pack8(g0 * sigmoid4(g0) * u0, g1 * sigmoid4(g1) * u1); }
    }
};

template <class Epi, class Sched, bool ALIGN_EPI = true>
__device__ __forceinline__ void gemm_phase(PG8_LAS unsigned char* lds, const Gemm g, const Sched& S, const Epi& E) {
    const int tid = threadIdx.x, wid = __builtin_amdgcn_readfirstlane(tid >> 6), lane = tid & 63, wr = wid >> 2, wc = wid & 3, fr = lane & 15, fq = lane >> 4;
    const int K = g.K, nt = K / BK;
    unsigned voffA[2], voffB[2];
#pragma unroll
    for (int i = 0; i < 2; ++i) { int R, C; stage_rc(tid * 16 + i * 8192, R, C); const int Rb = Epi::PERM ? ((R & ~31) + perm32(R & 31)) : R;
        voffA[i] = (unsigned)(R * K + C) * 2u; voffB[i] = (unsigned)(Rb * K + C) * 2u; }
    const size_t kstep = (size_t)(BK * 2);
    const size_t hstep = (size_t)HALF * K * 2;
    const size_t tstep = 2 * hstep;
    const unsigned ldsw = (unsigned)wid * 1024u;
    const int aoff = lds_byte(wr * 64 + fr, fq * 8), boff = lds_byte(wc * 32 + fr, fq * 8);
#define PG8_SA(b, h) (((b) * 2 + (h)) * HTB)
#define PG8_SB(b, h) ((4 + (b) * 2 + (h)) * HTB)
#define PG8_STAGE(bufoff, gbase, voff) do { _Pragma("unroll") for (int _i = 0; _i < 2; ++_i) \
        __builtin_amdgcn_global_load_lds((const unsigned*)((const char*)(gbase) + (voff)[_i]), (PG8_LAS unsigned*)(lds + (bufoff) + ldsw + _i * 8192), 16, 0, 0); } while (0)
#define PG8_LDA(dst, b, h) do { _Pragma("unroll") for (int m = 0; m < 4; ++m) _Pragma("unroll") for (int k = 0; k < 2; ++k) dst[m][k] = *(const PG8_LAS bf16x8*)(lds + PG8_SA(b, h) + aoff + m * 2048 + k * 1024); } while (0)
#define PG8_LDB(dst, b, h) do { _Pragma("unroll") for (int n = 0; n < 2; ++n) _Pragma("unroll") for (int k = 0; k < 2; ++k) dst[n][k] = *(const PG8_LAS bf16x8*)(lds + PG8_SB(b, h) + boff + n * 2048 + k * 1024); } while (0)
#define PG8_MMA(ai, bj, At, Bt) do { __builtin_amdgcn_s_setprio(1); _Pragma("unroll") for (int m = 0; m < 4; ++m) _Pragma("unroll") for (int n = 0; n < 2; ++n) _Pragma("unroll") for (int k = 0; k < 2; ++k) \
        acc[ai][bj][m][n] = __builtin_amdgcn_mfma_f32_16x16x32_bf16(Bt[n][k], At[m][k], acc[ai][bj][m][n], 0, 0, 0); __builtin_amdgcn_s_setprio(0); } while (0)
#define PG8_WAIT_V(n) asm volatile("s_waitcnt vmcnt(" #n ")" ::: "memory")
#define PG8_WAIT_L(n) asm volatile("s_waitcnt lgkmcnt(" #n ")" ::: "memory")
#define PG8_BAR __builtin_amdgcn_s_barrier()
#define PG8_SCHED __builtin_amdgcn_sched_barrier(0)
#define PG8_UA(u) ((const char*)((u).seg ? g.A1 : g.A0) + (size_t)(u).pm * tstep)
#define PG8_UB(u) ((const char*)((u).seg ? g.B1 : g.B0) + (size_t)(u).pn * tstep)
    Unit cur, nxt; int ui = 0;
    if (!S.next(0, cur)) return;
    Acc acc;
#pragma unroll
    for (int a = 0; a < 2; ++a)
#pragma unroll
        for (int b = 0; b < 2; ++b)
#pragma unroll
            for (int m = 0; m < 4; ++m)
#pragma unroll
                for (int n = 0; n < 2; ++n) acc[a][b][m][n] = (f32x4){0.f, 0.f, 0.f, 0.f};
    bf16x8 At[4][2], B0[2][2], B1[2][2];
    const char* cA = PG8_UA(cur); const char* cB = PG8_UB(cur);
    PG8_STAGE(PG8_SB(0, 0), cB, voffB); PG8_STAGE(PG8_SB(0, 1), cB + hstep, voffB); PG8_STAGE(PG8_SA(0, 0), cA, voffA); PG8_STAGE(PG8_SA(0, 1), cA + hstep, voffA);
    if (wr == 1) PG8_BAR;
    PG8_WAIT_V(2); PG8_BAR;
    PG8_STAGE(PG8_SB(1, 0), cB + kstep, voffB); PG8_STAGE(PG8_SA(1, 0), cA + kstep, voffA); PG8_STAGE(PG8_SB(1, 1), cB + hstep + kstep, voffB);
    PG8_WAIT_V(6); PG8_BAR;
    for (;;) {
        const bool has_next = S.next(ui + 1, nxt);
        const char* nA = has_next ? PG8_UA(nxt) : cA; const char* nB = has_next ? PG8_UB(nxt) : cB;
        for (int t = 0; t < nt; t += 2) {
            const bool last = (t == nt - 2);
            const char* a1 = cA + (size_t)(t + 1) * kstep;
            const char* a2 = last ? nA : cA + (size_t)(t + 2) * kstep; const char* b2 = last ? nB : cB + (size_t)(t + 2) * kstep;
            const char* a3 = a2 + kstep; const char* b3 = b2 + kstep;
            PG8_LDB(B0, 0, 0); PG8_LDB(B1, 0, 1); PG8_SCHED; PG8_LDA(At, 0, 0); PG8_STAGE(PG8_SA(1, 1), a1 + hstep, voffA);
            PG8_WAIT_V(8); PG8_WAIT_L(0); PG8_BAR; PG8_MMA(0, 0, At, B0); PG8_MMA(0, 1, At, B1); PG8_BAR; PG8_SCHED;
            PG8_LDA(At, 0, 1); PG8_STAGE(PG8_SB(0, 0), b2, voffB); PG8_STAGE(PG8_SB(0, 1), b2 + hstep, voffB); PG8_STAGE(PG8_SA(0, 0), a2, voffA);
            PG8_WAIT_V(8); PG8_WAIT_L(0); PG8_BAR; PG8_MMA(1, 0, At, B0); PG8_MMA(1, 1, At, B1); PG8_BAR; PG8_SCHED;
            PG8_LDB(B0, 1, 0); PG8_LDB(B1, 1, 1); PG8_SCHED; PG8_LDA(At, 1, 0); PG8_STAGE(PG8_SA(0, 1), a2 + hstep, voffA);
            PG8_WAIT_V(8); PG8_WAIT_L(0); PG8_BAR; PG8_MMA(0, 0, At, B0); PG8_MMA(0, 1, At, B1); PG8_BAR; PG8_SCHED;
            PG8_LDA(At, 1, 1); PG8_STAGE(PG8_SB(1, 0), b3, voffB); PG8_STAGE(PG8_SB(1, 1), b3 + hstep, voffB); PG8_STAGE(PG8_SA(1, 0), a3, voffA);
            PG8_WAIT_V(8); PG8_WAIT_L(0); PG8_BAR; PG8_MMA(1, 0, At, B0); PG8_MMA(1, 1, At, B1); PG8_BAR; PG8_SCHED;
        }
        if constexpr (ALIGN_EPI) { if (wr == 0) PG8_BAR; }
        E(acc, cur, wr, wc, fr, fq);
        if (!has_next) break;
        if (!(Epi::KEEP_ACC && cur.seg == 0)) {
#pragma unroll
        for (int a = 0; a < 2; ++a)
#pragma unroll
            for (int b = 0; b < 2; ++b)
#pragma unroll
                for (int m = 0; m < 4; ++m)
#pragma unroll
                    for (int n = 0; n < 2; ++n) acc[a][b][m][n] = (f32x4){0.f, 0.f, 0.f, 0.f};
        }
        cur = nxt; cA = nA; cB = nB; ++ui;
        if constexpr (ALIGN_EPI) { if (wr == 1) PG8_BAR; }
    }
    PG8_WAIT_V(0);
    if constexpr (!ALIGN_EPI) { if (wr == 0) PG8_BAR; }
    PG8_BAR;
#undef PG8_SA
#undef PG8_SB
#undef PG8_STAGE
#undef PG8_LDA
#undef PG8_LDB
#undef PG8_MMA
#undef PG8_WAIT_V
#undef PG8_WAIT_L
#undef PG8_BAR
#undef PG8_SCHED
#undef PG8_UA
#undef PG8_UB
}
}

constexpr int NWAVES = 8, NTHR = NWAVES * 64;
constexpr int DM = 2048, BATCH = 8, SEQ = 2048, M = BATCH * SEQ;
constexpr int INW = 8704, ZAW = 4608, ZGW = 4096;
constexpr int NMEM = 256, MROWS = BATCH * NMEM;
constexpr int DFF = 5632;
constexpr float RMS_EPS = 1e-6f;

constexpr size_t MiB = 1u << 20;
constexpr size_t WS_RS1 = 0;
constexpr size_t WS_SSQ = 506 * MiB;
constexpr size_t WS_ROPE = 1 * MiB;
constexpr size_t WS_WIN = 2 * MiB;
constexpr size_t WS_WA = 36 * MiB;
constexpr size_t WS_WC = 40 * MiB;
constexpr size_t WS_WO = 44 * MiB;
constexpr size_t WS_WCQ = 52 * MiB;
constexpr size_t WS_WCKV = 54 * MiB;
constexpr size_t WS_WCO = 58 * MiB;
constexpr size_t WS_WGU = 60 * MiB;
constexpr size_t WS_WDN = 104 * MiB;
constexpr size_t WS_MEMN = 126 * MiB;
constexpr size_t WS_MEMKV = 134 * MiB;
constexpr size_t WS_ZA = 138 * MiB;
constexpr size_t WS_ZG = 282 * MiB;
constexpr size_t WS_AO = 2 * MiB;
constexpr size_t WS_CV = 410 * MiB;
constexpr size_t WS_WOB = 410 * MiB;
constexpr size_t WS_XB = 442 * MiB;
constexpr size_t WS_WOQ = 508 * MiB;
constexpr size_t WS_END = 510 * MiB;
constexpr size_t WS_MG = WS_ZA;
constexpr size_t WS_X1B = WS_ZG + 32 * MiB;
constexpr size_t WS_X3B = WS_XB;
constexpr size_t WS_QC = WS_ZG;
constexpr size_t WS_CO = WS_ZG + 16 * MiB;
constexpr size_t WS_X2B = WS_ZA;
constexpr size_t WS_ACT = WS_ZA + 64 * MiB;
static_assert(WS_ACT + (size_t)M * DFF * 2 <= WS_CV, "ACT overlay");

constexpr int LDS_BYTES = 147456;

#define GAS __attribute__((address_space(1)))
#define LAS __attribute__((address_space(3)))
typedef unsigned short bf16;
typedef unsigned v4u __attribute__((ext_vector_type(4)));
typedef float f32x4 __attribute__((ext_vector_type(4)));
#define LDS_WAIT() asm volatile("s_waitcnt lgkmcnt(0)" ::: "memory")
__device__ __forceinline__ unsigned f2bf(float f) { unsigned u = __builtin_bit_cast(unsigned, f); return (u + 0x7fffu + ((u >> 16) & 1u)) >> 16; }
__device__ __forceinline__ unsigned pk2(float lo, float hi) { return f2bf(lo) | (f2bf(hi) << 16); }
__device__ __forceinline__ float bflo(unsigned w) { return __uint_as_float(w << 16); }
__device__ __forceinline__ float bfhi(unsigned w) { return __uint_as_float(w & 0xffff0000u); }
__device__ __forceinline__ float wave_sum(float v) {
#pragma unroll
    for (int o = 1; o < 64; o <<= 1) v += __shfl_xor(v, o);
    return v;
}
__device__ __forceinline__ float wave_max(float v) {
#pragma unroll
    for (int o = 1; o < 64; o <<= 1) v = fmaxf(v, __shfl_xor(v, o));
    return v;
}

__device__ __forceinline__ int dest_row(int n0, int mode) {
    if (mode == 1) return (n0 >> 7) * 256 + (n0 & 127);
    if (mode == 2) return (n0 >> 7) * 256 + 128 + (n0 & 127);
    if (mode == 3 && n0 < 1280) return (n0 >> 8) * 256 + ((n0 >> 6) & 1) * 128 + ((n0 >> 7) & 1) * 64 + (n0 & 63);
    return n0;
}
__device__ __forceinline__ void p0_transpose_item(const float* W, int K, int N, bf16* WT, int mode, const float* gk, LAS float* scr, int item, int lane) {
    const int nblk = N / 32, kb = item / nblk, nb = item % nblk, k0 = 64 * kb, n0 = 32 * nb;
    const int kr = lane >> 3, nq = lane & 7;
    f32x4 v[8];
#pragma unroll
    for (int i = 0; i < 8; ++i) v[i] = *(const f32x4*)(W + (size_t)(k0 + 8 * i + kr) * N + n0 + 4 * nq);
#pragma unroll
    for (int i = 0; i < 8; ++i) { const float g = gk ? gk[k0 + 8 * i + kr] : 1.0f; LAS float* p = scr + (8 * i + kr) * 33 + 4 * nq;
        p[0] = v[i].x * g; p[1] = v[i].y * g; p[2] = v[i].z * g; p[3] = v[i].w * g; }
    LDS_WAIT(); asm volatile("" ::: "memory");
    const int c = lane & 7, r0 = dest_row(n0, mode);
#pragma unroll
    for (int j = 0; j < 4; ++j) { const int n = (lane >> 3) + 8 * j; const LAS float* s = scr + (8 * c) * 33 + n;
        v4u o; o.x = pk2(s[0 * 33], s[1 * 33]); o.y = pk2(s[2 * 33], s[3 * 33]); o.z = pk2(s[4 * 33], s[5 * 33]); o.w = pk2(s[6 * 33], s[7 * 33]);
        *(v4u*)(WT + (size_t)(r0 + n) * K + k0 + 8 * c) = o; }
    LDS_WAIT(); asm volatile("" ::: "memory");
}
__device__ __forceinline__ void row_to_bf16_rs(const float* xrow, bf16* orow, float* rs_out, int lane) {
    const f32x4* xr = (const f32x4*)xrow + lane;
    f32x4 v[8]; float s = 0.f;
#pragma unroll
    for (int j = 0; j < 8; ++j) { v[j] = xr[64 * j]; s += (v[j].x * v[j].x + v[j].y * v[j].y) + (v[j].z * v[j].z + v[j].w * v[j].w); }
    const float rs = 1.0f / sqrtf(wave_sum(s) * (1.0f / DM) + RMS_EPS);
    if (lane == 0) *rs_out = rs;
    unsigned long long* o8 = (unsigned long long*)orow + lane;
#pragma unroll
    for (int j = 0; j < 8; ++j) o8[64 * j] = (unsigned long long)pk2(v[j].x, v[j].y) | ((unsigned long long)pk2(v[j].z, v[j].w) << 32);
}
__device__ __forceinline__ void rms_row_to_bf16(const float* xrow, const float* g, bf16* orow, int lane) {
    const f32x4* xr = (const f32x4*)xrow + lane; const f32x4* gr = (const f32x4*)g + lane;
    f32x4 v[8]; float s = 0.f;
#pragma unroll
    for (int j = 0; j < 8; ++j) { v[j] = xr[64 * j]; s += (v[j].x * v[j].x + v[j].y * v[j].y) + (v[j].z * v[j].z + v[j].w * v[j].w); }
    const float rs = 1.0f / sqrtf(wave_sum(s) * (1.0f / DM) + RMS_EPS);
    unsigned long long* o8 = (unsigned long long*)orow + lane;
#pragma unroll
    for (int j = 0; j < 8; ++j) { const f32x4 gg = gr[64 * j];
        o8[64 * j] = (unsigned long long)pk2(v[j].x * rs * gg.x, v[j].y * rs * gg.y) | ((unsigned long long)pk2(v[j].z * rs * gg.z, v[j].w * rs * gg.w) << 32); }
}

typedef float f32x16 __attribute__((ext_vector_type(16)));
typedef short s16x8 __attribute__((ext_vector_type(8)));
typedef short s16x4 __attribute__((ext_vector_type(4)));
constexpr int ATT_KP = 272, ATT_VP = 264, ATT_V_OFF = 128 * ATT_KP, ATT_LDS = ATT_V_OFF + 128 * ATT_VP;
constexpr float LOG2E = 1.4426950408889634f;
template <bool WINDOW>
__device__ __forceinline__ void attn_unit(LAS unsigned char* lds, const bf16* qw, int qpitch, const bf16* kg, const bf16* vg, int kvpitch, int nblk,
                                          int qpos, int kpos, float m_init, float l_init, float qs, bf16* ow, int opitch, int tid, int lane) {
    const int r = lane & 31, h = lane >> 5;
    s16x8 qf[8];
#pragma unroll
    for (int kk = 0; kk < 8; ++kk) qf[kk] = *(const s16x8*)(qw + (size_t)r * qpitch + 16 * kk + 8 * h);
    f32x16 o[4];
#pragma unroll
    for (int dt = 0; dt < 4; ++dt)
#pragma unroll
        for (int i = 0; i < 16; ++i) o[dt][i] = 0.f;
    float m = m_init, l = (h == 0) ? l_init : 0.f;
    const int kkey = tid >> 4, kc = tid & 15, vkey = tid & 127, vcg = tid >> 7;
    for (int blk = 0; blk < nblk; ++blk) {
        v4u kreg[4], vreg[4];
#pragma unroll
        for (int it = 0; it < 4; ++it) { kreg[it] = *(const v4u*)(kg + (size_t)(blk * 128 + kkey + 32 * it) * kvpitch + kc * 8); vreg[it] = *(const v4u*)(vg + (size_t)(blk * 128 + vkey) * kvpitch + (vcg * 4 + it) * 8); }
        __syncthreads();
#pragma unroll
        for (int it = 0; it < 4; ++it) { *(LAS v4u*)(lds + (kkey + 32 * it) * ATT_KP + kc * 16) = kreg[it];
            LAS unsigned short* vt = (LAS unsigned short*)(lds + ATT_V_OFF) + (size_t)((vcg * 4 + it) * 8) * (ATT_VP / 2) + vkey;
            const v4u w = vreg[it];
            vt[0 * (ATT_VP / 2)] = (unsigned short)(w.x & 0xffffu); vt[1 * (ATT_VP / 2)] = (unsigned short)(w.x >> 16); vt[2 * (ATT_VP / 2)] = (unsigned short)(w.y & 0xffffu); vt[3 * (ATT_VP / 2)] = (unsigned short)(w.y >> 16);
            vt[4 * (ATT_VP / 2)] = (unsigned short)(w.z & 0xffffu); vt[5 * (ATT_VP / 2)] = (unsigned short)(w.z >> 16); vt[6 * (ATT_VP / 2)] = (unsigned short)(w.w & 0xffffu); vt[7 * (ATT_VP / 2)] = (unsigned short)(w.w >> 16); }
        __syncthreads();
#pragma unroll 1
        for (int hf = 0; hf < 2; ++hf) {
        f32x16 sc[2];
#pragma unroll
        for (int kt = 0; kt < 2; ++kt) {
#pragma unroll
            for (int i = 0; i < 16; ++i) sc[kt][i] = 0.f;
#pragma unroll
            for (int kk = 0; kk < 8; ++kk) { const s16x8 kf = *(const LAS s16x8*)(lds + (64 * hf + 32 * kt + r) * ATT_KP + (16 * kk + 8 * h) * 2); sc[kt] = __builtin_amdgcn_mfma_f32_32x32x16_bf16(kf, qf[kk], sc[kt], 0, 0, 0); }
        }
        float mb = -1e30f;
#pragma unroll
        for (int kt = 0; kt < 2; ++kt)
#pragma unroll
            for (int i = 0; i < 16; ++i) {
                if (!WINDOW) sc[kt][i] *= qs;
                if (WINDOW) { const int d = (kpos + blk * 128 + 64 * hf + 32 * kt + (i & 3) + 8 * (i >> 2) + 4 * h) - (qpos + r); if (d > 128 || d < -128) sc[kt][i] = -1e30f; }
                mb = fmaxf(mb, sc[kt][i]); }
        mb = fmaxf(mb, __shfl_xor(mb, 32));
        const float mn = fmaxf(m, mb), alpha = __builtin_amdgcn_exp2f((m - mn) * LOG2E), mo = mn * LOG2E;
        m = mn; l *= alpha;
#pragma unroll
        for (int dt = 0; dt < 4; ++dt) o[dt] = o[dt] * alpha;
        float ls = 0.f;
#pragma unroll
        for (int kt = 0; kt < 2; ++kt)
#pragma unroll
            for (int i = 0; i < 16; ++i) { const float p = __builtin_amdgcn_exp2f(sc[kt][i] * LOG2E - mo); sc[kt][i] = p; ls += p; }
        l += ls;
#pragma unroll
        for (int kt = 0; kt < 2; ++kt)
#pragma unroll
            for (int st = 0; st < 2; ++st) {
                v4u pw; pw.x = pg8::cvt_pk_bf16(sc[kt][8 * st + 0], sc[kt][8 * st + 1]); pw.y = pg8::cvt_pk_bf16(sc[kt][8 * st + 2], sc[kt][8 * st + 3]);
                pw.z = pg8::cvt_pk_bf16(sc[kt][8 * st + 4], sc[kt][8 * st + 5]); pw.w = pg8::cvt_pk_bf16(sc[kt][8 * st + 6], sc[kt][8 * st + 7]);
                const s16x8 pf = __builtin_bit_cast(s16x8, pw);
#pragma unroll
                for (int dt = 0; dt < 4; ++dt) { const LAS unsigned char* vp = lds + ATT_V_OFF + (32 * dt + r) * ATT_VP + (64 * hf + 32 * kt + 16 * st + 4 * h) * 2;
                    const s16x4 lo = *(const LAS s16x4*)vp, hi = *(const LAS s16x4*)(vp + 16);
                    const s16x8 vf = __builtin_shufflevector(lo, hi, 0, 1, 2, 3, 4, 5, 6, 7);
                    o[dt] = __builtin_amdgcn_mfma_f32_32x32x16_bf16(vf, pf, o[dt], 0, 0, 0); }
            }
        }
    }
    l += __shfl_xor(l, 32);
    const float inv = 1.0f / l;
    bf16* orow = ow + (size_t)r * opitch + 4 * h;
#pragma unroll
    for (int dt = 0; dt < 4; ++dt)
#pragma unroll
        for (int g = 0; g < 4; ++g) { unsigned long long w = (unsigned long long)pg8::cvt_pk_bf16(o[dt][4 * g] * inv, o[dt][4 * g + 1] * inv) | ((unsigned long long)pg8::cvt_pk_bf16(o[dt][4 * g + 2] * inv, o[dt][4 * g + 3] * inv) << 32);
            *(unsigned long long*)(orow + 32 * dt + 8 * g) = w; }
}

struct Args { const float* in[20]; float* out; unsigned char* ws; int ph_lo, ph_hi; };

__global__ void __launch_bounds__(NTHR, 2) mk_fwd(Args args) {
    extern __shared__ __attribute__((aligned(16))) unsigned char lds_raw[];
    LAS unsigned char* lds = (LAS unsigned char*)lds_raw;
    const int tid = threadIdx.x, lane = tid & 63, wave = __builtin_amdgcn_readfirstlane(tid >> 6);
    const int G = gridDim.x, bx = blockIdx.x;
    const int gw = bx * NWAVES + wave, NGW = G * NWAVES;
    unsigned char* ws = args.ws;
    const float* x = args.in[0]; const float* mem = args.in[1]; const float* g_mix = args.in[2]; const float* w_in = args.in[3]; const float* sink = args.in[4];
    const float* conv_w = args.in[5]; const float* b_gate = args.in[6]; const float* w_attn_out = args.in[7]; const float* w_conv_out = args.in[8]; const float* w_o = args.in[9];
    const float* g_cross = args.in[10]; const float* g_mem = args.in[11]; const float* w_cq = args.in[12]; const float* w_ckv = args.in[13]; const float* w_co = args.in[14];
    const float* g_ffn = args.in[15]; const float* w_gate = args.in[16]; const float* w_up = args.in[17]; const float* w_down = args.in[18]; const float* g_final = args.in[19];
    float* out = args.out;
    float* ssq2 = (float*)(ws + WS_SSQ); float* ssq3 = ssq2 + M * 8; float* ssq4 = ssq3 + M * 8;
    PG8_LAS float* xch = (PG8_LAS float*)(lds + pg8::STAGE_BYTES);
    float* cosT = (float*)(ws + WS_ROPE); float* sinT = cosT + SEQ * 64;
    bf16* Wt_in = (bf16*)(ws + WS_WIN); bf16* Wt_a = (bf16*)(ws + WS_WA); bf16* Wt_c = (bf16*)(ws + WS_WC); bf16* Wt_o = (bf16*)(ws + WS_WO);
    bf16* Wt_cq = (bf16*)(ws + WS_WCQ); bf16* Wt_ckv = (bf16*)(ws + WS_WCKV); bf16* Wt_co = (bf16*)(ws + WS_WCO); bf16* Wt_gu = (bf16*)(ws + WS_WGU); bf16* Wt_dn = (bf16*)(ws + WS_WDN);
    bf16* MEMN = (bf16*)(ws + WS_MEMN); bf16* MEMKV = (bf16*)(ws + WS_MEMKV);
    bf16* ZA = (bf16*)(ws + WS_ZA); bf16* ZG = (bf16*)(ws + WS_ZG); bf16* AO = (bf16*)(ws + WS_AO); bf16* CV = (bf16*)(ws + WS_CV);
    bf16* MG = (bf16*)(ws + WS_MG); bf16* X1B = (bf16*)(ws + WS_X1B); bf16* X3B = (bf16*)(ws + WS_X3B); bf16* XB = (bf16*)(ws + WS_XB); bf16* WOB = (bf16*)(ws + WS_WOB); bf16* WOQ = (bf16*)(ws + WS_WOQ); float* rs1 = (float*)(ws + WS_RS1); bf16* QC = (bf16*)(ws + WS_QC); bf16* CO = (bf16*)(ws + WS_CO);
    bf16* X2B = (bf16*)(ws + WS_X2B); bf16* ACT = (bf16*)(ws + WS_ACT);
    cg::grid_group grid = cg::this_grid();
    const int lo = args.ph_lo, hi = args.ph_hi;
#define IN(k) (lo <= (k) && (k) < hi)
#define SEAM(k) do { if (IN(k) && IN((k) + 1)) { asm volatile("s_waitcnt vmcnt(0) lgkmcnt(0)" ::: "memory"); __syncthreads(); grid.sync(); } } while (0)

    if (IN(0)) {
        LAS float* scr = (LAS float*)(lds + wave * 16384);
        constexpr int I_IN = (DM / 64) * (INW / 32), I_A = (1024 / 64) * (DM / 32), I_O = (DM / 64) * (DM / 32), I_CQ = (DM / 64) * (512 / 32), I_CKV = (DM / 64) * (1024 / 32),
                      I_CO = (512 / 64) * (DM / 32), I_G = (DM / 64) * (DFF / 32), I_D = (DFF / 64) * (DM / 32);
        constexpr int NITEMS = I_IN + 2 * I_A + I_O + I_CQ + I_CKV + I_CO + 2 * I_G + I_D;
        for (int it = gw; it < NITEMS; it += NGW) {
            int r = it;
            if (r < I_IN) { p0_transpose_item(w_in, DM, INW, Wt_in, 3, g_mix, scr, r, lane); continue; } r -= I_IN;
            if (r < I_A) { p0_transpose_item(w_attn_out, 1024, DM, Wt_a, 0, nullptr, scr, r, lane); continue; } r -= I_A;
            if (r < I_A) { p0_transpose_item(w_conv_out, 1024, DM, Wt_c, 0, nullptr, scr, r, lane); continue; } r -= I_A;
            if (r < I_O) { p0_transpose_item(w_o, DM, DM, Wt_o, 0, nullptr, scr, r, lane); continue; } r -= I_O;
            if (r < I_CQ) { p0_transpose_item(w_cq, DM, 512, Wt_cq, 0, g_cross, scr, r, lane); continue; } r -= I_CQ;
            if (r < I_CKV) { p0_transpose_item(w_ckv, DM, 1024, Wt_ckv, 0, nullptr, scr, r, lane); continue; } r -= I_CKV;
            if (r < I_CO) { p0_transpose_item(w_co, 512, DM, Wt_co, 0, nullptr, scr, r, lane); continue; } r -= I_CO;
            if (r < I_G) { p0_transpose_item(w_gate, DM, DFF, Wt_gu, 1, g_ffn, scr, r, lane); continue; } r -= I_G;
            if (r < I_G) { p0_transpose_item(w_up, DM, DFF, Wt_gu, 2, g_ffn, scr, r, lane); continue; } r -= I_G;
            p0_transpose_item(w_down, DFF, DM, Wt_dn, 0, nullptr, scr, r, lane);
        }
        for (int m = gw; m < M; m += NGW) row_to_bf16_rs(x + (size_t)m * DM, XB + (size_t)m * DM, rs1 + m, lane);
        for (int i = bx * NTHR + tid; i < DM * DM / 8; i += G * NTHR) { const f32x4 a = *(const f32x4*)(w_o + (size_t)i * 8), b = *(const f32x4*)(w_o + (size_t)i * 8 + 4); *(v4u*)(WOB + (size_t)i * 8) = pg8::pack8(a, b); }
        for (int m = gw; m < MROWS; m += NGW) rms_row_to_bf16(mem + (size_t)m * DM, g_mem, MEMN + (size_t)m * DM, lane);
        for (int i = bx * NTHR + tid; i < SEQ * 64; i += G * NTHR) { const int pos = i >> 6, j = i & 63;
            const float inv = exp2f(-(float)j * (13.287712379549449f / 64.0f)); const float ang = (float)pos * inv;
            cosT[i] = cosf(ang); sinT[i] = sinf(ang); }
    }
    SEAM(0);

    if (IN(1)) {
        { pg8::Gemm g{XB, Wt_in, nullptr, nullptr, M, INW, DM}; pg8::StaticOrder S; S.init(M, INW, G, bx);
          pg8::EpiIn E{ZA, ZG, cosT, sinT, b_gate, 0.08838834764831845f, rs1};
          pg8::gemm_phase<pg8::EpiIn, pg8::StaticOrder>(lds, g, S, E); }
        { pg8::Gemm g{MEMN, Wt_ckv, nullptr, nullptr, MROWS, 1024, DM}; pg8::StaticOrder S; S.init(MROWS, 1024, G, (bx + G / 2) % G);
          pg8::EpiBf16 E{MEMKV, 1024};
          pg8::gemm_phase<pg8::EpiBf16, pg8::StaticOrder>(lds, g, S, E); }
        { pg8::Gemm g{Wt_cq, WOB, nullptr, nullptr, 512, DM, DM}; pg8::StaticOrder S; S.init(512, DM, G, (bx + G / 2 - 32 + G) % G);
          pg8::EpiBf16 E{WOQ, DM};
          pg8::gemm_phase<pg8::EpiBf16, pg8::StaticOrder>(lds, g, S, E); }
    }
    SEAM(1);

    if (IN(2)) {
        for (int it = 2 * bx; it < 512; it += 2 * G)
            for (int hp = 0; hp < 2; ++hp) { const int kvh = it >> 1 & 1, nb = (it >> 2) & 15, b = it >> 6;
                const int hq = kvh * 4 + hp * 2 + (wave >> 2), t0 = b * SEQ + nb * 128 + (wave & 3) * 32;
                const int kb0 = nb > 0 ? nb - 1 : 0, kb1 = nb < 15 ? nb + 1 : 15; const size_t kt0 = (size_t)b * SEQ + kb0 * 128;
                attn_unit<true>(lds, ZA + (size_t)t0 * ZAW + hq * 128, ZAW, ZA + kt0 * ZAW + 1024 + kvh * 128, ZA + kt0 * ZAW + 1280 + kvh * 128, ZAW, kb1 - kb0 + 1,
                                nb * 128 + (wave & 3) * 32, kb0 * 128, sink[hq], 1.0f, 1.0f, AO + (size_t)t0 * 1024 + hq * 128, 1024, tid, lane); }
        __syncthreads();
        for (int idx = bx * NTHR + tid; idx < (M / 16) * 128; idx += G * NTHR) { const int run = idx >> 7, c8 = (idx & 127) * 8, t0 = run * 16, s0 = t0 & (SEQ - 1);
            const f32x4 w0a = *(const f32x4*)(conv_w + c8), w0b = *(const f32x4*)(conv_w + c8 + 4), w1a = *(const f32x4*)(conv_w + 1024 + c8), w1b = *(const f32x4*)(conv_w + 1024 + c8 + 4),
                        w2a = *(const f32x4*)(conv_w + 2048 + c8), w2b = *(const f32x4*)(conv_w + 2048 + c8 + 4);
            const bf16* zr = ZA + (size_t)t0 * ZAW + c8;
            f32x4 pa = {0.f, 0.f, 0.f, 0.f}, pb = pa, ca, cb, ta, tb;
            if (s0 > 0) { pg8::unpack8(*(const v4u*)(zr - ZAW + 1536), pa, pb); pg8::unpack8(*(const v4u*)(zr - ZAW + 3584), ta, tb); pa = pa * ta; pb = pb * tb; }
            pg8::unpack8(*(const v4u*)(zr + 1536), ca, cb); pg8::unpack8(*(const v4u*)(zr + 3584), ta, tb); ca = ca * ta; cb = cb * tb;
#pragma unroll
            for (int i = 0; i < 16; ++i) { f32x4 na = {0.f, 0.f, 0.f, 0.f}, nbv = na, ga, gb;
                if (i < 15 || s0 + 16 < SEQ) { pg8::unpack8(*(const v4u*)(zr + (size_t)(i + 1) * ZAW + 1536), na, nbv); pg8::unpack8(*(const v4u*)(zr + (size_t)(i + 1) * ZAW + 3584), ta, tb); na = na * ta; nbv = nbv * tb; }
                pg8::unpack8(*(const v4u*)(zr + (size_t)i * ZAW + 2560), ga, gb);
                *(v4u*)(CV + (size_t)(t0 + i) * 1024 + c8) = pg8::pack8(ga * (w0a * pa + w1a * ca + w2a * na), gb * (w0b * pb + w1b * cb + w2b * nbv));
                pa = ca; pb = cb; ca = na; cb = nbv; }
        }
    }
    SEAM(2);

    if (IN(3)) {
        pg8::Gemm g{AO, Wt_a, CV, Wt_c, M, DM, 1024}; pg8::StaticOrder S; S.init(M, DM, G, bx, 2);
        pg8::EpiMerge E{ZG, MG};
        pg8::gemm_phase<pg8::EpiMerge, pg8::StaticOrder>(lds, g, S, E);
    }
    SEAM(3);

    if (IN(4)) {
        { pg8::Gemm g{XB, Wt_cq, MG, WOQ, M, 512, DM}; pg8::ListOrder S{bx, bx < 128 ? 1 : 0, 2, 2};
          pg8::EpiAcc2 E{QC, 512};
          pg8::gemm_phase<pg8::EpiAcc2, pg8::ListOrder>(lds, g, S, E); }
        { pg8::Gemm g{MG, Wt_o, nullptr, nullptr, M, DM, DM}; pg8::ListOrder S{bx < 128 ? bx : 128 + (bx - 128) * 3, bx < 128 ? 1 : 3, 8, 1};
          pg8::EpiResB E{XB, X1B, ssq2, xch};
          pg8::gemm_phase<pg8::EpiResB, pg8::ListOrder>(lds, g, S, E); }
    }
    SEAM(4);

    if (IN(6)) {
        for (int it = bx; it < 256; it += G) { const int rb = it & 7, hh = (it >> 3) & 3, b = it >> 5; const int t0 = b * SEQ + rb * 256 + wave * 32;
            attn_unit<false>(lds, QC + (size_t)t0 * 512 + hh * 128, 512, MEMKV + (size_t)(b * NMEM) * 1024 + hh * 128, MEMKV + (size_t)(b * NMEM) * 1024 + 512 + hh * 128, 1024, 2,
                             0, 0, -1e30f, 0.0f, pg8::row_rs(ssq2, t0 + (lane & 31)) * 0.08838834764831845f, CO + (size_t)t0 * 512 + hh * 128, 512, tid, lane); }
    }
    SEAM(6);

    if (IN(7)) {
        pg8::Gemm g{CO, Wt_co, nullptr, nullptr, M, DM, 512}; pg8::StaticOrder S; S.init(M, DM, G, bx);
        pg8::EpiResB E{X1B, X2B, ssq3, xch};
        pg8::gemm_phase<pg8::EpiResB, pg8::StaticOrder>(lds, g, S, E);
    }
    SEAM(7);

    if (IN(8)) {
        pg8::Gemm g{X2B, Wt_gu, nullptr, nullptr, M, 2 * DFF, DM}; pg8::StaticOrder S; S.init(M, 2 * DFF, G, bx);
        pg8::EpiSwiGLU E{ACT, ssq3};
        pg8::gemm_phase<pg8::EpiSwiGLU, pg8::StaticOrder>(lds, g, S, E);
    }
    SEAM(8);

    if (IN(9)) {
        pg8::Gemm g{ACT, Wt_dn, nullptr, nullptr, M, DM, DFF}; pg8::StaticOrder S; S.init(M, DM, G, bx);
        pg8::EpiResB E{X2B, X3B, ssq4, xch};
        pg8::gemm_phase<pg8::EpiResB, pg8::StaticOrder>(lds, g, S, E);
    }
    SEAM(9);

    if (IN(10)) {
        for (int m = gw; m < M; m += NGW) { const v4u* xr = (const v4u*)(X3B + (size_t)m * DM) + lane; f32x4* orow = (f32x4*)(out + (size_t)m * DM); const f32x4* gr = (const f32x4*)g_final;
            const float rs = pg8::row_rs(ssq4, m);
#pragma unroll
            for (int j = 0; j < 4; ++j) { f32x4 a, b; pg8::unpack8(xr[64 * j], a, b); const int c = (64 * j + lane) * 2;
                orow[c] = a * rs * gr[c]; orow[c + 1] = b * rs * gr[c + 1]; } }
    }
#if defined(MK_DUMP_OFF)
    if (hi == MK_CUT && MK_CUT < 11) {
        asm volatile("s_waitcnt vmcnt(0) lgkmcnt(0)" ::: "memory"); __syncthreads(); grid.sync();
        const bf16* src = (const bf16*)(ws + (size_t)(MK_DUMP_OFF));
        for (size_t i = (size_t)bx * NTHR + tid; i < (size_t)M * 2048; i += (size_t)G * NTHR) { const size_t r = i >> 11, c = i & 2047; out[i] = __uint_as_float((unsigned)src[r * (MK_DUMP_LD) + (c % (MK_DUMP_W)) + (c / (MK_DUMP_W)) * (size_t)(MK_DUMP_OFF2)] << 16); }
    }
#endif
#undef IN
#undef SEAM
}

extern "C" void kernel_launch(void* const* d_in, const int* in_sizes, int n_in, void* d_out, int out_size, void* d_ws, size_t ws_size, hipStream_t stream) {
    static int grid = 0;
    if (grid == 0) {
        if (n_in != 20 || in_sizes[0] != M * DM || out_size != M * DM || ws_size < WS_END) { fprintf(stderr, "kernel_launch: unexpected shapes / workspace (n_in %d, ws %zu)\n", n_in, ws_size); grid = -1; return; }
        int dev = 0, cus = 0, per_cu = 0;
        if (hipGetDevice(&dev) != hipSuccess || hipDeviceGetAttribute(&cus, hipDeviceAttributeMultiprocessorCount, dev) != hipSuccess) { grid = -1; return; }
        if (hipFuncSetAttribute((const void*)mk_fwd, hipFuncAttributeMaxDynamicSharedMemorySize, LDS_BYTES) != hipSuccess) { fprintf(stderr, "kernel_launch: hipFuncSetAttribute failed\n"); grid = -1; return; }
        if (hipOccupancyMaxActiveBlocksPerMultiprocessor(&per_cu, (const void*)mk_fwd, NTHR, LDS_BYTES) != hipSuccess || per_cu < 1) { fprintf(stderr, "kernel_launch: occupancy query says %d\n", per_cu); (void)hipGetLastError(); grid = -1; return; }
        grid = cus;
    }
    if (grid < 0) return;
    Args a{};
    for (int i = 0; i < 20; ++i) a.in[i] = (const float*)d_in[i];
    a.out = (float*)d_out; a.ws = (unsigned char*)d_ws;
#if defined(MK_PROBE_DUP)
    { void* kargs[] = {&a}; a.ph_lo = 0; a.ph_hi = MK_PROBE_DUP + 1; hipLaunchCooperativeKernel((const void*)mk_fwd, dim3(grid), dim3(NTHR), kargs, LDS_BYTES, stream);
      a.ph_lo = MK_PROBE_DUP; a.ph_hi = 11; hipLaunchCooperativeKernel((const void*)mk_fwd, dim3(grid), dim3(NTHR), kargs, LDS_BYTES, stream); }
#elif MK_N_LAUNCHES == 1
    a.ph_lo = 0; a.ph_hi = MK_CUT;
    void* kargs[] = {&a};
    hipError_t e = hipLaunchCooperativeKernel((const void*)mk_fwd, dim3(grid), dim3(NTHR), kargs, LDS_BYTES, stream);
    if (e != hipSuccess) fprintf(stderr, "kernel_launch: cooperative launch failed: %s (grid %d)\n", hipGetErrorString(e), grid);
#else
    for (int p = 0; p < 11; ++p) { a.ph_lo = p; a.ph_hi = p + 1; hipLaunchKernelGGL(mk_fwd, dim3(grid), dim3(NTHR), LDS_BYTES, stream, a); }
#endif
}
```

```cpp
#include <hip/hip_runtime.h>
#include <hip/hip_cooperative_groups.h>
#include <cstdio>
#include <cstdint>
namespace cg = cooperative_groups;

#ifndef MK_CUT
#define MK_CUT 11
#endif
#ifndef MK_N_LAUNCHES
#define MK_N_LAUNCHES 1
#endif

namespace pg8 {
#define PG8_LAS __attribute__((address_space(3)))
typedef unsigned short bf16_t;
typedef short bf16x8 __attribute__((ext_vector_type(8)));
typedef float f32x4 __attribute__((ext_vector_type(4)));
typedef unsigned u32x4 __attribute__((ext_vector_type(4)));
constexpr int BM = 256, BK = 64, HALF = 128, HTB = HALF * BK * 2, STAGE_BYTES = 8 * HTB, NXCD = 8, WGM = 8;

__host__ __device__ __forceinline__ int lds_byte(int r, int c) { const int st = (r >> 4) * 2 + (c >> 5), rr = r & 15, cc = c & 31, ob = rr * 64 + cc * 2; return st * 1024 + (ob ^ (((ob >> 9) & 1) << 5)); }
__host__ __device__ __forceinline__ void stage_rc(int b, int& R, int& C) { const int st = b / 1024, sb = b % 1024, swz = sb ^ (((sb >> 9) & 1) << 5); R = (st >> 1) * 16 + swz / 64; C = (st & 1) * 32 + (swz % 64) / 2; }
__host__ __device__ __forceinline__ int perm32(int rho) { const int n = rho >> 4, i = rho & 15; return 8 * (i >> 2) + 4 * n + (i & 3); }

struct Unit { int pm, pn, seg; };
struct Gemm { const bf16_t* A0; const bf16_t* B0; const bf16_t* A1; const bf16_t* B1; int M, N, K; };

struct StaticOrder {
    int nM, nN, nwg, G, c, nseg;
    __device__ void init(int M, int N, int G_, int c_, int nseg_ = 1) { nM = M / BM; nN = N / BM; nwg = nM * nN; G = G_; c = c_; nseg = nseg_; }
    __device__ bool next(int i, Unit& u) const {
        const int j = (nseg == 2) ? (i >> 1) : i; u.seg = (nseg == 2) ? (i & 1) : 0;
        const long L = (long)j * G + c; if (L >= nwg) return false;
        int wgid = (int)L; { const int q = nwg / NXCD, r = nwg % NXCD, xcd = wgid % NXCD, off = wgid / NXCD; wgid = (xcd < r ? xcd * (q + 1) : r * (q + 1) + (xcd - r) * q) + off; }
        const int nig = WGM * nN, gid = wgid / nig, fm = gid * WGM, gsz = (nM - fm) < WGM ? (nM - fm) : WGM;
        u.pm = fm + ((wgid % nig) % gsz); u.pn = (wgid % nig) / gsz; return true;
    }
};

typedef __bf16 bf16x2_t __attribute__((ext_vector_type(2)));
typedef float f32x2_t __attribute__((ext_vector_type(2)));
struct ListOrder {
    int first, count, nN, nseg;
    __device__ bool next(int i, Unit& u) const { const int j = (nseg == 2) ? (i >> 1) : i; u.seg = (nseg == 2) ? (i & 1) : 0; if (j >= count) return false; const int L = first + j; u.pm = L / nN; u.pn = L % nN; return true; }
};
__device__ __forceinline__ unsigned cvt_pk_bf16(float lo, float hi) { const f32x2_t v = {lo, hi}; const bf16x2_t r = __builtin_convertvector(v, bf16x2_t); return __builtin_bit_cast(unsigned, r); }
__device__ __forceinline__ u32x4 pack8(const f32x4 a, const f32x4 b) { u32x4 w; w.x = cvt_pk_bf16(a[0], a[1]); w.y = cvt_pk_bf16(a[2], a[3]); w.z = cvt_pk_bf16(b[0], b[1]); w.w = cvt_pk_bf16(b[2], b[3]); return w; }
__device__ __forceinline__ void unpack8(const u32x4 w, f32x4& a, f32x4& b) {
    a[0] = __uint_as_float(w.x << 16); a[1] = __uint_as_float(w.x & 0xffff0000u); a[2] = __uint_as_float(w.y << 16); a[3] = __uint_as_float(w.y & 0xffff0000u);
    b[0] = __uint_as_float(w.z << 16); b[1] = __uint_as_float(w.z & 0xffff0000u); b[2] = __uint_as_float(w.w << 16); b[3] = __uint_as_float(w.w & 0xffff0000u); }
__device__ __forceinline__ f32x4 sigmoid4(const f32x4 v) { f32x4 o;
#pragma unroll
    for (int i = 0; i < 4; ++i) o[i] = __builtin_amdgcn_rcpf(1.0f + __expf(-v[i]));
    return o; }

typedef f32x4 Acc[2][2][4][2];

struct EpiBf16 {
    static constexpr bool PERM = true, KEEP_ACC = false;
    bf16_t* O; int ldc;
    __device__ __forceinline__ void operator()(Acc& acc, const Unit& u, int wr, int wc, int fr, int fq) const {
        const int row0 = u.pm * BM + wr * 64 + fr, col0 = u.pn * BM + wc * 32 + 8 * fq;
#pragma unroll
        for (int ai = 0; ai < 2; ++ai)
#pragma unroll
            for (int m = 0; m < 4; ++m) { bf16_t* rowp = O + (size_t)(row0 + ai * HALF + m * 16) * ldc + col0;
#pragma unroll
                for (int bj = 0; bj < 2; ++bj) *(u32x4*)(rowp + bj * HALF) = pack8(acc[ai][bj][m][0], acc[ai][bj][m][1]); }
    }
};
struct EpiIn {
    static constexpr bool PERM = true, KEEP_ACC = false;
    bf16_t* ZA; bf16_t* ZG; const float* cosT; const float* sinT; const float* bgate; float qscale; const float* rs1;
    __device__ __forceinline__ void operator()(Acc& acc, const Unit& u, int wr, int wc, int fr, int fq) const {
        const int row0 = u.pm * BM + wr * 64 + fr;
#pragma unroll
        for (int ai = 0; ai < 2; ++ai)
#pragma unroll
            for (int m = 0; m < 4; ++m) { const float rs = rs1[row0 + ai * HALF + m * 16];
#pragma unroll
                for (int bj = 0; bj < 2; ++bj) { acc[ai][bj][m][0] = acc[ai][bj][m][0] * rs; acc[ai][bj][m][1] = acc[ai][bj][m][1] * rs; } }
        if (u.pn < 5) {
            const int p = wc * 32 + 8 * fq, hb = p >> 6, j0 = p & 63, c1 = u.pn * 256 + hb * 128 + j0;
            const float sc = u.pn < 4 ? qscale : 1.0f;
#pragma unroll
            for (int ai = 0; ai < 2; ++ai)
#pragma unroll
                for (int m = 0; m < 4; ++m) { const int row = row0 + ai * HALF + m * 16, pos = row & 2047;
                    const f32x4 ca = *(const f32x4*)(cosT + pos * 64 + j0), cb = *(const f32x4*)(cosT + pos * 64 + j0 + 4);
                    const f32x4 sa = *(const f32x4*)(sinT + pos * 64 + j0), sb = *(const f32x4*)(sinT + pos * 64 + j0 + 4);
                    const f32x4 t1a = acc[ai][0][m][0], t1b = acc[ai][0][m][1], t2a = acc[ai][1][m][0], t2b = acc[ai][1][m][1];
                    const f32x4 o1a = (t1a * ca - t2a * sa) * sc, o1b = (t1b * cb - t2b * sb) * sc, o2a = (t2a * ca + t1a * sa) * sc, o2b = (t2b * cb + t1b * sb) * sc;
                    bf16_t* rp = ZA + (size_t)row * 4608 + c1;
                    *(u32x4*)rp = pack8(o1a, o1b); *(u32x4*)(rp + 64) = pack8(o2a, o2b); }
        } else if (u.pn < 18) {
            const int col0 = u.pn * BM + wc * 32 + 8 * fq;
#pragma unroll
            for (int ai = 0; ai < 2; ++ai)
#pragma unroll
                for (int m = 0; m < 4; ++m) { bf16_t* rowp = ZA + (size_t)(row0 + ai * HALF + m * 16) * 4608 + col0;
#pragma unroll
                    for (int bj = 0; bj < 2; ++bj) *(u32x4*)(rowp + bj * HALF) = pack8(acc[ai][bj][m][0], acc[ai][bj][m][1]); }
        } else {
            const int col0 = (u.pn - 18) * BM + wc * 32 + 8 * fq;
#pragma unroll
            for (int bj = 0; bj < 2; ++bj) { const f32x4 b0 = *(const f32x4*)(bgate + col0 + bj * HALF), b1 = *(const f32x4*)(bgate + col0 + bj * HALF + 4);
#pragma unroll
                for (int ai = 0; ai < 2; ++ai)
#pragma unroll
                    for (int m = 0; m < 4; ++m) { bf16_t* rowp = ZG + (size_t)(row0 + ai * HALF + m * 16) * 4096 + col0 + bj * HALF;
                        *(u32x4*)rowp = pack8(sigmoid4(acc[ai][bj][m][0] + b0), sigmoid4(acc[ai][bj][m][1] + b1)); } }
        }
    }
};
struct EpiAcc2 {
    static constexpr bool PERM = true, KEEP_ACC = true;
    bf16_t* O; int ldc;
    __device__ __forceinline__ void operator()(Acc& acc, const Unit& u, int wr, int wc, int fr, int fq) const {
        if (u.seg == 0) return;
        const int row0 = u.pm * BM + wr * 64 + fr, col0 = u.pn * BM + wc * 32 + 8 * fq;
#pragma unroll
        for (int ai = 0; ai < 2; ++ai)
#pragma unroll
            for (int m = 0; m < 4; ++m) { bf16_t* rowp = O + (size_t)(row0 + ai * HALF + m * 16) * ldc + col0;
#pragma unroll
                for (int bj = 0; bj < 2; ++bj) *(u32x4*)(rowp + bj * HALF) = pack8(acc[ai][bj][m][0], acc[ai][bj][m][1]); }
    }
};
struct EpiMerge {
    static constexpr bool PERM = true, KEEP_ACC = true;
    const bf16_t* ZG; bf16_t* O;
    __device__ __forceinline__ void operator()(Acc& acc, const Unit& u, int wr, int wc, int fr, int fq) const {
        const int row0 = u.pm * BM + wr * 64 + fr, col0 = u.pn * BM + wc * 32 + 8 * fq;
#pragma unroll
        for (int ai = 0; ai < 2; ++ai)
#pragma unroll
            for (int m = 0; m < 4; ++m) { const int row = row0 + ai * HALF + m * 16;
#pragma unroll
                for (int bj = 0; bj < 2; ++bj) { const bf16_t* gp = ZG + (size_t)row * 4096 + col0 + bj * HALF;
                    f32x4 c0, c1; unpack8(*(const u32x4*)(gp + 2048), c0, c1);
                    if (u.seg == 0) { f32x4 a0, a1; unpack8(*(const u32x4*)gp, a0, a1);
#pragma unroll
                        for (int i = 0; i < 4; ++i) { acc[ai][bj][m][0][i] *= a0[i] * __builtin_amdgcn_rcpf(c0[i]); acc[ai][bj][m][1][i] *= a1[i] * __builtin_amdgcn_rcpf(c1[i]); }
                    } else { *(u32x4*)(O + (size_t)row * 2048 + col0 + bj * HALF) = pack8(acc[ai][bj][m][0] * c0, acc[ai][bj][m][1] * c1); } } }
    }
};
struct EpiRes {
    static constexpr bool PERM = true, KEEP_ACC = false;
    const float* base; float* out; bf16_t* outb; float* part; PG8_LAS float* xch;
    __device__ __forceinline__ void operator()(Acc& acc, const Unit& u, int wr, int wc, int fr, int fq) const {
        const int row0 = u.pm * BM + wr * 64 + fr, col0 = u.pn * BM + wc * 32 + 8 * fq;
#pragma unroll
        for (int ai = 0; ai < 2; ++ai)
#pragma unroll
            for (int m = 0; m < 4; ++m) { const int row = row0 + ai * HALF + m * 16; float ss = 0.f;
#pragma unroll
                for (int bj = 0; bj < 2; ++bj) { const size_t off = (size_t)row * 2048 + col0 + bj * HALF;
                    const f32x4 o0 = *(const f32x4*)(base + off) + acc[ai][bj][m][0], o1 = *(const f32x4*)(base + off + 4) + acc[ai][bj][m][1];
                    *(f32x4*)(out + off) = o0; *(f32x4*)(out + off + 4) = o1;
                    if (outb) *(u32x4*)(outb + off) = pack8(o0, o1);
                    ss += (o0[0] * o0[0] + o0[1] * o0[1]) + (o0[2] * o0[2] + o0[3] * o0[3]) + (o1[0] * o1[0] + o1[1] * o1[1]) + (o1[2] * o1[2] + o1[3] * o1[3]); }
                ss += __shfl_xor(ss, 16); ss += __shfl_xor(ss, 32);
                if (fq == 0) xch[(ai * HALF + wr * 64 + m * 16 + fr) * 4 + wc] = ss; }
        asm volatile("s_waitcnt lgkmcnt(0)" ::: "memory"); __builtin_amdgcn_s_barrier(); asm volatile("" ::: "memory");
        { const int t = threadIdx.x; if (t < 256) { const f32x4 v = *(const PG8_LAS f32x4*)(xch + t * 4); part[(size_t)(u.pm * BM + t) * 8 + u.pn] = (v[0] + v[1]) + (v[2] + v[3]); } }
        asm volatile("s_waitcnt lgkmcnt(0)" ::: "memory"); __builtin_amdgcn_s_barrier(); asm volatile("" ::: "memory");
    }
};
struct EpiResB {
    static constexpr bool PERM = true, KEEP_ACC = false;
    const bf16_t* base; bf16_t* outb; float* part; PG8_LAS float* xch;
    __device__ __forceinline__ void operator()(Acc& acc, const Unit& u, int wr, int wc, int fr, int fq) const {
        const int row0 = u.pm * BM + wr * 64 + fr, col0 = u.pn * BM + wc * 32 + 8 * fq;
#pragma unroll
        for (int ai = 0; ai < 2; ++ai)
#pragma unroll
            for (int m = 0; m < 4; ++m) { const int row = row0 + ai * HALF + m * 16; float ss = 0.f;
#pragma unroll
                for (int bj = 0; bj < 2; ++bj) { const size_t off = (size_t)row * 2048 + col0 + bj * HALF;
                    f32x4 b0, b1; unpack8(*(const u32x4*)(base + off), b0, b1);
                    const f32x4 o0 = b0 + acc[ai][bj][m][0], o1 = b1 + acc[ai][bj][m][1];
                    *(u32x4*)(outb + off) = pack8(o0, o1);
                    ss += (o0[0] * o0[0] + o0[1] * o0[1]) + (o0[2] * o0[2] + o0[3] * o0[3]) + (o1[0] * o1[0] + o1[1] * o1[1]) + (o1[2] * o1[2] + o1[3] * o1[3]); }
                ss += __shfl_xor(ss, 16); ss += __shfl_xor(ss, 32);
                if (fq == 0) xch[(ai * HALF + wr * 64 + m * 16 + fr) * 4 + wc] = ss; }
        asm volatile("s_waitcnt lgkmcnt(0)" ::: "memory"); __builtin_amdgcn_s_barrier(); asm volatile("" ::: "memory");
        { const int t = threadIdx.x; if (t < 256) { const f32x4 v = *(const PG8_LAS f32x4*)(xch + t * 4); part[(size_t)(u.pm * BM + t) * 8 + u.pn] = (v[0] + v[1]) + (v[2] + v[3]); } }
        asm volatile("s_waitcnt lgkmcnt(0)" ::: "memory"); __builtin_amdgcn_s_barrier(); asm volatile("" ::: "memory");
    }
};
__device__ __forceinline__ float row_rs(const float* part, int row) { const f32x4 a = *(const f32x4*)(part + (size_t)row * 8), b = *(const f32x4*)(part + (size_t)row * 8 + 4);
    return __builtin_amdgcn_rsqf((((a[0] + a[1]) + (a[2] + a[3])) + ((b[0] + b[1]) + (b[2] + b[3]))) * (1.0f / 2048.0f) + 1e-6f); }
struct EpiRowScale {
    static constexpr bool PERM = true, KEEP_ACC = false;
    bf16_t* O; int ldc; const float* ssq; float scale;
    __device__ __forceinline__ void operator()(Acc& acc, const Unit& u, int wr, int wc, int fr, int fq) const {
        const int row0 = u.pm * BM + wr * 64 + fr, col0 = u.pn * BM + wc * 32 + 8 * fq;
#pragma unroll
        for (int ai = 0; ai < 2; ++ai)
#pragma unroll
            for (int m = 0; m < 4; ++m) { const int row = row0 + ai * HALF + m * 16; const float rs = row_rs(ssq, row) * scale;
                bf16_t* rowp = O + (size_t)row * ldc + col0;
#pragma unroll
                for (int bj = 0; bj < 2; ++bj) *(u32x4*)(rowp + bj * HALF) = pack8(acc[ai][bj][m][0] * rs, acc[ai][bj][m][1] * rs); }
    }
};
struct EpiSwiGLU {
    static constexpr bool PERM = true, KEEP_ACC = false;
    bf16_t* O; const float* ssq;
    __device__ __forceinline__ void operator()(Acc& acc, const Unit& u, int wr, int wc, int fr, int fq) const {
        const int row0 = u.pm * BM + wr * 64 + fr, col0 = u.pn * HALF + wc * 32 + 8 * fq;
#pragma unroll
        for (int ai = 0; ai < 2; ++ai)
#pragma unroll
            for (int m = 0; m < 4; ++m) { const int row = row0 + ai * HALF + m * 16; const float rs = row_rs(ssq, row);
                const f32x4 g0 = acc[ai][0][m][0] * rs, g1 = acc[ai][0][m][1] * rs, u0 = acc[ai][1][m][0] * rs, u1 = acc[ai][1][m][1] * rs;
                *(u32x4*)(O + (size_t)row * 5632 + col0) = pack8(g0 * sigmoid4(g0) * u0, g1 * sigmoid4(g1) * u1); }
    }
};

template <class Epi, class Sched, bool ALIGN_EPI = true>
__device__ __forceinline__ void gemm_phase(PG8_LAS unsigned char* lds, const Gemm g, const Sched& S, const Epi& E) {
    const int tid = threadIdx.x, wid = __builtin_amdgcn_readfirstlane(tid >> 6), lane = tid & 63, wr = wid >> 2, wc = wid & 3, fr = lane & 15, fq = lane >> 4;
    const int K = g.K, nt = K / BK;
    unsigned voffA[2], voffB[2];
#pragma unroll
    for (int i = 0; i < 2; ++i) { int R, C; stage_rc(tid * 16 + i * 8192, R, C); const int Rb = Epi::PERM ? ((R & ~31) + perm32(R & 31)) : R;
        voffA[i] = (unsigned)(R * K + C) * 2u; voffB[i] = (unsigned)(Rb * K + C) * 2u; }
    const size_t kstep = (size_t)(BK * 2);
    const size_t hstep = (size_t)HALF * K * 2;
    const size_t tstep = 2 * hstep;
    const unsigned ldsw = (unsigned)wid * 1024u;
    const int aoff = lds_byte(wr * 64 + fr, fq * 8), boff = lds_byte(wc * 32 + fr, fq * 8);
#define PG8_SA(b, h) (((b) * 2 + (h)) * HTB)
#define PG8_SB(b, h) ((4 + (b) * 2 + (h)) * HTB)
#define PG8_STAGE(bufoff, gbase, voff) do { _Pragma("unroll") for (int _i = 0; _i < 2; ++_i) \
        __builtin_amdgcn_global_load_lds((const unsigned*)((const char*)(gbase) + (voff)[_i]), (PG8_LAS unsigned*)(lds + (bufoff) + ldsw + _i * 8192), 16, 0, 0); } while (0)
#define PG8_LDA(dst, b, h) do { _Pragma("unroll") for (int m = 0; m < 4; ++m) _Pragma("unroll") for (int k = 0; k < 2; ++k) dst[m][k] = *(const PG8_LAS bf16x8*)(lds + PG8_SA(b, h) + aoff + m * 2048 + k * 1024); } while (0)
#define PG8_LDB(dst, b, h) do { _Pragma("unroll") for (int n = 0; n < 2; ++n) _Pragma("unroll") for (int k = 0; k < 2; ++k) dst[n][k] = *(const PG8_LAS bf16x8*)(lds + PG8_SB(b, h) + boff + n * 2048 + k * 1024); } while (0)
#define PG8_MMA(ai, bj, At, Bt) do { __builtin_amdgcn_s_setprio(1); _Pragma("unroll") for (int m = 0; m < 4; ++m) _Pragma("unroll") for (int n = 0; n < 2; ++n) _Pragma("unroll") for (int k = 0; k < 2; ++k) \
        acc[ai][bj][m][n] = __builtin_amdgcn_mfma_f32_16x16x32_bf16(Bt[n][k], At[m][k], acc[ai][bj][m][n], 0, 0, 0); __builtin_amdgcn_s_setprio(0); } while (0)
#define PG8_WAIT_V(n) asm volatile("s_waitcnt vmcnt(" #n ")" ::: "memory")
#define PG8_WAIT_L(n) asm volatile("s_waitcnt lgkmcnt(" #n ")" ::: "memory")
#define PG8_BAR __builtin_amdgcn_s_barrier()
#define PG8_SCHED __builtin_amdgcn_sched_barrier(0)
#define PG8_UA(u) ((const char*)((u).seg ? g.A1 : g.A0) + (size_t)(u).pm * tstep)
#define PG8_UB(u) ((const char*)((u).seg ? g.B1 : g.B0) + (size_t)(u).pn * tstep)
    Unit cur, nxt; int ui = 0;
    if (!S.next(0, cur)) return;
    Acc acc;
#pragma unroll
    for (int a = 0; a < 2; ++a)
#pragma unroll
        for (int b = 0; b < 2; ++b)
#pragma unroll
            for (int m = 0; m < 4; ++m)
#pragma unroll
                for (int n = 0; n < 2; ++n) acc[a][b][m][n] = (f32x4){0.f, 0.f, 0.f, 0.f};
    bf16x8 At[4][2], B0[2][2], B1[2][2];
    const char* cA = PG8_UA(cur); const char* cB = PG8_UB(cur);
    PG8_STAGE(PG8_SB(0, 0), cB, voffB); PG8_STAGE(PG8_SB(0, 1), cB + hstep, voffB); PG8_STAGE(PG8_SA(0, 0), cA, voffA); PG8_STAGE(PG8_SA(0, 1), cA + hstep, voffA);
    if (wr == 1) PG8_BAR;
    PG8_WAIT_V(2); PG8_BAR;
    PG8_STAGE(PG8_SB(1, 0), cB + kstep, voffB); PG8_STAGE(PG8_SA(1, 0), cA + kstep, voffA); PG8_STAGE(PG8_SB(1, 1), cB + hstep + kstep, voffB);
    PG8_WAIT_V(6); PG8_BAR;
    for (;;) {
        const bool has_next = S.next(ui + 1, nxt);
        const char* nA = has_next ? PG8_UA(nxt) : cA; const char* nB = has_next ? PG8_UB(nxt) : cB;
        for (int t = 0; t < nt; t += 2) {
            const bool last = (t == nt - 2);
            const char* a1 = cA + (size_t)(t + 1) * kstep;
            const char* a2 = last ? nA : cA + (size_t)(t + 2) * kstep; const char* b2 = last ? nB : cB + (size_t)(t + 2) * kstep;
            const char* a3 = a2 + kstep; const char* b3 = b2 + kstep;
            PG8_LDB(B0, 0, 0); PG8_LDB(B1, 0, 1); PG8_SCHED; PG8_LDA(At, 0, 0); PG8_STAGE(PG8_SA(1, 1), a1 + hstep, voffA);
            PG8_WAIT_V(8); PG8_WAIT_L(0); PG8_BAR; PG8_MMA(0, 0, At, B0); PG8_MMA(0, 1, At, B1); PG8_BAR; PG8_SCHED;
            PG8_LDA(At, 0, 1); PG8_STAGE(PG8_SB(0, 0), b2, voffB); PG8_STAGE(PG8_SB(0, 1), b2 + hstep, voffB); PG8_STAGE(PG8_SA(0, 0), a2, voffA);
            PG8_WAIT_V(8); PG8_WAIT_L(0); PG8_BAR; PG8_MMA(1, 0, At, B0); PG8_MMA(1, 1, At, B1); PG8_BAR; PG8_SCHED;
            PG8_LDB(B0, 1, 0); PG8_LDB(B1, 1, 1); PG8_SCHED; PG8_LDA(At, 1, 0); PG8_STAGE(PG8_SA(0, 1), a2 + hstep, voffA);
            PG8_WAIT_V(8); PG8_WAIT_L(0); PG8_BAR; PG8_MMA(0, 0, At, B0); PG8_MMA(0, 1, At, B1); PG8_BAR; PG8_SCHED;
            PG8_LDA(At, 1, 1); PG8_STAGE(PG8_SB(1, 0), b3, voffB); PG8_STAGE(PG8_SB(1, 1), b3 + hstep, voffB); PG8_STAGE(PG8_SA(1, 0), a3, voffA);
            PG8_WAIT_V(8); PG8_WAIT_L(0); PG8_BAR; PG8_MMA(1, 0, At, B0); PG8_MMA(1, 1, At, B1); PG8_BAR; PG8_SCHED;
        }
        if constexpr (ALIGN_EPI) { if (wr == 0) PG8_BAR; }
        E(acc, cur, wr, wc, fr, fq);
        if (!has_next) break;
        if (!(Epi::KEEP_ACC && cur.seg == 0)) {
#pragma unroll
        for (int a = 0; a < 2; ++a)
#pragma unroll
            for (int b = 0; b < 2; ++b)
#pragma unroll
                for (int m = 0; m < 4; ++m)
#pragma unroll
                    for (int n = 0; n < 2; ++n) acc[a][b][m][n] = (f32x4){0.f, 0.f, 0.f, 0.f};
        }
        cur = nxt; cA = nA; cB = nB; ++ui;
        if constexpr (ALIGN_EPI) { if (wr == 1) PG8_BAR; }
    }
    PG8_WAIT_V(0);
    if constexpr (!ALIGN_EPI) { if (wr == 0) PG8_BAR; }
    PG8_BAR;
#undef PG8_SA
#undef PG8_SB
#undef PG8_STAGE
#undef PG8_LDA
#undef PG8_LDB
#undef PG8_MMA
#undef PG8_WAIT_V
#undef PG8_WAIT_L
#undef PG8_BAR
#undef PG8_SCHED
#undef PG8_UA
#undef PG8_UB
}
}

constexpr int NWAVES = 8, NTHR = NWAVES * 64;
constexpr int DM = 2048, BATCH = 8, SEQ = 2048, M = BATCH * SEQ;
constexpr int INW = 8704, ZAW = 4608, ZGW = 4096;
constexpr int NMEM = 256, MROWS = BATCH * NMEM;
constexpr int DFF = 5632;
constexpr float RMS_EPS = 1e-6f;

constexpr size_t MiB = 1u << 20;
constexpr size_t WS_BAR = 256 * 1024, WS_BAR_BYTES = 64 * 1024;
constexpr size_t WS_RS1 = 0;
constexpr size_t WS_SSQ = 506 * MiB;
constexpr size_t WS_ROPE = 1 * MiB;
constexpr size_t WS_WIN = 2 * MiB;
constexpr size_t WS_WA = 36 * MiB;
constexpr size_t WS_WC = 40 * MiB;
constexpr size_t WS_WO = 44 * MiB;
constexpr size_t WS_WCQ = 52 * MiB;
constexpr size_t WS_WCKV = 54 * MiB;
constexpr size_t WS_WCO = 58 * MiB;
constexpr size_t WS_WGU = 60 * MiB;
constexpr size_t WS_WDN = 104 * MiB;
constexpr size_t WS_MEMN = 126 * MiB;
constexpr size_t WS_MEMKV = 134 * MiB;
constexpr size_t WS_ZA = 138 * MiB;
constexpr size_t WS_ZG = 282 * MiB;
constexpr size_t WS_AO = 2 * MiB;
constexpr size_t WS_CV = 410 * MiB;
constexpr size_t WS_WOB = 410 * MiB;
constexpr size_t WS_XB = 442 * MiB;
constexpr size_t WS_WOQ = 508 * MiB;
constexpr size_t WS_END = 510 * MiB;
constexpr size_t WS_MG = WS_ZA;
constexpr size_t WS_X1B = WS_ZG + 32 * MiB;
constexpr size_t WS_X3B = WS_XB;
constexpr size_t WS_QC = WS_ZG;
constexpr size_t WS_CO = WS_ZG + 16 * MiB;
constexpr size_t WS_X2B = WS_ZA;
constexpr size_t WS_ACT = WS_ZA + 64 * MiB;
static_assert(WS_ACT + (size_t)M * DFF * 2 <= WS_CV, "ACT overlay");

constexpr int LDS_BYTES = 147456;

#define GAS __attribute__((address_space(1)))
#define LAS __attribute__((address_space(3)))
typedef unsigned short bf16;
typedef unsigned v4u __attribute__((ext_vector_type(4)));
typedef float f32x4 __attribute__((ext_vector_type(4)));
#define LDS_WAIT() asm volatile("s_waitcnt lgkmcnt(0)" ::: "memory")
__device__ __forceinline__ unsigned f2bf(float f) { unsigned u = __builtin_bit_cast(unsigned, f); return (u + 0x7fffu + ((u >> 16) & 1u)) >> 16; }
__device__ __forceinline__ unsigned pk2(float lo, float hi) { return f2bf(lo) | (f2bf(hi) << 16); }
__device__ __forceinline__ float bflo(unsigned w) { return __uint_as_float(w << 16); }
__device__ __forceinline__ float bfhi(unsigned w) { return __uint_as_float(w & 0xffff0000u); }
__device__ __forceinline__ float wave_sum(float v) {
#pragma unroll
    for (int o = 1; o < 64; o <<= 1) v += __shfl_xor(v, o);
    return v;
}
__device__ __forceinline__ float wave_max(float v) {
#pragma unroll
    for (int o = 1; o < 64; o <<= 1) v = fmaxf(v, __shfl_xor(v, o));
    return v;
}

__device__ __forceinline__ int dest_row(int n0, int mode) {
    if (mode == 1) return (n0 >> 7) * 256 + (n0 & 127);
    if (mode == 2) return (n0 >> 7) * 256 + 128 + (n0 & 127);
    if (mode == 3 && n0 < 1280) return (n0 >> 8) * 256 + ((n0 >> 6) & 1) * 128 + ((n0 >> 7) & 1) * 64 + (n0 & 63);
    return n0;
}
__device__ __forceinline__ void p0_transpose_item(const float* W, int K, int N, bf16* WT, int mode, const float* gk, LAS float* scr, int item, int lane) {
    const int nblk = N / 32, kb = item / nblk, nb = item % nblk, k0 = 64 * kb, n0 = 32 * nb;
    const int kr = lane >> 3, nq = lane & 7;
    f32x4 v[8];
#pragma unroll
    for (int i = 0; i < 8; ++i) v[i] = *(const f32x4*)(W + (size_t)(k0 + 8 * i + kr) * N + n0 + 4 * nq);
#pragma unroll
    for (int i = 0; i < 8; ++i) { const float g = gk ? gk[k0 + 8 * i + kr] : 1.0f; LAS float* p = scr + (8 * i + kr) * 33 + 4 * nq;
        p[0] = v[i].x * g; p[1] = v[i].y * g; p[2] = v[i].z * g; p[3] = v[i].w * g; }
    LDS_WAIT(); asm volatile("" ::: "memory");
    const int c = lane & 7, r0 = dest_row(n0, mode);
#pragma unroll
    for (int j = 0; j < 4; ++j) { const int n = (lane >> 3) + 8 * j; const LAS float* s = scr + (8 * c) * 33 + n;
        v4u o; o.x = pk2(s[0 * 33], s[1 * 33]); o.y = pk2(s[2 * 33], s[3 * 33]); o.z = pk2(s[4 * 33], s[5 * 33]); o.w = pk2(s[6 * 33], s[7 * 33]);
        *(v4u*)(WT + (size_t)(r0 + n) * K + k0 + 8 * c) = o; }
    LDS_WAIT(); asm volatile("" ::: "memory");
}
__device__ __forceinline__ void row_to_bf16_rs(const float* xrow, bf16* orow, float* rs_out, int lane) {
    const f32x4* xr = (const f32x4*)xrow + lane;
    f32x4 v[8]; float s = 0.f;
#pragma unroll
    for (int j = 0; j < 8; ++j) { v[j] = xr[64 * j]; s += (v[j].x * v[j].x + v[j].y * v[j].y) + (v[j].z * v[j].z + v[j].w * v[j].w); }
    const float rs = 1.0f / sqrtf(wave_sum(s) * (1.0f / DM) + RMS_EPS);
    if (lane == 0) *rs_out = rs;
    unsigned long long* o8 = (unsigned long long*)orow + lane;
#pragma unroll
    for (int j = 0; j < 8; ++j) o8[64 * j] = (unsigned long long)pk2(v[j].x, v[j].y) | ((unsigned long long)pk2(v[j].z, v[j].w) << 32);
}
__device__ __forceinline__ void rms_row_to_bf16(const float* xrow, const float* g, bf16* orow, int lane) {
    const f32x4* xr = (const f32x4*)xrow + lane; const f32x4* gr = (const f32x4*)g + lane;
    f32x4 v[8]; float s = 0.f;
#pragma unroll
    for (int j = 0; j < 8; ++j) { v[j] = xr[64 * j]; s += (v[j].x * v[j].x + v[j].y * v[j].y) + (v[j].z * v[j].z + v[j].w * v[j].w); }
    const float rs = 1.0f / sqrtf(wave_sum(s) * (1.0f / DM) + RMS_EPS);
    unsigned long long* o8 = (unsigned long long*)orow + lane;
#pragma unroll
    for (int j = 0; j < 8; ++j) { const f32x4 gg = gr[64 * j];
        o8[64 * j] = (unsigned long long)pk2(v[j].x * rs * gg.x, v[j].y * rs * gg.y) | ((unsigned long long)pk2(v[j].z * rs * gg.z, v[j].w * rs * gg.w) << 32); }
}

typedef float f32x16 __attribute__((ext_vector_type(16)));
typedef short s16x8 __attribute__((ext_vector_type(8)));
typedef short s16x4 __attribute__((ext_vector_type(4)));
constexpr int ATT_KP = 272, ATT_VP = 264, ATT_V_OFF = 128 * ATT_KP, ATT_LDS = ATT_V_OFF + 128 * ATT_VP;
constexpr float LOG2E = 1.4426950408889634f;
template <bool WINDOW>
__device__ __forceinline__ void attn_unit(LAS unsigned char* lds, const bf16* qw, int qpitch, const bf16* kg, const bf16* vg, int kvpitch, int nblk,
                                          int qpos, int kpos, float m_init, float l_init, float qs, bf16* ow, int opitch, int tid, int lane) {
    const int r = lane & 31, h = lane >> 5;
    s16x8 qf[8];
#pragma unroll
    for (int kk = 0; kk < 8; ++kk) qf[kk] = *(const s16x8*)(qw + (size_t)r * qpitch + 16 * kk + 8 * h);
    f32x16 o[4];
#pragma unroll
    for (int dt = 0; dt < 4; ++dt)
#pragma unroll
        for (int i = 0; i < 16; ++i) o[dt][i] = 0.f;
    float m = m_init, l = (h == 0) ? l_init : 0.f;
    const int kkey = tid >> 4, kc = tid & 15, vkey = tid & 127, vcg = tid >> 7;
    for (int blk = 0; blk < nblk; ++blk) {
        v4u kreg[4], vreg[4];
#pragma unroll
        for (int it = 0; it < 4; ++it) { kreg[it] = *(const v4u*)(kg + (size_t)(blk * 128 + kkey + 32 * it) * kvpitch + kc * 8); vreg[it] = *(const v4u*)(vg + (size_t)(blk * 128 + vkey) * kvpitch + (vcg * 4 + it) * 8); }
        __syncthreads();
#pragma unroll
        for (int it = 0; it < 4; ++it) { *(LAS v4u*)(lds + (kkey + 32 * it) * ATT_KP + kc * 16) = kreg[it];
            LAS unsigned short* vt = (LAS unsigned short*)(lds + ATT_V_OFF) + (size_t)((vcg * 4 + it) * 8) * (ATT_VP / 2) + vkey;
            const v4u w = vreg[it];
            vt[0 * (ATT_VP / 2)] = (unsigned short)(w.x & 0xffffu); vt[1 * (ATT_VP / 2)] = (unsigned short)(w.x >> 16); vt[2 * (ATT_VP / 2)] = (unsigned short)(w.y & 0xffffu); vt[3 * (ATT_VP / 2)] = (unsigned short)(w.y >> 16);
            vt[4 * (ATT_VP / 2)] = (unsigned short)(w.z & 0xffffu); vt[5 * (ATT_VP / 2)] = (unsigned short)(w.z >> 16); vt[6 * (ATT_VP / 2)] = (unsigned short)(w.w & 0xffffu); vt[7 * (ATT_VP / 2)] = (unsigned short)(w.w >> 16); }
        __syncthreads();
#pragma unroll 1
        for (int hf = 0; hf < 2; ++hf) {
        f32x16 sc[2];
#pragma unroll
        for (int kt = 0; kt < 2; ++kt) {
#pragma unroll
            for (int i = 0; i < 16; ++i) sc[kt][i] = 0.f;
#pragma unroll
            for (int kk = 0; kk < 8; ++kk) { const s16x8 kf = *(const LAS s16x8*)(lds + (64 * hf + 32 * kt + r) * ATT_KP + (16 * kk + 8 * h) * 2); sc[kt] = __builtin_amdgcn_mfma_f32_32x32x16_bf16(kf, qf[kk], sc[kt], 0, 0, 0); }
        }
        float mb = -1e30f;
#pragma unroll
        for (int kt = 0; kt < 2; ++kt)
#pragma unroll
            for (int i = 0; i < 16; ++i) {
                if (!WINDOW) sc[kt][i] *= qs;
                if (WINDOW) { const int d = (kpos + blk * 128 + 64 * hf + 32 * kt + (i & 3) + 8 * (i >> 2) + 4 * h) - (qpos + r); if (d > 128 || d < -128) sc[kt][i] = -1e30f; }
                mb = fmaxf(mb, sc[kt][i]); }
        mb = fmaxf(mb, __shfl_xor(mb, 32));
        const float mn = fmaxf(m, mb), alpha = __builtin_amdgcn_exp2f((m - mn) * LOG2E), mo = mn * LOG2E;
        m = mn; l *= alpha;
#pragma unroll
        for (int dt = 0; dt < 4; ++dt) o[dt] = o[dt] * alpha;
        float ls = 0.f;
#pragma unroll
        for (int kt = 0; kt < 2; ++kt)
#pragma unroll
            for (int i = 0; i < 16; ++i) { const float p = __builtin_amdgcn_exp2f(sc[kt][i] * LOG2E - mo); sc[kt][i] = p; ls += p; }
        l += ls;
#pragma unroll
        for (int kt = 0; kt < 2; ++kt)
#pragma unroll
            for (int st = 0; st < 2; ++st) {
                v4u pw; pw.x = pg8::cvt_pk_bf16(sc[kt][8 * st + 0], sc[kt][8 * st + 1]); pw.y = pg8::cvt_pk_bf16(sc[kt][8 * st + 2], sc[kt][8 * st + 3]);
                pw.z = pg8::cvt_pk_bf16(sc[kt][8 * st + 4], sc[kt][8 * st + 5]); pw.w = pg8::cvt_pk_bf16(sc[kt][8 * st + 6], sc[kt][8 * st + 7]);
                const s16x8 pf = __builtin_bit_cast(s16x8, pw);
#pragma unroll
                for (int dt = 0; dt < 4; ++dt) { const LAS unsigned char* vp = lds + ATT_V_OFF + (32 * dt + r) * ATT_VP + (64 * hf + 32 * kt + 16 * st + 4 * h) * 2;
                    const s16x4 lo = *(const LAS s16x4*)vp, hi = *(const LAS s16x4*)(vp + 16);
                    const s16x8 vf = __builtin_shufflevector(lo, hi, 0, 1, 2, 3, 4, 5, 6, 7);
                    o[dt] = __builtin_amdgcn_mfma_f32_32x32x16_bf16(vf, pf, o[dt], 0, 0, 0); }
            }
        }
    }
    l += __shfl_xor(l, 32);
    const float inv = 1.0f / l;
    bf16* orow = ow + (size_t)r * opitch + 4 * h;
#pragma unroll
    for (int dt = 0; dt < 4; ++dt)
#pragma unroll
        for (int g = 0; g < 4; ++g) { unsigned long long w = (unsigned long long)pg8::cvt_pk_bf16(o[dt][4 * g] * inv, o[dt][4 * g + 1] * inv) | ((unsigned long long)pg8::cvt_pk_bf16(o[dt][4 * g + 2] * inv, o[dt][4 * g + 3] * inv) << 32);
            *(unsigned long long*)(orow + 32 * dt + 8 * g) = w; }
}

#define RLX_AGENT __ATOMIC_RELAXED, __HIP_MEMORY_SCOPE_AGENT
#define XB_TMO      128
#define XB_XCNT(j)  (256  + 64 * (j))
#define XB_XSUB(j)  (1280 + 64 * (j))
#define XB_XGEN(j)  (2304 + 64 * (j))
#define XB_TOP      3328
#define XB_TOPGEN   3392
#define XCD_BAR_WORDS 3456
#define XB_SPIN_CAP (1u << 18)

__device__ __forceinline__ unsigned xb_ld(unsigned* p)              { return __hip_atomic_load(p, __ATOMIC_RELAXED, __HIP_MEMORY_SCOPE_AGENT); }
__device__ __forceinline__ unsigned xb_add(unsigned* p, unsigned v) { return __hip_atomic_fetch_add(p, v, __ATOMIC_RELAXED, __HIP_MEMORY_SCOPE_AGENT); }
__device__ __forceinline__ unsigned xb_xcc_id() { return (unsigned)__builtin_amdgcn_s_getreg((3 << 11) | 20) & 0xFu; }
#define XB_SPIN(cond, bar) do { unsigned _sp = 0; while (cond) { __builtin_amdgcn_s_sleep(1); \
    if ((++_sp & 255u) == 0u) { if (xb_ld(&(bar)[XB_TMO])) break; if (_sp > XB_SPIN_CAP) { atomicAdd(&(bar)[XB_TMO], 1u); break; } } } } while (0)

struct XcdBarrier {
    unsigned* bar; unsigned x;
    volatile LAS unsigned* st;
};

__device__ __forceinline__ XcdBarrier xcd_barrier_post(unsigned* bar, volatile LAS unsigned* st) {
    XcdBarrier b; b.bar = bar; b.x = xb_xcc_id(); b.st = st;
    if (threadIdx.x == 0) (void)xb_add(&bar[XB_XCNT(b.x)], 1u);
    return b;
}
__device__ __forceinline__ void xcd_barrier_complete(unsigned* bar, unsigned x, unsigned& nloc, unsigned& nx) {
    const unsigned G = gridDim.x * gridDim.y * gridDim.z;
    unsigned sum, cnt, mine, sp = 0u;
    for (;;) {
        sum = 0u; cnt = 0u; mine = 0u;
#pragma unroll
        for (unsigned j = 0; j < 16; ++j) { const unsigned c = xb_ld(&bar[XB_XCNT(j)]); sum += c; cnt += (c > 0u) ? 1u : 0u; mine = (j == x) ? c : mine; }
        if (sum == G) break;
        __builtin_amdgcn_s_sleep(1);
        if ((++sp & 255u) == 0u) { if (xb_ld(&bar[XB_TMO])) break; if (sp > XB_SPIN_CAP) { atomicAdd(&bar[XB_TMO], 1u); break; } }
    }
    nloc = mine > 0u ? mine : 1u; nx = cnt > 0u ? cnt : 1u;
}

__device__ __forceinline__ void xcd_barrier(const XcdBarrier& b) {
    asm volatile("s_waitcnt vmcnt(0)" ::: "memory");
    __syncthreads();
    if (threadIdx.x == 0) {
        unsigned* bar = b.bar;
        __builtin_amdgcn_s_waitcnt(0);
        unsigned nloc = b.st[0], nx = b.st[1];
        if (nloc == 0u) { xcd_barrier_complete(bar, b.x, nloc, nx); b.st[0] = nloc; b.st[1] = nx; }
        const unsigned old = xb_add(&bar[XB_XSUB(b.x)], 1u);
        const unsigned gen = old / nloc;
        if (old + 1u == (gen + 1u) * nloc) {
            __builtin_amdgcn_fence(__ATOMIC_RELEASE, "agent");
            asm volatile("s_waitcnt vmcnt(0)" ::: "memory");
            const unsigned og = xb_add(&bar[XB_TOP], 1u);
            const unsigned tg = og / nx;
            if (og + 1u == (tg + 1u) * nx) xb_add(&bar[XB_TOPGEN], 1u);
            else XB_SPIN(xb_ld(&bar[XB_TOPGEN]) == tg, bar);
            __builtin_amdgcn_fence(__ATOMIC_ACQUIRE, "agent");
            xb_add(&bar[XB_XGEN(b.x)], 1u);
            asm volatile("s_waitcnt vmcnt(0)" ::: "memory");
        } else {
            XB_SPIN(xb_ld(&bar[XB_XGEN(b.x)]) == gen, bar);
            __builtin_amdgcn_fence(__ATOMIC_ACQUIRE, "agent");
            asm volatile("s_waitcnt vmcnt(0)" ::: "memory");
        }
    }
    __syncthreads();
}

struct Args { const float* in[20]; float* out; unsigned char* ws; int ph_lo, ph_hi, li, pad; };

__global__ void __launch_bounds__(NTHR, 2) mk_fwd(Args args) {
    extern __shared__ __attribute__((aligned(16))) unsigned char lds_raw[];
    LAS unsigned char* lds = (LAS unsigned char*)lds_raw;
    const int tid = threadIdx.x, lane = tid & 63, wave = __builtin_amdgcn_readfirstlane(tid >> 6);
    const int G = gridDim.x, bx = blockIdx.x;
    const int gw = bx * NWAVES + wave, NGW = G * NWAVES;
    unsigned char* ws = args.ws;
    const float* x = args.in[0]; const float* mem = args.in[1]; const float* g_mix = args.in[2]; const float* w_in = args.in[3]; const float* sink = args.in[4];
    const float* conv_w = args.in[5]; const float* b_gate = args.in[6]; const float* w_attn_out = args.in[7]; const float* w_conv_out = args.in[8]; const float* w_o = args.in[9];
    const float* g_cross = args.in[10]; const float* g_mem = args.in[11]; const float* w_cq = args.in[12]; const float* w_ckv = args.in[13]; const float* w_co = args.in[14];
    const float* g_ffn = args.in[15]; const float* w_gate = args.in[16]; const float* w_up = args.in[17]; const float* w_down = args.in[18]; const float* g_final = args.in[19];
    float* out = args.out;
    float* ssq2 = (float*)(ws + WS_SSQ); float* ssq3 = ssq2 + M * 8; float* ssq4 = ssq3 + M * 8;
    PG8_LAS float* xch = (PG8_LAS float*)(lds + pg8::STAGE_BYTES);
    float* cosT = (float*)(ws + WS_ROPE); float* sinT = cosT + SEQ * 64;
    bf16* Wt_in = (bf16*)(ws + WS_WIN); bf16* Wt_a = (bf16*)(ws + WS_WA); bf16* Wt_c = (bf16*)(ws + WS_WC); bf16* Wt_o = (bf16*)(ws + WS_WO);
    bf16* Wt_cq = (bf16*)(ws + WS_WCQ); bf16* Wt_ckv = (bf16*)(ws + WS_WCKV); bf16* Wt_co = (bf16*)(ws + WS_WCO); bf16* Wt_gu = (bf16*)(ws + WS_WGU); bf16* Wt_dn = (bf16*)(ws + WS_WDN);
    bf16* MEMN = (bf16*)(ws + WS_MEMN); bf16* MEMKV = (bf16*)(ws + WS_MEMKV);
    bf16* ZA = (bf16*)(ws + WS_ZA); bf16* ZG = (bf16*)(ws + WS_ZG); bf16* AO = (bf16*)(ws + WS_AO); bf16* CV = (bf16*)(ws + WS_CV);
    bf16* MG = (bf16*)(ws + WS_MG); bf16* X1B = (bf16*)(ws + WS_X1B); bf16* X3B = (bf16*)(ws + WS_X3B); bf16* XB = (bf16*)(ws + WS_XB); bf16* WOB = (bf16*)(ws + WS_WOB); bf16* WOQ = (bf16*)(ws + WS_WOQ); float* rs1 = (float*)(ws + WS_RS1); bf16* QC = (bf16*)(ws + WS_QC); bf16* CO = (bf16*)(ws + WS_CO);
    bf16* X2B = (bf16*)(ws + WS_X2B); bf16* ACT = (bf16*)(ws + WS_ACT);
    cg::grid_group grid = cg::this_grid();
    const int lo = args.ph_lo, hi = args.ph_hi;
#define IN(k) (lo <= (k) && (k) < hi)
#define SEAM(k) do { if (IN(k) && IN((k) + 1)) { if ((k) == 0) { asm volatile("s_waitcnt vmcnt(0) lgkmcnt(0)" ::: "memory"); __syncthreads(); grid.sync(); } else xcd_barrier(xbar); } } while (0)
    if (tid < 4) ((LAS unsigned*)(lds + pg8::STAGE_BYTES + 8192))[tid] = 0u;
    __syncthreads();
    const XcdBarrier xbar = xcd_barrier_post((unsigned*)(ws + WS_BAR) + args.li * 4096, (volatile LAS unsigned*)(lds + pg8::STAGE_BYTES + 8192));

    if (IN(0)) {
        LAS float* scr = (LAS float*)(lds + wave * 16384);
        constexpr int I_IN = (DM / 64) * (INW / 32), I_A = (1024 / 64) * (DM / 32), I_O = (DM / 64) * (DM / 32), I_CQ = (DM / 64) * (512 / 32), I_CKV = (DM / 64) * (1024 / 32),
                      I_CO = (512 / 64) * (DM / 32), I_G = (DM / 64) * (DFF / 32), I_D = (DFF / 64) * (DM / 32);
        constexpr int NITEMS = I_IN + 2 * I_A + I_O + I_CQ + I_CKV + I_CO + 2 * I_G + I_D;
        for (int it = gw; it < NITEMS; it += NGW) {
            int r = it;
            if (r < I_IN) { p0_transpose_item(w_in, DM, INW, Wt_in, 3, g_mix, scr, r, lane); continue; } r -= I_IN;
            if (r < I_A) { p0_transpose_item(w_attn_out, 1024, DM, Wt_a, 0, nullptr, scr, r, lane); continue; } r -= I_A;
            if (r < I_A) { p0_transpose_item(w_conv_out, 1024, DM, Wt_c, 0, nullptr, scr, r, lane); continue; } r -= I_A;
            if (r < I_O) { p0_transpose_item(w_o, DM, DM, Wt_o, 0, nullptr, scr, r, lane); continue; } r -= I_O;
            if (r < I_CQ) { p0_transpose_item(w_cq, DM, 512, Wt_cq, 0, g_cross, scr, r, lane); continue; } r -= I_CQ;
            if (r < I_CKV) { p0_transpose_item(w_ckv, DM, 1024, Wt_ckv, 0, nullptr, scr, r, lane); continue; } r -= I_CKV;
            if (r < I_CO) { p0_transpose_item(w_co, 512, DM, Wt_co, 0, nullptr, scr, r, lane); continue; } r -= I_CO;
            if (r < I_G) { p0_transpose_item(w_gate, DM, DFF, Wt_gu, 1, g_ffn, scr, r, lane); continue; } r -= I_G;
            if (r < I_G) { p0_transpose_item(w_up, DM, DFF, Wt_gu, 2, g_ffn, scr, r, lane); continue; } r -= I_G;
            p0_transpose_item(w_down, DFF, DM, Wt_dn, 0, nullptr, scr, r, lane);
        }
        for (int m = gw; m < M; m += NGW) row_to_bf16_rs(x + (size_t)m * DM, XB + (size_t)m * DM, rs1 + m, lane);
        for (int i = bx * NTHR + tid; i < DM * DM / 8; i += G * NTHR) { const f32x4 a = *(const f32x4*)(w_o + (size_t)i * 8), b = *(const f32x4*)(w_o + (size_t)i * 8 + 4); *(v4u*)(WOB + (size_t)i * 8) = pg8::pack8(a, b); }
        for (int m = gw; m < MROWS; m += NGW) rms_row_to_bf16(mem + (size_t)m * DM, g_mem, MEMN + (size_t)m * DM, lane);
        for (int i = bx * NTHR + tid; i < SEQ * 64; i += G * NTHR) { const int pos = i >> 6, j = i & 63;
            const float inv = exp2f(-(float)j * (13.287712379549449f / 64.0f)); const float ang = (float)pos * inv;
            cosT[i] = cosf(ang); sinT[i] = sinf(ang); }
    }
    SEAM(0);

    if (IN(1)) {
        { pg8::Gemm g{XB, Wt_in, nullptr, nullptr, M, INW, DM}; pg8::StaticOrder S; S.init(M, INW, G, bx);
          pg8::EpiIn E{ZA, ZG, cosT, sinT, b_gate, 0.08838834764831845f, rs1};
          pg8::gemm_phase<pg8::EpiIn, pg8::StaticOrder>(lds, g, S, E); }
        { pg8::Gemm g{MEMN, Wt_ckv, nullptr, nullptr, MROWS, 1024, DM}; pg8::StaticOrder S; S.init(MROWS, 1024, G, (bx + G / 2) % G);
          pg8::EpiBf16 E{MEMKV, 1024};
          pg8::gemm_phase<pg8::EpiBf16, pg8::StaticOrder>(lds, g, S, E); }
        { pg8::Gemm g{Wt_cq, WOB, nullptr, nullptr, 512, DM, DM}; pg8::StaticOrder S; S.init(512, DM, G, (bx + G / 2 - 32 + G) % G);
          pg8::EpiBf16 E{WOQ, DM};
          pg8::gemm_phase<pg8::EpiBf16, pg8::StaticOrder>(lds, g, S, E); }
    }
    SEAM(1);

    if (IN(2)) {
        for (int it = 2 * bx; it < 512; it += 2 * G)
            for (int hp = 0; hp < 2; ++hp) { const int kvh = it >> 1 & 1, nb = (it >> 2) & 15, b = it >> 6;
                const int hq = kvh * 4 + hp * 2 + (wave >> 2), t0 = b * SEQ + nb * 128 + (wave & 3) * 32;
                const int kb0 = nb > 0 ? nb - 1 : 0, kb1 = nb < 15 ? nb + 1 : 15; const size_t kt0 = (size_t)b * SEQ + kb0 * 128;
                attn_unit<true>(lds, ZA + (size_t)t0 * ZAW + hq * 128, ZAW, ZA + kt0 * ZAW + 1024 + kvh * 128, ZA + kt0 * ZAW + 1280 + kvh * 128, ZAW, kb1 - kb0 + 1,
                                nb * 128 + (wave & 3) * 32, kb0 * 128, sink[hq], 1.0f, 1.0f, AO + (size_t)t0 * 1024 + hq * 128, 1024, tid, lane); }
        __syncthreads();
        for (int idx = bx * NTHR + tid; idx < (M / 16) * 128; idx += G * NTHR) { const int run = idx >> 7, c8 = (idx & 127) * 8, t0 = run * 16, s0 = t0 & (SEQ - 1);
            const f32x4 w0a = *(const f32x4*)(conv_w + c8), w0b = *(const f32x4*)(conv_w + c8 + 4), w1a = *(const f32x4*)(conv_w + 1024 + c8), w1b = *(const f32x4*)(conv_w + 1024 + c8 + 4),
                        w2a = *(const f32x4*)(conv_w + 2048 + c8), w2b = *(const f32x4*)(conv_w + 2048 + c8 + 4);
            const bf16* zr = ZA + (size_t)t0 * ZAW + c8;
            f32x4 pa = {0.f, 0.f, 0.f, 0.f}, pb = pa, ca, cb, ta, tb;
            if (s0 > 0) { pg8::unpack8(*(const v4u*)(zr - ZAW + 1536), pa, pb); pg8::unpack8(*(const v4u*)(zr - ZAW + 3584), ta, tb); pa = pa * ta; pb = pb * tb; }
            pg8::unpack8(*(const v4u*)(zr + 1536), ca, cb); pg8::unpack8(*(const v4u*)(zr + 3584), ta, tb); ca = ca * ta; cb = cb * tb;
#pragma unroll
            for (int i = 0; i < 16; ++i) { f32x4 na = {0.f, 0.f, 0.f, 0.f}, nbv = na, ga, gb;
                if (i < 15 || s0 + 16 < SEQ) { pg8::unpack8(*(const v4u*)(zr + (size_t)(i + 1) * ZAW + 1536), na, nbv); pg8::unpack8(*(const v4u*)(zr + (size_t)(i + 1) * ZAW + 3584), ta, tb); na = na * ta; nbv = nbv * tb; }
                pg8::unpack8(*(const v4u*)(zr + (size_t)i * ZAW + 2560), ga, gb);
                *(v4u*)(CV + (size_t)(t0 + i) * 1024 + c8) = pg8::pack8(ga * (w0a * pa + w1a * ca + w2a * na), gb * (w0b * pb + w1b * cb + w2b * nbv));
                pa = ca; pb = cb; ca = na; cb = nbv; }
        }
    }
    SEAM(2);

    if (IN(3)) {
        pg8::Gemm g{AO, Wt_a, CV, Wt_c, M, DM, 1024}; pg8::StaticOrder S; S.init(M, DM, G, bx, 2);
        pg8::EpiMerge E{ZG, MG};
        pg8::gemm_phase<pg8::EpiMerge, pg8::StaticOrder>(lds, g, S, E);
    }
    SEAM(3);

    if (IN(4)) {
        { pg8::Gemm g{XB, Wt_cq, MG, WOQ, M, 512, DM}; pg8::ListOrder S{bx, bx < 128 ? 1 : 0, 2, 2};
          pg8::EpiAcc2 E{QC, 512};
          pg8::gemm_phase<pg8::EpiAcc2, pg8::ListOrder>(lds, g, S, E); }
        { pg8::Gemm g{MG, Wt_o, nullptr, nullptr, M, DM, DM}; pg8::ListOrder S{bx < 128 ? bx : 128 + (bx - 128) * 3, bx < 128 ? 1 : 3, 8, 1};
          pg8::EpiResB E{XB, X1B, ssq2, xch};
          pg8::gemm_phase<pg8::EpiResB, pg8::ListOrder>(lds, g, S, E); }
    }
    SEAM(4);

    if (IN(6)) {
        for (int it = bx; it < 256; it += G) { const int rb = it & 7, hh = (it >> 3) & 3, b = it >> 5; const int t0 = b * SEQ + rb * 256 + wave * 32;
            attn_unit<false>(lds, QC + (size_t)t0 * 512 + hh * 128, 512, MEMKV + (size_t)(b * NMEM) * 1024 + hh * 128, MEMKV + (size_t)(b * NMEM) * 1024 + 512 + hh * 128, 1024, 2,
                             0, 0, -1e30f, 0.0f, pg8::row_rs(ssq2, t0 + (lane & 31)) * 0.08838834764831845f, CO + (size_t)t0 * 512 + hh * 128, 512, tid, lane); }
    }
    SEAM(6);

    if (IN(7)) {
        pg8::Gemm g{CO, Wt_co, nullptr, nullptr, M, DM, 512}; pg8::StaticOrder S; S.init(M, DM, G, bx);
        pg8::EpiResB E{X1B, X2B, ssq3, xch};
        pg8::gemm_phase<pg8::EpiResB, pg8::StaticOrder>(lds, g, S, E);
    }
    SEAM(7);

    if (IN(8)) {
        pg8::Gemm g{X2B, Wt_gu, nullptr, nullptr, M, 2 * DFF, DM}; pg8::StaticOrder S; S.init(M, 2 * DFF, G, bx);
        pg8::EpiSwiGLU E{ACT, ssq3};
        pg8::gemm_phase<pg8::EpiSwiGLU, pg8::StaticOrder>(lds, g, S, E);
    }
    SEAM(8);

    if (IN(9)) {
        pg8::Gemm g{ACT, Wt_dn, nullptr, nullptr, M, DM, DFF}; pg8::StaticOrder S; S.init(M, DM, G, bx);
        pg8::EpiResB E{X2B, X3B, ssq4, xch};
        pg8::gemm_phase<pg8::EpiResB, pg8::StaticOrder>(lds, g, S, E);
    }
    SEAM(9);

    if (IN(10)) {
        for (int m = gw; m < M; m += NGW) { const v4u* xr = (const v4u*)(X3B + (size_t)m * DM) + lane; f32x4* orow = (f32x4*)(out + (size_t)m * DM); const f32x4* gr = (const f32x4*)g_final;
            const float rs = pg8::row_rs(ssq4, m);
#pragma unroll
            for (int j = 0; j < 4; ++j) { f32x4 a, b; pg8::unpack8(xr[64 * j], a, b); const int c = (64 * j + lane) * 2;
                orow[c] = a * rs * gr[c]; orow[c + 1] = b * rs * gr[c + 1]; } }
    }
#if defined(MK_DUMP_OFF)
    if (hi == MK_CUT && MK_CUT < 11) {
        asm volatile("s_waitcnt vmcnt(0) lgkmcnt(0)" ::: "memory"); __syncthreads(); grid.sync();
        const bf16* src = (const bf16*)(ws + (size_t)(MK_DUMP_OFF));
        for (size_t i = (size_t)bx * NTHR + tid; i < (size_t)M * 2048; i += (size_t)G * NTHR) { const size_t r = i >> 11, c = i & 2047; out[i] = __uint_as_float((unsigned)src[r * (MK_DUMP_LD) + (c % (MK_DUMP_W)) + (c / (MK_DUMP_W)) * (size_t)(MK_DUMP_OFF2)] << 16); }
    }
#endif
#undef IN
#undef SEAM
}

extern "C" void kernel_launch(void* const* d_in, const int* in_sizes, int n_in, void* d_out, int out_size, void* d_ws, size_t ws_size, hipStream_t stream) {
    static int grid = 0;
    if (grid == 0) {
        if (n_in != 20 || in_sizes[0] != M * DM || out_size != M * DM || ws_size < WS_END) { fprintf(stderr, "kernel_launch: unexpected shapes / workspace (n_in %d, ws %zu)\n", n_in, ws_size); grid = -1; return; }
        int dev = 0, cus = 0, per_cu = 0;
        if (hipGetDevice(&dev) != hipSuccess || hipDeviceGetAttribute(&cus, hipDeviceAttributeMultiprocessorCount, dev) != hipSuccess) { grid = -1; return; }
        if (hipFuncSetAttribute((const void*)mk_fwd, hipFuncAttributeMaxDynamicSharedMemorySize, LDS_BYTES) != hipSuccess) { fprintf(stderr, "kernel_launch: hipFuncSetAttribute failed\n"); grid = -1; return; }
        if (hipOccupancyMaxActiveBlocksPerMultiprocessor(&per_cu, (const void*)mk_fwd, NTHR, LDS_BYTES) != hipSuccess || per_cu < 1) { fprintf(stderr, "kernel_launch: occupancy query says %d\n", per_cu); (void)hipGetLastError(); grid = -1; return; }
        grid = cus;
    }
    if (grid < 0) return;
    Args a{};
    for (int i = 0; i < 20; ++i) a.in[i] = (const float*)d_in[i];
    a.out = (float*)d_out; a.ws = (unsigned char*)d_ws;
    if (hipMemsetAsync((char*)d_ws + WS_BAR, 0, WS_BAR_BYTES, stream) != hipSuccess) { fprintf(stderr, "kernel_launch: hipMemsetAsync of the barrier words failed\n"); return; }
#if defined(MK_PROBE_DUP)
    { void* kargs[] = {&a}; a.ph_lo = 0; a.ph_hi = MK_PROBE_DUP + 1; hipLaunchCooperativeKernel((const void*)mk_fwd, dim3(grid), dim3(NTHR), kargs, LDS_BYTES, stream);
      a.ph_lo = MK_PROBE_DUP; a.ph_hi = 11; a.li = 1; hipLaunchCooperativeKernel((const void*)mk_fwd, dim3(grid), dim3(NTHR), kargs, LDS_BYTES, stream); }
#elif MK_N_LAUNCHES == 1
    a.ph_lo = 0; a.ph_hi = MK_CUT;
    void* kargs[] = {&a};
    hipError_t e = hipLaunchCooperativeKernel((const void*)mk_fwd, dim3(grid), dim3(NTHR), kargs, LDS_BYTES, stream);
    if (e != hipSuccess) fprintf(stderr, "kernel_launch: cooperative launch failed: %s (grid %d)\n", hipGetErrorString(e), grid);
#else
    for (int p = 0; p < 11; ++p) { a.ph_lo = p; a.ph_hi = p + 1; hipLaunchKernelGGL(mk_fwd, dim3(grid), dim3(NTHR), LDS_BYTES, stream, a); }
#endif
}
```

```cpp
#include <hip/hip_runtime.h>
#include <hip/hip_cooperative_groups.h>
#include <cstdio>
#include <cstdint>
namespace cg = cooperative_groups;

#ifndef MK_CUT
#define MK_CUT 11
#endif
#ifndef MK_N_LAUNCHES
#define MK_N_LAUNCHES 1
#endif

namespace pg8 {
#define PG8_LAS __attribute__((address_space(3)))
typedef unsigned short bf16_t;
typedef short bf16x8 __attribute__((ext_vector_type(8)));
typedef float f32x4 __attribute__((ext_vector_type(4)));
typedef unsigned u32x4 __attribute__((ext_vector_type(4)));
constexpr int BM = 256, BK = 64, HALF = 128, HTB = HALF * BK * 2, STAGE_BYTES = 8 * HTB, NXCD = 8, WGM = 8;

__host__ __device__ __forceinline__ int lds_byte(int r, int c) { const int st = (r >> 4) * 2 + (c >> 5), rr = r & 15, cc = c & 31, ob = rr * 64 + cc * 2; return st * 1024 + (ob ^ (((ob >> 9) & 1) << 5)); }
__host__ __device__ __forceinline__ void stage_rc(int b, int& R, int& C) { const int st = b / 1024, sb = b % 1024, swz = sb ^ (((sb >> 9) & 1) << 5); R = (st >> 1) * 16 + swz / 64; C = (st & 1) * 32 + (swz % 64) / 2; }
__host__ __device__ __forceinline__ int perm32(int rho) { const int n = rho >> 4, i = rho & 15; return 8 * (i >> 2) + 4 * n + (i & 3); }

struct Unit { int pm, pn, seg; };
struct Gemm { const bf16_t* A0; const bf16_t* B0; const bf16_t* A1; const bf16_t* B1; int M, N, K; };

struct StaticOrder {
    int nM, nN, nwg, G, c, nseg;
    __device__ void init(int M, int N, int G_, int c_, int nseg_ = 1) { nM = M / BM; nN = N / BM; nwg = nM * nN; G = G_; c = c_; nseg = nseg_; }
    __device__ bool next(int i, Unit& u) const {
        const int j = (nseg == 2) ? (i >> 1) : i; u.seg = (nseg == 2) ? (i & 1) : 0;
        const long L = (long)j * G + c; if (L >= nwg) return false;
        int wgid = (int)L; { const int q = nwg / NXCD, r = nwg % NXCD, xcd = wgid % NXCD, off = wgid / NXCD; wgid = (xcd < r ? xcd * (q + 1) : r * (q + 1) + (xcd - r) * q) + off; }
        const int nig = WGM * nN, gid = wgid / nig, fm = gid * WGM, gsz = (nM - fm) < WGM ? (nM - fm) : WGM;
        u.pm = fm + ((wgid % nig) % gsz); u.pn = (wgid % nig) / gsz; return true;
    }
};

typedef __bf16 bf16x2_t __attribute__((ext_vector_type(2)));
typedef float f32x2_t __attribute__((ext_vector_type(2)));
struct ListOrder {
    int first, count, nN, nseg;
    __device__ bool next(int i, Unit& u) const { const int j = (nseg == 2) ? (i >> 1) : i; u.seg = (nseg == 2) ? (i & 1) : 0; if (j >= count) return false; const int L = first + j; u.pm = L / nN; u.pn = L % nN; return true; }
};
__device__ __forceinline__ unsigned cvt_pk_bf16(float lo, float hi) { const f32x2_t v = {lo, hi}; const bf16x2_t r = __builtin_convertvector(v, bf16x2_t); return __builtin_bit_cast(unsigned, r); }
__device__ __forceinline__ u32x4 pack8(const f32x4 a, const f32x4 b) { u32x4 w; w.x = cvt_pk_bf16(a[0], a[1]); w.y = cvt_pk_bf16(a[2], a[3]); w.z = cvt_pk_bf16(b[0], b[1]); w.w = cvt_pk_bf16(b[2], b[3]); return w; }
__device__ __forceinline__ void unpack8(const u32x4 w, f32x4& a, f32x4& b) {
    a[0] = __uint_as_float(w.x << 16); a[1] = __uint_as_float(w.x & 0xffff0000u); a[2] = __uint_as_float(w.y << 16); a[3] = __uint_as_float(w.y & 0xffff0000u);
    b[0] = __uint_as_float(w.z << 16); b[1] = __uint_as_float(w.z & 0xffff0000u); b[2] = __uint_as_float(w.w << 16); b[3] = __uint_as_float(w.w & 0xffff0000u); }
__device__ __forceinline__ f32x4 sigmoid4(const f32x4 v) { f32x4 o;
#pragma unroll
    for (int i = 0; i < 4; ++i) o[i] = __builtin_amdgcn_rcpf(1.0f + __expf(-v[i]));
    return o; }

typedef f32x4 Acc[2][2][4][2];

struct EpiBf16 {
    static constexpr bool PERM = true, KEEP_ACC = false;
    bf16_t* O; int ldc;
    __device__ __forceinline__ void operator()(Acc& acc, const Unit& u, int wr, int wc, int fr, int fq) const {
        const int row0 = u.pm * BM + wr * 64 + fr, col0 = u.pn * BM + wc * 32 + 8 * fq;
#pragma unroll
        for (int ai = 0; ai < 2; ++ai)
#pragma unroll
            for (int m = 0; m < 4; ++m) { bf16_t* rowp = O + (size_t)(row0 + ai * HALF + m * 16) * ldc + col0;
#pragma unroll
                for (int bj = 0; bj < 2; ++bj) *(u32x4*)(rowp + bj * HALF) = pack8(acc[ai][bj][m][0], acc[ai][bj][m][1]); }
    }
};
struct EpiIn {
    static constexpr bool PERM = true, KEEP_ACC = false;
    bf16_t* ZA; bf16_t* ZG; const float* cosT; const float* sinT; const float* bgate; float qscale; const float* rs1;
    __device__ __forceinline__ void operator()(Acc& acc, const Unit& u, int wr, int wc, int fr, int fq) const {
        const int row0 = u.pm * BM + wr * 64 + fr;
#pragma unroll
        for (int ai = 0; ai < 2; ++ai)
#pragma unroll
            for (int m = 0; m < 4; ++m) { const float rs = rs1[row0 + ai * HALF + m * 16];
#pragma unroll
                for (int bj = 0; bj < 2; ++bj) { acc[ai][bj][m][0] = acc[ai][bj][m][0] * rs; acc[ai][bj][m][1] = acc[ai][bj][m][1] * rs; } }
        if (u.pn < 5) {
            const int p = wc * 32 + 8 * fq, hb = p >> 6, j0 = p & 63, c1 = u.pn * 256 + hb * 128 + j0;
            const float sc = u.pn < 4 ? qscale : 1.0f;
#pragma unroll
            for (int ai = 0; ai < 2; ++ai)
#pragma unroll
                for (int m = 0; m < 4; ++m) { const int row = row0 + ai * HALF + m * 16, pos = row & 2047;
                    const f32x4 ca = *(const f32x4*)(cosT + pos * 64 + j0), cb = *(const f32x4*)(cosT + pos * 64 + j0 + 4);
                    const f32x4 sa = *(const f32x4*)(sinT + pos * 64 + j0), sb = *(const f32x4*)(sinT + pos * 64 + j0 + 4);
                    const f32x4 t1a = acc[ai][0][m][0], t1b = acc[ai][0][m][1], t2a = acc[ai][1][m][0], t2b = acc[ai][1][m][1];
                    const f32x4 o1a = (t1a * ca - t2a * sa) * sc, o1b = (t1b * cb - t2b * sb) * sc, o2a = (t2a * ca + t1a * sa) * sc, o2b = (t2b * cb + t1b * sb) * sc;
                    bf16_t* rp = ZA + (size_t)row * 4608 + c1;
                    *(u32x4*)rp = pack8(o1a, o1b); *(u32x4*)(rp + 64) = pack8(o2a, o2b); }
        } else if (u.pn < 18) {
            const int col0 = u.pn * BM + wc * 32 + 8 * fq;
#pragma unroll
            for (int ai = 0; ai < 2; ++ai)
#pragma unroll
                for (int m = 0; m < 4; ++m) { bf16_t* rowp = ZA + (size_t)(row0 + ai * HALF + m * 16) * 4608 + col0;
#pragma unroll
                    for (int bj = 0; bj < 2; ++bj) *(u32x4*)(rowp + bj * HALF) = pack8(acc[ai][bj][m][0], acc[ai][bj][m][1]); }
        } else {
            const int col0 = (u.pn - 18) * BM + wc * 32 + 8 * fq;
#pragma unroll
            for (int bj = 0; bj < 2; ++bj) { const f32x4 b0 = *(const f32x4*)(bgate + col0 + bj * HALF), b1 = *(const f32x4*)(bgate + col0 + bj * HALF + 4);
#pragma unroll
                for (int ai = 0; ai < 2; ++ai)
#pragma unroll
                    for (int m = 0; m < 4; ++m) { bf16_t* rowp = ZG + (size_t)(row0 + ai * HALF + m * 16) * 4096 + col0 + bj * HALF;
                        *(u32x4*)rowp = pack8(sigmoid4(acc[ai][bj][m][0] + b0), sigmoid4(acc[ai][bj][m][1] + b1)); } }
        }
    }
};
struct EpiAcc2 {
    static constexpr bool PERM = true, KEEP_ACC = true;
    bf16_t* O; int ldc;
    __device__ __forceinline__ void operator()(Acc& acc, const Unit& u, int wr, int wc, int fr, int fq) const {
        if (u.seg == 0) return;
        const int row0 = u.pm * BM + wr * 64 + fr, col0 = u.pn * BM + wc * 32 + 8 * fq;
#pragma unroll
        for (int ai = 0; ai < 2; ++ai)
#pragma unroll
            for (int m = 0; m < 4; ++m) { bf16_t* rowp = O + (size_t)(row0 + ai * HALF + m * 16) * ldc + col0;
#pragma unroll
                for (int bj = 0; bj < 2; ++bj) *(u32x4*)(rowp + bj * HALF) = pack8(acc[ai][bj][m][0], acc[ai][bj][m][1]); }
    }
};
struct EpiMerge {
    static constexpr bool PERM = true, KEEP_ACC = true;
    const bf16_t* ZG; bf16_t* O;
    __device__ __forceinline__ void operator()(Acc& acc, const Unit& u, int wr, int wc, int fr, int fq) const {
        const int row0 = u.pm * BM + wr * 64 + fr, col0 = u.pn * BM + wc * 32 + 8 * fq;
#pragma unroll
        for (int ai = 0; ai < 2; ++ai)
#pragma unroll
            for (int m = 0; m < 4; ++m) { const int row = row0 + ai * HALF + m * 16;
#pragma unroll
                for (int bj = 0; bj < 2; ++bj) { const bf16_t* gp = ZG + (size_t)row * 4096 + col0 + bj * HALF;
                    f32x4 c0, c1; unpack8(*(const u32x4*)(gp + 2048), c0, c1);
                    if (u.seg == 0) { f32x4 a0, a1; unpack8(*(const u32x4*)gp, a0, a1);
#pragma unroll
                        for (int i = 0; i < 4; ++i) { acc[ai][bj][m][0][i] *= a0[i] * __builtin_amdgcn_rcpf(c0[i]); acc[ai][bj][m][1][i] *= a1[i] * __builtin_amdgcn_rcpf(c1[i]); }
                    } else { *(u32x4*)(O + (size_t)row * 2048 + col0 + bj * HALF) = pack8(acc[ai][bj][m][0] * c0, acc[ai][bj][m][1] * c1); } } }
    }
};
struct EpiRes {
    static constexpr bool PERM = true, KEEP_ACC = false;
    const float* base; float* out; bf16_t* outb; float* part; PG8_LAS float* xch;
    __device__ __forceinline__ void operator()(Acc& acc, const Unit& u, int wr, int wc, int fr, int fq) const {
        const int row0 = u.pm * BM + wr * 64 + fr, col0 = u.pn * BM + wc * 32 + 8 * fq;
#pragma unroll
        for (int ai = 0; ai < 2; ++ai)
#pragma unroll
            for (int m = 0; m < 4; ++m) { const int row = row0 + ai * HALF + m * 16; float ss = 0.f;
#pragma unroll
                for (int bj = 0; bj < 2; ++bj) { const size_t off = (size_t)row * 2048 + col0 + bj * HALF;
                    const f32x4 o0 = *(const f32x4*)(base + off) + acc[ai][bj][m][0], o1 = *(const f32x4*)(base + off + 4) + acc[ai][bj][m][1];
                    *(f32x4*)(out + off) = o0; *(f32x4*)(out + off + 4) = o1;
                    if (outb) *(u32x4*)(outb + off) = pack8(o0, o1);
                    ss += (o0[0] * o0[0] + o0[1] * o0[1]) + (o0[2] * o0[2] + o0[3] * o0[3]) + (o1[0] * o1[0] + o1[1] * o1[1]) + (o1[2] * o1[2] + o1[3] * o1[3]); }
                ss += __shfl_xor(ss, 16); ss += __shfl_xor(ss, 32);
                if (fq == 0) xch[(ai * HALF + wr * 64 + m * 16 + fr) * 4 + wc] = ss; }
        asm volatile("s_waitcnt lgkmcnt(0)" ::: "memory"); __builtin_amdgcn_s_barrier(); asm volatile("" ::: "memory");
        { const int t = threadIdx.x; if (t < 256) { const f32x4 v = *(const PG8_LAS f32x4*)(xch + t * 4); part[(size_t)(u.pm * BM + t) * 8 + u.pn] = (v[0] + v[1]) + (v[2] + v[3]); } }
        asm volatile("s_waitcnt lgkmcnt(0)" ::: "memory"); __builtin_amdgcn_s_barrier(); asm volatile("" ::: "memory");
    }
};
struct EpiResB {
    static constexpr bool PERM = true, KEEP_ACC = false;
    const bf16_t* base; bf16_t* outb; float* part; PG8_LAS float* xch;
    __device__ __forceinline__ void operator()(Acc& acc, const Unit& u, int wr, int wc, int fr, int fq) const {
        const int row0 = u.pm * BM + wr * 64 + fr, col0 = u.pn * BM + wc * 32 + 8 * fq;
#pragma unroll
        for (int ai = 0; ai < 2; ++ai)
#pragma unroll
            for (int m = 0; m < 4; ++m) { const int row = row0 + ai * HALF + m * 16; float ss = 0.f;
#pragma unroll
                for (int bj = 0; bj < 2; ++bj) { const size_t off = (size_t)row * 2048 + col0 + bj * HALF;
                    f32x4 b0, b1; unpack8(*(const u32x4*)(base + off), b0, b1);
                    const f32x4 o0 = b0 + acc[ai][bj][m][0], o1 = b1 + acc[ai][bj][m][1];
                    *(u32x4*)(outb + off) = pack8(o0, o1);
                    ss += (o0[0] * o0[0] + o0[1] * o0[1]) + (o0[2] * o0[2] + o0[3] * o0[3]) + (o1[0] * o1[0] + o1[1] * o1[1]) + (o1[2] * o1[2] + o1[3] * o1[3]); }
                ss += __shfl_xor(ss, 16); ss += __shfl_xor(ss, 32);
                if (fq == 0) xch[(ai * HALF + wr * 64 + m * 16 + fr) * 4 + wc] = ss; }
        asm volatile("s_waitcnt lgkmcnt(0)" ::: "memory"); __builtin_amdgcn_s_barrier(); asm volatile("" ::: "memory");
        { const int t = threadIdx.x; if (t < 256) { const f32x4 v = *(const PG8_LAS f32x4*)(xch + t * 4); part[(size_t)(u.pm * BM + t) * 8 + u.pn] = (v[0] + v[1]) + (v[2] + v[3]); } }
        asm volatile("s_waitcnt lgkmcnt(0)" ::: "memory"); __builtin_amdgcn_s_barrier(); asm volatile("" ::: "memory");
    }
};
__device__ __forceinline__ float row_rs(const float* part, int row) { const f32x4 a = *(const f32x4*)(part + (size_t)row * 8), b = *(const f32x4*)(part + (size_t)row * 8 + 4);
    return __builtin_amdgcn_rsqf((((a[0] + a[1]) + (a[2] + a[3])) + ((b[0] + b[1]) + (b[2] + b[3]))) * (1.0f / 2048.0f) + 1e-6f); }
struct EpiRowScale {
    static constexpr bool PERM = true, KEEP_ACC = false;
    bf16_t* O; int ldc; const float* ssq; float scale;
    __device__ __forceinline__ void operator()(Acc& acc, const Unit& u, int wr, int wc, int fr, int fq) const {
        const int row0 = u.pm * BM + wr * 64 + fr, col0 = u.pn * BM + wc * 32 + 8 * fq;
#pragma unroll
        for (int ai = 0; ai < 2; ++ai)
#pragma unroll
            for (int m = 0; m < 4; ++m) { const int row = row0 + ai * HALF + m * 16; const float rs = row_rs(ssq, row) * scale;
                bf16_t* rowp = O + (size_t)row * ldc + col0;
#pragma unroll
                for (int bj = 0; bj < 2; ++bj) *(u32x4*)(rowp + bj * HALF) = pack8(acc[ai][bj][m][0] * rs, acc[ai][bj][m][1] * rs); }
    }
};
struct EpiSwiGLU {
    static constexpr bool PERM = true, KEEP_ACC = false;
    bf16_t* O; const float* ssq;
    __device__ __forceinline__ void operator()(Acc& acc, const Unit& u, int wr, int wc, int fr, int fq) const {
        const int row0 = u.pm * BM + wr * 64 + fr, col0 = u.pn * HALF + wc * 32 + 8 * fq;
#pragma unroll
        for (int ai = 0; ai < 2; ++ai)
#pragma unroll
            for (int m = 0; m < 4; ++m) { const int row = row0 + ai * HALF + m * 16; const float rs = row_rs(ssq, row);
                const f32x4 g0 = acc[ai][0][m][0] * rs, g1 = acc[ai][0][m][1] * rs, u0 = acc[ai][1][m][0] * rs, u1 = acc[ai][1][m][1] * rs;
                *(u32x4*)(O + (size_t)row * 5632 + col0) = pack8(g0 * sigmoid4(g0) * u0, g1 * sigmoid4(g1) * u1); }
    }
};

template <class Epi, class Sched, bool ALIGN_EPI = true>
__device__ __forceinline__ void gemm_phase(PG8_LAS unsigned char* lds, const Gemm g, const Sched& S, const Epi& E) {
    const int tid = threadIdx.x, wid = __builtin_amdgcn_readfirstlane(tid >> 6), lane = tid & 63, wr = wid >> 2, wc = wid & 3, fr = lane & 15, fq = lane >> 4;
    const int K = g.K, nt = K / BK;
    unsigned voffA[2], voffB[2];
#pragma unroll
    for (int i = 0; i < 2; ++i) { int R, C; stage_rc(tid * 16 + i * 8192, R, C); const int Rb = Epi::PERM ? ((R & ~31) + perm32(R & 31)) : R;
        voffA[i] = (unsigned)(R * K + C) * 2u; voffB[i] = (unsigned)(Rb * K + C) * 2u; }
    const size_t kstep = (size_t)(BK * 2);
    const size_t hstep = (size_t)HALF * K * 2;
    const size_t tstep = 2 * hstep;
    const unsigned ldsw = (unsigned)wid * 1024u;
    const int aoff = lds_byte(wr * 64 + fr, fq * 8), boff = lds_byte(wc * 32 + fr, fq * 8);
#define PG8_SA(b, h) (((b) * 2 + (h)) * HTB)
#define PG8_SB(b, h) ((4 + (b) * 2 + (h)) * HTB)
#define PG8_STAGE(bufoff, gbase, voff) do { _Pragma("unroll") for (int _i = 0; _i < 2; ++_i) \
        __builtin_amdgcn_global_load_lds((const unsigned*)((const char*)(gbase) + (voff)[_i]), (PG8_LAS unsigned*)(lds + (bufoff) + ldsw + _i * 8192), 16, 0, 0); } while (0)
#define PG8_LDA(dst, b, h) do { _Pragma("unroll") for (int m = 0; m < 4; ++m) _Pragma("unroll") for (int k = 0; k < 2; ++k) dst[m][k] = *(const PG8_LAS bf16x8*)(lds + PG8_SA(b, h) + aoff + m * 2048 + k * 1024); } while (0)
#define PG8_LDB(dst, b, h) do { _Pragma("unroll") for (int n = 0; n < 2; ++n) _Pragma("unroll") for (int k = 0; k < 2; ++k) dst[n][k] = *(const PG8_LAS bf16x8*)(lds + PG8_SB(b, h) + boff + n * 2048 + k * 1024); } while (0)
#define PG8_MMA(ai, bj, At, Bt) do { __builtin_amdgcn_s_setprio(1); _Pragma("unroll") for (int m = 0; m < 4; ++m) _Pragma("unroll") for (int n = 0; n < 2; ++n) _Pragma("unroll") for (int k = 0; k < 2; ++k) \
        acc[ai][bj][m][n] = __builtin_amdgcn_mfma_f32_16x16x32_bf16(Bt[n][k], At[m][k], acc[ai][bj][m][n], 0, 0, 0); __builtin_amdgcn_s_setprio(0); } while (0)
#define PG8_WAIT_V(n) asm volatile("s_waitcnt vmcnt(" #n ")" ::: "memory")
#define PG8_WAIT_L(n) asm volatile("s_waitcnt lgkmcnt(" #n ")" ::: "memory")
#define PG8_BAR __builtin_amdgcn_s_barrier()
#define PG8_SCHED __builtin_amdgcn_sched_barrier(0)
#define PG8_UA(u) ((const char*)((u).seg ? g.A1 : g.A0) + (size_t)(u).pm * tstep)
#define PG8_UB(u) ((const char*)((u).seg ? g.B1 : g.B0) + (size_t)(u).pn * tstep)
    Unit cur, nxt; int ui = 0;
    if (!S.next(0, cur)) return;
    Acc acc;
#pragma unroll
    for (int a = 0; a < 2; ++a)
#pragma unroll
        for (int b = 0; b < 2; ++b)
#pragma unroll
            for (int m = 0; m < 4; ++m)
#pragma unroll
                for (int n = 0; n < 2; ++n) acc[a][b][m][n] = (f32x4){0.f, 0.f, 0.f, 0.f};
    bf16x8 At[4][2], B0[2][2], B1[2][2];
    const char* cA = PG8_UA(cur); const char* cB = PG8_UB(cur);
    PG8_STAGE(PG8_SB(0, 0), cB, voffB); PG8_STAGE(PG8_SB(0, 1), cB + hstep, voffB); PG8_STAGE(PG8_SA(0, 0), cA, voffA); PG8_STAGE(PG8_SA(0, 1), cA + hstep, voffA);
    if (wr == 1) PG8_BAR;
    PG8_WAIT_V(2); PG8_BAR;
    PG8_STAGE(PG8_SB(1, 0), cB + kstep, voffB); PG8_STAGE(PG8_SA(1, 0), cA + kstep, voffA); PG8_STAGE(PG8_SB(1, 1), cB + hstep + kstep, voffB);
    PG8_WAIT_V(6); PG8_BAR;
    for (;;) {
        const bool has_next = S.next(ui + 1, nxt);
        const char* nA = has_next ? PG8_UA(nxt) : cA; const char* nB = has_next ? PG8_UB(nxt) : cB;
        for (int t = 0; t < nt; t += 2) {
            const bool last = (t == nt - 2);
            const char* a1 = cA + (size_t)(t + 1) * kstep;
            const char* a2 = last ? nA : cA + (size_t)(t + 2) * kstep; const char* b2 = last ? nB : cB + (size_t)(t + 2) * kstep;
            const char* a3 = a2 + kstep; const char* b3 = b2 + kstep;
            PG8_LDB(B0, 0, 0); PG8_LDB(B1, 0, 1); PG8_SCHED; PG8_LDA(At, 0, 0); PG8_STAGE(PG8_SA(1, 1), a1 + hstep, voffA);
            PG8_WAIT_V(8); PG8_WAIT_L(0); PG8_BAR; PG8_MMA(0, 0, At, B0); PG8_MMA(0, 1, At, B1); PG8_BAR; PG8_SCHED;
            PG8_LDA(At, 0, 1); PG8_STAGE(PG8_SB(0, 0), b2, voffB); PG8_STAGE(PG8_SB(0, 1), b2 + hstep, voffB); PG8_STAGE(PG8_SA(0, 0), a2, voffA);
            PG8_WAIT_V(8); PG8_WAIT_L(0); PG8_BAR; PG8_MMA(1, 0, At, B0); PG8_MMA(1, 1, At, B1); PG8_BAR; PG8_SCHED;
            PG8_LDB(B0, 1, 0); PG8_LDB(B1, 1, 1); PG8_SCHED; PG8_LDA(At, 1, 0); PG8_STAGE(PG8_SA(0, 1), a2 + hstep, voffA);
            PG8_WAIT_V(8); PG8_WAIT_L(0); PG8_BAR; PG8_MMA(0, 0, At, B0); PG8_MMA(0, 1, At, B1); PG8_BAR; PG8_SCHED;
            PG8_LDA(At, 1, 1); PG8_STAGE(PG8_SB(1, 0), b3, voffB); PG8_STAGE(PG8_SB(1, 1), b3 + hstep, voffB); PG8_STAGE(PG8_SA(1, 0), a3, voffA);
            PG8_WAIT_V(8); PG8_WAIT_L(0); PG8_BAR; PG8_MMA(1, 0, At, B0); PG8_MMA(1, 1, At, B1); PG8_BAR; PG8_SCHED;
        }
        if constexpr (ALIGN_EPI) { if (wr == 0) PG8_BAR; }
        E(acc, cur, wr, wc, fr, fq);
        if (!has_next) break;
        if (!(Epi::KEEP_ACC && cur.seg == 0)) {
#pragma unroll
        for (int a = 0; a < 2; ++a)
#pragma unroll
            for (int b = 0; b < 2; ++b)
#pragma unroll
                for (int m = 0; m < 4; ++m)
#pragma unroll
                    for (int n = 0; n < 2; ++n) acc[a][b][m][n] = (f32x4){0.f, 0.f, 0.f, 0.f};
        }
        cur = nxt; cA = nA; cB = nB; ++ui;
        if constexpr (ALIGN_EPI) { if (wr == 1) PG8_BAR; }
    }
    PG8_WAIT_V(0);
    if constexpr (!ALIGN_EPI) { if (wr == 0) PG8_BAR; }
    PG8_BAR;
#undef PG8_SA
#undef PG8_SB
#undef PG8_STAGE
#undef PG8_LDA
#undef PG8_LDB
#undef PG8_MMA
#undef PG8_WAIT_V
#undef PG8_WAIT_L
#undef PG8_BAR
#undef PG8_SCHED
#undef PG8_UA
#undef PG8_UB
}
}

constexpr int NWAVES = 8, NTHR = NWAVES * 64;
constexpr int DM = 2048, BATCH = 8, SEQ = 2048, M = BATCH * SEQ;
constexpr int INW = 8704, ZAW = 4608, ZGW = 4096;
constexpr int NMEM = 256, MROWS = BATCH * NMEM;
constexpr int DFF = 5632;
constexpr float RMS_EPS = 1e-6f;

constexpr size_t MiB = 1u << 20;
constexpr size_t WS_BAR = 256 * 1024, WS_BAR_BYTES = 64 * 1024;
constexpr size_t WS_RS1 = 0;
constexpr size_t WS_SSQ = 506 * MiB;
constexpr size_t WS_ROPE = 1 * MiB;
constexpr size_t WS_WIN = 2 * MiB;
constexpr size_t WS_WA = 36 * MiB;
constexpr size_t WS_WC = 40 * MiB;
constexpr size_t WS_WO = 44 * MiB;
constexpr size_t WS_WCQ = 52 * MiB;
constexpr size_t WS_WCKV = 54 * MiB;
constexpr size_t WS_WCO = 58 * MiB;
constexpr size_t WS_WGU = 60 * MiB;
constexpr size_t WS_WDN = 104 * MiB;
constexpr size_t WS_MEMN = 126 * MiB;
constexpr size_t WS_MEMKV = 134 * MiB;
constexpr size_t WS_ZA = 138 * MiB;
constexpr size_t WS_ZG = 282 * MiB;
constexpr size_t WS_AO = 2 * MiB;
constexpr size_t WS_CV = 410 * MiB;
constexpr size_t WS_WOB = 410 * MiB;
constexpr size_t WS_XB = 442 * MiB;
constexpr size_t WS_WOQ = 508 * MiB;
constexpr size_t WS_END = 510 * MiB;
constexpr size_t WS_MG = WS_ZA;
constexpr size_t WS_X1B = WS_ZG + 32 * MiB;
constexpr size_t WS_X3B = WS_XB;
constexpr size_t WS_QC = WS_ZG;
constexpr size_t WS_CO = WS_ZG + 16 * MiB;
constexpr size_t WS_X2B = WS_ZA;
constexpr size_t WS_ACT = WS_ZA + 64 * MiB;
static_assert(WS_ACT + (size_t)M * DFF * 2 <= WS_CV, "ACT overlay");

constexpr int LDS_BYTES = 147456;

#define GAS __attribute__((address_space(1)))
#define LAS __attribute__((address_space(3)))
typedef unsigned short bf16;
typedef unsigned v4u __attribute__((ext_vector_type(4)));
typedef float f32x4 __attribute__((ext_vector_type(4)));
#define LDS_WAIT() asm volatile("s_waitcnt lgkmcnt(0)" ::: "memory")
__device__ __forceinline__ unsigned f2bf(float f) { unsigned u = __builtin_bit_cast(unsigned, f); return (u + 0x7fffu + ((u >> 16) & 1u)) >> 16; }
__device__ __forceinline__ unsigned pk2(float lo, float hi) { return f2bf(lo) | (f2bf(hi) << 16); }
__device__ __forceinline__ float bflo(unsigned w) { return __uint_as_float(w << 16); }
__device__ __forceinline__ float bfhi(unsigned w) { return __uint_as_float(w & 0xffff0000u); }
__device__ __forceinline__ float wave_sum(float v) {
#pragma unroll
    for (int o = 1; o < 64; o <<= 1) v += __shfl_xor(v, o);
    return v;
}
__device__ __forceinline__ float wave_max(float v) {
#pragma unroll
    for (int o = 1; o < 64; o <<= 1) v = fmaxf(v, __shfl_xor(v, o));
    return v;
}

__device__ __forceinline__ int dest_row(int n0, int mode) {
    if (mode == 1) return (n0 >> 7) * 256 + (n0 & 127);
    if (mode == 2) return (n0 >> 7) * 256 + 128 + (n0 & 127);
    if (mode == 3 && n0 < 1280) return (n0 >> 8) * 256 + ((n0 >> 6) & 1) * 128 + ((n0 >> 7) & 1) * 64 + (n0 & 63);
    return n0;
}
struct TItem { const float* W; bf16* WT; const float* gk; int K, N, mode, item; };
__device__ __forceinline__ void p0_t_load(const TItem& t, f32x4 (&v)[8], int lane) {
    const int nblk = t.N / 32, kb = t.item / nblk, nb = t.item % nblk, k0 = 64 * kb, n0 = 32 * nb, kr = lane >> 3, nq = lane & 7;
#pragma unroll
    for (int i = 0; i < 8; ++i) v[i] = *(const f32x4*)(t.W + (size_t)(k0 + 8 * i + kr) * t.N + n0 + 4 * nq);
}
__device__ __forceinline__ void p0_t_store(const TItem& t, const f32x4 (&v)[8], LAS float* scr, int lane) {
    const int nblk = t.N / 32, kb = t.item / nblk, nb = t.item % nblk, k0 = 64 * kb, n0 = 32 * nb, kr = lane >> 3, nq = lane & 7;
#pragma unroll
    for (int i = 0; i < 8; ++i) { const float g = t.gk ? t.gk[k0 + 8 * i + kr] : 1.0f; LAS float* p = scr + (8 * i + kr) * 33 + 4 * nq;
        p[0] = v[i].x * g; p[1] = v[i].y * g; p[2] = v[i].z * g; p[3] = v[i].w * g; }
    LDS_WAIT(); asm volatile("" ::: "memory");
    const int c = lane & 7, r0 = dest_row(n0, t.mode);
#pragma unroll
    for (int j = 0; j < 4; ++j) { const int n = (lane >> 3) + 8 * j; const LAS float* s = scr + (8 * c) * 33 + n;
        v4u o; o.x = pk2(s[0 * 33], s[1 * 33]); o.y = pk2(s[2 * 33], s[3 * 33]); o.z = pk2(s[4 * 33], s[5 * 33]); o.w = pk2(s[6 * 33], s[7 * 33]);
        *(v4u*)(t.WT + (size_t)(r0 + n) * t.K + k0 + 8 * c) = o; }
    LDS_WAIT(); asm volatile("" ::: "memory");
}
__device__ __forceinline__ void row_to_bf16_rs(const float* xrow, bf16* orow, float* rs_out, int lane) {
    const f32x4* xr = (const f32x4*)xrow + lane;
    f32x4 v[8]; float s = 0.f;
#pragma unroll
    for (int j = 0; j < 8; ++j) { v[j] = xr[64 * j]; s += (v[j].x * v[j].x + v[j].y * v[j].y) + (v[j].z * v[j].z + v[j].w * v[j].w); }
    const float rs = 1.0f / sqrtf(wave_sum(s) * (1.0f / DM) + RMS_EPS);
    if (lane == 0) *rs_out = rs;
    unsigned long long* o8 = (unsigned long long*)orow + lane;
#pragma unroll
    for (int j = 0; j < 8; ++j) o8[64 * j] = (unsigned long long)pk2(v[j].x, v[j].y) | ((unsigned long long)pk2(v[j].z, v[j].w) << 32);
}
__device__ __forceinline__ void rms_row_to_bf16(const float* xrow, const float* g, bf16* orow, int lane) {
    const f32x4* xr = (const f32x4*)xrow + lane; const f32x4* gr = (const f32x4*)g + lane;
    f32x4 v[8]; float s = 0.f;
#pragma unroll
    for (int j = 0; j < 8; ++j) { v[j] = xr[64 * j]; s += (v[j].x * v[j].x + v[j].y * v[j].y) + (v[j].z * v[j].z + v[j].w * v[j].w); }
    const float rs = 1.0f / sqrtf(wave_sum(s) * (1.0f / DM) + RMS_EPS);
    unsigned long long* o8 = (unsigned long long*)orow + lane;
#pragma unroll
    for (int j = 0; j < 8; ++j) { const f32x4 gg = gr[64 * j];
        o8[64 * j] = (unsigned long long)pk2(v[j].x * rs * gg.x, v[j].y * rs * gg.y) | ((unsigned long long)pk2(v[j].z * rs * gg.z, v[j].w * rs * gg.w) << 32); }
}

typedef float f32x16 __attribute__((ext_vector_type(16)));
typedef short s16x8 __attribute__((ext_vector_type(8)));
typedef short s16x4 __attribute__((ext_vector_type(4)));
constexpr int ATT_KP = 272, ATT_VP = 264, ATT_V_OFF = 128 * ATT_KP, ATT_LDS = ATT_V_OFF + 128 * ATT_VP;
constexpr float LOG2E = 1.4426950408889634f;
template <bool WINDOW>
__device__ __forceinline__ void attn_unit(LAS unsigned char* lds, const bf16* qw, int qpitch, const bf16* kg, const bf16* vg, int kvpitch, int nblk,
                                          int qpos, int kpos, float m_init, float l_init, float qs, bf16* ow, int opitch, int tid, int lane) {
    const int r = lane & 31, h = lane >> 5;
    s16x8 qf[8];
#pragma unroll
    for (int kk = 0; kk < 8; ++kk) qf[kk] = *(const s16x8*)(qw + (size_t)r * qpitch + 16 * kk + 8 * h);
    f32x16 o[4];
#pragma unroll
    for (int dt = 0; dt < 4; ++dt)
#pragma unroll
        for (int i = 0; i < 16; ++i) o[dt][i] = 0.f;
    float m = m_init, l = (h == 0) ? l_init : 0.f;
    const int kkey = tid >> 4, kc = tid & 15, vkey = tid & 127, vcg = tid >> 7;
    for (int blk = 0; blk < nblk; ++blk) {
        v4u kreg[4], vreg[4];
#pragma unroll
        for (int it = 0; it < 4; ++it) { kreg[it] = *(const v4u*)(kg + (size_t)(blk * 128 + kkey + 32 * it) * kvpitch + kc * 8); vreg[it] = *(const v4u*)(vg + (size_t)(blk * 128 + vkey) * kvpitch + (vcg * 4 + it) * 8); }
        __syncthreads();
#pragma unroll
        for (int it = 0; it < 4; ++it) { *(LAS v4u*)(lds + (kkey + 32 * it) * ATT_KP + kc * 16) = kreg[it];
            LAS unsigned short* vt = (LAS unsigned short*)(lds + ATT_V_OFF) + (size_t)((vcg * 4 + it) * 8) * (ATT_VP / 2) + vkey;
            const v4u w = vreg[it];
            vt[0 * (ATT_VP / 2)] = (unsigned short)(w.x & 0xffffu); vt[1 * (ATT_VP / 2)] = (unsigned short)(w.x >> 16); vt[2 * (ATT_VP / 2)] = (unsigned short)(w.y & 0xffffu); vt[3 * (ATT_VP / 2)] = (unsigned short)(w.y >> 16);
            vt[4 * (ATT_VP / 2)] = (unsigned short)(w.z & 0xffffu); vt[5 * (ATT_VP / 2)] = (unsigned short)(w.z >> 16); vt[6 * (ATT_VP / 2)] = (unsigned short)(w.w & 0xffffu); vt[7 * (ATT_VP / 2)] = (unsigned short)(w.w >> 16); }
        __syncthreads();
#pragma unroll 1
        for (int hf = 0; hf < 2; ++hf) {
        const int thr0 = WINDOW ? (qpos - (kpos + blk * 128 + 64 * hf)) : 0;
        if (WINDOW && (thr0 - 63 > 128 || thr0 + 31 < -128)) continue;
        const bool need_mask = WINDOW && (thr0 + 31 > 128 || thr0 - 63 < -128);
        const int thr = thr0 + r - 4 * h;
        f32x16 sc[2];
#pragma unroll
        for (int kt = 0; kt < 2; ++kt) {
#pragma unroll
            for (int i = 0; i < 16; ++i) sc[kt][i] = 0.f;
#pragma unroll
            for (int kk = 0; kk < 8; ++kk) { const s16x8 kf = *(const LAS s16x8*)(lds + (64 * hf + 32 * kt + r) * ATT_KP + (16 * kk + 8 * h) * 2); sc[kt] = __builtin_amdgcn_mfma_f32_32x32x16_bf16(kf, qf[kk], sc[kt], 0, 0, 0); }
        }
        float mb = -1e30f;
#pragma unroll
        for (int kt = 0; kt < 2; ++kt)
#pragma unroll
            for (int i = 0; i < 16; ++i) {
                if (!WINDOW) sc[kt][i] *= qs;
                if (WINDOW) { if (need_mask && (unsigned)((32 * kt + (i & 3) + 8 * (i >> 2)) - thr + 128) > 256u) sc[kt][i] = -1e30f; }
                mb = fmaxf(mb, sc[kt][i]); }
        mb = fmaxf(mb, __shfl_xor(mb, 32));
        const float mn = fmaxf(m, mb), alpha = __builtin_amdgcn_exp2f((m - mn) * LOG2E), mo = mn * LOG2E;
        m = mn; l *= alpha;
#pragma unroll
        for (int dt = 0; dt < 4; ++dt) o[dt] = o[dt] * alpha;
        float ls = 0.f;
#pragma unroll
        for (int kt = 0; kt < 2; ++kt)
#pragma unroll
            for (int i = 0; i < 16; ++i) { const float p = __builtin_amdgcn_exp2f(sc[kt][i] * LOG2E - mo); sc[kt][i] = p; ls += p; }
        l += ls;
#pragma unroll
        for (int kt = 0; kt < 2; ++kt)
#pragma unroll
            for (int st = 0; st < 2; ++st) {
                v4u pw; pw.x = pg8::cvt_pk_bf16(sc[kt][8 * st + 0], sc[kt][8 * st + 1]); pw.y = pg8::cvt_pk_bf16(sc[kt][8 * st + 2], sc[kt][8 * st + 3]);
                pw.z = pg8::cvt_pk_bf16(sc[kt][8 * st + 4], sc[kt][8 * st + 5]); pw.w = pg8::cvt_pk_bf16(sc[kt][8 * st + 6], sc[kt][8 * st + 7]);
                const s16x8 pf = __builtin_bit_cast(s16x8, pw);
#pragma unroll
                for (int dt = 0; dt < 4; ++dt) { const LAS unsigned char* vp = lds + ATT_V_OFF + (32 * dt + r) * ATT_VP + (64 * hf + 32 * kt + 16 * st + 4 * h) * 2;
                    const s16x4 lo = *(const LAS s16x4*)vp, hi = *(const LAS s16x4*)(vp + 16);
                    const s16x8 vf = __builtin_shufflevector(lo, hi, 0, 1, 2, 3, 4, 5, 6, 7);
                    o[dt] = __builtin_amdgcn_mfma_f32_32x32x16_bf16(vf, pf, o[dt], 0, 0, 0); }
            }
        }
    }
    l += __shfl_xor(l, 32);
    const float inv = 1.0f / l;
    bf16* orow = ow + (size_t)r * opitch + 4 * h;
#pragma unroll
    for (int dt = 0; dt < 4; ++dt)
#pragma unroll
        for (int g = 0; g < 4; ++g) { unsigned long long w = (unsigned long long)pg8::cvt_pk_bf16(o[dt][4 * g] * inv, o[dt][4 * g + 1] * inv) | ((unsigned long long)pg8::cvt_pk_bf16(o[dt][4 * g + 2] * inv, o[dt][4 * g + 3] * inv) << 32);
            *(unsigned long long*)(orow + 32 * dt + 8 * g) = w; }
}

#define RLX_AGENT __ATOMIC_RELAXED, __HIP_MEMORY_SCOPE_AGENT
#define XB_TMO      128
#define XB_XCNT(j)  (256  + 64 * (j))
#define XB_XSUB(j)  (1280 + 64 * (j))
#define XB_XGEN(j)  (2304 + 64 * (j))
#define XB_TOP      3328
#define XB_TOPGEN   3392
#define XCD_BAR_WORDS 3456
#define XB_SPIN_CAP (1u << 18)

__device__ __forceinline__ unsigned xb_ld(unsigned* p)              { return __hip_atomic_load(p, __ATOMIC_RELAXED, __HIP_MEMORY_SCOPE_AGENT); }
__device__ __forceinline__ unsigned xb_add(unsigned* p, unsigned v) { return __hip_atomic_fetch_add(p, v, __ATOMIC_RELAXED, __HIP_MEMORY_SCOPE_AGENT); }
__device__ __forceinline__ unsigned xb_xcc_id() { return (unsigned)__builtin_amdgcn_s_getreg((3 << 11) | 20) & 0xFu; }
#define XB_SPIN(cond, bar) do { unsigned _sp = 0; while (cond) { __builtin_amdgcn_s_sleep(1); \
    if ((++_sp & 255u) == 0u) { if (xb_ld(&(bar)[XB_TMO])) break; if (_sp > XB_SPIN_CAP) { atomicAdd(&(bar)[XB_TMO], 1u); break; } } } } while (0)

struct XcdBarrier {
    unsigned* bar; unsigned x;
    volatile LAS unsigned* st;
};

__device__ __forceinline__ XcdBarrier xcd_barrier_post(unsigned* bar, volatile LAS unsigned* st) {
    XcdBarrier b; b.bar = bar; b.x = xb_xcc_id(); b.st = st;
    if (threadIdx.x == 0) (void)xb_add(&bar[XB_XCNT(b.x)], 1u);
    return b;
}
__device__ __forceinline__ void xcd_barrier_complete(unsigned* bar, unsigned x, unsigned& nloc, unsigned& nx) {
    const unsigned G = gridDim.x * gridDim.y * gridDim.z;
    unsigned sum, cnt, mine, sp = 0u;
    for (;;) {
        sum = 0u; cnt = 0u; mine = 0u;
#pragma unroll
        for (unsigned j = 0; j < 16; ++j) { const unsigned c = xb_ld(&bar[XB_XCNT(j)]); sum += c; cnt += (c > 0u) ? 1u : 0u; mine = (j == x) ? c : mine; }
        if (sum == G) break;
        __builtin_amdgcn_s_sleep(1);
        if ((++sp & 255u) == 0u) { if (xb_ld(&bar[XB_TMO])) break; if (sp > XB_SPIN_CAP) { atomicAdd(&bar[XB_TMO], 1u); break; } }
    }
    nloc = mine > 0u ? mine : 1u; nx = cnt > 0u ? cnt : 1u;
}

__device__ __forceinline__ void xcd_barrier(const XcdBarrier& b) {
    asm volatile("s_waitcnt vmcnt(0)" ::: "memory");
    __syncthreads();
    if (threadIdx.x == 0) {
        unsigned* bar = b.bar;
        __builtin_amdgcn_s_waitcnt(0);
        unsigned nloc = b.st[0], nx = b.st[1];
        if (nloc == 0u) { xcd_barrier_complete(bar, b.x, nloc, nx); b.st[0] = nloc; b.st[1] = nx; }
        const unsigned old = xb_add(&bar[XB_XSUB(b.x)], 1u);
        const unsigned gen = old / nloc;
        if (old + 1u == (gen + 1u) * nloc) {
            __builtin_amdgcn_fence(__ATOMIC_RELEASE, "agent");
            asm volatile("s_waitcnt vmcnt(0)" ::: "memory");
            const unsigned og = xb_add(&bar[XB_TOP], 1u);
            const unsigned tg = og / nx;
            if (og + 1u == (tg + 1u) * nx) xb_add(&bar[XB_TOPGEN], 1u);
            else XB_SPIN(xb_ld(&bar[XB_TOPGEN]) == tg, bar);
            __builtin_amdgcn_fence(__ATOMIC_ACQUIRE, "agent");
            xb_add(&bar[XB_XGEN(b.x)], 1u);
            asm volatile("s_waitcnt vmcnt(0)" ::: "memory");
        } else {
            XB_SPIN(xb_ld(&bar[XB_XGEN(b.x)]) == gen, bar);
            __builtin_amdgcn_fence(__ATOMIC_ACQUIRE, "agent");
            asm volatile("s_waitcnt vmcnt(0)" ::: "memory");
        }
    }
    __syncthreads();
}

struct Args { const float* in[20]; float* out; unsigned char* ws; int ph_lo, ph_hi, li, pad; };

__global__ void __launch_bounds__(NTHR, 2) mk_fwd(Args args) {
    extern __shared__ __attribute__((aligned(16))) unsigned char lds_raw[];
    LAS unsigned char* lds = (LAS unsigned char*)lds_raw;
    const int tid = threadIdx.x, lane = tid & 63, wave = __builtin_amdgcn_readfirstlane(tid >> 6);
    const int G = gridDim.x, bx = blockIdx.x;
    const int gw = bx * NWAVES + wave, NGW = G * NWAVES;
    unsigned char* ws = args.ws;
    const float* x = args.in[0]; const float* mem = args.in[1]; const float* g_mix = args.in[2]; const float* w_in = args.in[3]; const float* sink = args.in[4];
    const float* conv_w = args.in[5]; const float* b_gate = args.in[6]; const float* w_attn_out = args.in[7]; const float* w_conv_out = args.in[8]; const float* w_o = args.in[9];
    const float* g_cross = args.in[10]; const float* g_mem = args.in[11]; const float* w_cq = args.in[12]; const float* w_ckv = args.in[13]; const float* w_co = args.in[14];
    const float* g_ffn = args.in[15]; const float* w_gate = args.in[16]; const float* w_up = args.in[17]; const float* w_down = args.in[18]; const float* g_final = args.in[19];
    float* out = args.out;
    float* ssq2 = (float*)(ws + WS_SSQ); float* ssq3 = ssq2 + M * 8; float* ssq4 = ssq3 + M * 8;
    PG8_LAS float* xch = (PG8_LAS float*)(lds + pg8::STAGE_BYTES);
    float* cosT = (float*)(ws + WS_ROPE); float* sinT = cosT + SEQ * 64;
    bf16* Wt_in = (bf16*)(ws + WS_WIN); bf16* Wt_a = (bf16*)(ws + WS_WA); bf16* Wt_c = (bf16*)(ws + WS_WC); bf16* Wt_o = (bf16*)(ws + WS_WO);
    bf16* Wt_cq = (bf16*)(ws + WS_WCQ); bf16* Wt_ckv = (bf16*)(ws + WS_WCKV); bf16* Wt_co = (bf16*)(ws + WS_WCO); bf16* Wt_gu = (bf16*)(ws + WS_WGU); bf16* Wt_dn = (bf16*)(ws + WS_WDN);
    bf16* MEMN = (bf16*)(ws + WS_MEMN); bf16* MEMKV = (bf16*)(ws + WS_MEMKV);
    bf16* ZA = (bf16*)(ws + WS_ZA); bf16* ZG = (bf16*)(ws + WS_ZG); bf16* AO = (bf16*)(ws + WS_AO); bf16* CV = (bf16*)(ws + WS_CV);
    bf16* MG = (bf16*)(ws + WS_MG); bf16* X1B = (bf16*)(ws + WS_X1B); bf16* X3B = (bf16*)(ws + WS_X3B); bf16* XB = (bf16*)(ws + WS_XB); bf16* WOB = (bf16*)(ws + WS_WOB); bf16* WOQ = (bf16*)(ws + WS_WOQ); float* rs1 = (float*)(ws + WS_RS1); bf16* QC = (bf16*)(ws + WS_QC); bf16* CO = (bf16*)(ws + WS_CO);
    bf16* X2B = (bf16*)(ws + WS_X2B); bf16* ACT = (bf16*)(ws + WS_ACT);
    cg::grid_group grid = cg::this_grid();
    const int lo = args.ph_lo, hi = args.ph_hi;
#define IN(k) (lo <= (k) && (k) < hi)
#define SEAM(k) do { if (IN(k) && IN((k) + 1)) { if (args.ph_hi > 1000) { asm volatile("s_waitcnt vmcnt(0) lgkmcnt(0)" ::: "memory"); __syncthreads(); grid.sync(); } else xcd_barrier(xbar); } } while (0)
    if (tid < 4) ((LAS unsigned*)(lds + pg8::STAGE_BYTES + 8192))[tid] = 0u;
    __syncthreads();
    const XcdBarrier xbar = xcd_barrier_post((unsigned*)(ws + WS_BAR) + args.li * 4096, (volatile LAS unsigned*)(lds + pg8::STAGE_BYTES + 8192));

    if (IN(0)) {
        LAS float* scr = (LAS float*)(lds + wave * 16384);
        constexpr int I_IN = (DM / 64) * (INW / 32), I_A = (1024 / 64) * (DM / 32), I_O = (DM / 64) * (DM / 32), I_CQ = (DM / 64) * (512 / 32), I_CKV = (DM / 64) * (1024 / 32),
                      I_CO = (512 / 64) * (DM / 32), I_G = (DM / 64) * (DFF / 32), I_D = (DFF / 64) * (DM / 32);
        constexpr int NITEMS = I_IN + 2 * I_A + I_O + I_CQ + I_CKV + I_CO + 2 * I_G + I_D;
#define P0_PICK(t, itx) do { int r = (itx); \
            if (r < I_IN) { t = TItem{w_in, Wt_in, g_mix, DM, INW, 3, r}; break; } r -= I_IN; \
            if (r < I_A) { t = TItem{w_attn_out, Wt_a, nullptr, 1024, DM, 0, r}; break; } r -= I_A; \
            if (r < I_A) { t = TItem{w_conv_out, Wt_c, nullptr, 1024, DM, 0, r}; break; } r -= I_A; \
            if (r < I_O) { t = TItem{w_o, Wt_o, nullptr, DM, DM, 0, r}; break; } r -= I_O; \
            if (r < I_CQ) { t = TItem{w_cq, Wt_cq, g_cross, DM, 512, 0, r}; break; } r -= I_CQ; \
            if (r < I_CKV) { t = TItem{w_ckv, Wt_ckv, nullptr, DM, 1024, 0, r}; break; } r -= I_CKV; \
            if (r < I_CO) { t = TItem{w_co, Wt_co, nullptr, 512, DM, 0, r}; break; } r -= I_CO; \
            if (r < I_G) { t = TItem{w_gate, Wt_gu, g_ffn, DM, DFF, 1, r}; break; } r -= I_G; \
            if (r < I_G) { t = TItem{w_up, Wt_gu, g_ffn, DM, DFF, 2, r}; break; } r -= I_G; \
            t = TItem{w_down, Wt_dn, nullptr, DFF, DM, 0, r}; } while (0)
        for (int it = gw; it < NITEMS; it += 2 * NGW) {
            TItem t0, t1; f32x4 v0[8], v1[8]; const bool two = it + NGW < NITEMS;
            P0_PICK(t0, it); p0_t_load(t0, v0, lane);
            if (two) { P0_PICK(t1, it + NGW); p0_t_load(t1, v1, lane); }
            p0_t_store(t0, v0, scr, lane);
            if (two) p0_t_store(t1, v1, scr, lane);
        }
#undef P0_PICK
        for (int m = gw; m < M; m += NGW) row_to_bf16_rs(x + (size_t)m * DM, XB + (size_t)m * DM, rs1 + m, lane);
        for (int i = bx * NTHR + tid; i < DM * DM / 8; i += G * NTHR) { const f32x4 a = *(const f32x4*)(w_o + (size_t)i * 8), b = *(const f32x4*)(w_o + (size_t)i * 8 + 4); *(v4u*)(WOB + (size_t)i * 8) = pg8::pack8(a, b); }
        for (int m = gw; m < MROWS; m += NGW) rms_row_to_bf16(mem + (size_t)m * DM, g_mem, MEMN + (size_t)m * DM, lane);
        for (int i = bx * NTHR + tid; i < SEQ * 64; i += G * NTHR) { const int pos = i >> 6, j = i & 63;
            const float inv = exp2f(-(float)j * (13.287712379549449f / 64.0f)); const float ang = (float)pos * inv;
            cosT[i] = cosf(ang); sinT[i] = sinf(ang); }
    }
    SEAM(0);

    if (IN(1)) {
        { pg8::Gemm g{XB, Wt_in, nullptr, nullptr, M, INW, DM}; pg8::StaticOrder S; S.init(M, INW, G, bx);
          pg8::EpiIn E{ZA, ZG, cosT, sinT, b_gate, 0.08838834764831845f, rs1};
          pg8::gemm_phase<pg8::EpiIn, pg8::StaticOrder>(lds, g, S, E); }
        { pg8::Gemm g{MEMN, Wt_ckv, nullptr, nullptr, MROWS, 1024, DM}; pg8::StaticOrder S; S.init(MROWS, 1024, G, (bx + G / 2) % G);
          pg8::EpiBf16 E{MEMKV, 1024};
          pg8::gemm_phase<pg8::EpiBf16, pg8::StaticOrder>(lds, g, S, E); }
        { pg8::Gemm g{Wt_cq, WOB, nullptr, nullptr, 512, DM, DM}; pg8::StaticOrder S; S.init(512, DM, G, (bx + G / 2 - 32 + G) % G);
          pg8::EpiBf16 E{WOQ, DM};
          pg8::gemm_phase<pg8::EpiBf16, pg8::StaticOrder>(lds, g, S, E); }
    }
    SEAM(1);

    if (IN(2)) {
        for (int it = 2 * bx; it < 512; it += 2 * G)
            for (int hp = 0; hp < 2; ++hp) { const int kvh = it >> 1 & 1, nb = (it >> 2) & 15, b = it >> 6;
                const int hq = kvh * 4 + hp * 2 + (wave >> 2), t0 = b * SEQ + nb * 128 + (wave & 3) * 32;
                const int kb0 = nb > 0 ? nb - 1 : 0, kb1 = nb < 15 ? nb + 1 : 15; const size_t kt0 = (size_t)b * SEQ + kb0 * 128;
                attn_unit<true>(lds, ZA + (size_t)t0 * ZAW + hq * 128, ZAW, ZA + kt0 * ZAW + 1024 + kvh * 128, ZA + kt0 * ZAW + 1280 + kvh * 128, ZAW, kb1 - kb0 + 1,
                                nb * 128 + (wave & 3) * 32, kb0 * 128, sink[hq], 1.0f, 1.0f, AO + (size_t)t0 * 1024 + hq * 128, 1024, tid, lane); }
        __syncthreads();
        for (int idx = bx * NTHR + tid; idx < (M / 16) * 128; idx += G * NTHR) { const int run = idx >> 7, c8 = (idx & 127) * 8, t0 = run * 16, s0 = t0 & (SEQ - 1);
            const f32x4 w0a = *(const f32x4*)(conv_w + c8), w0b = *(const f32x4*)(conv_w + c8 + 4), w1a = *(const f32x4*)(conv_w + 1024 + c8), w1b = *(const f32x4*)(conv_w + 1024 + c8 + 4),
                        w2a = *(const f32x4*)(conv_w + 2048 + c8), w2b = *(const f32x4*)(conv_w + 2048 + c8 + 4);
            const bf16* zr = ZA + (size_t)t0 * ZAW + c8;
            f32x4 pa = {0.f, 0.f, 0.f, 0.f}, pb = pa, ca, cb, ta, tb;
            if (s0 > 0) { pg8::unpack8(*(const v4u*)(zr - ZAW + 1536), pa, pb); pg8::unpack8(*(const v4u*)(zr - ZAW + 3584), ta, tb); pa = pa * ta; pb = pb * tb; }
            pg8::unpack8(*(const v4u*)(zr + 1536), ca, cb); pg8::unpack8(*(const v4u*)(zr + 3584), ta, tb); ca = ca * ta; cb = cb * tb;
#pragma unroll
            for (int i = 0; i < 16; ++i) { f32x4 na = {0.f, 0.f, 0.f, 0.f}, nbv = na, ga, gb;
                if (i < 15 || s0 + 16 < SEQ) { pg8::unpack8(*(const v4u*)(zr + (size_t)(i + 1) * ZAW + 1536), na, nbv); pg8::unpack8(*(const v4u*)(zr + (size_t)(i + 1) * ZAW + 3584), ta, tb); na = na * ta; nbv = nbv * tb; }
                pg8::unpack8(*(const v4u*)(zr + (size_t)i * ZAW + 2560), ga, gb);
                *(v4u*)(CV + (size_t)(t0 + i) * 1024 + c8) = pg8::pack8(ga * (w0a * pa + w1a * ca + w2a * na), gb * (w0b * pb + w1b * cb + w2b * nbv));
                pa = ca; pb = cb; ca = na; cb = nbv; }
        }
    }
    SEAM(2);

    if (IN(3)) {
        pg8::Gemm g{AO, Wt_a, CV, Wt_c, M, DM, 1024}; pg8::StaticOrder S; S.init(M, DM, G, bx, 2);
        pg8::EpiMerge E{ZG, MG};
        pg8::gemm_phase<pg8::EpiMerge, pg8::StaticOrder>(lds, g, S, E);
    }
    SEAM(3);

    if (IN(4)) {
        { pg8::Gemm g{XB, Wt_cq, MG, WOQ, M, 512, DM}; pg8::ListOrder S{bx, bx < 128 ? 1 : 0, 2, 2};
          pg8::EpiAcc2 E{QC, 512};
          pg8::gemm_phase<pg8::EpiAcc2, pg8::ListOrder>(lds, g, S, E); }
        { pg8::Gemm g{MG, Wt_o, nullptr, nullptr, M, DM, DM}; pg8::ListOrder S{bx < 128 ? bx : 128 + (bx - 128) * 3, bx < 128 ? 1 : 3, 8, 1};
          pg8::EpiResB E{XB, X1B, ssq2, xch};
          pg8::gemm_phase<pg8::EpiResB, pg8::ListOrder>(lds, g, S, E); }
    }
    SEAM(4);

    if (IN(6)) {
        for (int it = bx; it < 256; it += G) { const int rb = it & 7, hh = (it >> 3) & 3, b = it >> 5; const int t0 = b * SEQ + rb * 256 + wave * 32;
            attn_unit<false>(lds, QC + (size_t)t0 * 512 + hh * 128, 512, MEMKV + (size_t)(b * NMEM) * 1024 + hh * 128, MEMKV + (size_t)(b * NMEM) * 1024 + 512 + hh * 128, 1024, 2,
                             0, 0, -1e30f, 0.0f, pg8::row_rs(ssq2, t0 + (lane & 31)) * 0.08838834764831845f, CO + (size_t)t0 * 512 + hh * 128, 512, tid, lane); }
    }
    SEAM(6);

    if (IN(7)) {
        pg8::Gemm g{CO, Wt_co, nullptr, nullptr, M, DM, 512}; pg8::StaticOrder S; S.init(M, DM, G, bx);
        pg8::EpiResB E{X1B, X2B, ssq3, xch};
        pg8::gemm_phase<pg8::EpiResB, pg8::StaticOrder>(lds, g, S, E);
    }
    SEAM(7);

    if (IN(8)) {
        pg8::Gemm g{X2B, Wt_gu, nullptr, nullptr, M, 2 * DFF, DM}; pg8::StaticOrder S; S.init(M, 2 * DFF, G, bx);
        pg8::EpiSwiGLU E{ACT, ssq3};
        pg8::gemm_phase<pg8::EpiSwiGLU, pg8::StaticOrder>(lds, g, S, E);
    }
    SEAM(8);

    if (IN(9)) {
        pg8::Gemm g{ACT, Wt_dn, nullptr, nullptr, M, DM, DFF}; pg8::StaticOrder S; S.init(M, DM, G, bx);
        pg8::EpiResB E{X2B, X3B, ssq4, xch};
        pg8::gemm_phase<pg8::EpiResB, pg8::StaticOrder>(lds, g, S, E);
    }
    SEAM(9);

    if (IN(10)) {
        for (int m = gw; m < M; m += NGW) { const v4u* xr = (const v4u*)(X3B + (size_t)m * DM) + lane; f32x4* orow = (f32x4*)(out + (size_t)m * DM); const f32x4* gr = (const f32x4*)g_final;
            const float rs = pg8::row_rs(ssq4, m);
#pragma unroll
            for (int j = 0; j < 4; ++j) { f32x4 a, b; pg8::unpack8(xr[64 * j], a, b); const int c = (64 * j + lane) * 2;
                orow[c] = a * rs * gr[c]; orow[c + 1] = b * rs * gr[c + 1]; } }
    }
#if defined(MK_DUMP_OFF)
    if (hi == MK_CUT && MK_CUT < 11) {
        asm volatile("s_waitcnt vmcnt(0) lgkmcnt(0)" ::: "memory"); __syncthreads(); grid.sync();
        const bf16* src = (const bf16*)(ws + (size_t)(MK_DUMP_OFF));
        for (size_t i = (size_t)bx * NTHR + tid; i < (size_t)M * 2048; i += (size_t)G * NTHR) { const size_t r = i >> 11, c = i & 2047; out[i] = __uint_as_float((unsigned)src[r * (MK_DUMP_LD) + (c % (MK_DUMP_W)) + (c / (MK_DUMP_W)) * (size_t)(MK_DUMP_OFF2)] << 16); }
    }
#endif
#undef IN
#undef SEAM
}

extern "C" void kernel_launch(void* const* d_in, const int* in_sizes, int n_in, void* d_out, int out_size, void* d_ws, size_t ws_size, hipStream_t stream) {
    static int grid = 0;
    if (grid == 0) {
        if (n_in != 20 || in_sizes[0] != M * DM || out_size != M * DM || ws_size < WS_END) { fprintf(stderr, "kernel_launch: unexpected shapes / workspace (n_in %d, ws %zu)\n", n_in, ws_size); grid = -1; return; }
        int dev = 0, cus = 0, per_cu = 0;
        if (hipGetDevice(&dev) != hipSuccess || hipDeviceGetAttribute(&cus, hipDeviceAttributeMultiprocessorCount, dev) != hipSuccess) { grid = -1; return; }
        if (hipFuncSetAttribute((const void*)mk_fwd, hipFuncAttributeMaxDynamicSharedMemorySize, LDS_BYTES) != hipSuccess) { fprintf(stderr, "kernel_launch: hipFuncSetAttribute failed\n"); grid = -1; return; }
        if (hipOccupancyMaxActiveBlocksPerMultiprocessor(&per_cu, (const void*)mk_fwd, NTHR, LDS_BYTES) != hipSuccess || per_cu < 1) { fprintf(stderr, "kernel_launch: occupancy query says %d\n", per_cu); (void)hipGetLastError(); grid = -1; return; }
        grid = cus;
    }
    if (grid < 0) return;
    Args a{};
    for (int i = 0; i < 20; ++i) a.in[i] = (const float*)d_in[i];
    a.out = (float*)d_out; a.ws = (unsigned char*)d_ws;
    if (hipMemsetAsync((char*)d_ws + WS_BAR, 0, WS_BAR_BYTES, stream) != hipSuccess) { fprintf(stderr, "kernel_launch: hipMemsetAsync of the barrier words failed\n"); return; }
#if defined(MK_PROBE_DUP)
    { void* kargs[] = {&a}; a.ph_lo = 0; a.ph_hi = MK_PROBE_DUP + 1; hipLaunchCooperativeKernel((const void*)mk_fwd, dim3(grid), dim3(NTHR), kargs, LDS_BYTES, stream);
      a.ph_lo = MK_PROBE_DUP; a.ph_hi = 11; a.li = 1; hipLaunchCooperativeKernel((const void*)mk_fwd, dim3(grid), dim3(NTHR), kargs, LDS_BYTES, stream); }
#elif MK_N_LAUNCHES == 1
    a.ph_lo = 0; a.ph_hi = MK_CUT;
    void* kargs[] = {&a};
    hipError_t e = hipLaunchCooperativeKernel((const void*)mk_fwd, dim3(grid), dim3(NTHR), kargs, LDS_BYTES, stream);
    if (e != hipSuccess) fprintf(stderr, "kernel_launch: cooperative launch failed: %s (grid %d)\n", hipGetErrorString(e), grid);
#else
    for (int p = 0; p < 11; ++p) { a.ph_lo = p; a.ph_hi = p + 1; hipLaunchKernelGGL(mk_fwd, dim3(grid), dim3(NTHR), LDS_BYTES, stream, a); }
#endif
}
```

```cpp
#include <hip/hip_runtime.h>
#include <hip/hip_cooperative_groups.h>
#include <cstdio>
#include <cstdint>
namespace cg = cooperative_groups;

#ifndef MK_CUT
#define MK_CUT 11
#endif
#ifndef MK_N_LAUNCHES
#define MK_N_LAUNCHES 1
#endif

namespace pg8 {
#define PG8_LAS __attribute__((address_space(3)))
typedef unsigned short bf16_t;
typedef short bf16x8 __attribute__((ext_vector_type(8)));
typedef float f32x4 __attribute__((ext_vector_type(4)));
typedef unsigned u32x4 __attribute__((ext_vector_type(4)));
constexpr int BM = 256, BK = 64, HALF = 128, HTB = HALF * BK * 2, STAGE_BYTES = 8 * HTB, NXCD = 8, WGM = 8;

__host__ __device__ __forceinline__ int lds_byte(int r, int c) { const int st = (r >> 4) * 2 + (c >> 5), rr = r & 15, cc = c & 31, ob = rr * 64 + cc * 2; return st * 1024 + (ob ^ (((ob >> 9) & 1) << 5)); }
__host__ __device__ __forceinline__ void stage_rc(int b, int& R, int& C) { const int st = b / 1024, sb = b % 1024, swz = sb ^ (((sb >> 9) & 1) << 5); R = (st >> 1) * 16 + swz / 64; C = (st & 1) * 32 + (swz % 64) / 2; }
__host__ __device__ __forceinline__ int perm32(int rho) { const int n = rho >> 4, i = rho & 15; return 8 * (i >> 2) + 4 * n + (i & 3); }

struct Unit { int pm, pn, seg; };
struct Gemm { const bf16_t* A0; const bf16_t* B0; const bf16_t* A1; const bf16_t* B1; int M, N, K; };

struct StaticOrder {
    int nM, nN, nwg, G, c, nseg;
    __device__ void init(int M, int N, int G_, int c_, int nseg_ = 1) { nM = M / BM; nN = N / BM; nwg = nM * nN; G = G_; c = c_; nseg = nseg_; }
    __device__ bool next(int i, Unit& u) const {
        const int j = (nseg == 2) ? (i >> 1) : i; u.seg = (nseg == 2) ? (i & 1) : 0;
        const long L = (long)j * G + c; if (L >= nwg) return false;
        int wgid = (int)L; { const int q = nwg / NXCD, r = nwg % NXCD, xcd = wgid % NXCD, off = wgid / NXCD; wgid = (xcd < r ? xcd * (q + 1) : r * (q + 1) + (xcd - r) * q) + off; }
        const int nig = WGM * nN, gid = wgid / nig, fm = gid * WGM, gsz = (nM - fm) < WGM ? (nM - fm) : WGM;
        u.pm = fm + ((wgid % nig) % gsz); u.pn = (wgid % nig) / gsz; return true;
    }
};

typedef __bf16 bf16x2_t __attribute__((ext_vector_type(2)));
typedef float f32x2_t __attribute__((ext_vector_type(2)));
struct ListOrder {
    int first, count, nN, nseg;
    __device__ bool next(int i, Unit& u) const { const int j = (nseg == 2) ? (i >> 1) : i; u.seg = (nseg == 2) ? (i & 1) : 0; if (j >= count) return false; const int L = first + j; u.pm = L / nN; u.pn = L % nN; return true; }
};
__device__ __forceinline__ unsigned cvt_pk_bf16(float lo, float hi) { const f32x2_t v = {lo, hi}; const bf16x2_t r = __builtin_convertvector(v, bf16x2_t); return __builtin_bit_cast(unsigned, r); }
__device__ __forceinline__ u32x4 pack8(const f32x4 a, const f32x4 b) { u32x4 w; w.x = cvt_pk_bf16(a[0], a[1]); w.y = cvt_pk_bf16(a[2], a[3]); w.z = cvt_pk_bf16(b[0], b[1]); w.w = cvt_pk_bf16(b[2], b[3]); return w; }
__device__ __forceinline__ void unpack8(const u32x4 w, f32x4& a, f32x4& b) {
    a[0] = __uint_as_float(w.x << 16); a[1] = __uint_as_float(w.x & 0xffff0000u); a[2] = __uint_as_float(w.y << 16); a[3] = __uint_as_float(w.y & 0xffff0000u);
    b[0] = __uint_as_float(w.z << 16); b[1] = __uint_as_float(w.z & 0xffff0000u); b[2] = __uint_as_float(w.w << 16); b[3] = __uint_as_float(w.w & 0xffff0000u); }
__device__ __forceinline__ f32x4 sigmoid4(const f32x4 v) { f32x4 o;
#pragma unroll
    for (int i = 0; i < 4; ++i) o[i] = __builtin_amdgcn_rcpf(1.0f + __expf(-v[i]));
    return o; }

typedef f32x4 Acc[2][2][4][2];

struct EpiBf16 {
    static constexpr bool PERM = true, KEEP_ACC = false;
    bf16_t* O; int ldc;
    __device__ __forceinline__ void operator()(Acc& acc, const Unit& u, int wr, int wc, int fr, int fq) const {
        const int row0 = u.pm * BM + wr * 64 + fr, col0 = u.pn * BM + wc * 32 + 8 * fq;
#pragma unroll
        for (int ai = 0; ai < 2; ++ai)
#pragma unroll
            for (int m = 0; m < 4; ++m) { bf16_t* rowp = O + (size_t)(row0 + ai * HALF + m * 16) * ldc + col0;
#pragma unroll
                for (int bj = 0; bj < 2; ++bj) *(u32x4*)(rowp + bj * HALF) = pack8(acc[ai][bj][m][0], acc[ai][bj][m][1]); }
    }
};
struct EpiIn {
    static constexpr bool PERM = true, KEEP_ACC = false;
    bf16_t* ZA; bf16_t* ZG; const float* cosT; const float* sinT; const float* bgate; float qscale; const float* rs1;
    __device__ __forceinline__ void operator()(Acc& acc, const Unit& u, int wr, int wc, int fr, int fq) const {
        const int row0 = u.pm * BM + wr * 64 + fr;
#pragma unroll
        for (int ai = 0; ai < 2; ++ai)
#pragma unroll
            for (int m = 0; m < 4; ++m) { const float rs = rs1[row0 + ai * HALF + m * 16];
#pragma unroll
                for (int bj = 0; bj < 2; ++bj) { acc[ai][bj][m][0] = acc[ai][bj][m][0] * rs; acc[ai][bj][m][1] = acc[ai][bj][m][1] * rs; } }
        if (u.pn < 5) {
            const int p = wc * 32 + 8 * fq, hb = p >> 6, j0 = p & 63, c1 = u.pn * 256 + hb * 128 + j0;
            const float sc = u.pn < 4 ? qscale : 1.0f;
#pragma unroll
            for (int ai = 0; ai < 2; ++ai)
#pragma unroll
                for (int m = 0; m < 4; ++m) { const int row = row0 + ai * HALF + m * 16, pos = row & 2047;
                    const f32x4 ca = *(const f32x4*)(cosT + pos * 64 + j0), cb = *(const f32x4*)(cosT + pos * 64 + j0 + 4);
                    const f32x4 sa = *(const f32x4*)(sinT + pos * 64 + j0), sb = *(const f32x4*)(sinT + pos * 64 + j0 + 4);
                    const f32x4 t1a = acc[ai][0][m][0], t1b = acc[ai][0][m][1], t2a = acc[ai][1][m][0], t2b = acc[ai][1][m][1];
                    const f32x4 o1a = (t1a * ca - t2a * sa) * sc, o1b = (t1b * cb - t2b * sb) * sc, o2a = (t2a * ca + t1a * sa) * sc, o2b = (t2b * cb + t1b * sb) * sc;
                    bf16_t* rp = ZA + (size_t)row * 4608 + c1;
                    *(u32x4*)rp = pack8(o1a, o1b); *(u32x4*)(rp + 64) = pack8(o2a, o2b); }
        } else if (u.pn < 18) {
            const int col0 = u.pn * BM + wc * 32 + 8 * fq;
#pragma unroll
            for (int ai = 0; ai < 2; ++ai)
#pragma unroll
                for (int m = 0; m < 4; ++m) { bf16_t* rowp = ZA + (size_t)(row0 + ai * HALF + m * 16) * 4608 + col0;
#pragma unroll
                    for (int bj = 0; bj < 2; ++bj) *(u32x4*)(rowp + bj * HALF) = pack8(acc[ai][bj][m][0], acc[ai][bj][m][1]); }
        } else {
            const int col0 = (u.pn - 18) * BM + wc * 32 + 8 * fq;
#pragma unroll
            for (int bj = 0; bj < 2; ++bj) { const f32x4 b0 = *(const f32x4*)(bgate + col0 + bj * HALF), b1 = *(const f32x4*)(bgate + col0 + bj * HALF + 4);
#pragma unroll
                for (int ai = 0; ai < 2; ++ai)
#pragma unroll
                    for (int m = 0; m < 4; ++m) { bf16_t* rowp = ZG + (size_t)(row0 + ai * HALF + m * 16) * 4096 + col0 + bj * HALF;
                        *(u32x4*)rowp = pack8(sigmoid4(acc[ai][bj][m][0] + b0), sigmoid4(acc[ai][bj][m][1] + b1)); } }
        }
    }
};
struct EpiAcc2 {
    static constexpr bool PERM = true, KEEP_ACC = true;
    bf16_t* O; int ldc;
    __device__ __forceinline__ void operator()(Acc& acc, const Unit& u, int wr, int wc, int fr, int fq) const {
        if (u.seg == 0) return;
        const int row0 = u.pm * BM + wr * 64 + fr, col0 = u.pn * BM + wc * 32 + 8 * fq;
#pragma unroll
        for (int ai = 0; ai < 2; ++ai)
#pragma unroll
            for (int m = 0; m < 4; ++m) { bf16_t* rowp = O + (size_t)(row0 + ai * HALF + m * 16) * ldc + col0;
#pragma unroll
                for (int bj = 0; bj < 2; ++bj) *(u32x4*)(rowp + bj * HALF) = pack8(acc[ai][bj][m][0], acc[ai][bj][m][1]); }
    }
};
struct EpiMerge {
    static constexpr bool PERM = true, KEEP_ACC = true;
    const bf16_t* ZG; bf16_t* O;
    __device__ __forceinline__ void operator()(Acc& acc, const Unit& u, int wr, int wc, int fr, int fq) const {
        const int row0 = u.pm * BM + wr * 64 + fr, col0 = u.pn * BM + wc * 32 + 8 * fq;
#pragma unroll
        for (int ai = 0; ai < 2; ++ai)
#pragma unroll
            for (int m = 0; m < 4; ++m) { const int row = row0 + ai * HALF + m * 16;
#pragma unroll
                for (int bj = 0; bj < 2; ++bj) { const bf16_t* gp = ZG + (size_t)row * 4096 + col0 + bj * HALF;
                    f32x4 c0, c1; unpack8(*(const u32x4*)(gp + 2048), c0, c1);
                    if (u.seg == 0) { f32x4 a0, a1; unpack8(*(const u32x4*)gp, a0, a1);
#pragma unroll
                        for (int i = 0; i < 4; ++i) { acc[ai][bj][m][0][i] *= a0[i] * __builtin_amdgcn_rcpf(c0[i]); acc[ai][bj][m][1][i] *= a1[i] * __builtin_amdgcn_rcpf(c1[i]); }
                    } else { *(u32x4*)(O + (size_t)row * 2048 + col0 + bj * HALF) = pack8(acc[ai][bj][m][0] * c0, acc[ai][bj][m][1] * c1); } } }
    }
};
struct EpiRes {
    static constexpr bool PERM = true, KEEP_ACC = false;
    const float* base; float* out; bf16_t* outb; float* part; PG8_LAS float* xch;
    __device__ __forceinline__ void operator()(Acc& acc, const Unit& u, int wr, int wc, int fr, int fq) const {
        const int row0 = u.pm * BM + wr * 64 + fr, col0 = u.pn * BM + wc * 32 + 8 * fq;
#pragma unroll
        for (int ai = 0; ai < 2; ++ai)
#pragma unroll
            for (int m = 0; m < 4; ++m) { const int row = row0 + ai * HALF + m * 16; float ss = 0.f;
#pragma unroll
                for (int bj = 0; bj < 2; ++bj) { const size_t off = (size_t)row * 2048 + col0 + bj * HALF;
                    const f32x4 o0 = *(const f32x4*)(base + off) + acc[ai][bj][m][0], o1 = *(const f32x4*)(base + off + 4) + acc[ai][bj][m][1];
                    *(f32x4*)(out + off) = o0; *(f32x4*)(out + off + 4) = o1;
                    if (outb) *(u32x4*)(outb + off) = pack8(o0, o1);
                    ss += (o0[0] * o0[0] + o0[1] * o0[1]) + (o0[2] * o0[2] + o0[3] * o0[3]) + (o1[0] * o1[0] + o1[1] * o1[1]) + (o1[2] * o1[2] + o1[3] * o1[3]); }
                ss += __shfl_xor(ss, 16); ss += __shfl_xor(ss, 32);
                if (fq == 0) xch[(ai * HALF + wr * 64 + m * 16 + fr) * 4 + wc] = ss; }
        asm volatile("s_waitcnt lgkmcnt(0)" ::: "memory"); __builtin_amdgcn_s_barrier(); asm volatile("" ::: "memory");
        { const int t = threadIdx.x; if (t < 256) { const f32x4 v = *(const PG8_LAS f32x4*)(xch + t * 4); part[(size_t)(u.pm * BM + t) * 8 + u.pn] = (v[0] + v[1]) + (v[2] + v[3]); } }
        asm volatile("s_waitcnt lgkmcnt(0)" ::: "memory"); __builtin_amdgcn_s_barrier(); asm volatile("" ::: "memory");
    }
};
struct EpiResB {
    static constexpr bool PERM = true, KEEP_ACC = false;
    const bf16_t* base; bf16_t* outb; float* part; PG8_LAS float* xch;
    __device__ __forceinline__ void operator()(Acc& acc, const Unit& u, int wr, int wc, int fr, int fq) const {
        const int row0 = u.pm * BM + wr * 64 + fr, col0 = u.pn * BM + wc * 32 + 8 * fq;
#pragma unroll
        for (int ai = 0; ai < 2; ++ai)
#pragma unroll
            for (int m = 0; m < 4; ++m) { const int row = row0 + ai * HALF + m * 16; float ss = 0.f;
#pragma unroll
                for (int bj = 0; bj < 2; ++bj) { const size_t off = (size_t)row * 2048 + col0 + bj * HALF;
                    f32x4 b0, b1; unpack8(*(const u32x4*)(base + off), b0, b1);
                    const f32x4 o0 = b0 + acc[ai][bj][m][0], o1 = b1 + acc[ai][bj][m][1];
                    *(u32x4*)(outb + off) = pack8(o0, o1);
                    ss += (o0[0] * o0[0] + o0[1] * o0[1]) + (o0[2] * o0[2] + o0[3] * o0[3]) + (o1[0] * o1[0] + o1[1] * o1[1]) + (o1[2] * o1[2] + o1[3] * o1[3]); }
                ss += __shfl_xor(ss, 16); ss += __shfl_xor(ss, 32);
                if (fq == 0) xch[(ai * HALF + wr * 64 + m * 16 + fr) * 4 + wc] = ss; }
        asm volatile("s_waitcnt lgkmcnt(0)" ::: "memory"); __builtin_amdgcn_s_barrier(); asm volatile("" ::: "memory");
        { const int t = threadIdx.x; if (t < 256) { const f32x4 v = *(const PG8_LAS f32x4*)(xch + t * 4); part[(size_t)(u.pm * BM + t) * 8 + u.pn] = (v[0] + v[1]) + (v[2] + v[3]); } }
        asm volatile("s_waitcnt lgkmcnt(0)" ::: "memory"); __builtin_amdgcn_s_barrier(); asm volatile("" ::: "memory");
    }
};
__device__ __forceinline__ float row_rs(const float* part, int row) { const f32x4 a = *(const f32x4*)(part + (size_t)row * 8), b = *(const f32x4*)(part + (size_t)row * 8 + 4);
    return __builtin_amdgcn_rsqf((((a[0] + a[1]) + (a[2] + a[3])) + ((b[0] + b[1]) + (b[2] + b[3]))) * (1.0f / 2048.0f) + 1e-6f); }
struct EpiRowScale {
    static constexpr bool PERM = true, KEEP_ACC = false;
    bf16_t* O; int ldc; const float* ssq; float scale;
    __device__ __forceinline__ void operator()(Acc& acc, const Unit& u, int wr, int wc, int fr, int fq) const {
        const int row0 = u.pm * BM + wr * 64 + fr, col0 = u.pn * BM + wc * 32 + 8 * fq;
#pragma unroll
        for (int ai = 0; ai < 2; ++ai)
#pragma unroll
            for (int m = 0; m < 4; ++m) { const int row = row0 + ai * HALF + m * 16; const float rs = row_rs(ssq, row) * scale;
                bf16_t* rowp = O + (size_t)row * ldc + col0;
#pragma unroll
                for (int bj = 0; bj < 2; ++bj) *(u32x4*)(rowp + bj * HALF) = pack8(acc[ai][bj][m][0] * rs, acc[ai][bj][m][1] * rs); }
    }
};
struct EpiSwiGLU {
    static constexpr bool PERM = true, KEEP_ACC = false;
    bf16_t* O; const float* ssq;
    __device__ __forceinline__ void operator()(Acc& acc, const Unit& u, int wr, int wc, int fr, int fq) const {
        const int row0 = u.pm * BM + wr * 64 + fr, col0 = u.pn * HALF + wc * 32 + 8 * fq;
#pragma unroll
        for (int ai = 0; ai < 2; ++ai)
#pragma unroll
            for (int m = 0; m < 4; ++m) { const int row = row0 + ai * HALF + m * 16; const float rs = row_rs(ssq, row);
                const f32x4 g0 = acc[ai][0][m][0] * rs, g1 = acc[ai][0][m][1] * rs, u0 = acc[ai][1][m][0] * rs, u1 = acc[ai][1][m][1] * rs;
                *(u32x4*)(O + (size_t)row * 5632 + col0) = pack8(g0 * sigmoid4(g0) * u0, g1 * sigmoid4(g1) * u1); }
    }
};

template <class Epi, class Sched, bool ALIGN_EPI = true>
__device__ __forceinline__ void gemm_phase(PG8_LAS unsigned char* lds, const Gemm g, const Sched& S, const Epi& E) {
    const int tid = threadIdx.x, wid = __builtin_amdgcn_readfirstlane(tid >> 6), lane = tid & 63, wr = wid >> 2, wc = wid & 3, fr = lane & 15, fq = lane >> 4;
    const int K = g.K, nt = K / BK;
    unsigned voffA[2], voffB[2];
#pragma unroll
    for (int i = 0; i < 2; ++i) { int R, C; stage_rc(tid * 16 + i * 8192, R, C); const int Rb = Epi::PERM ? ((R & ~31) + perm32(R & 31)) : R;
        voffA[i] = (unsigned)(R * K + C) * 2u; voffB[i] = (unsigned)(Rb * K + C) * 2u; }
    const size_t kstep = (size_t)(BK * 2);
    const size_t hstep = (size_t)HALF * K * 2;
    const size_t tstep = 2 * hstep;
    const unsigned ldsw = (unsigned)wid * 1024u;
    const int aoff = lds_byte(wr * 64 + fr, fq * 8), boff = lds_byte(wc * 32 + fr, fq * 8);
#define PG8_SA(b, h) (((b) * 2 + (h)) * HTB)
#define PG8_SB(b, h) ((4 + (b) * 2 + (h)) * HTB)
#define PG8_STAGE(bufoff, gbase, voff) do { _Pragma("unroll") for (int _i = 0; _i < 2; ++_i) \
        __builtin_amdgcn_global_load_lds((const unsigned*)((const char*)(gbase) + (voff)[_i]), (PG8_LAS unsigned*)(lds + (bufoff) + ldsw + _i * 8192), 16, 0, 0); } while (0)
#define PG8_LDA(dst, b, h) do { _Pragma("unroll") for (int m = 0; m < 4; ++m) _Pragma("unroll") for (int k = 0; k < 2; ++k) dst[m][k] = *(const PG8_LAS bf16x8*)(lds + PG8_SA(b, h) + aoff + m * 2048 + k * 1024); } while (0)
#define PG8_LDB(dst, b, h) do { _Pragma("unroll") for (int n = 0; n < 2; ++n) _Pragma("unroll") for (int k = 0; k < 2; ++k) dst[n][k] = *(const PG8_LAS bf16x8*)(lds + PG8_SB(b, h) + boff + n * 2048 + k * 1024); } while (0)
#define PG8_MMA(ai, bj, At, Bt) do { __builtin_amdgcn_s_setprio(1); _Pragma("unroll") for (int m = 0; m < 4; ++m) _Pragma("unroll") for (int n = 0; n < 2; ++n) _Pragma("unroll") for (int k = 0; k < 2; ++k) \
        acc[ai][bj][m][n] = __builtin_amdgcn_mfma_f32_16x16x32_bf16(Bt[n][k], At[m][k], acc[ai][bj][m][n], 0, 0, 0); __builtin_amdgcn_s_setprio(0); } while (0)
#define PG8_WAIT_V(n) asm volatile("s_waitcnt vmcnt(" #n ")" ::: "memory")
#define PG8_WAIT_L(n) asm volatile("s_waitcnt lgkmcnt(" #n ")" ::: "memory")
#define PG8_BAR __builtin_amdgcn_s_barrier()
#define PG8_SCHED __builtin_amdgcn_sched_barrier(0)
#define PG8_UA(u) ((const char*)((u).seg ? g.A1 : g.A0) + (size_t)(u).pm * tstep)
#define PG8_UB(u) ((const char*)((u).seg ? g.B1 : g.B0) + (size_t)(u).pn * tstep)
    Unit cur, nxt; int ui = 0;
    if (!S.next(0, cur)) return;
    Acc acc;
#pragma unroll
    for (int a = 0; a < 2; ++a)
#pragma unroll
        for (int b = 0; b < 2; ++b)
#pragma unroll
            for (int m = 0; m < 4; ++m)
#pragma unroll
                for (int n = 0; n < 2; ++n) acc[a][b][m][n] = (f32x4){0.f, 0.f, 0.f, 0.f};
    bf16x8 At[4][2], B0[2][2], B1[2][2];
    const char* cA = PG8_UA(cur); const char* cB = PG8_UB(cur);
    PG8_STAGE(PG8_SB(0, 0), cB, voffB); PG8_STAGE(PG8_SB(0, 1), cB + hstep, voffB); PG8_STAGE(PG8_SA(0, 0), cA, voffA); PG8_STAGE(PG8_SA(0, 1), cA + hstep, voffA);
    if (wr == 1) PG8_BAR;
    PG8_WAIT_V(2); PG8_BAR;
    PG8_STAGE(PG8_SB(1, 0), cB + kstep, voffB); PG8_STAGE(PG8_SA(1, 0), cA + kstep, voffA); PG8_STAGE(PG8_SB(1, 1), cB + hstep + kstep, voffB);
    PG8_WAIT_V(6); PG8_BAR;
    for (;;) {
        const bool has_next = S.next(ui + 1, nxt);
        const char* nA = has_next ? PG8_UA(nxt) : cA; const char* nB = has_next ? PG8_UB(nxt) : cB;
        for (int t = 0; t < nt; t += 2) {
            const bool last = (t == nt - 2);
            const char* a1 = cA + (size_t)(t + 1) * kstep;
            const char* a2 = last ? nA : cA + (size_t)(t + 2) * kstep; const char* b2 = last ? nB : cB + (size_t)(t + 2) * kstep;
            const char* a3 = a2 + kstep; const char* b3 = b2 + kstep;
            PG8_LDB(B0, 0, 0); PG8_LDB(B1, 0, 1); PG8_SCHED; PG8_LDA(At, 0, 0); PG8_STAGE(PG8_SA(1, 1), a1 + hstep, voffA);
            PG8_WAIT_V(8); PG8_WAIT_L(0); PG8_BAR; PG8_MMA(0, 0, At, B0); PG8_MMA(0, 1, At, B1); PG8_BAR; PG8_SCHED;
            PG8_LDA(At, 0, 1); PG8_STAGE(PG8_SB(0, 0), b2, voffB); PG8_STAGE(PG8_SB(0, 1), b2 + hstep, voffB); PG8_STAGE(PG8_SA(0, 0), a2, voffA);
            PG8_WAIT_V(8); PG8_WAIT_L(0); PG8_BAR; PG8_MMA(1, 0, At, B0); PG8_MMA(1, 1, At, B1); PG8_BAR; PG8_SCHED;
            PG8_LDB(B0, 1, 0); PG8_LDB(B1, 1, 1); PG8_SCHED; PG8_LDA(At, 1, 0); PG8_STAGE(PG8_SA(0, 1), a2 + hstep, voffA);
            PG8_WAIT_V(8); PG8_WAIT_L(0); PG8_BAR; PG8_MMA(0, 0, At, B0); PG8_MMA(0, 1, At, B1); PG8_BAR; PG8_SCHED;
            PG8_LDA(At, 1, 1); PG8_STAGE(PG8_SB(1, 0), b3, voffB); PG8_STAGE(PG8_SB(1, 1), b3 + hstep, voffB); PG8_STAGE(PG8_SA(1, 0), a3, voffA);
            PG8_WAIT_V(8); PG8_WAIT_L(0); PG8_BAR; PG8_MMA(1, 0, At, B0); PG8_MMA(1, 1, At, B1); PG8_BAR; PG8_SCHED;
        }
        if constexpr (ALIGN_EPI) { if (wr == 0) PG8_BAR; }
        E(acc, cur, wr, wc, fr, fq);
        if (!has_next) break;
        if (!(Epi::KEEP_ACC && cur.seg == 0)) {
#pragma unroll
        for (int a = 0; a < 2; ++a)
#pragma unroll
            for (int b = 0; b < 2; ++b)
#pragma unroll
                for (int m = 0; m < 4; ++m)
#pragma unroll
                    for (int n = 0; n < 2; ++n) acc[a][b][m][n] = (f32x4){0.f, 0.f, 0.f, 0.f};
        }
        cur = nxt; cA = nA; cB = nB; ++ui;
        if constexpr (ALIGN_EPI) { if (wr == 1) PG8_BAR; }
    }
    PG8_WAIT_V(0);
    if constexpr (!ALIGN_EPI) { if (wr == 0) PG8_BAR; }
    PG8_BAR;
#undef PG8_SA
#undef PG8_SB
#undef PG8_STAGE
#undef PG8_LDA
#undef PG8_LDB
#undef PG8_MMA
#undef PG8_WAIT_V
#undef PG8_WAIT_L
#undef PG8_BAR
#undef PG8_SCHED
#undef PG8_UA
#undef PG8_UB
}
}

constexpr int NWAVES = 8, NTHR = NWAVES * 64;
constexpr int DM = 2048, BATCH = 8, SEQ = 2048, M = BATCH * SEQ;
constexpr int INW = 8704, ZAW = 4608, ZGW = 4096;
constexpr int NMEM = 256, MROWS = BATCH * NMEM;
constexpr int DFF = 5632;
constexpr float RMS_EPS = 1e-6f;

constexpr size_t MiB = 1u << 20;
constexpr size_t WS_BAR = 256 * 1024, WS_BAR_BYTES = 64 * 1024;
constexpr size_t WS_RS1 = 0;
constexpr size_t WS_SSQ = 506 * MiB;
constexpr size_t WS_ROPE = 1 * MiB;
constexpr size_t WS_WIN = 2 * MiB;
constexpr size_t WS_WA = 36 * MiB;
constexpr size_t WS_WC = 40 * MiB;
constexpr size_t WS_WO = 44 * MiB;
constexpr size_t WS_WCQ = 52 * MiB;
constexpr size_t WS_WCKV = 54 * MiB;
constexpr size_t WS_WCO = 58 * MiB;
constexpr size_t WS_WGU = 60 * MiB;
constexpr size_t WS_WDN = 104 * MiB;
constexpr size_t WS_MEMN = 126 * MiB;
constexpr size_t WS_MEMKV = 134 * MiB;
constexpr size_t WS_ZA = 138 * MiB;
constexpr size_t WS_ZG = 282 * MiB;
constexpr size_t WS_AO = 2 * MiB;
constexpr size_t WS_CV = 410 * MiB;
constexpr size_t WS_WOB = 410 * MiB;
constexpr size_t WS_XB = 442 * MiB;
constexpr size_t WS_WOQ = 508 * MiB;
constexpr size_t WS_END = 510 * MiB;
constexpr size_t WS_MG = WS_ZA;
constexpr size_t WS_X1B = WS_ZG + 32 * MiB;
constexpr size_t WS_X3B = WS_XB;
constexpr size_t WS_QC = WS_ZG;
constexpr size_t WS_CO = WS_ZG + 16 * MiB;
constexpr size_t WS_X2B = WS_ZA;
constexpr size_t WS_ACT = WS_ZA + 64 * MiB;
static_assert(WS_ACT + (size_t)M * DFF * 2 <= WS_CV, "ACT overlay");

constexpr int LDS_BYTES = 147456;

#define GAS __attribute__((address_space(1)))
#define LAS __attribute__((address_space(3)))
typedef unsigned short bf16;
typedef unsigned v4u __attribute__((ext_vector_type(4)));
typedef float f32x4 __attribute__((ext_vector_type(4)));
#define LDS_WAIT() asm volatile("s_waitcnt lgkmcnt(0)" ::: "memory")
__device__ __forceinline__ unsigned f2bf(float f) { unsigned u = __builtin_bit_cast(unsigned, f); return (u + 0x7fffu + ((u >> 16) & 1u)) >> 16; }
__device__ __forceinline__ unsigned pk2(float lo, float hi) { return f2bf(lo) | (f2bf(hi) << 16); }
__device__ __forceinline__ float bflo(unsigned w) { return __uint_as_float(w << 16); }
__device__ __forceinline__ float bfhi(unsigned w) { return __uint_as_float(w & 0xffff0000u); }
__device__ __forceinline__ float wave_sum(float v) {
#pragma unroll
    for (int o = 1; o < 64; o <<= 1) v += __shfl_xor(v, o);
    return v;
}
__device__ __forceinline__ float wave_max(float v) {
#pragma unroll
    for (int o = 1; o < 64; o <<= 1) v = fmaxf(v, __shfl_xor(v, o));
    return v;
}

__device__ __forceinline__ int dest_row(int n0, int mode) {
    if (mode == 1) return (n0 >> 7) * 256 + (n0 & 127);
    if (mode == 2) return (n0 >> 7) * 256 + 128 + (n0 & 127);
    if (mode == 3 && n0 < 1280) return (n0 >> 8) * 256 + ((n0 >> 6) & 1) * 128 + ((n0 >> 7) & 1) * 64 + (n0 & 63);
    return n0;
}
struct TItem { const float* W; bf16* WT; const float* gk; int K, N, mode, item; };
__device__ __forceinline__ void p0_t_load(const TItem& t, f32x4 (&v)[8], int lane) {
    const int nblk = t.N / 32, kb = t.item / nblk, nb = t.item % nblk, k0 = 64 * kb, n0 = 32 * nb, kr2 = lane >> 3, nq = lane & 7;
#pragma unroll
    for (int i = 0; i < 4; ++i) { const float* p = t.W + (size_t)(k0 + 16 * i + 2 * kr2) * t.N + n0 + 4 * nq; v[2 * i] = *(const f32x4*)p; v[2 * i + 1] = *(const f32x4*)(p + t.N); }
}
__device__ __forceinline__ void p0_t_store(const TItem& t, const f32x4 (&v)[8], LAS float* scrf, int lane) {
    LAS unsigned* scr = (LAS unsigned*)scrf;
    const int nblk = t.N / 32, kb = t.item / nblk, nb = t.item % nblk, k0 = 64 * kb, n0 = 32 * nb, kr2 = lane >> 3, nq = lane & 7;
#pragma unroll
    for (int i = 0; i < 4; ++i) { float g0 = 1.0f, g1 = 1.0f; if (t.gk) { g0 = t.gk[k0 + 16 * i + 2 * kr2]; g1 = t.gk[k0 + 16 * i + 2 * kr2 + 1]; }
        LAS unsigned* p = scr + (4 * nq) * 36 + 8 * i + kr2;
        p[0 * 36] = pk2(v[2 * i].x * g0, v[2 * i + 1].x * g1); p[1 * 36] = pk2(v[2 * i].y * g0, v[2 * i + 1].y * g1);
        p[2 * 36] = pk2(v[2 * i].z * g0, v[2 * i + 1].z * g1); p[3 * 36] = pk2(v[2 * i].w * g0, v[2 * i + 1].w * g1); }
    LDS_WAIT(); asm volatile("" ::: "memory");
    const int c = lane & 7, r0 = dest_row(n0, t.mode);
#pragma unroll
    for (int j = 0; j < 4; ++j) { const int n = (lane >> 3) + 8 * j; *(v4u*)(t.WT + (size_t)(r0 + n) * t.K + k0 + 8 * c) = *(const LAS v4u*)(scr + n * 36 + 4 * c); }
    LDS_WAIT(); asm volatile("" ::: "memory");
}
__device__ __forceinline__ void row_to_bf16_rs(const float* xrow, bf16* orow, float* rs_out, int lane) {
    const f32x4* xr = (const f32x4*)xrow + lane;
    f32x4 v[8]; float s = 0.f;
#pragma unroll
    for (int j = 0; j < 8; ++j) { v[j] = xr[64 * j]; s += (v[j].x * v[j].x + v[j].y * v[j].y) + (v[j].z * v[j].z + v[j].w * v[j].w); }
    const float rs = 1.0f / sqrtf(wave_sum(s) * (1.0f / DM) + RMS_EPS);
    if (lane == 0) *rs_out = rs;
    unsigned long long* o8 = (unsigned long long*)orow + lane;
#pragma unroll
    for (int j = 0; j < 8; ++j) o8[64 * j] = (unsigned long long)pk2(v[j].x, v[j].y) | ((unsigned long long)pk2(v[j].z, v[j].w) << 32);
}
__device__ __forceinline__ void rms_row_to_bf16(const float* xrow, const float* g, bf16* orow, int lane) {
    const f32x4* xr = (const f32x4*)xrow + lane; const f32x4* gr = (const f32x4*)g + lane;
    f32x4 v[8]; float s = 0.f;
#pragma unroll
    for (int j = 0; j < 8; ++j) { v[j] = xr[64 * j]; s += (v[j].x * v[j].x + v[j].y * v[j].y) + (v[j].z * v[j].z + v[j].w * v[j].w); }
    const float rs = 1.0f / sqrtf(wave_sum(s) * (1.0f / DM) + RMS_EPS);
    unsigned long long* o8 = (unsigned long long*)orow + lane;
#pragma unroll
    for (int j = 0; j < 8; ++j) { const f32x4 gg = gr[64 * j];
        o8[64 * j] = (unsigned long long)pk2(v[j].x * rs * gg.x, v[j].y * rs * gg.y) | ((unsigned long long)pk2(v[j].z * rs * gg.z, v[j].w * rs * gg.w) << 32); }
}

typedef float f32x16 __attribute__((ext_vector_type(16)));
typedef short s16x8 __attribute__((ext_vector_type(8)));
typedef short s16x4 __attribute__((ext_vector_type(4)));
constexpr int ATT_KP = 272, ATT_VP = 264, ATT_V_OFF = 128 * ATT_KP, ATT_LDS = ATT_V_OFF + 128 * ATT_VP;
constexpr float LOG2E = 1.4426950408889634f;
template <bool WINDOW>
__device__ __forceinline__ void attn_unit(LAS unsigned char* lds, const bf16* qw, int qpitch, const bf16* kg, const bf16* vg, int kvpitch, int nblk,
                                          int qpos, int kpos, float m_init, float l_init, float qs, bf16* ow, int opitch, int tid, int lane) {
    const int r = lane & 31, h = lane >> 5;
    s16x8 qf[8];
#pragma unroll
    for (int kk = 0; kk < 8; ++kk) qf[kk] = *(const s16x8*)(qw + (size_t)r * qpitch + 16 * kk + 8 * h);
    f32x16 o[4];
#pragma unroll
    for (int dt = 0; dt < 4; ++dt)
#pragma unroll
        for (int i = 0; i < 16; ++i) o[dt][i] = 0.f;
    float m = m_init, l = (h == 0) ? l_init : 0.f;
    const int kkey = tid >> 4, kc = tid & 15, vkey = tid & 127, vcg = tid >> 7;
    for (int blk = 0; blk < nblk; ++blk) {
        v4u kreg[4], vreg[4];
#pragma unroll
        for (int it = 0; it < 4; ++it) { kreg[it] = *(const v4u*)(kg + (size_t)(blk * 128 + kkey + 32 * it) * kvpitch + kc * 8); vreg[it] = *(const v4u*)(vg + (size_t)(blk * 128 + vkey) * kvpitch + (vcg * 4 + it) * 8); }
        __syncthreads();
#pragma unroll
        for (int it = 0; it < 4; ++it) { *(LAS v4u*)(lds + (kkey + 32 * it) * ATT_KP + kc * 16) = kreg[it];
            LAS unsigned short* vt = (LAS unsigned short*)(lds + ATT_V_OFF) + (size_t)((vcg * 4 + it) * 8) * (ATT_VP / 2) + vkey;
            const v4u w = vreg[it];
            vt[0 * (ATT_VP / 2)] = (unsigned short)(w.x & 0xffffu); vt[1 * (ATT_VP / 2)] = (unsigned short)(w.x >> 16); vt[2 * (ATT_VP / 2)] = (unsigned short)(w.y & 0xffffu); vt[3 * (ATT_VP / 2)] = (unsigned short)(w.y >> 16);
            vt[4 * (ATT_VP / 2)] = (unsigned short)(w.z & 0xffffu); vt[5 * (ATT_VP / 2)] = (unsigned short)(w.z >> 16); vt[6 * (ATT_VP / 2)] = (unsigned short)(w.w & 0xffffu); vt[7 * (ATT_VP / 2)] = (unsigned short)(w.w >> 16); }
        __syncthreads();
#pragma unroll 1
        for (int hf = 0; hf < 2; ++hf) {
        const int thr0 = WINDOW ? (qpos - (kpos + blk * 128 + 64 * hf)) : 0;
        if (WINDOW && (thr0 - 63 > 128 || thr0 + 31 < -128)) continue;
        const bool need_mask = WINDOW && (thr0 + 31 > 128 || thr0 - 63 < -128);
        const int thr = thr0 + r - 4 * h;
        f32x16 sc[2];
#pragma unroll
        for (int kt = 0; kt < 2; ++kt) {
#pragma unroll
            for (int i = 0; i < 16; ++i) sc[kt][i] = 0.f;
#pragma unroll
            for (int kk = 0; kk < 8; ++kk) { const s16x8 kf = *(const LAS s16x8*)(lds + (64 * hf + 32 * kt + r) * ATT_KP + (16 * kk + 8 * h) * 2); sc[kt] = __builtin_amdgcn_mfma_f32_32x32x16_bf16(kf, qf[kk], sc[kt], 0, 0, 0); }
        }
        float mb = -1e30f;
#pragma unroll
        for (int kt = 0; kt < 2; ++kt)
#pragma unroll
            for (int i = 0; i < 16; ++i) {
                if (!WINDOW) sc[kt][i] *= qs;
                if (WINDOW) { if (need_mask && (unsigned)((32 * kt + (i & 3) + 8 * (i >> 2)) - thr + 128) > 256u) sc[kt][i] = -1e30f; }
                mb = fmaxf(mb, sc[kt][i]); }
        mb = fmaxf(mb, __shfl_xor(mb, 32));
        const float mn = fmaxf(m, mb), alpha = __builtin_amdgcn_exp2f((m - mn) * LOG2E), mo = mn * LOG2E;
        m = mn; l *= alpha;
#pragma unroll
        for (int dt = 0; dt < 4; ++dt) o[dt] = o[dt] * alpha;
        float ls = 0.f;
#pragma unroll
        for (int kt = 0; kt < 2; ++kt)
#pragma unroll
            for (int i = 0; i < 16; ++i) { const float p = __builtin_amdgcn_exp2f(sc[kt][i] * LOG2E - mo); sc[kt][i] = p; ls += p; }
        l += ls;
#pragma unroll
        for (int kt = 0; kt < 2; ++kt)
#pragma unroll
            for (int st = 0; st < 2; ++st) {
                v4u pw; pw.x = pg8::cvt_pk_bf16(sc[kt][8 * st + 0], sc[kt][8 * st + 1]); pw.y = pg8::cvt_pk_bf16(sc[kt][8 * st + 2], sc[kt][8 * st + 3]);
                pw.z = pg8::cvt_pk_bf16(sc[kt][8 * st + 4], sc[kt][8 * st + 5]); pw.w = pg8::cvt_pk_bf16(sc[kt][8 * st + 6], sc[kt][8 * st + 7]);
                const s16x8 pf = __builtin_bit_cast(s16x8, pw);
#pragma unroll
                for (int dt = 0; dt < 4; ++dt) { const LAS unsigned char* vp = lds + ATT_V_OFF + (32 * dt + r) * ATT_VP + (64 * hf + 32 * kt + 16 * st + 4 * h) * 2;
                    const s16x4 lo = *(const LAS s16x4*)vp, hi = *(const LAS s16x4*)(vp + 16);
                    const s16x8 vf = __builtin_shufflevector(lo, hi, 0, 1, 2, 3, 4, 5, 6, 7);
                    o[dt] = __builtin_amdgcn_mfma_f32_32x32x16_bf16(vf, pf, o[dt], 0, 0, 0); }
            }
        }
    }
    l += __shfl_xor(l, 32);
    const float inv = 1.0f / l;
    bf16* orow = ow + (size_t)r * opitch + 4 * h;
#pragma unroll
    for (int dt = 0; dt < 4; ++dt)
#pragma unroll
        for (int g = 0; g < 4; ++g) { unsigned long long w = (unsigned long long)pg8::cvt_pk_bf16(o[dt][4 * g] * inv, o[dt][4 * g + 1] * inv) | ((unsigned long long)pg8::cvt_pk_bf16(o[dt][4 * g + 2] * inv, o[dt][4 * g + 3] * inv) << 32);
            *(unsigned long long*)(orow + 32 * dt + 8 * g) = w; }
}

#define RLX_AGENT __ATOMIC_RELAXED, __HIP_MEMORY_SCOPE_AGENT
#define XB_TMO      128
#define XB_XCNT(j)  (256  + 64 * (j))
#define XB_XSUB(j)  (1280 + 64 * (j))
#define XB_XGEN(j)  (2304 + 64 * (j))
#define XB_TOP      3328
#define XB_TOPGEN   3392
#define XCD_BAR_WORDS 3456
#define XB_SPIN_CAP (1u << 18)

__device__ __forceinline__ unsigned xb_ld(unsigned* p)              { return __hip_atomic_load(p, __ATOMIC_RELAXED, __HIP_MEMORY_SCOPE_AGENT); }
__device__ __forceinline__ unsigned xb_add(unsigned* p, unsigned v) { return __hip_atomic_fetch_add(p, v, __ATOMIC_RELAXED, __HIP_MEMORY_SCOPE_AGENT); }
__device__ __forceinline__ unsigned xb_xcc_id() { return (unsigned)__builtin_amdgcn_s_getreg((3 << 11) | 20) & 0xFu; }
#define XB_SPIN(cond, bar) do { unsigned _sp = 0; while (cond) { __builtin_amdgcn_s_sleep(1); \
    if ((++_sp & 255u) == 0u) { if (xb_ld(&(bar)[XB_TMO])) break; if (_sp > XB_SPIN_CAP) { atomicAdd(&(bar)[XB_TMO], 1u); break; } } } } while (0)

struct XcdBarrier {
    unsigned* bar; unsigned x;
    volatile LAS unsigned* st;
};

__device__ __forceinline__ XcdBarrier xcd_barrier_post(unsigned* bar, volatile LAS unsigned* st) {
    XcdBarrier b; b.bar = bar; b.x = xb_xcc_id(); b.st = st;
    if (threadIdx.x == 0) (void)xb_add(&bar[XB_XCNT(b.x)], 1u);
    return b;
}
__device__ __forceinline__ void xcd_barrier_complete(unsigned* bar, unsigned x, unsigned& nloc, unsigned& nx) {
    const unsigned G = gridDim.x * gridDim.y * gridDim.z;
    unsigned sum, cnt, mine, sp = 0u;
    for (;;) {
        sum = 0u; cnt = 0u; mine = 0u;
#pragma unroll
        for (unsigned j = 0; j < 16; ++j) { const unsigned c = xb_ld(&bar[XB_XCNT(j)]); sum += c; cnt += (c > 0u) ? 1u : 0u; mine = (j == x) ? c : mine; }
        if (sum == G) break;
        __builtin_amdgcn_s_sleep(1);
        if ((++sp & 255u) == 0u) { if (xb_ld(&bar[XB_TMO])) break; if (sp > XB_SPIN_CAP) { atomicAdd(&bar[XB_TMO], 1u); break; } }
    }
    nloc = mine > 0u ? mine : 1u; nx = cnt > 0u ? cnt : 1u;
}

__device__ __forceinline__ void xcd_barrier(const XcdBarrier& b) {
    asm volatile("s_waitcnt vmcnt(0)" ::: "memory");
    __syncthreads();
    if (threadIdx.x == 0) {
        unsigned* bar = b.bar;
        __builtin_amdgcn_s_waitcnt(0);
        unsigned nloc = b.st[0], nx = b.st[1];
        if (nloc == 0u) { xcd_barrier_complete(bar, b.x, nloc, nx); b.st[0] = nloc; b.st[1] = nx; }
        const unsigned old = xb_add(&bar[XB_XSUB(b.x)], 1u);
        const unsigned gen = old / nloc;
        if (old + 1u == (gen + 1u) * nloc) {
            __builtin_amdgcn_fence(__ATOMIC_RELEASE, "agent");
            asm volatile("s_waitcnt vmcnt(0)" ::: "memory");
            const unsigned og = xb_add(&bar[XB_TOP], 1u);
            const unsigned tg = og / nx;
            if (og + 1u == (tg + 1u) * nx) xb_add(&bar[XB_TOPGEN], 1u);
            else XB_SPIN(xb_ld(&bar[XB_TOPGEN]) == tg, bar);
            __builtin_amdgcn_fence(__ATOMIC_ACQUIRE, "agent");
            xb_add(&bar[XB_XGEN(b.x)], 1u);
            asm volatile("s_waitcnt vmcnt(0)" ::: "memory");
        } else {
            XB_SPIN(xb_ld(&bar[XB_XGEN(b.x)]) == gen, bar);
            __builtin_amdgcn_fence(__ATOMIC_ACQUIRE, "agent");
            asm volatile("s_waitcnt vmcnt(0)" ::: "memory");
        }
    }
    __syncthreads();
}

struct Args { const float* in[20]; float* out; unsigned char* ws; int ph_lo, ph_hi, li, pad; };

__global__ void __launch_bounds__(NTHR, 2) mk_fwd(Args args) {
    extern __shared__ __attribute__((aligned(16))) unsigned char lds_raw[];
    LAS unsigned char* lds = (LAS unsigned char*)lds_raw;
    const int tid = threadIdx.x, lane = tid & 63, wave = __builtin_amdgcn_readfirstlane(tid >> 6);
    const int G = gridDim.x, bx = blockIdx.x;
    const int gw = bx * NWAVES + wave, NGW = G * NWAVES;
    unsigned char* ws = args.ws;
    const float* x = args.in[0]; const float* mem = args.in[1]; const float* g_mix = args.in[2]; const float* w_in = args.in[3]; const float* sink = args.in[4];
    const float* conv_w = args.in[5]; const float* b_gate = args.in[6]; const float* w_attn_out = args.in[7]; const float* w_conv_out = args.in[8]; const float* w_o = args.in[9];
    const float* g_cross = args.in[10]; const float* g_mem = args.in[11]; const float* w_cq = args.in[12]; const float* w_ckv = args.in[13]; const float* w_co = args.in[14];
    const float* g_ffn = args.in[15]; const float* w_gate = args.in[16]; const float* w_up = args.in[17]; const float* w_down = args.in[18]; const float* g_final = args.in[19];
    float* out = args.out;
    float* ssq2 = (float*)(ws + WS_SSQ); float* ssq3 = ssq2 + M * 8; float* ssq4 = ssq3 + M * 8;
    PG8_LAS float* xch = (PG8_LAS float*)(lds + pg8::STAGE_BYTES);
    float* cosT = (float*)(ws + WS_ROPE); float* sinT = cosT + SEQ * 64;
    bf16* Wt_in = (bf16*)(ws + WS_WIN); bf16* Wt_a = (bf16*)(ws + WS_WA); bf16* Wt_c = (bf16*)(ws + WS_WC); bf16* Wt_o = (bf16*)(ws + WS_WO);
    bf16* Wt_cq = (bf16*)(ws + WS_WCQ); bf16* Wt_ckv = (bf16*)(ws + WS_WCKV); bf16* Wt_co = (bf16*)(ws + WS_WCO); bf16* Wt_gu = (bf16*)(ws + WS_WGU); bf16* Wt_dn = (bf16*)(ws + WS_WDN);
    bf16* MEMN = (bf16*)(ws + WS_MEMN); bf16* MEMKV = (bf16*)(ws + WS_MEMKV);
    bf16* ZA = (bf16*)(ws + WS_ZA); bf16* ZG = (bf16*)(ws + WS_ZG); bf16* AO = (bf16*)(ws + WS_AO); bf16* CV = (bf16*)(ws + WS_CV);
    bf16* MG = (bf16*)(ws + WS_MG); bf16* X1B = (bf16*)(ws + WS_X1B); bf16* X3B = (bf16*)(ws + WS_X3B); bf16* XB = (bf16*)(ws + WS_XB); bf16* WOB = (bf16*)(ws + WS_WOB); bf16* WOQ = (bf16*)(ws + WS_WOQ); float* rs1 = (float*)(ws + WS_RS1); bf16* QC = (bf16*)(ws + WS_QC); bf16* CO = (bf16*)(ws + WS_CO);
    bf16* X2B = (bf16*)(ws + WS_X2B); bf16* ACT = (bf16*)(ws + WS_ACT);
    cg::grid_group grid = cg::this_grid();
    const int lo = args.ph_lo, hi = args.ph_hi;
#define IN(k) (lo <= (k) && (k) < hi)
#define SEAM(k) do { if (IN(k) && IN((k) + 1)) { if (args.ph_hi > 1000) { asm volatile("s_waitcnt vmcnt(0) lgkmcnt(0)" ::: "memory"); __syncthreads(); grid.sync(); } else xcd_barrier(xbar); } } while (0)
    if (tid < 4) ((LAS unsigned*)(lds + pg8::STAGE_BYTES + 8192))[tid] = 0u;
    __syncthreads();
    const XcdBarrier xbar = xcd_barrier_post((unsigned*)(ws + WS_BAR) + args.li * 4096, (volatile LAS unsigned*)(lds + pg8::STAGE_BYTES + 8192));

    if (IN(0)) {
        LAS float* scr = (LAS float*)(lds + wave * 16384);
        constexpr int I_IN = (DM / 64) * (INW / 32), I_A = (1024 / 64) * (DM / 32), I_O = (DM / 64) * (DM / 32), I_CQ = (DM / 64) * (512 / 32), I_CKV = (DM / 64) * (1024 / 32),
                      I_CO = (512 / 64) * (DM / 32), I_G = (DM / 64) * (DFF / 32), I_D = (DFF / 64) * (DM / 32);
        constexpr int NITEMS = I_IN + 2 * I_A + I_O + I_CQ + I_CKV + I_CO;
#define P0_PICK(t, itx) do { int r = (itx); \
            if (r < I_IN) { t = TItem{w_in, Wt_in, g_mix, DM, INW, 3, r}; break; } r -= I_IN; \
            if (r < I_A) { t = TItem{w_attn_out, Wt_a, nullptr, 1024, DM, 0, r}; break; } r -= I_A; \
            if (r < I_A) { t = TItem{w_conv_out, Wt_c, nullptr, 1024, DM, 0, r}; break; } r -= I_A; \
            if (r < I_O) { t = TItem{w_o, Wt_o, nullptr, DM, DM, 0, r}; break; } r -= I_O; \
            if (r < I_CQ) { t = TItem{w_cq, Wt_cq, g_cross, DM, 512, 0, r}; break; } r -= I_CQ; \
            if (r < I_CKV) { t = TItem{w_ckv, Wt_ckv, nullptr, DM, 1024, 0, r}; break; } r -= I_CKV; \
            t = TItem{w_co, Wt_co, nullptr, 512, DM, 0, r}; } while (0)
        for (int it = gw; it < NITEMS; it += 2 * NGW) {
            TItem t0, t1; f32x4 v0[8], v1[8]; const bool two = it + NGW < NITEMS;
            P0_PICK(t0, it); p0_t_load(t0, v0, lane);
            if (two) { P0_PICK(t1, it + NGW); p0_t_load(t1, v1, lane); }
            p0_t_store(t0, v0, scr, lane);
            if (two) p0_t_store(t1, v1, scr, lane);
        }
#undef P0_PICK
        for (int m = gw; m < M; m += NGW) row_to_bf16_rs(x + (size_t)m * DM, XB + (size_t)m * DM, rs1 + m, lane);
        for (int i = bx * NTHR + tid; i < DM * DM / 8; i += G * NTHR) { const f32x4 a = *(const f32x4*)(w_o + (size_t)i * 8), b = *(const f32x4*)(w_o + (size_t)i * 8 + 4); *(v4u*)(WOB + (size_t)i * 8) = pg8::pack8(a, b); }
        for (int m = gw; m < MROWS; m += NGW) rms_row_to_bf16(mem + (size_t)m * DM, g_mem, MEMN + (size_t)m * DM, lane);
        for (int i = bx * NTHR + tid; i < SEQ * 64; i += G * NTHR) { const int pos = i >> 6, j = i & 63;
            const float inv = exp2f(-(float)j * (13.287712379549449f / 64.0f)); const float ang = (float)pos * inv;
            cosT[i] = cosf(ang); sinT[i] = sinf(ang); }
    }
    SEAM(0);

    if (IN(1)) {
        { pg8::Gemm g{XB, Wt_in, nullptr, nullptr, M, INW, DM}; pg8::StaticOrder S; S.init(M, INW, G, bx);
          pg8::EpiIn E{ZA, ZG, cosT, sinT, b_gate, 0.08838834764831845f, rs1};
          pg8::gemm_phase<pg8::EpiIn, pg8::StaticOrder>(lds, g, S, E); }
        { pg8::Gemm g{MEMN, Wt_ckv, nullptr, nullptr, MROWS, 1024, DM}; pg8::StaticOrder S; S.init(MROWS, 1024, G, (bx + G / 2) % G);
          pg8::EpiBf16 E{MEMKV, 1024};
          pg8::gemm_phase<pg8::EpiBf16, pg8::StaticOrder>(lds, g, S, E); }
        { pg8::Gemm g{Wt_cq, WOB, nullptr, nullptr, 512, DM, DM}; pg8::StaticOrder S; S.init(512, DM, G, (bx + G / 2 - 32 + G) % G);
          pg8::EpiBf16 E{WOQ, DM};
          pg8::gemm_phase<pg8::EpiBf16, pg8::StaticOrder>(lds, g, S, E); }
        if (G == 256 ? bx >= 176 : true) {
            __syncthreads();
            LAS float* scr = (LAS float*)(lds + wave * 16384);
            constexpr int I_G = (DM / 64) * (DFF / 32), I_D = (DFF / 64) * (DM / 32), NF = 2 * I_G + I_D;
            const int fw = (G == 256 ? (bx - 176) : bx) * NWAVES + wave, NFW = (G == 256 ? 80 : G) * NWAVES;
#define P1_PICK(t, itx) do { int r = (itx); \
            if (r < I_G) { t = TItem{w_gate, Wt_gu, g_ffn, DM, DFF, 1, r}; break; } r -= I_G; \
            if (r < I_G) { t = TItem{w_up, Wt_gu, g_ffn, DM, DFF, 2, r}; break; } r -= I_G; \
            t = TItem{w_down, Wt_dn, nullptr, DFF, DM, 0, r}; } while (0)
            for (int it = fw; it < NF; it += 4 * NFW) {
                TItem t0, t1, t2, t3; f32x4 v0[8], v1[8], v2[8], v3[8]; const bool h1 = it + NFW < NF, h2 = it + 2 * NFW < NF, h3 = it + 3 * NFW < NF;
                P1_PICK(t0, it); p0_t_load(t0, v0, lane);
                if (h1) { P1_PICK(t1, it + NFW); p0_t_load(t1, v1, lane); }
                if (h2) { P1_PICK(t2, it + 2 * NFW); p0_t_load(t2, v2, lane); }
                if (h3) { P1_PICK(t3, it + 3 * NFW); p0_t_load(t3, v3, lane); }
                p0_t_store(t0, v0, scr, lane);
                if (h1) p0_t_store(t1, v1, scr, lane);
                if (h2) p0_t_store(t2, v2, scr, lane);
                if (h3) p0_t_store(t3, v3, scr, lane);
            }
#undef P1_PICK
        }
    }
    SEAM(1);

    if (IN(2)) {
        for (int it = 2 * bx; it < 512; it += 2 * G)
            for (int hp = 0; hp < 2; ++hp) { const int kvh = it >> 1 & 1, nb = (it >> 2) & 15, b = it >> 6;
                const int hq = kvh * 4 + hp * 2 + (wave >> 2), t0 = b * SEQ + nb * 128 + (wave & 3) * 32;
                const int kb0 = nb > 0 ? nb - 1 : 0, kb1 = nb < 15 ? nb + 1 : 15; const size_t kt0 = (size_t)b * SEQ + kb0 * 128;
                attn_unit<true>(lds, ZA + (size_t)t0 * ZAW + hq * 128, ZAW, ZA + kt0 * ZAW + 1024 + kvh * 128, ZA + kt0 * ZAW + 1280 + kvh * 128, ZAW, kb1 - kb0 + 1,
                                nb * 128 + (wave & 3) * 32, kb0 * 128, sink[hq], 1.0f, 1.0f, AO + (size_t)t0 * 1024 + hq * 128, 1024, tid, lane); }
        __syncthreads();
        for (int idx = bx * NTHR + tid; idx < (M / 16) * 128; idx += G * NTHR) { const int run = idx >> 7, c8 = (idx & 127) * 8, t0 = run * 16, s0 = t0 & (SEQ - 1);
            const f32x4 w0a = *(const f32x4*)(conv_w + c8), w0b = *(const f32x4*)(conv_w + c8 + 4), w1a = *(const f32x4*)(conv_w + 1024 + c8), w1b = *(const f32x4*)(conv_w + 1024 + c8 + 4),
                        w2a = *(const f32x4*)(conv_w + 2048 + c8), w2b = *(const f32x4*)(conv_w + 2048 + c8 + 4);
            const bf16* zr = ZA + (size_t)t0 * ZAW + c8;
            f32x4 pa = {0.f, 0.f, 0.f, 0.f}, pb = pa, ca, cb, ta, tb;
            if (s0 > 0) { pg8::unpack8(*(const v4u*)(zr - ZAW + 1536), pa, pb); pg8::unpack8(*(const v4u*)(zr - ZAW + 3584), ta, tb); pa = pa * ta; pb = pb * tb; }
            pg8::unpack8(*(const v4u*)(zr + 1536), ca, cb); pg8::unpack8(*(const v4u*)(zr + 3584), ta, tb); ca = ca * ta; cb = cb * tb;
#pragma unroll
            for (int i = 0; i < 16; ++i) { f32x4 na = {0.f, 0.f, 0.f, 0.f}, nbv = na, ga, gb;
                if (i < 15 || s0 + 16 < SEQ) { pg8::unpack8(*(const v4u*)(zr + (size_t)(i + 1) * ZAW + 1536), na, nbv); pg8::unpack8(*(const v4u*)(zr + (size_t)(i + 1) * ZAW + 3584), ta, tb); na = na * ta; nbv = nbv * tb; }
                pg8::unpack8(*(const v4u*)(zr + (size_t)i * ZAW + 2560), ga, gb);
                *(v4u*)(CV + (size_t)(t0 + i) * 1024 + c8) = pg8::pack8(ga * (w0a * pa + w1a * ca + w2a * na), gb * (w0b * pb + w1b * cb + w2b * nbv));
                pa = ca; pb = cb; ca = na; cb = nbv; }
        }
    }
    SEAM(2);

    if (IN(3)) {
        pg8::Gemm g{AO, Wt_a, CV, Wt_c, M, DM, 1024}; pg8::StaticOrder S; S.init(M, DM, G, bx, 2);
        pg8::EpiMerge E{ZG, MG};
        pg8::gemm_phase<pg8::EpiMerge, pg8::StaticOrder>(lds, g, S, E);
    }
    SEAM(3);

    if (IN(4)) {
        { pg8::Gemm g{XB, Wt_cq, MG, WOQ, M, 512, DM}; pg8::ListOrder S{bx, bx < 128 ? 1 : 0, 2, 2};
          pg8::EpiAcc2 E{QC, 512};
          pg8::gemm_phase<pg8::EpiAcc2, pg8::ListOrder>(lds, g, S, E); }
        { pg8::Gemm g{MG, Wt_o, nullptr, nullptr, M, DM, DM}; pg8::ListOrder S{bx < 128 ? bx : 128 + (bx - 128) * 3, bx < 128 ? 1 : 3, 8, 1};
          pg8::EpiResB E{XB, X1B, ssq2, xch};
          pg8::gemm_phase<pg8::EpiResB, pg8::ListOrder>(lds, g, S, E); }
    }
    SEAM(4);

    if (IN(6)) {
        for (int it = bx; it < 256; it += G) { const int rb = it & 7, hh = (it >> 3) & 3, b = it >> 5; const int t0 = b * SEQ + rb * 256 + wave * 32;
            attn_unit<false>(lds, QC + (size_t)t0 * 512 + hh * 128, 512, MEMKV + (size_t)(b * NMEM) * 1024 + hh * 128, MEMKV + (size_t)(b * NMEM) * 1024 + 512 + hh * 128, 1024, 2,
                             0, 0, -1e30f, 0.0f, pg8::row_rs(ssq2, t0 + (lane & 31)) * 0.08838834764831845f, CO + (size_t)t0 * 512 + hh * 128, 512, tid, lane); }
    }
    SEAM(6);

    if (IN(7)) {
        pg8::Gemm g{CO, Wt_co, nullptr, nullptr, M, DM, 512}; pg8::StaticOrder S; S.init(M, DM, G, bx);
        pg8::EpiResB E{X1B, X2B, ssq3, xch};
        pg8::gemm_phase<pg8::EpiResB, pg8::StaticOrder>(lds, g, S, E);
    }
    SEAM(7);

    if (IN(8)) {
        pg8::Gemm g{X2B, Wt_gu, nullptr, nullptr, M, 2 * DFF, DM}; pg8::StaticOrder S; S.init(M, 2 * DFF, G, bx);
        pg8::EpiSwiGLU E{ACT, ssq3};
        pg8::gemm_phase<pg8::EpiSwiGLU, pg8::StaticOrder>(lds, g, S, E);
    }
    SEAM(8);

    if (IN(9)) {
        pg8::Gemm g{ACT, Wt_dn, nullptr, nullptr, M, DM, DFF}; pg8::StaticOrder S; S.init(M, DM, G, bx);
        pg8::EpiResB E{X2B, X3B, ssq4, xch};
        pg8::gemm_phase<pg8::EpiResB, pg8::StaticOrder>(lds, g, S, E);
    }
    SEAM(9);

    if (IN(10)) {
        for (int m = gw; m < M; m += NGW) { const v4u* xr = (const v4u*)(X3B + (size_t)m * DM) + lane; f32x4* orow = (f32x4*)(out + (size_t)m * DM); const f32x4* gr = (const f32x4*)g_final;
            const float rs = pg8::row_rs(ssq4, m);
#pragma unroll
            for (int j = 0; j < 4; ++j) { f32x4 a, b; pg8::unpack8(xr[64 * j], a, b); const int c = (64 * j + lane) * 2;
                orow[c] = a * rs * gr[c]; orow[c + 1] = b * rs * gr[c + 1]; } }
    }
#if defined(MK_DUMP_OFF)
    if (hi == MK_CUT && MK_CUT < 11) {
        asm volatile("s_waitcnt vmcnt(0) lgkmcnt(0)" ::: "memory"); __syncthreads(); grid.sync();
        const bf16* src = (const bf16*)(ws + (size_t)(MK_DUMP_OFF));
        for (size_t i = (size_t)bx * NTHR + tid; i < (size_t)M * 2048; i += (size_t)G * NTHR) { const size_t r = i >> 11, c = i & 2047; out[i] = __uint_as_float((unsigned)src[r * (MK_DUMP_LD) + (c % (MK_DUMP_W)) + (c / (MK_DUMP_W)) * (size_t)(MK_DUMP_OFF2)] << 16); }
    }
#endif
#undef IN
#undef SEAM
}

extern "C" void kernel_launch(void* const* d_in, const int* in_sizes, int n_in, void* d_out, int out_size, void* d_ws, size_t ws_size, hipStream_t stream) {
    static int grid = 0;
    if (grid == 0) {
        if (n_in != 20 || in_sizes[0] != M * DM || out_size != M * DM || ws_size < WS_END) { fprintf(stderr, "kernel_launch: unexpected shapes / workspace (n_in %d, ws %zu)\n", n_in, ws_size); grid = -1; return; }
        int dev = 0, cus = 0, per_cu = 0;
        if (hipGetDevice(&dev) != hipSuccess || hipDeviceGetAttribute(&cus, hipDeviceAttributeMultiprocessorCount, dev) != hipSuccess) { grid = -1; return; }
        if (hipFuncSetAttribute((const void*)mk_fwd, hipFuncAttributeMaxDynamicSharedMemorySize, LDS_BYTES) != hipSuccess) { fprintf(stderr, "kernel_launch: hipFuncSetAttribute failed\n"); grid = -1; return; }
        if (hipOccupancyMaxActiveBlocksPerMultiprocessor(&per_cu, (const void*)mk_fwd, NTHR, LDS_BYTES) != hipSuccess || per_cu < 1) { fprintf(stderr, "kernel_launch: occupancy query says %d\n", per_cu); (void)hipGetLastError(); grid = -1; return; }
        grid = cus;
    }
    if (grid < 0) return;
    Args a{};
    for (int i = 0; i < 20; ++i) a.in[i] = (const float*)d_in[i];
    a.out = (float*)d_out; a.ws = (unsigned char*)d_ws;
    if (hipMemsetAsync((char*)d_ws + WS_BAR, 0, WS_BAR_BYTES, stream) != hipSuccess) { fprintf(stderr, "kernel_launch: hipMemsetAsync of the barrier words failed\n"); return; }
#if defined(MK_PROBE_DUP)
    { void* kargs[] = {&a}; a.ph_lo = 0; a.ph_hi = MK_PROBE_DUP + 1; hipLaunchCooperativeKernel((const void*)mk_fwd, dim3(grid), dim3(NTHR), kargs, LDS_BYTES, stream);
      a.ph_lo = MK_PROBE_DUP; a.ph_hi = 11; a.li = 1; hipLaunchCooperativeKernel((const void*)mk_fwd, dim3(grid), dim3(NTHR), kargs, LDS_BYTES, stream); }
#elif MK_N_LAUNCHES == 1
    a.ph_lo = 0; a.ph_hi = MK_CUT;
    void* kargs[] = {&a};
    hipError_t e = hipLaunchCooperativeKernel((const void*)mk_fwd, dim3(grid), dim3(NTHR), kargs, LDS_BYTES, stream);
    if (e != hipSuccess) fprintf(stderr, "kernel_launch: cooperative launch failed: %s (grid %d)\n", hipGetErrorString(e), grid);
#else
    for (int p = 0; p < 11; ++p) { a.ph_lo = p; a.ph_hi = p + 1; hipLaunchKernelGGL(mk_fwd, dim3(grid), dim3(NTHR), LDS_BYTES, stream, a); }
#endif
}
```

```cpp
#include <hip/hip_runtime.h>
#include <hip/hip_cooperative_groups.h>
#include <cstdio>
#include <cstdint>
namespace cg = cooperative_groups;

#ifndef MK_CUT
#define MK_CUT 11
#endif
#ifndef MK_N_LAUNCHES
#define MK_N_LAUNCHES 1
#endif

namespace pg8 {
#define PG8_LAS __attribute__((address_space(3)))
typedef unsigned short bf16_t;
typedef short bf16x8 __attribute__((ext_vector_type(8)));
typedef float f32x4 __attribute__((ext_vector_type(4)));
typedef unsigned u32x4 __attribute__((ext_vector_type(4)));
constexpr int BM = 256, BK = 64, HALF = 128, HTB = HALF * BK * 2, STAGE_BYTES = 8 * HTB, NXCD = 8, WGM = 8;

__host__ __device__ __forceinline__ int lds_byte(int r, int c) { const int st = (r >> 4) * 2 + (c >> 5), rr = r & 15, cc = c & 31, ob = rr * 64 + cc * 2; return st * 1024 + (ob ^ (((ob >> 9) & 1) << 5)); }
__host__ __device__ __forceinline__ void stage_rc(int b, int& R, int& C) { const int st = b / 1024, sb = b % 1024, swz = sb ^ (((sb >> 9) & 1) << 5); R = (st >> 1) * 16 + swz / 64; C = (st & 1) * 32 + (swz % 64) / 2; }
__host__ __device__ __forceinline__ int perm32(int rho) { const int n = rho >> 4, i = rho & 15; return 8 * (i >> 2) + 4 * n + (i & 3); }

struct Unit { int pm, pn, seg; };
struct Gemm { const bf16_t* A0; const bf16_t* B0; const bf16_t* A1; const bf16_t* B1; int M, N, K; };

struct StaticOrder {
    int nM, nN, nwg, G, c, nseg;
    __device__ void init(int M, int N, int G_, int c_, int nseg_ = 1) { nM = M / BM; nN = N / BM; nwg = nM * nN; G = G_; c = c_; nseg = nseg_; }
    __device__ bool next(int i, Unit& u) const {
        const int j = (nseg == 2) ? (i >> 1) : i; u.seg = (nseg == 2) ? (i & 1) : 0;
        const long L = (long)j * G + c; if (L >= nwg) return false;
        int wgid = (int)L; { const int q = nwg / NXCD, r = nwg % NXCD, xcd = wgid % NXCD, off = wgid / NXCD; wgid = (xcd < r ? xcd * (q + 1) : r * (q + 1) + (xcd - r) * q) + off; }
        const int nig = WGM * nN, gid = wgid / nig, fm = gid * WGM, gsz = (nM - fm) < WGM ? (nM - fm) : WGM;
        u.pm = fm + ((wgid % nig) % gsz); u.pn = (wgid % nig) / gsz; return true;
    }
};

typedef __bf16 bf16x2_t __attribute__((ext_vector_type(2)));
typedef float f32x2_t __attribute__((ext_vector_type(2)));
struct ListOrder {
    int first, count, nN, nseg;
    __device__ bool next(int i, Unit& u) const { const int j = (nseg == 2) ? (i >> 1) : i; u.seg = (nseg == 2) ? (i & 1) : 0; if (j >= count) return false; const int L = first + j; u.pm = L / nN; u.pn = L % nN; return true; }
};
__device__ __forceinline__ unsigned cvt_pk_bf16(float lo, float hi) { const f32x2_t v = {lo, hi}; const bf16x2_t r = __builtin_convertvector(v, bf16x2_t); return __builtin_bit_cast(unsigned, r); }
__device__ __forceinline__ u32x4 pack8(const f32x4 a, const f32x4 b) { u32x4 w; w.x = cvt_pk_bf16(a[0], a[1]); w.y = cvt_pk_bf16(a[2], a[3]); w.z = cvt_pk_bf16(b[0], b[1]); w.w = cvt_pk_bf16(b[2], b[3]); return w; }
__device__ __forceinline__ void unpack8(const u32x4 w, f32x4& a, f32x4& b) {
    a[0] = __uint_as_float(w.x << 16); a[1] = __uint_as_float(w.x & 0xffff0000u); a[2] = __uint_as_float(w.y << 16); a[3] = __uint_as_float(w.y & 0xffff0000u);
    b[0] = __uint_as_float(w.z << 16); b[1] = __uint_as_float(w.z & 0xffff0000u); b[2] = __uint_as_float(w.w << 16); b[3] = __uint_as_float(w.w & 0xffff0000u); }
__device__ __forceinline__ f32x4 sigmoid4(const f32x4 v) { f32x4 o;
#pragma unroll
    for (int i = 0; i < 4; ++i) o[i] = __builtin_amdgcn_rcpf(1.0f + __expf(-v[i]));
    return o; }

typedef f32x4 Acc[2][2][4][2];

struct EpiBf16 {
    static constexpr bool PERM = true, KEEP_ACC = false;
    bf16_t* O; int ldc;
    __device__ __forceinline__ void operator()(Acc& acc, const Unit& u, int wr, int wc, int fr, int fq) const {
        const int row0 = u.pm * BM + wr * 64 + fr, col0 = u.pn * BM + wc * 32 + 8 * fq;
#pragma unroll
        for (int ai = 0; ai < 2; ++ai)
#pragma unroll
            for (int m = 0; m < 4; ++m) { bf16_t* rowp = O + (size_t)(row0 + ai * HALF + m * 16) * ldc + col0;
#pragma unroll
                for (int bj = 0; bj < 2; ++bj) *(u32x4*)(rowp + bj * HALF) = pack8(acc[ai][bj][m][0], acc[ai][bj][m][1]); }
    }
};
struct EpiIn {
    static constexpr bool PERM = true, KEEP_ACC = false;
    bf16_t* ZA; bf16_t* ZG; const float* cosT; const float* sinT; const float* bgate; float qscale; const float* rs1;
    __device__ __forceinline__ void operator()(Acc& acc, const Unit& u, int wr, int wc, int fr, int fq) const {
        const int row0 = u.pm * BM + wr * 64 + fr;
#pragma unroll
        for (int ai = 0; ai < 2; ++ai)
#pragma unroll
            for (int m = 0; m < 4; ++m) { const float rs = rs1[row0 + ai * HALF + m * 16];
#pragma unroll
                for (int bj = 0; bj < 2; ++bj) { acc[ai][bj][m][0] = acc[ai][bj][m][0] * rs; acc[ai][bj][m][1] = acc[ai][bj][m][1] * rs; } }
        if (u.pn < 5) {
            const int p = wc * 32 + 8 * fq, hb = p >> 6, j0 = p & 63, c1 = u.pn * 256 + hb * 128 + j0;
            const float sc = u.pn < 4 ? qscale : 1.0f;
#pragma unroll
            for (int ai = 0; ai < 2; ++ai)
#pragma unroll
                for (int m = 0; m < 4; ++m) { const int row = row0 + ai * HALF + m * 16, pos = row & 2047;
                    const f32x4 ca = *(const f32x4*)(cosT + pos * 64 + j0), cb = *(const f32x4*)(cosT + pos * 64 + j0 + 4);
                    const f32x4 sa = *(const f32x4*)(sinT + pos * 64 + j0), sb = *(const f32x4*)(sinT + pos * 64 + j0 + 4);
                    const f32x4 t1a = acc[ai][0][m][0], t1b = acc[ai][0][m][1], t2a = acc[ai][1][m][0], t2b = acc[ai][1][m][1];
                    const f32x4 o1a = (t1a * ca - t2a * sa) * sc, o1b = (t1b * cb - t2b * sb) * sc, o2a = (t2a * ca + t1a * sa) * sc, o2b = (t2b * cb + t1b * sb) * sc;
                    bf16_t* rp = ZA + (size_t)row * 4608 + c1;
                    *(u32x4*)rp = pack8(o1a, o1b); *(u32x4*)(rp + 64) = pack8(o2a, o2b); }
        } else if (u.pn < 18) {
            const int col0 = u.pn * BM + wc * 32 + 8 * fq;
#pragma unroll
            for (int ai = 0; ai < 2; ++ai)
#pragma unroll
                for (int m = 0; m < 4; ++m) { bf16_t* rowp = ZA + (size_t)(row0 + ai * HALF + m * 16) * 4608 + col0;
#pragma unroll
                    for (int bj = 0; bj < 2; ++bj) *(u32x4*)(rowp + bj * HALF) = pack8(acc[ai][bj][m][0], acc[ai][bj][m][1]); }
        } else {
            const int ch0 = (u.pn - 18) * HALF + wc * 32 + 8 * fq;
            const f32x4 ba0 = *(const f32x4*)(bgate + ch0), ba1 = *(const f32x4*)(bgate + ch0 + 4), bc0 = *(const f32x4*)(bgate + 2048 + ch0), bc1 = *(const f32x4*)(bgate + 2048 + ch0 + 4);
#pragma unroll
            for (int ai = 0; ai < 2; ++ai)
#pragma unroll
                for (int m = 0; m < 4; ++m) { bf16_t* rowp = ZG + (size_t)(row0 + ai * HALF + m * 16) * 4096 + ch0;
                    const f32x4 a0 = acc[ai][0][m][0] + ba0, a1 = acc[ai][0][m][1] + ba1, c0 = acc[ai][1][m][0] + bc0, c1 = acc[ai][1][m][1] + bc1;
                    f32x4 r0, r1, g0, g1;
#pragma unroll
                    for (int i = 0; i < 4; ++i) { const float ec0 = 1.0f + __expf(-c0[i]), ec1 = 1.0f + __expf(-c1[i]);
                        g0[i] = __builtin_amdgcn_rcpf(ec0); g1[i] = __builtin_amdgcn_rcpf(ec1);
                        r0[i] = ec0 * __builtin_amdgcn_rcpf(1.0f + __expf(-a0[i])); r1[i] = ec1 * __builtin_amdgcn_rcpf(1.0f + __expf(-a1[i])); }
                    *(u32x4*)rowp = pack8(r0, r1); *(u32x4*)(rowp + 2048) = pack8(g0, g1); }
        }
    }
};
struct EpiAcc2 {
    static constexpr bool PERM = true, KEEP_ACC = true;
    bf16_t* O; int ldc;
    __device__ __forceinline__ void operator()(Acc& acc, const Unit& u, int wr, int wc, int fr, int fq) const {
        if (u.seg == 0) return;
        const int row0 = u.pm * BM + wr * 64 + fr, col0 = u.pn * BM + wc * 32 + 8 * fq;
#pragma unroll
        for (int ai = 0; ai < 2; ++ai)
#pragma unroll
            for (int m = 0; m < 4; ++m) { bf16_t* rowp = O + (size_t)(row0 + ai * HALF + m * 16) * ldc + col0;
#pragma unroll
                for (int bj = 0; bj < 2; ++bj) *(u32x4*)(rowp + bj * HALF) = pack8(acc[ai][bj][m][0], acc[ai][bj][m][1]); }
    }
};
struct EpiMerge {
    static constexpr bool PERM = true, KEEP_ACC = true;
    const bf16_t* ZG; bf16_t* O;
    __device__ __forceinline__ void operator()(Acc& acc, const Unit& u, int wr, int wc, int fr, int fq) const {
        const int row0 = u.pm * BM + wr * 64 + fr, col0 = u.pn * BM + wc * 32 + 8 * fq;
#pragma unroll
        for (int ai = 0; ai < 2; ++ai)
#pragma unroll
            for (int m = 0; m < 4; ++m) { const int row = row0 + ai * HALF + m * 16;
#pragma unroll
                for (int bj = 0; bj < 2; ++bj) { const bf16_t* gp = ZG + (size_t)row * 4096 + col0 + bj * HALF;
                    if (u.seg == 0) { f32x4 a0, a1; unpack8(*(const u32x4*)gp, a0, a1); acc[ai][bj][m][0] = acc[ai][bj][m][0] * a0; acc[ai][bj][m][1] = acc[ai][bj][m][1] * a1; }
                    else { f32x4 c0, c1; unpack8(*(const u32x4*)(gp + 2048), c0, c1); *(u32x4*)(O + (size_t)row * 2048 + col0 + bj * HALF) = pack8(acc[ai][bj][m][0] * c0, acc[ai][bj][m][1] * c1); } } }
    }
};
struct EpiRes {
    static constexpr bool PERM = true, KEEP_ACC = false;
    const float* base; float* out; bf16_t* outb; float* part; PG8_LAS float* xch;
    __device__ __forceinline__ void operator()(Acc& acc, const Unit& u, int wr, int wc, int fr, int fq) const {
        const int row0 = u.pm * BM + wr * 64 + fr, col0 = u.pn * BM + wc * 32 + 8 * fq;
#pragma unroll
        for (int ai = 0; ai < 2; ++ai)
#pragma unroll
            for (int m = 0; m < 4; ++m) { const int row = row0 + ai * HALF + m * 16; float ss = 0.f;
#pragma unroll
                for (int bj = 0; bj < 2; ++bj) { const size_t off = (size_t)row * 2048 + col0 + bj * HALF;
                    const f32x4 o0 = *(const f32x4*)(base + off) + acc[ai][bj][m][0], o1 = *(const f32x4*)(base + off + 4) + acc[ai][bj][m][1];
                    *(f32x4*)(out + off) = o0; *(f32x4*)(out + off + 4) = o1;
                    if (outb) *(u32x4*)(outb + off) = pack8(o0, o1);
                    ss += (o0[0] * o0[0] + o0[1] * o0[1]) + (o0[2] * o0[2] + o0[3] * o0[3]) + (o1[0] * o1[0] + o1[1] * o1[1]) + (o1[2] * o1[2] + o1[3] * o1[3]); }
                ss += __shfl_xor(ss, 16); ss += __shfl_xor(ss, 32);
                if (fq == 0) xch[(ai * HALF + wr * 64 + m * 16 + fr) * 4 + wc] = ss; }
        asm volatile("s_waitcnt lgkmcnt(0)" ::: "memory"); __builtin_amdgcn_s_barrier(); asm volatile("" ::: "memory");
        { const int t = threadIdx.x; if (t < 256) { const f32x4 v = *(const PG8_LAS f32x4*)(xch + t * 4); part[(size_t)(u.pm * BM + t) * 8 + u.pn] = (v[0] + v[1]) + (v[2] + v[3]); } }
        asm volatile("s_waitcnt lgkmcnt(0)" ::: "memory"); __builtin_amdgcn_s_barrier(); asm volatile("" ::: "memory");
    }
};
struct EpiResB {
    static constexpr bool PERM = true, KEEP_ACC = false;
    const bf16_t* base; bf16_t* outb; float* part; PG8_LAS float* xch;
    __device__ __forceinline__ void operator()(Acc& acc, const Unit& u, int wr, int wc, int fr, int fq) const {
        const int row0 = u.pm * BM + wr * 64 + fr, col0 = u.pn * BM + wc * 32 + 8 * fq;
#pragma unroll
        for (int ai = 0; ai < 2; ++ai)
#pragma unroll
            for (int m = 0; m < 4; ++m) { const int row = row0 + ai * HALF + m * 16; float ss = 0.f;
#pragma unroll
                for (int bj = 0; bj < 2; ++bj) { const size_t off = (size_t)row * 2048 + col0 + bj * HALF;
                    f32x4 b0, b1; unpack8(*(const u32x4*)(base + off), b0, b1);
                    const f32x4 o0 = b0 + acc[ai][bj][m][0], o1 = b1 + acc[ai][bj][m][1];
                    *(u32x4*)(outb + off) = pack8(o0, o1);
                    ss += (o0[0] * o0[0] + o0[1] * o0[1]) + (o0[2] * o0[2] + o0[3] * o0[3]) + (o1[0] * o1[0] + o1[1] * o1[1]) + (o1[2] * o1[2] + o1[3] * o1[3]); }
                ss += __shfl_xor(ss, 16); ss += __shfl_xor(ss, 32);
                if (fq == 0) xch[(ai * HALF + wr * 64 + m * 16 + fr) * 4 + wc] = ss; }
        asm volatile("s_waitcnt lgkmcnt(0)" ::: "memory"); __builtin_amdgcn_s_barrier(); asm volatile("" ::: "memory");
        { const int t = threadIdx.x; if (t < 256) { const f32x4 v = *(const PG8_LAS f32x4*)(xch + t * 4); part[(size_t)(u.pm * BM + t) * 8 + u.pn] = (v[0] + v[1]) + (v[2] + v[3]); } }
        asm volatile("s_waitcnt lgkmcnt(0)" ::: "memory"); __builtin_amdgcn_s_barrier(); asm volatile("" ::: "memory");
    }
};
__device__ __forceinline__ float row_rs(const float* part, int row) { const f32x4 a = *(const f32x4*)(part + (size_t)row * 8), b = *(const f32x4*)(part + (size_t)row * 8 + 4);
    return __builtin_amdgcn_rsqf((((a[0] + a[1]) + (a[2] + a[3])) + ((b[0] + b[1]) + (b[2] + b[3]))) * (1.0f / 2048.0f) + 1e-6f); }
struct EpiRowScale {
    static constexpr bool PERM = true, KEEP_ACC = false;
    bf16_t* O; int ldc; const float* ssq; float scale;
    __device__ __forceinline__ void operator()(Acc& acc, const Unit& u, int wr, int wc, int fr, int fq) const {
        const int row0 = u.pm * BM + wr * 64 + fr, col0 = u.pn * BM + wc * 32 + 8 * fq;
#pragma unroll
        for (int ai = 0; ai < 2; ++ai)
#pragma unroll
            for (int m = 0; m < 4; ++m) { const int row = row0 + ai * HALF + m * 16; const float rs = row_rs(ssq, row) * scale;
                bf16_t* rowp = O + (size_t)row * ldc + col0;
#pragma unroll
                for (int bj = 0; bj < 2; ++bj) *(u32x4*)(rowp + bj * HALF) = pack8(acc[ai][bj][m][0] * rs, acc[ai][bj][m][1] * rs); }
    }
};
struct EpiSwiGLU {
    static constexpr bool PERM = true, KEEP_ACC = false;
    bf16_t* O; const float* ssq;
    __device__ __forceinline__ void operator()(Acc& acc, const Unit& u, int wr, int wc, int fr, int fq) const {
        const int row0 = u.pm * BM + wr * 64 + fr, col0 = u.pn * HALF + wc * 32 + 8 * fq;
#pragma unroll
        for (int ai = 0; ai < 2; ++ai)
#pragma unroll
            for (int m = 0; m < 4; ++m) { const int row = row0 + ai * HALF + m * 16; const float rs = row_rs(ssq, row);
                const f32x4 g0 = acc[ai][0][m][0] * rs, g1 = acc[ai][0][m][1] * rs, u0 = acc[ai][1][m][0] * rs, u1 = acc[ai][1][m][1] * rs;
                *(u32x4*)(O + (size_t)row * 5632 + col0) = pack8(g0 * sigmoid4(g0) * u0, g1 * sigmoid4(g1) * u1); }
    }
};

template <class Epi, class Sched, bool ALIGN_EPI = true>
__device__ __forceinline__ void gemm_phase(PG8_LAS unsigned char* lds, const Gemm g, const Sched& S, const Epi& E) {
    const int tid = threadIdx.x, wid = __builtin_amdgcn_readfirstlane(tid >> 6), lane = tid & 63, wr = wid >> 2, wc = wid & 3, fr = lane & 15, fq = lane >> 4;
    const int K = g.K, nt = K / BK;
    unsigned voffA[2], voffB[2];
#pragma unroll
    for (int i = 0; i < 2; ++i) { int R, C; stage_rc(tid * 16 + i * 8192, R, C); const int Rb = Epi::PERM ? ((R & ~31) + perm32(R & 31)) : R;
        voffA[i] = (unsigned)(R * K + C) * 2u; voffB[i] = (unsigned)(Rb * K + C) * 2u; }
    const size_t kstep = (size_t)(BK * 2);
    const size_t hstep = (size_t)HALF * K * 2;
    const size_t tstep = 2 * hstep;
    const unsigned ldsw = (unsigned)wid * 1024u;
    const int aoff = lds_byte(wr * 64 + fr, fq * 8), boff = lds_byte(wc * 32 + fr, fq * 8);
#define PG8_SA(b, h) (((b) * 2 + (h)) * HTB)
#define PG8_SB(b, h) ((4 + (b) * 2 + (h)) * HTB)
#define PG8_STAGE(bufoff, gbase, voff) do { _Pragma("unroll") for (int _i = 0; _i < 2; ++_i) \
        __builtin_amdgcn_global_load_lds((const unsigned*)((const char*)(gbase) + (voff)[_i]), (PG8_LAS unsigned*)(lds + (bufoff) + ldsw + _i * 8192), 16, 0, 0); } while (0)
#define PG8_LDA(dst, b, h) do { _Pragma("unroll") for (int m = 0; m < 4; ++m) _Pragma("unroll") for (int k = 0; k < 2; ++k) dst[m][k] = *(const PG8_LAS bf16x8*)(lds + PG8_SA(b, h) + aoff + m * 2048 + k * 1024); } while (0)
#define PG8_LDB(dst, b, h) do { _Pragma("unroll") for (int n = 0; n < 2; ++n) _Pragma("unroll") for (int k = 0; k < 2; ++k) dst[n][k] = *(const PG8_LAS bf16x8*)(lds + PG8_SB(b, h) + boff + n * 2048 + k * 1024); } while (0)
#define PG8_MMA(ai, bj, At, Bt) do { __builtin_amdgcn_s_setprio(1); _Pragma("unroll") for (int m = 0; m < 4; ++m) _Pragma("unroll") for (int n = 0; n < 2; ++n) _Pragma("unroll") for (int k = 0; k < 2; ++k) \
        acc[ai][bj][m][n] = __builtin_amdgcn_mfma_f32_16x16x32_bf16(Bt[n][k], At[m][k], acc[ai][bj][m][n], 0, 0, 0); __builtin_amdgcn_s_setprio(0); } while (0)
#define PG8_WAIT_V(n) asm volatile("s_waitcnt vmcnt(" #n ")" ::: "memory")
#define PG8_WAIT_L(n) asm volatile("s_waitcnt lgkmcnt(" #n ")" ::: "memory")
#define PG8_BAR __builtin_amdgcn_s_barrier()
#define PG8_SCHED __builtin_amdgcn_sched_barrier(0)
#define PG8_UA(u) ((const char*)((u).seg ? g.A1 : g.A0) + (size_t)(u).pm * tstep)
#define PG8_UB(u) ((const char*)((u).seg ? g.B1 : g.B0) + (size_t)(u).pn * tstep)
    Unit cur, nxt; int ui = 0;
    if (!S.next(0, cur)) return;
    Acc acc;
#pragma unroll
    for (int a = 0; a < 2; ++a)
#pragma unroll
        for (int b = 0; b < 2; ++b)
#pragma unroll
            for (int m = 0; m < 4; ++m)
#pragma unroll
                for (int n = 0; n < 2; ++n) acc[a][b][m][n] = (f32x4){0.f, 0.f, 0.f, 0.f};
    bf16x8 At[4][2], B0[2][2], B1[2][2];
    const char* cA = PG8_UA(cur); const char* cB = PG8_UB(cur);
    PG8_STAGE(PG8_SB(0, 0), cB, voffB); PG8_STAGE(PG8_SB(0, 1), cB + hstep, voffB); PG8_STAGE(PG8_SA(0, 0), cA, voffA); PG8_STAGE(PG8_SA(0, 1), cA + hstep, voffA);
    if (wr == 1) PG8_BAR;
    PG8_WAIT_V(2); PG8_BAR;
    PG8_STAGE(PG8_SB(1, 0), cB + kstep, voffB); PG8_STAGE(PG8_SA(1, 0), cA + kstep, voffA); PG8_STAGE(PG8_SB(1, 1), cB + hstep + kstep, voffB);
    PG8_WAIT_V(6); PG8_BAR;
    for (;;) {
        const bool has_next = S.next(ui + 1, nxt);
        const char* nA = has_next ? PG8_UA(nxt) : cA; const char* nB = has_next ? PG8_UB(nxt) : cB;
        for (int t = 0; t < nt; t += 2) {
            const bool last = (t == nt - 2);
            const char* a1 = cA + (size_t)(t + 1) * kstep;
            const char* a2 = last ? nA : cA + (size_t)(t + 2) * kstep; const char* b2 = last ? nB : cB + (size_t)(t + 2) * kstep;
            const char* a3 = a2 + kstep; const char* b3 = b2 + kstep;
            PG8_LDB(B0, 0, 0); PG8_LDB(B1, 0, 1); PG8_SCHED; PG8_LDA(At, 0, 0); PG8_STAGE(PG8_SA(1, 1), a1 + hstep, voffA);
            PG8_WAIT_V(8); PG8_WAIT_L(0); PG8_BAR; PG8_MMA(0, 0, At, B0); PG8_MMA(0, 1, At, B1); PG8_BAR; PG8_SCHED;
            PG8_LDA(At, 0, 1); PG8_STAGE(PG8_SB(0, 0), b2, voffB); PG8_STAGE(PG8_SB(0, 1), b2 + hstep, voffB); PG8_STAGE(PG8_SA(0, 0), a2, voffA);
            PG8_WAIT_V(8); PG8_WAIT_L(0); PG8_BAR; PG8_MMA(1, 0, At, B0); PG8_MMA(1, 1, At, B1); PG8_BAR; PG8_SCHED;
            PG8_LDB(B0, 1, 0); PG8_LDB(B1, 1, 1); PG8_SCHED; PG8_LDA(At, 1, 0); PG8_STAGE(PG8_SA(0, 1), a2 + hstep, voffA);
            PG8_WAIT_V(8); PG8_WAIT_L(0); PG8_BAR; PG8_MMA(0, 0, At, B0); PG8_MMA(0, 1, At, B1); PG8_BAR; PG8_SCHED;
            PG8_LDA(At, 1, 1); PG8_STAGE(PG8_SB(1, 0), b3, voffB); PG8_STAGE(PG8_SB(1, 1), b3 + hstep, voffB); PG8_STAGE(PG8_SA(1, 0), a3, voffA);
            PG8_WAIT_V(8); PG8_WAIT_L(0); PG8_BAR; PG8_MMA(1, 0, At, B0); PG8_MMA(1, 1, At, B1); PG8_BAR; PG8_SCHED;
        }
        if constexpr (ALIGN_EPI) { if (wr == 0) PG8_BAR; }
        E(acc, cur, wr, wc, fr, fq);
        if (!has_next) break;
        if (!(Epi::KEEP_ACC && cur.seg == 0)) {
#pragma unroll
        for (int a = 0; a < 2; ++a)
#pragma unroll
            for (int b = 0; b < 2; ++b)
#pragma unroll
                for (int m = 0; m < 4; ++m)
#pragma unroll
                    for (int n = 0; n < 2; ++n) acc[a][b][m][n] = (f32x4){0.f, 0.f, 0.f, 0.f};
        }
        cur = nxt; cA = nA; cB = nB; ++ui;
        if constexpr (ALIGN_EPI) { if (wr == 1) PG8_BAR; }
    }
    PG8_WAIT_V(0);
    if constexpr (!ALIGN_EPI) { if (wr == 0) PG8_BAR; }
    PG8_BAR;
#undef PG8_SA
#undef PG8_SB
#undef PG8_STAGE
#undef PG8_LDA
#undef PG8_LDB
#undef PG8_MMA
#undef PG8_WAIT_V
#undef PG8_WAIT_L
#undef PG8_BAR
#undef PG8_SCHED
#undef PG8_UA
#undef PG8_UB
}
}

constexpr int NWAVES = 8, NTHR = NWAVES * 64;
constexpr int DM = 2048, BATCH = 8, SEQ = 2048, M = BATCH * SEQ;
constexpr int INW = 8704, ZAW = 4608, ZGW = 4096;
constexpr int NMEM = 256, MROWS = BATCH * NMEM;
constexpr int DFF = 5632;
constexpr float RMS_EPS = 1e-6f;

constexpr size_t MiB = 1u << 20;
constexpr size_t WS_BAR = 256 * 1024, WS_BAR_BYTES = 64 * 1024;
constexpr size_t WS_RS1 = 0;
constexpr size_t WS_SSQ = 506 * MiB;
constexpr size_t WS_ROPE = 1 * MiB;
constexpr size_t WS_WIN = 2 * MiB;
constexpr size_t WS_WA = 36 * MiB;
constexpr size_t WS_WC = 40 * MiB;
constexpr size_t WS_WO = 44 * MiB;
constexpr size_t WS_WCQ = 52 * MiB;
constexpr size_t WS_WCKV = 54 * MiB;
constexpr size_t WS_WCO = 58 * MiB;
constexpr size_t WS_WGU = 60 * MiB;
constexpr size_t WS_WDN = 104 * MiB;
constexpr size_t WS_MEMN = 126 * MiB;
constexpr size_t WS_MEMKV = 134 * MiB;
constexpr size_t WS_ZA = 138 * MiB;
constexpr size_t WS_ZG = 282 * MiB;
constexpr size_t WS_AO = 2 * MiB;
constexpr size_t WS_CV = 410 * MiB;
constexpr size_t WS_WOB = 410 * MiB;
constexpr size_t WS_XB = 442 * MiB;
constexpr size_t WS_WOQ = 508 * MiB;
constexpr size_t WS_END = 510 * MiB;
constexpr size_t WS_MG = WS_ZA;
constexpr size_t WS_X1B = WS_ZG + 32 * MiB;
constexpr size_t WS_X3B = WS_XB;
constexpr size_t WS_QC = WS_ZG;
constexpr size_t WS_CO = WS_ZG + 16 * MiB;
constexpr size_t WS_X2B = WS_ZA;
constexpr size_t WS_ACT = WS_ZA + 64 * MiB;
static_assert(WS_ACT + (size_t)M * DFF * 2 <= WS_CV, "ACT overlay");

constexpr int LDS_BYTES = 147456;

#define GAS __attribute__((address_space(1)))
#define LAS __attribute__((address_space(3)))
typedef unsigned short bf16;
typedef unsigned v4u __attribute__((ext_vector_type(4)));
typedef float f32x4 __attribute__((ext_vector_type(4)));
#define LDS_WAIT() asm volatile("s_waitcnt lgkmcnt(0)" ::: "memory")
__device__ __forceinline__ unsigned f2bf(float f) { unsigned u = __builtin_bit_cast(unsigned, f); return (u + 0x7fffu + ((u >> 16) & 1u)) >> 16; }
__device__ __forceinline__ unsigned pk2(float lo, float hi) { return f2bf(lo) | (f2bf(hi) << 16); }
__device__ __forceinline__ float bflo(unsigned w) { return __uint_as_float(w << 16); }
__device__ __forceinline__ float bfhi(unsigned w) { return __uint_as_float(w & 0xffff0000u); }
__device__ __forceinline__ float wave_sum(float v) {
#pragma unroll
    for (int o = 1; o < 64; o <<= 1) v += __shfl_xor(v, o);
    return v;
}
__device__ __forceinline__ float wave_max(float v) {
#pragma unroll
    for (int o = 1; o < 64; o <<= 1) v = fmaxf(v, __shfl_xor(v, o));
    return v;
}

__device__ __forceinline__ int dest_row(int n0, int mode) {
    if (mode == 1) return (n0 >> 7) * 256 + (n0 & 127);
    if (mode == 2) return (n0 >> 7) * 256 + 128 + (n0 & 127);
    if (mode == 3 && n0 < 1280) return (n0 >> 8) * 256 + ((n0 >> 6) & 1) * 128 + ((n0 >> 7) & 1) * 64 + (n0 & 63);
    if (mode == 3 && n0 >= 4608) { const int g = n0 - 4608, br = g >> 11, ch = g & 2047; return 4608 + (ch >> 7) * 256 + br * 128 + (ch & 127); }
    return n0;
}
struct TItem { const float* W; bf16* WT; const float* gk; int K, N, mode, item; };
__device__ __forceinline__ void p0_t_load(const TItem& t, f32x4 (&v)[8], int lane) {
    const int nblk = t.N / 32, kb = t.item / nblk, nb = t.item % nblk, k0 = 64 * kb, n0 = 32 * nb, kr2 = lane >> 3, nq = lane & 7;
#pragma unroll
    for (int i = 0; i < 4; ++i) { const float* p = t.W + (size_t)(k0 + 16 * i + 2 * kr2) * t.N + n0 + 4 * nq; v[2 * i] = *(const f32x4*)p; v[2 * i + 1] = *(const f32x4*)(p + t.N); }
}
__device__ __forceinline__ void p0_t_store(const TItem& t, const f32x4 (&v)[8], LAS float* scrf, int lane) {
    LAS unsigned* scr = (LAS unsigned*)scrf;
    const int nblk = t.N / 32, kb = t.item / nblk, nb = t.item % nblk, k0 = 64 * kb, n0 = 32 * nb, kr2 = lane >> 3, nq = lane & 7;
#pragma unroll
    for (int i = 0; i < 4; ++i) { float g0 = 1.0f, g1 = 1.0f; if (t.gk) { g0 = t.gk[k0 + 16 * i + 2 * kr2]; g1 = t.gk[k0 + 16 * i + 2 * kr2 + 1]; }
        LAS unsigned* p = scr + (4 * nq) * 36 + 8 * i + kr2;
        p[0 * 36] = pk2(v[2 * i].x * g0, v[2 * i + 1].x * g1); p[1 * 36] = pk2(v[2 * i].y * g0, v[2 * i + 1].y * g1);
        p[2 * 36] = pk2(v[2 * i].z * g0, v[2 * i + 1].z * g1); p[3 * 36] = pk2(v[2 * i].w * g0, v[2 * i + 1].w * g1); }
    LDS_WAIT(); asm volatile("" ::: "memory");
    const int c = lane & 7, r0 = dest_row(n0, t.mode);
#pragma unroll
    for (int j = 0; j < 4; ++j) { const int n = (lane >> 3) + 8 * j; *(v4u*)(t.WT + (size_t)(r0 + n) * t.K + k0 + 8 * c) = *(const LAS v4u*)(scr + n * 36 + 4 * c); }
    LDS_WAIT(); asm volatile("" ::: "memory");
}
__device__ __forceinline__ void row_to_bf16_rs(const float* xrow, bf16* orow, float* rs_out, int lane) {
    const f32x4* xr = (const f32x4*)xrow + lane;
    f32x4 v[8]; float s = 0.f;
#pragma unroll
    for (int j = 0; j < 8; ++j) { v[j] = xr[64 * j]; s += (v[j].x * v[j].x + v[j].y * v[j].y) + (v[j].z * v[j].z + v[j].w * v[j].w); }
    const float rs = 1.0f / sqrtf(wave_sum(s) * (1.0f / DM) + RMS_EPS);
    if (lane == 0) *rs_out = rs;
    unsigned long long* o8 = (unsigned long long*)orow + lane;
#pragma unroll
    for (int j = 0; j < 8; ++j) o8[64 * j] = (unsigned long long)pk2(v[j].x, v[j].y) | ((unsigned long long)pk2(v[j].z, v[j].w) << 32);
}
__device__ __forceinline__ void rms_row_to_bf16(const float* xrow, const float* g, bf16* orow, int lane) {
    const f32x4* xr = (const f32x4*)xrow + lane; const f32x4* gr = (const f32x4*)g + lane;
    f32x4 v[8]; float s = 0.f;
#pragma unroll
    for (int j = 0; j < 8; ++j) { v[j] = xr[64 * j]; s += (v[j].x * v[j].x + v[j].y * v[j].y) + (v[j].z * v[j].z + v[j].w * v[j].w); }
    const float rs = 1.0f / sqrtf(wave_sum(s) * (1.0f / DM) + RMS_EPS);
    unsigned long long* o8 = (unsigned long long*)orow + lane;
#pragma unroll
    for (int j = 0; j < 8; ++j) { const f32x4 gg = gr[64 * j];
        o8[64 * j] = (unsigned long long)pk2(v[j].x * rs * gg.x, v[j].y * rs * gg.y) | ((unsigned long long)pk2(v[j].z * rs * gg.z, v[j].w * rs * gg.w) << 32); }
}

typedef float f32x16 __attribute__((ext_vector_type(16)));
typedef short s16x8 __attribute__((ext_vector_type(8)));
typedef short s16x4 __attribute__((ext_vector_type(4)));
constexpr int ATT_KP = 272, ATT_VP = 264, ATT_V_OFF = 128 * ATT_KP, ATT_LDS = ATT_V_OFF + 128 * ATT_VP;
constexpr float LOG2E = 1.4426950408889634f;
template <bool WINDOW>
__device__ __forceinline__ void attn_unit(LAS unsigned char* lds, const bf16* qw, int qpitch, const bf16* kg, const bf16* vg, int kvpitch, int nblk,
                                          int qpos, int kpos, float m_init, float l_init, float qs, bf16* ow, int opitch, int tid, int lane) {
    const int r = lane & 31, h = lane >> 5;
    s16x8 qf[8];
#pragma unroll
    for (int kk = 0; kk < 8; ++kk) qf[kk] = *(const s16x8*)(qw + (size_t)r * qpitch + 16 * kk + 8 * h);
    f32x16 o[4];
#pragma unroll
    for (int dt = 0; dt < 4; ++dt)
#pragma unroll
        for (int i = 0; i < 16; ++i) o[dt][i] = 0.f;
    float m = m_init, l = (h == 0) ? l_init : 0.f;
    const int kkey = tid >> 4, kc = tid & 15, vkey = tid & 127, vcg = tid >> 7;
    for (int blk = 0; blk < nblk; ++blk) {
        v4u kreg[4], vreg[4];
#pragma unroll
        for (int it = 0; it < 4; ++it) { kreg[it] = *(const v4u*)(kg + (size_t)(blk * 128 + kkey + 32 * it) * kvpitch + kc * 8); vreg[it] = *(const v4u*)(vg + (size_t)(blk * 128 + vkey) * kvpitch + (vcg * 4 + it) * 8); }
        __syncthreads();
#pragma unroll
        for (int it = 0; it < 4; ++it) { *(LAS v4u*)(lds + (kkey + 32 * it) * ATT_KP + kc * 16) = kreg[it];
            LAS unsigned short* vt = (LAS unsigned short*)(lds + ATT_V_OFF) + (size_t)((vcg * 4 + it) * 8) * (ATT_VP / 2) + vkey;
            const v4u w = vreg[it];
            vt[0 * (ATT_VP / 2)] = (unsigned short)(w.x & 0xffffu); vt[1 * (ATT_VP / 2)] = (unsigned short)(w.x >> 16); vt[2 * (ATT_VP / 2)] = (unsigned short)(w.y & 0xffffu); vt[3 * (ATT_VP / 2)] = (unsigned short)(w.y >> 16);
            vt[4 * (ATT_VP / 2)] = (unsigned short)(w.z & 0xffffu); vt[5 * (ATT_VP / 2)] = (unsigned short)(w.z >> 16); vt[6 * (ATT_VP / 2)] = (unsigned short)(w.w & 0xffffu); vt[7 * (ATT_VP / 2)] = (unsigned short)(w.w >> 16); }
        __syncthreads();
#pragma unroll 1
        for (int hf = 0; hf < 2; ++hf) {
        const int thr0 = WINDOW ? (qpos - (kpos + blk * 128 + 64 * hf)) : 0;
        if (WINDOW && (thr0 - 63 > 128 || thr0 + 31 < -128)) continue;
        const bool need_mask = WINDOW && (thr0 + 31 > 128 || thr0 - 63 < -128);
        const int thr = thr0 + r - 4 * h;
        f32x16 sc[2];
#pragma unroll
        for (int kt = 0; kt < 2; ++kt) {
#pragma unroll
            for (int i = 0; i < 16; ++i) sc[kt][i] = 0.f;
#pragma unroll
            for (int kk = 0; kk < 8; ++kk) { const s16x8 kf = *(const LAS s16x8*)(lds + (64 * hf + 32 * kt + r) * ATT_KP + (16 * kk + 8 * h) * 2); sc[kt] = __builtin_amdgcn_mfma_f32_32x32x16_bf16(kf, qf[kk], sc[kt], 0, 0, 0); }
        }
        float mb = -1e30f;
#pragma unroll
        for (int kt = 0; kt < 2; ++kt)
#pragma unroll
            for (int i = 0; i < 16; ++i) {
                if (!WINDOW) sc[kt][i] *= qs;
                if (WINDOW) { if (need_mask && (unsigned)((32 * kt + (i & 3) + 8 * (i >> 2)) - thr + 128) > 256u) sc[kt][i] = -1e30f; }
                mb = fmaxf(mb, sc[kt][i]); }
        mb = fmaxf(mb, __shfl_xor(mb, 32));
        const float mn = fmaxf(m, mb), alpha = __builtin_amdgcn_exp2f((m - mn) * LOG2E), mo = mn * LOG2E;
        m = mn; l *= alpha;
#pragma unroll
        for (int dt = 0; dt < 4; ++dt) o[dt] = o[dt] * alpha;
        float ls = 0.f;
#pragma unroll
        for (int kt = 0; kt < 2; ++kt)
#pragma unroll
            for (int i = 0; i < 16; ++i) { const float p = __builtin_amdgcn_exp2f(sc[kt][i] * LOG2E - mo); sc[kt][i] = p; ls += p; }
        l += ls;
#pragma unroll
        for (int kt = 0; kt < 2; ++kt)
#pragma unroll
            for (int st = 0; st < 2; ++st) {
                v4u pw; pw.x = pg8::cvt_pk_bf16(sc[kt][8 * st + 0], sc[kt][8 * st + 1]); pw.y = pg8::cvt_pk_bf16(sc[kt][8 * st + 2], sc[kt][8 * st + 3]);
                pw.z = pg8::cvt_pk_bf16(sc[kt][8 * st + 4], sc[kt][8 * st + 5]); pw.w = pg8::cvt_pk_bf16(sc[kt][8 * st + 6], sc[kt][8 * st + 7]);
                const s16x8 pf = __builtin_bit_cast(s16x8, pw);
#pragma unroll
                for (int dt = 0; dt < 4; ++dt) { const LAS unsigned char* vp = lds + ATT_V_OFF + (32 * dt + r) * ATT_VP + (64 * hf + 32 * kt + 16 * st + 4 * h) * 2;
                    const s16x4 lo = *(const LAS s16x4*)vp, hi = *(const LAS s16x4*)(vp + 16);
                    const s16x8 vf = __builtin_shufflevector(lo, hi, 0, 1, 2, 3, 4, 5, 6, 7);
                    o[dt] = __builtin_amdgcn_mfma_f32_32x32x16_bf16(vf, pf, o[dt], 0, 0, 0); }
            }
        }
    }
    l += __shfl_xor(l, 32);
    const float inv = 1.0f / l;
    bf16* orow = ow + (size_t)r * opitch + 4 * h;
#pragma unroll
    for (int dt = 0; dt < 4; ++dt)
#pragma unroll
        for (int g = 0; g < 4; ++g) { unsigned long long w = (unsigned long long)pg8::cvt_pk_bf16(o[dt][4 * g] * inv, o[dt][4 * g + 1] * inv) | ((unsigned long long)pg8::cvt_pk_bf16(o[dt][4 * g + 2] * inv, o[dt][4 * g + 3] * inv) << 32);
            *(unsigned long long*)(orow + 32 * dt + 8 * g) = w; }
}

#define RLX_AGENT __ATOMIC_RELAXED, __HIP_MEMORY_SCOPE_AGENT
#define XB_TMO      128
#define XB_XCNT(j)  (256  + 64 * (j))
#define XB_XSUB(j)  (1280 + 64 * (j))
#define XB_XGEN(j)  (2304 + 64 * (j))
#define XB_TOP      3328
#define XB_TOPGEN   3392
#define XCD_BAR_WORDS 3456
#define XB_SPIN_CAP (1u << 18)

__device__ __forceinline__ unsigned xb_ld(unsigned* p)              { return __hip_atomic_load(p, __ATOMIC_RELAXED, __HIP_MEMORY_SCOPE_AGENT); }
__device__ __forceinline__ unsigned xb_add(unsigned* p, unsigned v) { return __hip_atomic_fetch_add(p, v, __ATOMIC_RELAXED, __HIP_MEMORY_SCOPE_AGENT); }
__device__ __forceinline__ unsigned xb_xcc_id() { return (unsigned)__builtin_amdgcn_s_getreg((3 << 11) | 20) & 0xFu; }
#define XB_SPIN(cond, bar) do { unsigned _sp = 0; while (cond) { __builtin_amdgcn_s_sleep(1); \
    if ((++_sp & 255u) == 0u) { if (xb_ld(&(bar)[XB_TMO])) break; if (_sp > XB_SPIN_CAP) { atomicAdd(&(bar)[XB_TMO], 1u); break; } } } } while (0)

struct XcdBarrier {
    unsigned* bar; unsigned x;
    volatile LAS unsigned* st;
};

__device__ __forceinline__ XcdBarrier xcd_barrier_post(unsigned* bar, volatile LAS unsigned* st) {
    XcdBarrier b; b.bar = bar; b.x = xb_xcc_id(); b.st = st;
    if (threadIdx.x == 0) (void)xb_add(&bar[XB_XCNT(b.x)], 1u);
    return b;
}
__device__ __forceinline__ void xcd_barrier_complete(unsigned* bar, unsigned x, unsigned& nloc, unsigned& nx) {
    const unsigned G = gridDim.x * gridDim.y * gridDim.z;
    unsigned sum, cnt, mine, sp = 0u;
    for (;;) {
        sum = 0u; cnt = 0u; mine = 0u;
#pragma unroll
        for (unsigned j = 0; j < 16; ++j) { const unsigned c = xb_ld(&bar[XB_XCNT(j)]); sum += c; cnt += (c > 0u) ? 1u : 0u; mine = (j == x) ? c : mine; }
        if (sum == G) break;
        __builtin_amdgcn_s_sleep(1);
        if ((++sp & 255u) == 0u) { if (xb_ld(&bar[XB_TMO])) break; if (sp > XB_SPIN_CAP) { atomicAdd(&bar[XB_TMO], 1u); break; } }
    }
    nloc = mine > 0u ? mine : 1u; nx = cnt > 0u ? cnt : 1u;
}

__device__ __forceinline__ void xcd_barrier(const XcdBarrier& b) {
    asm volatile("s_waitcnt vmcnt(0)" ::: "memory");
    __syncthreads();
    if (threadIdx.x == 0) {
        unsigned* bar = b.bar;
        __builtin_amdgcn_s_waitcnt(0);
        unsigned nloc = b.st[0], nx = b.st[1];
        if (nloc == 0u) { xcd_barrier_complete(bar, b.x, nloc, nx); b.st[0] = nloc; b.st[1] = nx; }
        const unsigned old = xb_add(&bar[XB_XSUB(b.x)], 1u);
        const unsigned gen = old / nloc;
        if (old + 1u == (gen + 1u) * nloc) {
            __builtin_amdgcn_fence(__ATOMIC_RELEASE, "agent");
            asm volatile("s_waitcnt vmcnt(0)" ::: "memory");
            const unsigned og = xb_add(&bar[XB_TOP], 1u);
            const unsigned tg = og / nx;
            if (og + 1u == (tg + 1u) * nx) xb_add(&bar[XB_TOPGEN], 1u);
            else XB_SPIN(xb_ld(&bar[XB_TOPGEN]) == tg, bar);
            __builtin_amdgcn_fence(__ATOMIC_ACQUIRE, "agent");
            xb_add(&bar[XB_XGEN(b.x)], 1u);
            asm volatile("s_waitcnt vmcnt(0)" ::: "memory");
        } else {
            XB_SPIN(xb_ld(&bar[XB_XGEN(b.x)]) == gen, bar);
            __builtin_amdgcn_fence(__ATOMIC_ACQUIRE, "agent");
            asm volatile("s_waitcnt vmcnt(0)" ::: "memory");
        }
    }
    __syncthreads();
}

struct Args { const float* in[20]; float* out; unsigned char* ws; int ph_lo, ph_hi, li, pad; };

__global__ void __launch_bounds__(NTHR, 2) mk_fwd(Args args) {
    extern __shared__ __attribute__((aligned(16))) unsigned char lds_raw[];
    LAS unsigned char* lds = (LAS unsigned char*)lds_raw;
    const int tid = threadIdx.x, lane = tid & 63, wave = __builtin_amdgcn_readfirstlane(tid >> 6);
    const int G = gridDim.x, bx = blockIdx.x;
    const int gw = bx * NWAVES + wave, NGW = G * NWAVES;
    unsigned char* ws = args.ws;
    const float* x = args.in[0]; const float* mem = args.in[1]; const float* g_mix = args.in[2]; const float* w_in = args.in[3]; const float* sink = args.in[4];
    const float* conv_w = args.in[5]; const float* b_gate = args.in[6]; const float* w_attn_out = args.in[7]; const float* w_conv_out = args.in[8]; const float* w_o = args.in[9];
    const float* g_cross = args.in[10]; const float* g_mem = args.in[11]; const float* w_cq = args.in[12]; const float* w_ckv = args.in[13]; const float* w_co = args.in[14];
    const float* g_ffn = args.in[15]; const float* w_gate = args.in[16]; const float* w_up = args.in[17]; const float* w_down = args.in[18]; const float* g_final = args.in[19];
    float* out = args.out;
    float* ssq2 = (float*)(ws + WS_SSQ); float* ssq3 = ssq2 + M * 8; float* ssq4 = ssq3 + M * 8;
    PG8_LAS float* xch = (PG8_LAS float*)(lds + pg8::STAGE_BYTES);
    float* cosT = (float*)(ws + WS_ROPE); float* sinT = cosT + SEQ * 64;
    bf16* Wt_in = (bf16*)(ws + WS_WIN); bf16* Wt_a = (bf16*)(ws + WS_WA); bf16* Wt_c = (bf16*)(ws + WS_WC); bf16* Wt_o = (bf16*)(ws + WS_WO);
    bf16* Wt_cq = (bf16*)(ws + WS_WCQ); bf16* Wt_ckv = (bf16*)(ws + WS_WCKV); bf16* Wt_co = (bf16*)(ws + WS_WCO); bf16* Wt_gu = (bf16*)(ws + WS_WGU); bf16* Wt_dn = (bf16*)(ws + WS_WDN);
    bf16* MEMN = (bf16*)(ws + WS_MEMN); bf16* MEMKV = (bf16*)(ws + WS_MEMKV);
    bf16* ZA = (bf16*)(ws + WS_ZA); bf16* ZG = (bf16*)(ws + WS_ZG); bf16* AO = (bf16*)(ws + WS_AO); bf16* CV = (bf16*)(ws + WS_CV);
    bf16* MG = (bf16*)(ws + WS_MG); bf16* X1B = (bf16*)(ws + WS_X1B); bf16* X3B = (bf16*)(ws + WS_X3B); bf16* XB = (bf16*)(ws + WS_XB); bf16* WOB = (bf16*)(ws + WS_WOB); bf16* WOQ = (bf16*)(ws + WS_WOQ); float* rs1 = (float*)(ws + WS_RS1); bf16* QC = (bf16*)(ws + WS_QC); bf16* CO = (bf16*)(ws + WS_CO);
    bf16* X2B = (bf16*)(ws + WS_X2B); bf16* ACT = (bf16*)(ws + WS_ACT);
    cg::grid_group grid = cg::this_grid();
    const int lo = args.ph_lo, hi = args.ph_hi;
#define IN(k) (lo <= (k) && (k) < hi)
#define SEAM(k) do { if (IN(k) && IN((k) + 1)) { if (args.ph_hi > 1000) { asm volatile("s_waitcnt vmcnt(0) lgkmcnt(0)" ::: "memory"); __syncthreads(); grid.sync(); } else xcd_barrier(xbar); } } while (0)
    if (tid < 4) ((LAS unsigned*)(lds + pg8::STAGE_BYTES + 8192))[tid] = 0u;
    __syncthreads();
    const XcdBarrier xbar = xcd_barrier_post((unsigned*)(ws + WS_BAR) + args.li * 4096, (volatile LAS unsigned*)(lds + pg8::STAGE_BYTES + 8192));

    if (IN(0)) {
        LAS float* scr = (LAS float*)(lds + wave * 16384);
        constexpr int I_IN = (DM / 64) * (INW / 32), I_A = (1024 / 64) * (DM / 32), I_O = (DM / 64) * (DM / 32), I_CQ = (DM / 64) * (512 / 32), I_CKV = (DM / 64) * (1024 / 32),
                      I_CO = (512 / 64) * (DM / 32), I_G = (DM / 64) * (DFF / 32), I_D = (DFF / 64) * (DM / 32);
        constexpr int NITEMS = I_IN + 2 * I_A + I_O + I_CQ + I_CKV + I_CO;
#define P0_PICK(t, itx) do { int r = (itx); \
            if (r < I_IN) { t = TItem{w_in, Wt_in, g_mix, DM, INW, 3, r}; break; } r -= I_IN; \
            if (r < I_A) { t = TItem{w_attn_out, Wt_a, nullptr, 1024, DM, 0, r}; break; } r -= I_A; \
            if (r < I_A) { t = TItem{w_conv_out, Wt_c, nullptr, 1024, DM, 0, r}; break; } r -= I_A; \
            if (r < I_O) { t = TItem{w_o, Wt_o, nullptr, DM, DM, 0, r}; break; } r -= I_O; \
            if (r < I_CQ) { t = TItem{w_cq, Wt_cq, g_cross, DM, 512, 0, r}; break; } r -= I_CQ; \
            if (r < I_CKV) { t = TItem{w_ckv, Wt_ckv, nullptr, DM, 1024, 0, r}; break; } r -= I_CKV; \
            t = TItem{w_co, Wt_co, nullptr, 512, DM, 0, r}; } while (0)
        for (int it = gw; it < NITEMS; it += 2 * NGW) {
            TItem t0, t1; f32x4 v0[8], v1[8]; const bool two = it + NGW < NITEMS;
            P0_PICK(t0, it); p0_t_load(t0, v0, lane);
            if (two) { P0_PICK(t1, it + NGW); p0_t_load(t1, v1, lane); }
            p0_t_store(t0, v0, scr, lane);
            if (two) p0_t_store(t1, v1, scr, lane);
        }
#undef P0_PICK
        for (int m = gw * 2; m < M; m += NGW * 2) {
            f32x4 va[8], vb[8]; const f32x4* xa = (const f32x4*)(x + (size_t)m * DM) + lane; const f32x4* xb2 = xa + DM / 4;
#pragma unroll
            for (int j = 0; j < 8; ++j) { va[j] = xa[64 * j]; vb[j] = xb2[64 * j]; }
            float sa = 0.f, sb = 0.f;
#pragma unroll
            for (int j = 0; j < 8; ++j) { sa += (va[j].x * va[j].x + va[j].y * va[j].y) + (va[j].z * va[j].z + va[j].w * va[j].w); sb += (vb[j].x * vb[j].x + vb[j].y * vb[j].y) + (vb[j].z * vb[j].z + vb[j].w * vb[j].w); }
            sa = wave_sum(sa); sb = wave_sum(sb);
            if (lane == 0) { rs1[m] = 1.0f / sqrtf(sa * (1.0f / DM) + RMS_EPS); rs1[m + 1] = 1.0f / sqrtf(sb * (1.0f / DM) + RMS_EPS); }
            unsigned long long* oa = (unsigned long long*)(XB + (size_t)m * DM) + lane; unsigned long long* ob = oa + DM / 4;
#pragma unroll
            for (int j = 0; j < 8; ++j) { oa[64 * j] = (unsigned long long)pk2(va[j].x, va[j].y) | ((unsigned long long)pk2(va[j].z, va[j].w) << 32);
                ob[64 * j] = (unsigned long long)pk2(vb[j].x, vb[j].y) | ((unsigned long long)pk2(vb[j].z, vb[j].w) << 32); }
        }
        for (int i = bx * NTHR + tid; i < DM * DM / 8; i += G * NTHR) { const f32x4 a = *(const f32x4*)(w_o + (size_t)i * 8), b = *(const f32x4*)(w_o + (size_t)i * 8 + 4); *(v4u*)(WOB + (size_t)i * 8) = pg8::pack8(a, b); }
        for (int m = gw; m < MROWS; m += NGW) rms_row_to_bf16(mem + (size_t)m * DM, g_mem, MEMN + (size_t)m * DM, lane);
        for (int i = bx * NTHR + tid; i < SEQ * 64; i += G * NTHR) { const int pos = i >> 6, j = i & 63;
            const float inv = exp2f(-(float)j * (13.287712379549449f / 64.0f)); const float ang = (float)pos * inv;
            cosT[i] = cosf(ang); sinT[i] = sinf(ang); }
    }
    SEAM(0);

    if (IN(1)) {
        { pg8::Gemm g{XB, Wt_in, nullptr, nullptr, M, INW, DM}; pg8::StaticOrder S; S.init(M, INW, G, bx);
          pg8::EpiIn E{ZA, ZG, cosT, sinT, b_gate, 0.08838834764831845f, rs1};
          pg8::gemm_phase<pg8::EpiIn, pg8::StaticOrder>(lds, g, S, E); }
        { pg8::Gemm g{MEMN, Wt_ckv, nullptr, nullptr, MROWS, 1024, DM}; pg8::StaticOrder S; S.init(MROWS, 1024, G, (bx + G / 2) % G);
          pg8::EpiBf16 E{MEMKV, 1024};
          pg8::gemm_phase<pg8::EpiBf16, pg8::StaticOrder>(lds, g, S, E); }
        { pg8::Gemm g{Wt_cq, WOB, nullptr, nullptr, 512, DM, DM}; pg8::StaticOrder S; S.init(512, DM, G, (bx + G / 2 - 32 + G) % G);
          pg8::EpiBf16 E{WOQ, DM};
          pg8::gemm_phase<pg8::EpiBf16, pg8::StaticOrder>(lds, g, S, E); }
        if (G == 256 ? bx >= 176 : true) {
            __syncthreads();
            LAS float* scr = (LAS float*)(lds + wave * 16384);
            constexpr int I_G = (DM / 64) * (DFF / 32), I_D = (DFF / 64) * (DM / 32), NF = 2 * I_G + I_D;
            const int fw = (G == 256 ? (bx - 176) : bx) * NWAVES + wave, NFW = (G == 256 ? 80 : G) * NWAVES;
#define P1_PICK(t, itx) do { int r = (itx); \
            if (r < I_G) { t = TItem{w_gate, Wt_gu, g_ffn, DM, DFF, 1, r}; break; } r -= I_G; \
            if (r < I_G) { t = TItem{w_up, Wt_gu, g_ffn, DM, DFF, 2, r}; break; } r -= I_G; \
            t = TItem{w_down, Wt_dn, nullptr, DFF, DM, 0, r}; } while (0)
            for (int it = fw; it < NF; it += 4 * NFW) {
                TItem t0, t1, t2, t3; f32x4 v0[8], v1[8], v2[8], v3[8]; const bool h1 = it + NFW < NF, h2 = it + 2 * NFW < NF, h3 = it + 3 * NFW < NF;
                P1_PICK(t0, it); p0_t_load(t0, v0, lane);
                if (h1) { P1_PICK(t1, it + NFW); p0_t_load(t1, v1, lane); }
                if (h2) { P1_PICK(t2, it + 2 * NFW); p0_t_load(t2, v2, lane); }
                if (h3) { P1_PICK(t3, it + 3 * NFW); p0_t_load(t3, v3, lane); }
                p0_t_store(t0, v0, scr, lane);
                if (h1) p0_t_store(t1, v1, scr, lane);
                if (h2) p0_t_store(t2, v2, scr, lane);
                if (h3) p0_t_store(t3, v3, scr, lane);
            }
#undef P1_PICK
        }
    }
    SEAM(1);

    if (IN(2)) {
        for (int it = 2 * bx; it < 512; it += 2 * G)
            for (int hp = 0; hp < 2; ++hp) { const int kvh = it >> 1 & 1, nb = (it >> 2) & 15, b = it >> 6;
                const int hq = kvh * 4 + hp * 2 + (wave >> 2), t0 = b * SEQ + nb * 128 + (wave & 3) * 32;
                const int kb0 = nb > 0 ? nb - 1 : 0, kb1 = nb < 15 ? nb + 1 : 15; const size_t kt0 = (size_t)b * SEQ + kb0 * 128;
                attn_unit<true>(lds, ZA + (size_t)t0 * ZAW + hq * 128, ZAW, ZA + kt0 * ZAW + 1024 + kvh * 128, ZA + kt0 * ZAW + 1280 + kvh * 128, ZAW, kb1 - kb0 + 1,
                                nb * 128 + (wave & 3) * 32, kb0 * 128, sink[hq], 1.0f, 1.0f, AO + (size_t)t0 * 1024 + hq * 128, 1024, tid, lane); }
        __syncthreads();
        for (int idx = bx * NTHR + tid; idx < (M / 16) * 128; idx += G * NTHR) { const int run = idx >> 7, c8 = (idx & 127) * 8, t0 = run * 16, s0 = t0 & (SEQ - 1);
            const f32x4 w0a = *(const f32x4*)(conv_w + c8), w0b = *(const f32x4*)(conv_w + c8 + 4), w1a = *(const f32x4*)(conv_w + 1024 + c8), w1b = *(const f32x4*)(conv_w + 1024 + c8 + 4),
                        w2a = *(const f32x4*)(conv_w + 2048 + c8), w2b = *(const f32x4*)(conv_w + 2048 + c8 + 4);
            const bf16* zr = ZA + (size_t)t0 * ZAW + c8;
            f32x4 pa = {0.f, 0.f, 0.f, 0.f}, pb = pa, ca, cb, ta, tb;
            if (s0 > 0) { pg8::unpack8(*(const v4u*)(zr - ZAW + 1536), pa, pb); pg8::unpack8(*(const v4u*)(zr - ZAW + 3584), ta, tb); pa = pa * ta; pb = pb * tb; }
            pg8::unpack8(*(const v4u*)(zr + 1536), ca, cb); pg8::unpack8(*(const v4u*)(zr + 3584), ta, tb); ca = ca * ta; cb = cb * tb;
#pragma unroll
            for (int i = 0; i < 16; ++i) { f32x4 na = {0.f, 0.f, 0.f, 0.f}, nbv = na, ga, gb;
                if (i < 15 || s0 + 16 < SEQ) { pg8::unpack8(*(const v4u*)(zr + (size_t)(i + 1) * ZAW + 1536), na, nbv); pg8::unpack8(*(const v4u*)(zr + (size_t)(i + 1) * ZAW + 3584), ta, tb); na = na * ta; nbv = nbv * tb; }
                pg8::unpack8(*(const v4u*)(zr + (size_t)i * ZAW + 2560), ga, gb);
                *(v4u*)(CV + (size_t)(t0 + i) * 1024 + c8) = pg8::pack8(ga * (w0a * pa + w1a * ca + w2a * na), gb * (w0b * pb + w1b * cb + w2b * nbv));
                pa = ca; pb = cb; ca = na; cb = nbv; }
        }
    }
    SEAM(2);

    if (IN(3)) {
        pg8::Gemm g{AO, Wt_a, CV, Wt_c, M, DM, 1024}; pg8::StaticOrder S; S.init(M, DM, G, bx, 2);
        pg8::EpiMerge E{ZG, MG};
        pg8::gemm_phase<pg8::EpiMerge, pg8::StaticOrder>(lds, g, S, E);
    }
    SEAM(3);

    if (IN(4)) {
        { pg8::Gemm g{XB, Wt_cq, MG, WOQ, M, 512, DM}; pg8::ListOrder S{bx, bx < 128 ? 1 : 0, 2, 2};
          pg8::EpiAcc2 E{QC, 512};
          pg8::gemm_phase<pg8::EpiAcc2, pg8::ListOrder>(lds, g, S, E); }
        { pg8::Gemm g{MG, Wt_o, nullptr, nullptr, M, DM, DM}; pg8::ListOrder S{bx < 128 ? bx : 128 + (bx - 128) * 3, bx < 128 ? 1 : 3, 8, 1};
          pg8::EpiResB E{XB, X1B, ssq2, xch};
          pg8::gemm_phase<pg8::EpiResB, pg8::ListOrder>(lds, g, S, E); }
    }
    SEAM(4);

    if (IN(6)) {
        for (int it = bx; it < 256; it += G) { const int rb = it & 7, hh = (it >> 3) & 3, b = it >> 5; const int t0 = b * SEQ + rb * 256 + wave * 32;
            attn_unit<false>(lds, QC + (size_t)t0 * 512 + hh * 128, 512, MEMKV + (size_t)(b * NMEM) * 1024 + hh * 128, MEMKV + (size_t)(b * NMEM) * 1024 + 512 + hh * 128, 1024, 2,
                             0, 0, -1e30f, 0.0f, pg8::row_rs(ssq2, t0 + (lane & 31)) * 0.08838834764831845f, CO + (size_t)t0 * 512 + hh * 128, 512, tid, lane); }
    }
    SEAM(6);

    if (IN(7)) {
        pg8::Gemm g{CO, Wt_co, nullptr, nullptr, M, DM, 512}; pg8::StaticOrder S; S.init(M, DM, G, bx);
        pg8::EpiResB E{X1B, X2B, ssq3, xch};
        pg8::gemm_phase<pg8::EpiResB, pg8::StaticOrder>(lds, g, S, E);
    }
    SEAM(7);

    if (IN(8)) {
        pg8::Gemm g{X2B, Wt_gu, nullptr, nullptr, M, 2 * DFF, DM}; pg8::StaticOrder S; S.init(M, 2 * DFF, G, bx);
        pg8::EpiSwiGLU E{ACT, ssq3};
        pg8::gemm_phase<pg8::EpiSwiGLU, pg8::StaticOrder>(lds, g, S, E);
    }
    SEAM(8);

    if (IN(9)) {
        pg8::Gemm g{ACT, Wt_dn, nullptr, nullptr, M, DM, DFF}; pg8::StaticOrder S; S.init(M, DM, G, bx);
        pg8::EpiResB E{X2B, X3B, ssq4, xch};
        pg8::gemm_phase<pg8::EpiResB, pg8::StaticOrder>(lds, g, S, E);
    }
    SEAM(9);

    if (IN(10)) {
        const f32x4* gr = (const f32x4*)g_final;
        for (int m0 = gw * 4; m0 < M; m0 += NGW * 4) {
            v4u xv[4][4]; float rs[4];
#pragma unroll
            for (int q = 0; q < 4; ++q) { const v4u* xr = (const v4u*)(X3B + (size_t)(m0 + q) * DM) + lane;
#pragma unroll
                for (int j = 0; j < 4; ++j) xv[q][j] = xr[64 * j];
                rs[q] = pg8::row_rs(ssq4, m0 + q); }
#pragma unroll
            for (int q = 0; q < 4; ++q) { f32x4* orow = (f32x4*)(out + (size_t)(m0 + q) * DM);
#pragma unroll
                for (int j = 0; j < 4; ++j) { f32x4 a, b2; pg8::unpack8(xv[q][j], a, b2); const int c = (64 * j + lane) * 2;
                    orow[c] = a * rs[q] * gr[c]; orow[c + 1] = b2 * rs[q] * gr[c + 1]; } }
        }
    }
#if defined(MK_DUMP_OFF)
    if (hi == MK_CUT && MK_CUT < 11) {
        asm volatile("s_waitcnt vmcnt(0) lgkmcnt(0)" ::: "memory"); __syncthreads(); grid.sync();
        const bf16* src = (const bf16*)(ws + (size_t)(MK_DUMP_OFF));
        for (size_t i = (size_t)bx * NTHR + tid; i < (size_t)M * 2048; i += (size_t)G * NTHR) { const size_t r = i >> 11, c = i & 2047; out[i] = __uint_as_float((unsigned)src[r * (MK_DUMP_LD) + (c % (MK_DUMP_W)) + (c / (MK_DUMP_W)) * (size_t)(MK_DUMP_OFF2)] << 16); }
    }
#endif
#undef IN
#undef SEAM
}

extern "C" void kernel_launch(void* const* d_in, const int* in_sizes, int n_in, void* d_out, int out_size, void* d_ws, size_t ws_size, hipStream_t stream) {
    static int grid = 0;
    if (grid == 0) {
        if (n_in != 20 || in_sizes[0] != M * DM || out_size != M * DM || ws_size < WS_END) { fprintf(stderr, "kernel_launch: unexpected shapes / workspace (n_in %d, ws %zu)\n", n_in, ws_size); grid = -1; return; }
        int dev = 0, cus = 0, per_cu = 0;
        if (hipGetDevice(&dev) != hipSuccess || hipDeviceGetAttribute(&cus, hipDeviceAttributeMultiprocessorCount, dev) != hipSuccess) { grid = -1; return; }
        if (hipFuncSetAttribute((const void*)mk_fwd, hipFuncAttributeMaxDynamicSharedMemorySize, LDS_BYTES) != hipSuccess) { fprintf(stderr, "kernel_launch: hipFuncSetAttribute failed\n"); grid = -1; return; }
        if (hipOccupancyMaxActiveBlocksPerMultiprocessor(&per_cu, (const void*)mk_fwd, NTHR, LDS_BYTES) != hipSuccess || per_cu < 1) { fprintf(stderr, "kernel_launch: occupancy query says %d\n", per_cu); (void)hipGetLastError(); grid = -1; return; }
        grid = cus;
    }
    if (grid < 0) return;
    Args a{};
    for (int i = 0; i < 20; ++i) a.in[i] = (const float*)d_in[i];
    a.out = (float*)d_out; a.ws = (unsigned char*)d_ws;
    if (hipMemsetAsync((char*)d_ws + WS_BAR, 0, WS_BAR_BYTES, stream) != hipSuccess) { fprintf(stderr, "kernel_launch: hipMemsetAsync of the barrier words failed\n"); return; }
#if defined(MK_PROBE_DUP)
    { void* kargs[] = {&a}; a.ph_lo = 0; a.ph_hi = MK_PROBE_DUP + 1; hipLaunchCooperativeKernel((const void*)mk_fwd, dim3(grid), dim3(NTHR), kargs, LDS_BYTES, stream);
      a.ph_lo = MK_PROBE_DUP; a.ph_hi = 11; a.li = 1; hipLaunchCooperativeKernel((const void*)mk_fwd, dim3(grid), dim3(NTHR), kargs, LDS_BYTES, stream); }
#elif MK_N_LAUNCHES == 1
    a.ph_lo = 0; a.ph_hi = MK_CUT;
    void* kargs[] = {&a};
    hipError_t e = hipLaunchCooperativeKernel((const void*)mk_fwd, dim3(grid), dim3(NTHR), kargs, LDS_BYTES, stream);
    if (e != hipSuccess) fprintf(stderr, "kernel_launch: cooperative launch failed: %s (grid %d)\n", hipGetErrorString(e), grid);
#else
    for (int p = 0; p < 11; ++p) { a.ph_lo = p; a.ph_hi = p + 1; hipLaunchKernelGGL(mk_fwd, dim3(grid), dim3(NTHR), LDS_BYTES, stream, a); }
#endif
}
```

```cpp
#include <hip/hip_runtime.h>
#include <hip/hip_cooperative_groups.h>
#include <cstdio>
#include <cstdint>
namespace cg = cooperative_groups;

#ifndef MK_CUT
#define MK_CUT 11
#endif
#ifndef MK_N_LAUNCHES
#define MK_N_LAUNCHES 1
#endif

namespace pg8 {
#define PG8_LAS __attribute__((address_space(3)))
typedef unsigned short bf16_t;
typedef short bf16x8 __attribute__((ext_vector_type(8)));
typedef float f32x4 __attribute__((ext_vector_type(4)));
typedef unsigned u32x4 __attribute__((ext_vector_type(4)));
constexpr int BM = 256, BK = 64, HALF = 128, HTB = HALF * BK * 2, STAGE_BYTES = 8 * HTB, NXCD = 8, WGM = 8;

__host__ __device__ __forceinline__ int lds_byte(int r, int c) { const int st = (r >> 4) * 2 + (c >> 5), rr = r & 15, cc = c & 31, ob = rr * 64 + cc * 2; return st * 1024 + (ob ^ (((ob >> 9) & 1) << 5)); }
__host__ __device__ __forceinline__ void stage_rc(int b, int& R, int& C) { const int st = b / 1024, sb = b % 1024, swz = sb ^ (((sb >> 9) & 1) << 5); R = (st >> 1) * 16 + swz / 64; C = (st & 1) * 32 + (swz % 64) / 2; }
__host__ __device__ __forceinline__ int perm32(int rho) { const int n = rho >> 4, i = rho & 15; return 8 * (i >> 2) + 4 * n + (i & 3); }

struct Unit { int pm, pn, seg; };
struct Gemm { const bf16_t* A0; const bf16_t* B0; const bf16_t* A1; const bf16_t* B1; int M, N, K; };

struct StaticOrder {
    int nM, nN, nwg, G, c, nseg;
    __device__ void init(int M, int N, int G_, int c_, int nseg_ = 1) { nM = M / BM; nN = N / BM; nwg = nM * nN; G = G_; c = c_; nseg = nseg_; }
    __device__ bool next(int i, Unit& u) const {
        const int j = (nseg == 2) ? (i >> 1) : i; u.seg = (nseg == 2) ? (i & 1) : 0;
        const long L = (long)j * G + c; if (L >= nwg) return false;
        int wgid = (int)L; { const int q = nwg / NXCD, r = nwg % NXCD, xcd = wgid % NXCD, off = wgid / NXCD; wgid = (xcd < r ? xcd * (q + 1) : r * (q + 1) + (xcd - r) * q) + off; }
        const int nig = WGM * nN, gid = wgid / nig, fm = gid * WGM, gsz = (nM - fm) < WGM ? (nM - fm) : WGM;
        u.pm = fm + ((wgid % nig) % gsz); u.pn = (wgid % nig) / gsz; return true;
    }
};

typedef __bf16 bf16x2_t __attribute__((ext_vector_type(2)));
typedef float f32x2_t __attribute__((ext_vector_type(2)));
struct ListOrder {
    int first, count, nN, nseg;
    __device__ bool next(int i, Unit& u) const { const int j = (nseg == 2) ? (i >> 1) : i; u.seg = (nseg == 2) ? (i & 1) : 0; if (j >= count) return false; const int L = first + j; u.pm = L / nN; u.pn = L % nN; return true; }
};
struct PanelOrder {
    int c;
    __device__ bool next(int i, Unit& u) const { u.seg = 0; if (i >= 2) return false; const int q = c >> 3; u.pm = i * 32 + (c & 7) * 4 + (q >> 3); u.pn = q & 7; return true; }
};
__device__ __forceinline__ unsigned cvt_pk_bf16(float lo, float hi) { const f32x2_t v = {lo, hi}; const bf16x2_t r = __builtin_convertvector(v, bf16x2_t); return __builtin_bit_cast(unsigned, r); }
__device__ __forceinline__ u32x4 pack8(const f32x4 a, const f32x4 b) { u32x4 w; w.x = cvt_pk_bf16(a[0], a[1]); w.y = cvt_pk_bf16(a[2], a[3]); w.z = cvt_pk_bf16(b[0], b[1]); w.w = cvt_pk_bf16(b[2], b[3]); return w; }
__device__ __forceinline__ void unpack8(const u32x4 w, f32x4& a, f32x4& b) {
    a[0] = __uint_as_float(w.x << 16); a[1] = __uint_as_float(w.x & 0xffff0000u); a[2] = __uint_as_float(w.y << 16); a[3] = __uint_as_float(w.y & 0xffff0000u);
    b[0] = __uint_as_float(w.z << 16); b[1] = __uint_as_float(w.z & 0xffff0000u); b[2] = __uint_as_float(w.w << 16); b[3] = __uint_as_float(w.w & 0xffff0000u); }
__device__ __forceinline__ f32x4 sigmoid4(const f32x4 v) { f32x4 o;
#pragma unroll
    for (int i = 0; i < 4; ++i) o[i] = __builtin_amdgcn_rcpf(1.0f + __expf(-v[i]));
    return o; }

typedef f32x4 Acc[2][2][4][2];

struct EpiBf16 {
    static constexpr bool PERM = true, KEEP_ACC = false;
    bf16_t* O; int ldc;
    __device__ __forceinline__ void operator()(Acc& acc, const Unit& u, int wr, int wc, int fr, int fq) const {
        const int row0 = u.pm * BM + wr * 64 + fr, col0 = u.pn * BM + wc * 32 + 8 * fq;
#pragma unroll
        for (int ai = 0; ai < 2; ++ai)
#pragma unroll
            for (int m = 0; m < 4; ++m) { bf16_t* rowp = O + (size_t)(row0 + ai * HALF + m * 16) * ldc + col0;
#pragma unroll
                for (int bj = 0; bj < 2; ++bj) *(u32x4*)(rowp + bj * HALF) = pack8(acc[ai][bj][m][0], acc[ai][bj][m][1]); }
    }
};
struct EpiIn {
    static constexpr bool PERM = true, KEEP_ACC = false;
    bf16_t* ZA; bf16_t* ZG; const float* cosT; const float* sinT; const float* bgate; float qscale; const float* rs1;
    __device__ __forceinline__ void operator()(Acc& acc, const Unit& u, int wr, int wc, int fr, int fq) const {
        const int row0 = u.pm * BM + wr * 64 + fr;
#pragma unroll
        for (int ai = 0; ai < 2; ++ai)
#pragma unroll
            for (int m = 0; m < 4; ++m) { const float rs = rs1[row0 + ai * HALF + m * 16];
#pragma unroll
                for (int bj = 0; bj < 2; ++bj) { acc[ai][bj][m][0] = acc[ai][bj][m][0] * rs; acc[ai][bj][m][1] = acc[ai][bj][m][1] * rs; } }
        if (u.pn < 5) {
            const int p = wc * 32 + 8 * fq, hb = p >> 6, j0 = p & 63, c1 = u.pn * 256 + hb * 128 + j0;
            const float sc = u.pn < 4 ? qscale : 1.0f;
#pragma unroll
            for (int ai = 0; ai < 2; ++ai)
#pragma unroll
                for (int m = 0; m < 4; ++m) { const int row = row0 + ai * HALF + m * 16, pos = row & 2047;
                    const f32x4 ca = *(const f32x4*)(cosT + pos * 64 + j0), cb = *(const f32x4*)(cosT + pos * 64 + j0 + 4);
                    const f32x4 sa = *(const f32x4*)(sinT + pos * 64 + j0), sb = *(const f32x4*)(sinT + pos * 64 + j0 + 4);
                    const f32x4 t1a = acc[ai][0][m][0], t1b = acc[ai][0][m][1], t2a = acc[ai][1][m][0], t2b = acc[ai][1][m][1];
                    const f32x4 o1a = (t1a * ca - t2a * sa) * sc, o1b = (t1b * cb - t2b * sb) * sc, o2a = (t2a * ca + t1a * sa) * sc, o2b = (t2b * cb + t1b * sb) * sc;
                    bf16_t* rp = ZA + (size_t)row * 4608 + c1;
                    *(u32x4*)rp = pack8(o1a, o1b); *(u32x4*)(rp + 64) = pack8(o2a, o2b); }
        } else if (u.pn < 18) {
            const int col0 = u.pn * BM + wc * 32 + 8 * fq;
#pragma unroll
            for (int ai = 0; ai < 2; ++ai)
#pragma unroll
                for (int m = 0; m < 4; ++m) { bf16_t* rowp = ZA + (size_t)(row0 + ai * HALF + m * 16) * 4608 + col0;
#pragma unroll
                    for (int bj = 0; bj < 2; ++bj) *(u32x4*)(rowp + bj * HALF) = pack8(acc[ai][bj][m][0], acc[ai][bj][m][1]); }
        } else {
            const int ch0 = (u.pn - 18) * HALF + wc * 32 + 8 * fq;
            const f32x4 ba0 = *(const f32x4*)(bgate + ch0), ba1 = *(const f32x4*)(bgate + ch0 + 4), bc0 = *(const f32x4*)(bgate + 2048 + ch0), bc1 = *(const f32x4*)(bgate + 2048 + ch0 + 4);
#pragma unroll
            for (int ai = 0; ai < 2; ++ai)
#pragma unroll
                for (int m = 0; m < 4; ++m) { bf16_t* rowp = ZG + (size_t)(row0 + ai * HALF + m * 16) * 4096 + ch0;
                    const f32x4 a0 = acc[ai][0][m][0] + ba0, a1 = acc[ai][0][m][1] + ba1, c0 = acc[ai][1][m][0] + bc0, c1 = acc[ai][1][m][1] + bc1;
                    f32x4 r0, r1, g0, g1;
#pragma unroll
                    for (int i = 0; i < 4; ++i) { const float ec0 = 1.0f + __expf(-c0[i]), ec1 = 1.0f + __expf(-c1[i]);
                        g0[i] = __builtin_amdgcn_rcpf(ec0); g1[i] = __builtin_amdgcn_rcpf(ec1);
                        r0[i] = ec0 * __builtin_amdgcn_rcpf(1.0f + __expf(-a0[i])); r1[i] = ec1 * __builtin_amdgcn_rcpf(1.0f + __expf(-a1[i])); }
                    *(u32x4*)rowp = pack8(r0, r1); *(u32x4*)(rowp + 2048) = pack8(g0, g1); }
        }
    }
};
struct EpiAcc2 {
    static constexpr bool PERM = true, KEEP_ACC = true;
    bf16_t* O; int ldc;
    __device__ __forceinline__ void operator()(Acc& acc, const Unit& u, int wr, int wc, int fr, int fq) const {
        if (u.seg == 0) return;
        const int row0 = u.pm * BM + wr * 64 + fr, col0 = u.pn * BM + wc * 32 + 8 * fq;
#pragma unroll
        for (int ai = 0; ai < 2; ++ai)
#pragma unroll
            for (int m = 0; m < 4; ++m) { bf16_t* rowp = O + (size_t)(row0 + ai * HALF + m * 16) * ldc + col0;
#pragma unroll
                for (int bj = 0; bj < 2; ++bj) *(u32x4*)(rowp + bj * HALF) = pack8(acc[ai][bj][m][0], acc[ai][bj][m][1]); }
    }
};
struct EpiMerge {
    static constexpr bool PERM = true, KEEP_ACC = true;
    const bf16_t* ZG; bf16_t* O;
    __device__ __forceinline__ void operator()(Acc& acc, const Unit& u, int wr, int wc, int fr, int fq) const {
        const int row0 = u.pm * BM + wr * 64 + fr, col0 = u.pn * BM + wc * 32 + 8 * fq;
#pragma unroll
        for (int ai = 0; ai < 2; ++ai)
#pragma unroll
            for (int m = 0; m < 4; ++m) { const int row = row0 + ai * HALF + m * 16;
#pragma unroll
                for (int bj = 0; bj < 2; ++bj) { const bf16_t* gp = ZG + (size_t)row * 4096 + col0 + bj * HALF;
                    if (u.seg == 0) { f32x4 a0, a1; unpack8(*(const u32x4*)gp, a0, a1); acc[ai][bj][m][0] = acc[ai][bj][m][0] * a0; acc[ai][bj][m][1] = acc[ai][bj][m][1] * a1; }
                    else { f32x4 c0, c1; unpack8(*(const u32x4*)(gp + 2048), c0, c1); *(u32x4*)(O + (size_t)row * 2048 + col0 + bj * HALF) = pack8(acc[ai][bj][m][0] * c0, acc[ai][bj][m][1] * c1); } } }
    }
};
struct EpiRes {
    static constexpr bool PERM = true, KEEP_ACC = false;
    const float* base; float* out; bf16_t* outb; float* part; PG8_LAS float* xch;
    __device__ __forceinline__ void operator()(Acc& acc, const Unit& u, int wr, int wc, int fr, int fq) const {
        const int row0 = u.pm * BM + wr * 64 + fr, col0 = u.pn * BM + wc * 32 + 8 * fq;
#pragma unroll
        for (int ai = 0; ai < 2; ++ai)
#pragma unroll
            for (int m = 0; m < 4; ++m) { const int row = row0 + ai * HALF + m * 16; float ss = 0.f;
#pragma unroll
                for (int bj = 0; bj < 2; ++bj) { const size_t off = (size_t)row * 2048 + col0 + bj * HALF;
                    const f32x4 o0 = *(const f32x4*)(base + off) + acc[ai][bj][m][0], o1 = *(const f32x4*)(base + off + 4) + acc[ai][bj][m][1];
                    *(f32x4*)(out + off) = o0; *(f32x4*)(out + off + 4) = o1;
                    if (outb) *(u32x4*)(outb + off) = pack8(o0, o1);
                    ss += (o0[0] * o0[0] + o0[1] * o0[1]) + (o0[2] * o0[2] + o0[3] * o0[3]) + (o1[0] * o1[0] + o1[1] * o1[1]) + (o1[2] * o1[2] + o1[3] * o1[3]); }
                ss += __shfl_xor(ss, 16); ss += __shfl_xor(ss, 32);
                if (fq == 0) xch[(ai * HALF + wr * 64 + m * 16 + fr) * 4 + wc] = ss; }
        asm volatile("s_waitcnt lgkmcnt(0)" ::: "memory"); __builtin_amdgcn_s_barrier(); asm volatile("" ::: "memory");
        { const int t = threadIdx.x; if (t < 256) { const f32x4 v = *(const PG8_LAS f32x4*)(xch + t * 4); part[(size_t)(u.pm * BM + t) * 8 + u.pn] = (v[0] + v[1]) + (v[2] + v[3]); } }
        asm volatile("s_waitcnt lgkmcnt(0)" ::: "memory"); __builtin_amdgcn_s_barrier(); asm volatile("" ::: "memory");
    }
};
struct EpiResB {
    static constexpr bool PERM = true, KEEP_ACC = false;
    const bf16_t* base; bf16_t* outb; float* part; PG8_LAS float* xch;
    __device__ __forceinline__ void operator()(Acc& acc, const Unit& u, int wr, int wc, int fr, int fq) const {
        const int row0 = u.pm * BM + wr * 64 + fr, col0 = u.pn * BM + wc * 32 + 8 * fq;
#pragma unroll
        for (int ai = 0; ai < 2; ++ai)
#pragma unroll
            for (int m = 0; m < 4; ++m) { const int row = row0 + ai * HALF + m * 16; float ss = 0.f;
#pragma unroll
                for (int bj = 0; bj < 2; ++bj) { const size_t off = (size_t)row * 2048 + col0 + bj * HALF;
                    f32x4 b0, b1; unpack8(*(const u32x4*)(base + off), b0, b1);
                    const f32x4 o0 = b0 + acc[ai][bj][m][0], o1 = b1 + acc[ai][bj][m][1];
                    *(u32x4*)(outb + off) = pack8(o0, o1);
                    ss += (o0[0] * o0[0] + o0[1] * o0[1]) + (o0[2] * o0[2] + o0[3] * o0[3]) + (o1[0] * o1[0] + o1[1] * o1[1]) + (o1[2] * o1[2] + o1[3] * o1[3]); }
                ss += __shfl_xor(ss, 16); ss += __shfl_xor(ss, 32);
                if (fq == 0) xch[(ai * HALF + wr * 64 + m * 16 + fr) * 4 + wc] = ss; }
        asm volatile("s_waitcnt lgkmcnt(0)" ::: "memory"); __builtin_amdgcn_s_barrier(); asm volatile("" ::: "memory");
        { const int t = threadIdx.x; if (t < 256) { const f32x4 v = *(const PG8_LAS f32x4*)(xch + t * 4); part[(size_t)(u.pm * BM + t) * 8 + u.pn] = (v[0] + v[1]) + (v[2] + v[3]); } }
        asm volatile("s_waitcnt lgkmcnt(0)" ::: "memory"); __builtin_amdgcn_s_barrier(); asm volatile("" ::: "memory");
    }
};
struct EpiFinal {
    static constexpr bool PERM = true, KEEP_ACC = false;
    const bf16_t* base; float* out; const float* gfin; float* part; unsigned* cnt; PG8_LAS float* xch;
    __device__ __forceinline__ void operator()(Acc& acc, const Unit& u, int wr, int wc, int fr, int fq) const {
        const int row0 = u.pm * BM + wr * 64 + fr, col0 = u.pn * BM + wc * 32 + 8 * fq;
        const int tid = threadIdx.x, wid = __builtin_amdgcn_readfirstlane(tid >> 6), lane = tid & 63;
        PG8_LAS float* S = xch + 1024; PG8_LAS unsigned* flag = (PG8_LAS unsigned*)(xch + 1024 + 256);
#pragma unroll
        for (int ai = 0; ai < 2; ++ai)
#pragma unroll
            for (int m = 0; m < 4; ++m) { const int row = row0 + ai * HALF + m * 16; float ss = 0.f;
#pragma unroll
                for (int bj = 0; bj < 2; ++bj) { f32x4 b0, b1; unpack8(*(const u32x4*)(base + (size_t)row * 2048 + col0 + bj * HALF), b0, b1);
                    const f32x4 o0 = b0 + acc[ai][bj][m][0], o1 = b1 + acc[ai][bj][m][1]; acc[ai][bj][m][0] = o0; acc[ai][bj][m][1] = o1;
                    ss += (o0[0] * o0[0] + o0[1] * o0[1]) + (o0[2] * o0[2] + o0[3] * o0[3]) + (o1[0] * o1[0] + o1[1] * o1[1]) + (o1[2] * o1[2] + o1[3] * o1[3]); }
                ss += __shfl_xor(ss, 16); ss += __shfl_xor(ss, 32);
                if (fq == 0) xch[(ai * HALF + wr * 64 + m * 16 + fr) * 4 + wc] = ss; }
        asm volatile("s_waitcnt lgkmcnt(0)" ::: "memory"); __builtin_amdgcn_s_barrier(); asm volatile("" ::: "memory");
        if (tid < 256) { const f32x4 v = *(const PG8_LAS f32x4*)(xch + tid * 4);
            __hip_atomic_store(part + (size_t)(u.pm * BM + tid) * 8 + u.pn, (v[0] + v[1]) + (v[2] + v[3]), __ATOMIC_RELAXED, __HIP_MEMORY_SCOPE_AGENT);
            asm volatile("s_waitcnt vmcnt(0)" ::: "memory");
            if (lane == 0) __hip_atomic_fetch_add(cnt + 64 * u.pm, 1u, __ATOMIC_RELAXED, __HIP_MEMORY_SCOPE_AGENT); }
        if (wid == 0) { unsigned dead = 0u, sp = 0u;
            while ((unsigned)__builtin_amdgcn_readfirstlane(__hip_atomic_load(cnt + 64 * u.pm, __ATOMIC_RELAXED, __HIP_MEMORY_SCOPE_AGENT)) < 32u) { __builtin_amdgcn_s_sleep(2); if (++sp > (1u << 20)) { dead = 1u; break; } }
            __builtin_amdgcn_fence(__ATOMIC_ACQUIRE, "agent");
            if (lane == 0) flag[0] = dead; }
        asm volatile("s_waitcnt vmcnt(0) lgkmcnt(0)" ::: "memory"); __builtin_amdgcn_s_barrier(); asm volatile("" ::: "memory");
        if (tid < 256) { const float* p = part + (size_t)(u.pm * BM + tid) * 8; float t = 0.f;
#pragma unroll
            for (int j = 0; j < 8; ++j) t += __hip_atomic_load(p + j, __ATOMIC_RELAXED, __HIP_MEMORY_SCOPE_AGENT);
            S[tid] = (flag[0] != 0u) ? __builtin_nanf("") : __builtin_amdgcn_rsqf(t * (1.0f / 2048.0f) + 1e-6f); }
        asm volatile("s_waitcnt vmcnt(0) lgkmcnt(0)" ::: "memory"); __builtin_amdgcn_s_barrier(); asm volatile("" ::: "memory");
        f32x4 gv[2][2];
#pragma unroll
        for (int bj = 0; bj < 2; ++bj) { gv[bj][0] = *(const f32x4*)(gfin + col0 + bj * HALF); gv[bj][1] = *(const f32x4*)(gfin + col0 + bj * HALF + 4); }
#pragma unroll
        for (int ai = 0; ai < 2; ++ai)
#pragma unroll
            for (int m = 0; m < 4; ++m) { const int rl = ai * HALF + wr * 64 + m * 16 + fr; const float rs = S[rl]; float* orow = out + (size_t)(u.pm * BM + rl) * 2048 + col0;
#pragma unroll
                for (int bj = 0; bj < 2; ++bj) { *(f32x4*)(orow + bj * HALF) = acc[ai][bj][m][0] * rs * gv[bj][0]; *(f32x4*)(orow + bj * HALF + 4) = acc[ai][bj][m][1] * rs * gv[bj][1]; } }
        asm volatile("s_waitcnt lgkmcnt(0)" ::: "memory"); __builtin_amdgcn_s_barrier(); asm volatile("" ::: "memory");
    }
};
__device__ __forceinline__ float row_rs(const float* part, int row) { const f32x4 a = *(const f32x4*)(part + (size_t)row * 8), b = *(const f32x4*)(part + (size_t)row * 8 + 4);
    return __builtin_amdgcn_rsqf((((a[0] + a[1]) + (a[2] + a[3])) + ((b[0] + b[1]) + (b[2] + b[3]))) * (1.0f / 2048.0f) + 1e-6f); }
struct EpiRowScale {
    static constexpr bool PERM = true, KEEP_ACC = false;
    bf16_t* O; int ldc; const float* ssq; float scale;
    __device__ __forceinline__ void operator()(Acc& acc, const Unit& u, int wr, int wc, int fr, int fq) const {
        const int row0 = u.pm * BM + wr * 64 + fr, col0 = u.pn * BM + wc * 32 + 8 * fq;
#pragma unroll
        for (int ai = 0; ai < 2; ++ai)
#pragma unroll
            for (int m = 0; m < 4; ++m) { const int row = row0 + ai * HALF + m * 16; const float rs = row_rs(ssq, row) * scale;
                bf16_t* rowp = O + (size_t)row * ldc + col0;
#pragma unroll
                for (int bj = 0; bj < 2; ++bj) *(u32x4*)(rowp + bj * HALF) = pack8(acc[ai][bj][m][0] * rs, acc[ai][bj][m][1] * rs); }
    }
};
struct EpiSwiGLU {
    static constexpr bool PERM = true, KEEP_ACC = false;
    bf16_t* O; const float* ssq;
    __device__ __forceinline__ void operator()(Acc& acc, const Unit& u, int wr, int wc, int fr, int fq) const {
        const int row0 = u.pm * BM + wr * 64 + fr, col0 = u.pn * HALF + wc * 32 + 8 * fq;
#pragma unroll
        for (int ai = 0; ai < 2; ++ai)
#pragma unroll
            for (int m = 0; m < 4; ++m) { const int row = row0 + ai * HALF + m * 16; const float rs = row_rs(ssq, row);
                const f32x4 g0 = acc[ai][0][m][0] * rs, g1 = acc[ai][0][m][1] * rs, u0 = acc[ai][1][m][0] * rs, u1 = acc[ai][1][m][1] * rs;
                *(u32x4*)(O + (size_t)row * 5632 + col0) = pack8(g0 * sigmoid4(g0) * u0, g1 * sigmoid4(g1) * u1); }
    }
};

template <class Epi, class Sched, bool ALIGN_EPI = true>
__device__ __forceinline__ void gemm_phase(PG8_LAS unsigned char* lds, const Gemm g, const Sched& S, const Epi& E) {
    const int tid = threadIdx.x, wid = __builtin_amdgcn_readfirstlane(tid >> 6), lane = tid & 63, wr = wid >> 2, wc = wid & 3, fr = lane & 15, fq = lane >> 4;
    const int K = g.K, nt = K / BK;
    unsigned voffA[2], voffB[2];
#pragma unroll
    for (int i = 0; i < 2; ++i) { int R, C; stage_rc(tid * 16 + i * 8192, R, C); const int Rb = Epi::PERM ? ((R & ~31) + perm32(R & 31)) : R;
        voffA[i] = (unsigned)(R * K + C) * 2u; voffB[i] = (unsigned)(Rb * K + C) * 2u; }
    const size_t kstep = (size_t)(BK * 2);
    const size_t hstep = (size_t)HALF * K * 2;
    const size_t tstep = 2 * hstep;
    const unsigned ldsw = (unsigned)wid * 1024u;
    const int aoff = lds_byte(wr * 64 + fr, fq * 8), boff = lds_byte(wc * 32 + fr, fq * 8);
#define PG8_SA(b, h) (((b) * 2 + (h)) * HTB)
#define PG8_SB(b, h) ((4 + (b) * 2 + (h)) * HTB)
#define PG8_STAGE(bufoff, gbase, voff) do { _Pragma("unroll") for (int _i = 0; _i < 2; ++_i) \
        __builtin_amdgcn_global_load_lds((const unsigned*)((const char*)(gbase) + (voff)[_i]), (PG8_LAS unsigned*)(lds + (bufoff) + ldsw + _i * 8192), 16, 0, 0); } while (0)
#define PG8_LDA(dst, b, h) do { _Pragma("unroll") for (int m = 0; m < 4; ++m) _Pragma("unroll") for (int k = 0; k < 2; ++k) dst[m][k] = *(const PG8_LAS bf16x8*)(lds + PG8_SA(b, h) + aoff + m * 2048 + k * 1024); } while (0)
#define PG8_LDB(dst, b, h) do { _Pragma("unroll") for (int n = 0; n < 2; ++n) _Pragma("unroll") for (int k = 0; k < 2; ++k) dst[n][k] = *(const PG8_LAS bf16x8*)(lds + PG8_SB(b, h) + boff + n * 2048 + k * 1024); } while (0)
#define PG8_MMA(ai, bj, At, Bt) do { __builtin_amdgcn_s_setprio(1); _Pragma("unroll") for (int m = 0; m < 4; ++m) _Pragma("unroll") for (int n = 0; n < 2; ++n) _Pragma("unroll") for (int k = 0; k < 2; ++k) \
        acc[ai][bj][m][n] = __builtin_amdgcn_mfma_f32_16x16x32_bf16(Bt[n][k], At[m][k], acc[ai][bj][m][n], 0, 0, 0); __builtin_amdgcn_s_setprio(0); } while (0)
#define PG8_WAIT_V(n) asm volatile("s_waitcnt vmcnt(" #n ")" ::: "memory")
#define PG8_WAIT_L(n) asm volatile("s_waitcnt lgkmcnt(" #n ")" ::: "memory")
#define PG8_BAR __builtin_amdgcn_s_barrier()
#define PG8_SCHED __builtin_amdgcn_sched_barrier(0)
#define PG8_UA(u) ((const char*)((u).seg ? g.A1 : g.A0) + (size_t)(u).pm * tstep)
#define PG8_UB(u) ((const char*)((u).seg ? g.B1 : g.B0) + (size_t)(u).pn * tstep)
    Unit cur, nxt; int ui = 0;
    if (!S.next(0, cur)) return;
    Acc acc;
#pragma unroll
    for (int a = 0; a < 2; ++a)
#pragma unroll
        for (int b = 0; b < 2; ++b)
#pragma unroll
            for (int m = 0; m < 4; ++m)
#pragma unroll
                for (int n = 0; n < 2; ++n) acc[a][b][m][n] = (f32x4){0.f, 0.f, 0.f, 0.f};
    bf16x8 At[4][2], B0[2][2], B1[2][2];
    const char* cA = PG8_UA(cur); const char* cB = PG8_UB(cur);
    PG8_STAGE(PG8_SB(0, 0), cB, voffB); PG8_STAGE(PG8_SB(0, 1), cB + hstep, voffB); PG8_STAGE(PG8_SA(0, 0), cA, voffA); PG8_STAGE(PG8_SA(0, 1), cA + hstep, voffA);
    if (wr == 1) PG8_BAR;
    PG8_WAIT_V(2); PG8_BAR;
    PG8_STAGE(PG8_SB(1, 0), cB + kstep, voffB); PG8_STAGE(PG8_SA(1, 0), cA + kstep, voffA); PG8_STAGE(PG8_SB(1, 1), cB + hstep + kstep, voffB);
    PG8_WAIT_V(6); PG8_BAR;
    for (;;) {
        const bool has_next = S.next(ui + 1, nxt);
        const char* nA = has_next ? PG8_UA(nxt) : cA; const char* nB = has_next ? PG8_UB(nxt) : cB;
        for (int t = 0; t < nt; t += 2) {
            const bool last = (t == nt - 2);
            const char* a1 = cA + (size_t)(t + 1) * kstep;
            const char* a2 = last ? nA : cA + (size_t)(t + 2) * kstep; const char* b2 = last ? nB : cB + (size_t)(t + 2) * kstep;
            const char* a3 = a2 + kstep; const char* b3 = b2 + kstep;
            PG8_LDB(B0, 0, 0); PG8_LDB(B1, 0, 1); PG8_SCHED; PG8_LDA(At, 0, 0); PG8_STAGE(PG8_SA(1, 1), a1 + hstep, voffA);
            PG8_WAIT_V(8); PG8_WAIT_L(0); PG8_BAR; PG8_MMA(0, 0, At, B0); PG8_MMA(0, 1, At, B1); PG8_BAR; PG8_SCHED;
            PG8_LDA(At, 0, 1); PG8_STAGE(PG8_SB(0, 0), b2, voffB); PG8_STAGE(PG8_SB(0, 1), b2 + hstep, voffB); PG8_STAGE(PG8_SA(0, 0), a2, voffA);
            PG8_WAIT_V(8); PG8_WAIT_L(0); PG8_BAR; PG8_MMA(1, 0, At, B0); PG8_MMA(1, 1, At, B1); PG8_BAR; PG8_SCHED;
            PG8_LDB(B0, 1, 0); PG8_LDB(B1, 1, 1); PG8_SCHED; PG8_LDA(At, 1, 0); PG8_STAGE(PG8_SA(0, 1), a2 + hstep, voffA);
            PG8_WAIT_V(8); PG8_WAIT_L(0); PG8_BAR; PG8_MMA(0, 0, At, B0); PG8_MMA(0, 1, At, B1); PG8_BAR; PG8_SCHED;
            PG8_LDA(At, 1, 1); PG8_STAGE(PG8_SB(1, 0), b3, voffB); PG8_STAGE(PG8_SB(1, 1), b3 + hstep, voffB); PG8_STAGE(PG8_SA(1, 0), a3, voffA);
            PG8_WAIT_V(8); PG8_WAIT_L(0); PG8_BAR; PG8_MMA(1, 0, At, B0); PG8_MMA(1, 1, At, B1); PG8_BAR; PG8_SCHED;
        }
        if constexpr (ALIGN_EPI) { if (wr == 0) PG8_BAR; }
        E(acc, cur, wr, wc, fr, fq);
        if (!has_next) break;
        if (!(Epi::KEEP_ACC && cur.seg == 0)) {
#pragma unroll
        for (int a = 0; a < 2; ++a)
#pragma unroll
            for (int b = 0; b < 2; ++b)
#pragma unroll
                for (int m = 0; m < 4; ++m)
#pragma unroll
                    for (int n = 0; n < 2; ++n) acc[a][b][m][n] = (f32x4){0.f, 0.f, 0.f, 0.f};
        }
        cur = nxt; cA = nA; cB = nB; ++ui;
        if constexpr (ALIGN_EPI) { if (wr == 1) PG8_BAR; }
    }
    PG8_WAIT_V(0);
    if constexpr (!ALIGN_EPI) { if (wr == 0) PG8_BAR; }
    PG8_BAR;
#undef PG8_SA
#undef PG8_SB
#undef PG8_STAGE
#undef PG8_LDA
#undef PG8_LDB
#undef PG8_MMA
#undef PG8_WAIT_V
#undef PG8_WAIT_L
#undef PG8_BAR
#undef PG8_SCHED
#undef PG8_UA
#undef PG8_UB
}
}

constexpr int NWAVES = 8, NTHR = NWAVES * 64;
constexpr int DM = 2048, BATCH = 8, SEQ = 2048, M = BATCH * SEQ;
constexpr int INW = 8704, ZAW = 4608, ZGW = 4096;
constexpr int NMEM = 256, MROWS = BATCH * NMEM;
constexpr int DFF = 5632;
constexpr float RMS_EPS = 1e-6f;

constexpr size_t MiB = 1u << 20;
constexpr size_t WS_BAR = 256 * 1024, WS_BAR_BYTES = 128 * 1024, WS_PCNT = WS_BAR + 64 * 1024;
constexpr size_t WS_RS1 = 0;
constexpr size_t WS_SSQ = 506 * MiB;
constexpr size_t WS_ROPE = 1 * MiB;
constexpr size_t WS_WIN = 2 * MiB;
constexpr size_t WS_WA = 36 * MiB;
constexpr size_t WS_WC = 40 * MiB;
constexpr size_t WS_WO = 44 * MiB;
constexpr size_t WS_WCQ = 52 * MiB;
constexpr size_t WS_WCKV = 54 * MiB;
constexpr size_t WS_WCO = 58 * MiB;
constexpr size_t WS_WGU = 60 * MiB;
constexpr size_t WS_WDN = 104 * MiB;
constexpr size_t WS_MEMN = 126 * MiB;
constexpr size_t WS_MEMKV = 134 * MiB;
constexpr size_t WS_ZA = 138 * MiB;
constexpr size_t WS_ZG = 282 * MiB;
constexpr size_t WS_AO = 2 * MiB;
constexpr size_t WS_CV = 410 * MiB;
constexpr size_t WS_WOB = 410 * MiB;
constexpr size_t WS_XB = 442 * MiB;
constexpr size_t WS_WOQ = 508 * MiB;
constexpr size_t WS_END = 510 * MiB;
constexpr size_t WS_MG = WS_ZA;
constexpr size_t WS_X1B = WS_ZG + 32 * MiB;
constexpr size_t WS_X3B = WS_XB;
constexpr size_t WS_QC = WS_ZG;
constexpr size_t WS_CO = WS_ZG + 16 * MiB;
constexpr size_t WS_X2B = WS_ZA;
constexpr size_t WS_ACT = WS_ZA + 64 * MiB;
static_assert(WS_ACT + (size_t)M * DFF * 2 <= WS_CV, "ACT overlay");

constexpr int LDS_BYTES = 147456;

#define GAS __attribute__((address_space(1)))
#define LAS __attribute__((address_space(3)))
typedef unsigned short bf16;
typedef unsigned v4u __attribute__((ext_vector_type(4)));
typedef float f32x4 __attribute__((ext_vector_type(4)));
#define LDS_WAIT() asm volatile("s_waitcnt lgkmcnt(0)" ::: "memory")
__device__ __forceinline__ unsigned f2bf(float f) { unsigned u = __builtin_bit_cast(unsigned, f); return (u + 0x7fffu + ((u >> 16) & 1u)) >> 16; }
__device__ __forceinline__ unsigned pk2(float lo, float hi) { return f2bf(lo) | (f2bf(hi) << 16); }
__device__ __forceinline__ float bflo(unsigned w) { return __uint_as_float(w << 16); }
__device__ __forceinline__ float bfhi(unsigned w) { return __uint_as_float(w & 0xffff0000u); }
__device__ __forceinline__ float wave_sum(float v) {
#pragma unroll
    for (int o = 1; o < 64; o <<= 1) v += __shfl_xor(v, o);
    return v;
}
__device__ __forceinline__ float wave_max(float v) {
#pragma unroll
    for (int o = 1; o < 64; o <<= 1) v = fmaxf(v, __shfl_xor(v, o));
    return v;
}

__device__ __forceinline__ int dest_row(int n0, int mode) {
    if (mode == 1) return (n0 >> 7) * 256 + (n0 & 127);
    if (mode == 2) return (n0 >> 7) * 256 + 128 + (n0 & 127);
    if (mode == 3 && n0 < 1280) return (n0 >> 8) * 256 + ((n0 >> 6) & 1) * 128 + ((n0 >> 7) & 1) * 64 + (n0 & 63);
    if (mode == 3 && n0 >= 4608) { const int g = n0 - 4608, br = g >> 11, ch = g & 2047; return 4608 + (ch >> 7) * 256 + br * 128 + (ch & 127); }
    return n0;
}
struct TItem { const float* W; bf16* WT; const float* gk; int K, N, mode, item; };
__device__ __forceinline__ void p0_t_load(const TItem& t, f32x4 (&v)[8], int lane) {
    const int nblk = t.N / 32, kb = t.item / nblk, nb = t.item % nblk, k0 = 64 * kb, n0 = 32 * nb, kr2 = lane >> 3, nq = lane & 7;
#pragma unroll
    for (int i = 0; i < 4; ++i) { const float* p = t.W + (size_t)(k0 + 16 * i + 2 * kr2) * t.N + n0 + 4 * nq; v[2 * i] = *(const f32x4*)p; v[2 * i + 1] = *(const f32x4*)(p + t.N); }
}
__device__ __forceinline__ void p0_t_store(const TItem& t, const f32x4 (&v)[8], LAS float* scrf, int lane) {
    LAS unsigned* scr = (LAS unsigned*)scrf;
    const int nblk = t.N / 32, kb = t.item / nblk, nb = t.item % nblk, k0 = 64 * kb, n0 = 32 * nb, kr2 = lane >> 3, nq = lane & 7;
#pragma unroll
    for (int i = 0; i < 4; ++i) { float g0 = 1.0f, g1 = 1.0f; if (t.gk) { g0 = t.gk[k0 + 16 * i + 2 * kr2]; g1 = t.gk[k0 + 16 * i + 2 * kr2 + 1]; }
        LAS unsigned* p = scr + (4 * nq) * 36 + 8 * i + kr2;
        p[0 * 36] = pk2(v[2 * i].x * g0, v[2 * i + 1].x * g1); p[1 * 36] = pk2(v[2 * i].y * g0, v[2 * i + 1].y * g1);
        p[2 * 36] = pk2(v[2 * i].z * g0, v[2 * i + 1].z * g1); p[3 * 36] = pk2(v[2 * i].w * g0, v[2 * i + 1].w * g1); }
    LDS_WAIT(); asm volatile("" ::: "memory");
    const int c = lane & 7, r0 = dest_row(n0, t.mode);
#pragma unroll
    for (int j = 0; j < 4; ++j) { const int n = (lane >> 3) + 8 * j; *(v4u*)(t.WT + (size_t)(r0 + n) * t.K + k0 + 8 * c) = *(const LAS v4u*)(scr + n * 36 + 4 * c); }
    LDS_WAIT(); asm volatile("" ::: "memory");
}
__device__ __forceinline__ void row_to_bf16_rs(const float* xrow, bf16* orow, float* rs_out, int lane) {
    const f32x4* xr = (const f32x4*)xrow + lane;
    f32x4 v[8]; float s = 0.f;
#pragma unroll
    for (int j = 0; j < 8; ++j) { v[j] = xr[64 * j]; s += (v[j].x * v[j].x + v[j].y * v[j].y) + (v[j].z * v[j].z + v[j].w * v[j].w); }
    const float rs = 1.0f / sqrtf(wave_sum(s) * (1.0f / DM) + RMS_EPS);
    if (lane == 0) *rs_out = rs;
    unsigned long long* o8 = (unsigned long long*)orow + lane;
#pragma unroll
    for (int j = 0; j < 8; ++j) o8[64 * j] = (unsigned long long)pk2(v[j].x, v[j].y) | ((unsigned long long)pk2(v[j].z, v[j].w) << 32);
}
__device__ __forceinline__ void rms_row_to_bf16(const float* xrow, const float* g, bf16* orow, int lane) {
    const f32x4* xr = (const f32x4*)xrow + lane; const f32x4* gr = (const f32x4*)g + lane;
    f32x4 v[8]; float s = 0.f;
#pragma unroll
    for (int j = 0; j < 8; ++j) { v[j] = xr[64 * j]; s += (v[j].x * v[j].x + v[j].y * v[j].y) + (v[j].z * v[j].z + v[j].w * v[j].w); }
    const float rs = 1.0f / sqrtf(wave_sum(s) * (1.0f / DM) + RMS_EPS);
    unsigned long long* o8 = (unsigned long long*)orow + lane;
#pragma unroll
    for (int j = 0; j < 8; ++j) { const f32x4 gg = gr[64 * j];
        o8[64 * j] = (unsigned long long)pk2(v[j].x * rs * gg.x, v[j].y * rs * gg.y) | ((unsigned long long)pk2(v[j].z * rs * gg.z, v[j].w * rs * gg.w) << 32); }
}

typedef float f32x16 __attribute__((ext_vector_type(16)));
typedef short s16x8 __attribute__((ext_vector_type(8)));
typedef short s16x4 __attribute__((ext_vector_type(4)));
constexpr int ATT_KP = 272, ATT_VP = 264, ATT_V_OFF = 128 * ATT_KP, ATT_LDS = ATT_V_OFF + 128 * ATT_VP;
constexpr float LOG2E = 1.4426950408889634f;
template <bool WINDOW>
__device__ __forceinline__ void attn_unit(LAS unsigned char* lds, const bf16* qw, int qpitch, const bf16* kg, const bf16* vg, int kvpitch, int nblk,
                                          int qpos, int kpos, float m_init, float l_init, float qs, bf16* ow, int opitch, int tid, int lane) {
    const int r = lane & 31, h = lane >> 5;
    s16x8 qf[8];
#pragma unroll
    for (int kk = 0; kk < 8; ++kk) qf[kk] = *(const s16x8*)(qw + (size_t)r * qpitch + 16 * kk + 8 * h);
    f32x16 o[4];
#pragma unroll
    for (int dt = 0; dt < 4; ++dt)
#pragma unroll
        for (int i = 0; i < 16; ++i) o[dt][i] = 0.f;
    float m = m_init, l = (h == 0) ? l_init : 0.f;
    const int kkey = tid >> 4, kc = tid & 15, vkey = tid & 127, vcg = tid >> 7;
    for (int blk = 0; blk < nblk; ++blk) {
        v4u kreg[4], vreg[4];
#pragma unroll
        for (int it = 0; it < 4; ++it) { kreg[it] = *(const v4u*)(kg + (size_t)(blk * 128 + kkey + 32 * it) * kvpitch + kc * 8); vreg[it] = *(const v4u*)(vg + (size_t)(blk * 128 + vkey) * kvpitch + (vcg * 4 + it) * 8); }
        __syncthreads();
#pragma unroll
        for (int it = 0; it < 4; ++it) { *(LAS v4u*)(lds + (kkey + 32 * it) * ATT_KP + kc * 16) = kreg[it];
            LAS unsigned short* vt = (LAS unsigned short*)(lds + ATT_V_OFF) + (size_t)((vcg * 4 + it) * 8) * (ATT_VP / 2) + vkey;
            const v4u w = vreg[it];
            vt[0 * (ATT_VP / 2)] = (unsigned short)(w.x & 0xffffu); vt[1 * (ATT_VP / 2)] = (unsigned short)(w.x >> 16); vt[2 * (ATT_VP / 2)] = (unsigned short)(w.y & 0xffffu); vt[3 * (ATT_VP / 2)] = (unsigned short)(w.y >> 16);
            vt[4 * (ATT_VP / 2)] = (unsigned short)(w.z & 0xffffu); vt[5 * (ATT_VP / 2)] = (unsigned short)(w.z >> 16); vt[6 * (ATT_VP / 2)] = (unsigned short)(w.w & 0xffffu); vt[7 * (ATT_VP / 2)] = (unsigned short)(w.w >> 16); }
        __syncthreads();
#pragma unroll 1
        for (int hf = 0; hf < 2; ++hf) {
        const int thr0 = WINDOW ? (qpos - (kpos + blk * 128 + 64 * hf)) : 0;
        if (WINDOW && (thr0 - 63 > 128 || thr0 + 31 < -128)) continue;
        const bool need_mask = WINDOW && (thr0 + 31 > 128 || thr0 - 63 < -128);
        const int thr = thr0 + r - 4 * h;
        f32x16 sc[2];
#pragma unroll
        for (int kt = 0; kt < 2; ++kt) {
#pragma unroll
            for (int i = 0; i < 16; ++i) sc[kt][i] = 0.f;
#pragma unroll
            for (int kk = 0; kk < 8; ++kk) { const s16x8 kf = *(const LAS s16x8*)(lds + (64 * hf + 32 * kt + r) * ATT_KP + (16 * kk + 8 * h) * 2); sc[kt] = __builtin_amdgcn_mfma_f32_32x32x16_bf16(kf, qf[kk], sc[kt], 0, 0, 0); }
        }
        float mb = -1e30f;
#pragma unroll
        for (int kt = 0; kt < 2; ++kt)
#pragma unroll
            for (int i = 0; i < 16; ++i) {
                if (!WINDOW) sc[kt][i] *= qs;
                if (WINDOW) { if (need_mask && (unsigned)((32 * kt + (i & 3) + 8 * (i >> 2)) - thr + 128) > 256u) sc[kt][i] = -1e30f; }
                mb = fmaxf(mb, sc[kt][i]); }
        mb = fmaxf(mb, __shfl_xor(mb, 32));
        const float mn = fmaxf(m, mb), alpha = __builtin_amdgcn_exp2f((m - mn) * LOG2E), mo = mn * LOG2E;
        m = mn; l *= alpha;
#pragma unroll
        for (int dt = 0; dt < 4; ++dt) o[dt] = o[dt] * alpha;
        float ls = 0.f;
#pragma unroll
        for (int kt = 0; kt < 2; ++kt)
#pragma unroll
            for (int i = 0; i < 16; ++i) { const float p = __builtin_amdgcn_exp2f(sc[kt][i] * LOG2E - mo); sc[kt][i] = p; ls += p; }
        l += ls;
#pragma unroll
        for (int kt = 0; kt < 2; ++kt)
#pragma unroll
            for (int st = 0; st < 2; ++st) {
                v4u pw; pw.x = pg8::cvt_pk_bf16(sc[kt][8 * st + 0], sc[kt][8 * st + 1]); pw.y = pg8::cvt_pk_bf16(sc[kt][8 * st + 2], sc[kt][8 * st + 3]);
                pw.z = pg8::cvt_pk_bf16(sc[kt][8 * st + 4], sc[kt][8 * st + 5]); pw.w = pg8::cvt_pk_bf16(sc[kt][8 * st + 6], sc[kt][8 * st + 7]);
                const s16x8 pf = __builtin_bit_cast(s16x8, pw);
#pragma unroll
                for (int dt = 0; dt < 4; ++dt) { const LAS unsigned char* vp = lds + ATT_V_OFF + (32 * dt + r) * ATT_VP + (64 * hf + 32 * kt + 16 * st + 4 * h) * 2;
                    const s16x4 lo = *(const LAS s16x4*)vp, hi = *(const LAS s16x4*)(vp + 16);
                    const s16x8 vf = __builtin_shufflevector(lo, hi, 0, 1, 2, 3, 4, 5, 6, 7);
                    o[dt] = __builtin_amdgcn_mfma_f32_32x32x16_bf16(vf, pf, o[dt], 0, 0, 0); }
            }
        }
    }
    l += __shfl_xor(l, 32);
    const float inv = 1.0f / l;
    bf16* orow = ow + (size_t)r * opitch + 4 * h;
#pragma unroll
    for (int dt = 0; dt < 4; ++dt)
#pragma unroll
        for (int g = 0; g < 4; ++g) { unsigned long long w = (unsigned long long)pg8::cvt_pk_bf16(o[dt][4 * g] * inv, o[dt][4 * g + 1] * inv) | ((unsigned long long)pg8::cvt_pk_bf16(o[dt][4 * g + 2] * inv, o[dt][4 * g + 3] * inv) << 32);
            *(unsigned long long*)(orow + 32 * dt + 8 * g) = w; }
}

#define RLX_AGENT __ATOMIC_RELAXED, __HIP_MEMORY_SCOPE_AGENT
#define XB_TMO      128
#define XB_XCNT(j)  (256  + 64 * (j))
#define XB_XSUB(j)  (1280 + 64 * (j))
#define XB_XGEN(j)  (2304 + 64 * (j))
#define XB_TOP      3328
#define XB_TOPGEN   3392
#define XCD_BAR_WORDS 3456
#define XB_SPIN_CAP (1u << 18)

__device__ __forceinline__ unsigned xb_ld(unsigned* p)              { return __hip_atomic_load(p, __ATOMIC_RELAXED, __HIP_MEMORY_SCOPE_AGENT); }
__device__ __forceinline__ unsigned xb_add(unsigned* p, unsigned v) { return __hip_atomic_fetch_add(p, v, __ATOMIC_RELAXED, __HIP_MEMORY_SCOPE_AGENT); }
__device__ __forceinline__ unsigned xb_xcc_id() { return (unsigned)__builtin_amdgcn_s_getreg((3 << 11) | 20) & 0xFu; }
#define XB_SPIN(cond, bar) do { unsigned _sp = 0; while (cond) { __builtin_amdgcn_s_sleep(1); \
    if ((++_sp & 255u) == 0u) { if (xb_ld(&(bar)[XB_TMO])) break; if (_sp > XB_SPIN_CAP) { atomicAdd(&(bar)[XB_TMO], 1u); break; } } } } while (0)

struct XcdBarrier {
    unsigned* bar; unsigned x;
    volatile LAS unsigned* st;
};

__device__ __forceinline__ XcdBarrier xcd_barrier_post(unsigned* bar, volatile LAS unsigned* st) {
    XcdBarrier b; b.bar = bar; b.x = xb_xcc_id(); b.st = st;
    if (threadIdx.x == 0) (void)xb_add(&bar[XB_XCNT(b.x)], 1u);
    return b;
}
__device__ __forceinline__ void xcd_barrier_complete(unsigned* bar, unsigned x, unsigned& nloc, unsigned& nx) {
    const unsigned G = gridDim.x * gridDim.y * gridDim.z;
    unsigned sum, cnt, mine, sp = 0u;
    for (;;) {
        sum = 0u; cnt = 0u; mine = 0u;
#pragma unroll
        for (unsigned j = 0; j < 16; ++j) { const unsigned c = xb_ld(&bar[XB_XCNT(j)]); sum += c; cnt += (c > 0u) ? 1u : 0u; mine = (j == x) ? c : mine; }
        if (sum == G) break;
        __builtin_amdgcn_s_sleep(1);
        if ((++sp & 255u) == 0u) { if (xb_ld(&bar[XB_TMO])) break; if (sp > XB_SPIN_CAP) { atomicAdd(&bar[XB_TMO], 1u); break; } }
    }
    nloc = mine > 0u ? mine : 1u; nx = cnt > 0u ? cnt : 1u;
}

__device__ __forceinline__ void xcd_barrier(const XcdBarrier& b) {
    asm volatile("s_waitcnt vmcnt(0)" ::: "memory");
    __syncthreads();
    if (threadIdx.x == 0) {
        unsigned* bar = b.bar;
        __builtin_amdgcn_s_waitcnt(0);
        unsigned nloc = b.st[0], nx = b.st[1];
        if (nloc == 0u) { xcd_barrier_complete(bar, b.x, nloc, nx); b.st[0] = nloc; b.st[1] = nx; }
        const unsigned old = xb_add(&bar[XB_XSUB(b.x)], 1u);
        const unsigned gen = old / nloc;
        if (old + 1u == (gen + 1u) * nloc) {
            __builtin_amdgcn_fence(__ATOMIC_RELEASE, "agent");
            asm volatile("s_waitcnt vmcnt(0)" ::: "memory");
            const unsigned og = xb_add(&bar[XB_TOP], 1u);
            const unsigned tg = og / nx;
            if (og + 1u == (tg + 1u) * nx) xb_add(&bar[XB_TOPGEN], 1u);
            else XB_SPIN(xb_ld(&bar[XB_TOPGEN]) == tg, bar);
            __builtin_amdgcn_fence(__ATOMIC_ACQUIRE, "agent");
            xb_add(&bar[XB_XGEN(b.x)], 1u);
            asm volatile("s_waitcnt vmcnt(0)" ::: "memory");
        } else {
            XB_SPIN(xb_ld(&bar[XB_XGEN(b.x)]) == gen, bar);
            __builtin_amdgcn_fence(__ATOMIC_ACQUIRE, "agent");
            asm volatile("s_waitcnt vmcnt(0)" ::: "memory");
        }
    }
    __syncthreads();
}

struct Args { const float* in[20]; float* out; unsigned char* ws; int ph_lo, ph_hi, li, pad; };

__global__ void __launch_bounds__(NTHR, 2) mk_fwd(Args args) {
    extern __shared__ __attribute__((aligned(16))) unsigned char lds_raw[];
    LAS unsigned char* lds = (LAS unsigned char*)lds_raw;
    const int tid = threadIdx.x, lane = tid & 63, wave = __builtin_amdgcn_readfirstlane(tid >> 6);
    const int G = gridDim.x, bx = blockIdx.x;
    const int gw = bx * NWAVES + wave, NGW = G * NWAVES;
    unsigned char* ws = args.ws;
    const float* x = args.in[0]; const float* mem = args.in[1]; const float* g_mix = args.in[2]; const float* w_in = args.in[3]; const float* sink = args.in[4];
    const float* conv_w = args.in[5]; const float* b_gate = args.in[6]; const float* w_attn_out = args.in[7]; const float* w_conv_out = args.in[8]; const float* w_o = args.in[9];
    const float* g_cross = args.in[10]; const float* g_mem = args.in[11]; const float* w_cq = args.in[12]; const float* w_ckv = args.in[13]; const float* w_co = args.in[14];
    const float* g_ffn = args.in[15]; const float* w_gate = args.in[16]; const float* w_up = args.in[17]; const float* w_down = args.in[18]; const float* g_final = args.in[19];
    float* out = args.out;
    float* ssq2 = (float*)(ws + WS_SSQ); float* ssq3 = ssq2 + M * 8; float* ssq4 = ssq3 + M * 8;
    PG8_LAS float* xch = (PG8_LAS float*)(lds + pg8::STAGE_BYTES);
    float* cosT = (float*)(ws + WS_ROPE); float* sinT = cosT + SEQ * 64;
    bf16* Wt_in = (bf16*)(ws + WS_WIN); bf16* Wt_a = (bf16*)(ws + WS_WA); bf16* Wt_c = (bf16*)(ws + WS_WC); bf16* Wt_o = (bf16*)(ws + WS_WO);
    bf16* Wt_cq = (bf16*)(ws + WS_WCQ); bf16* Wt_ckv = (bf16*)(ws + WS_WCKV); bf16* Wt_co = (bf16*)(ws + WS_WCO); bf16* Wt_gu = (bf16*)(ws + WS_WGU); bf16* Wt_dn = (bf16*)(ws + WS_WDN);
    bf16* MEMN = (bf16*)(ws + WS_MEMN); bf16* MEMKV = (bf16*)(ws + WS_MEMKV);
    bf16* ZA = (bf16*)(ws + WS_ZA); bf16* ZG = (bf16*)(ws + WS_ZG); bf16* AO = (bf16*)(ws + WS_AO); bf16* CV = (bf16*)(ws + WS_CV);
    bf16* MG = (bf16*)(ws + WS_MG); bf16* X1B = (bf16*)(ws + WS_X1B); bf16* X3B = (bf16*)(ws + WS_X3B); bf16* XB = (bf16*)(ws + WS_XB); bf16* WOB = (bf16*)(ws + WS_WOB); bf16* WOQ = (bf16*)(ws + WS_WOQ); float* rs1 = (float*)(ws + WS_RS1); bf16* QC = (bf16*)(ws + WS_QC); bf16* CO = (bf16*)(ws + WS_CO);
    bf16* X2B = (bf16*)(ws + WS_X2B); bf16* ACT = (bf16*)(ws + WS_ACT);
    cg::grid_group grid = cg::this_grid();
    const int lo = args.ph_lo, hi = args.ph_hi;
#define IN(k) (lo <= (k) && (k) < hi)
#define SEAM(k) do { if (IN(k) && IN((k) + 1)) { if (args.ph_hi > 1000) { asm volatile("s_waitcnt vmcnt(0) lgkmcnt(0)" ::: "memory"); __syncthreads(); grid.sync(); } else xcd_barrier(xbar); } } while (0)
    if (tid < 4) ((LAS unsigned*)(lds + pg8::STAGE_BYTES + 8192))[tid] = 0u;
    __syncthreads();
    const XcdBarrier xbar = xcd_barrier_post((unsigned*)(ws + WS_BAR) + args.li * 4096, (volatile LAS unsigned*)(lds + pg8::STAGE_BYTES + 8192));

    if (IN(0)) {
        LAS float* scr = (LAS float*)(lds + wave * 16384);
        constexpr int I_IN = (DM / 64) * (INW / 32), I_A = (1024 / 64) * (DM / 32), I_O = (DM / 64) * (DM / 32), I_CQ = (DM / 64) * (512 / 32), I_CKV = (DM / 64) * (1024 / 32),
                      I_CO = (512 / 64) * (DM / 32), I_G = (DM / 64) * (DFF / 32), I_D = (DFF / 64) * (DM / 32);
        constexpr int NITEMS = I_IN + 2 * I_A + I_O + I_CQ + I_CKV + I_CO;
#define P0_PICK(t, itx) do { int r = (itx); \
            if (r < I_IN) { t = TItem{w_in, Wt_in, g_mix, DM, INW, 3, r}; break; } r -= I_IN; \
            if (r < I_A) { t = TItem{w_attn_out, Wt_a, nullptr, 1024, DM, 0, r}; break; } r -= I_A; \
            if (r < I_A) { t = TItem{w_conv_out, Wt_c, nullptr, 1024, DM, 0, r}; break; } r -= I_A; \
            if (r < I_O) { t = TItem{w_o, Wt_o, nullptr, DM, DM, 0, r}; break; } r -= I_O; \
            if (r < I_CQ) { t = TItem{w_cq, Wt_cq, g_cross, DM, 512, 0, r}; break; } r -= I_CQ; \
            if (r < I_CKV) { t = TItem{w_ckv, Wt_ckv, nullptr, DM, 1024, 0, r}; break; } r -= I_CKV; \
            t = TItem{w_co, Wt_co, nullptr, 512, DM, 0, r}; } while (0)
        for (int it = gw; it < NITEMS; it += 2 * NGW) {
            TItem t0, t1; f32x4 v0[8], v1[8]; const bool two = it + NGW < NITEMS;
            P0_PICK(t0, it); p0_t_load(t0, v0, lane);
            if (two) { P0_PICK(t1, it + NGW); p0_t_load(t1, v1, lane); }
            p0_t_store(t0, v0, scr, lane);
            if (two) p0_t_store(t1, v1, scr, lane);
        }
#undef P0_PICK
        for (int m = gw * 2; m < M; m += NGW * 2) {
            f32x4 va[8], vb[8]; const f32x4* xa = (const f32x4*)(x + (size_t)m * DM) + lane; const f32x4* xb2 = xa + DM / 4;
#pragma unroll
            for (int j = 0; j < 8; ++j) { va[j] = xa[64 * j]; vb[j] = xb2[64 * j]; }
            float sa = 0.f, sb = 0.f;
#pragma unroll
            for (int j = 0; j < 8; ++j) { sa += (va[j].x * va[j].x + va[j].y * va[j].y) + (va[j].z * va[j].z + va[j].w * va[j].w); sb += (vb[j].x * vb[j].x + vb[j].y * vb[j].y) + (vb[j].z * vb[j].z + vb[j].w * vb[j].w); }
            sa = wave_sum(sa); sb = wave_sum(sb);
            if (lane == 0) { rs1[m] = 1.0f / sqrtf(sa * (1.0f / DM) + RMS_EPS); rs1[m + 1] = 1.0f / sqrtf(sb * (1.0f / DM) + RMS_EPS); }
            unsigned long long* oa = (unsigned long long*)(XB + (size_t)m * DM) + lane; unsigned long long* ob = oa + DM / 4;
#pragma unroll
            for (int j = 0; j < 8; ++j) { oa[64 * j] = (unsigned long long)pk2(va[j].x, va[j].y) | ((unsigned long long)pk2(va[j].z, va[j].w) << 32);
                ob[64 * j] = (unsigned long long)pk2(vb[j].x, vb[j].y) | ((unsigned long long)pk2(vb[j].z, vb[j].w) << 32); }
        }
        for (int i = bx * NTHR + tid; i < DM * DM / 8; i += G * NTHR) { const f32x4 a = *(const f32x4*)(w_o + (size_t)i * 8), b = *(const f32x4*)(w_o + (size_t)i * 8 + 4); *(v4u*)(WOB + (size_t)i * 8) = pg8::pack8(a, b); }
        for (int m = gw; m < MROWS; m += NGW) rms_row_to_bf16(mem + (size_t)m * DM, g_mem, MEMN + (size_t)m * DM, lane);
        for (int i = bx * NTHR + tid; i < SEQ * 64; i += G * NTHR) { const int pos = i >> 6, j = i & 63;
            const float inv = exp2f(-(float)j * (13.287712379549449f / 64.0f)); const float ang = (float)pos * inv;
            cosT[i] = cosf(ang); sinT[i] = sinf(ang); }
    }
    SEAM(0);

    if (IN(1)) {
        { pg8::Gemm g{XB, Wt_in, nullptr, nullptr, M, INW, DM}; pg8::StaticOrder S; S.init(M, INW, G, bx);
          pg8::EpiIn E{ZA, ZG, cosT, sinT, b_gate, 0.08838834764831845f, rs1};
          pg8::gemm_phase<pg8::EpiIn, pg8::StaticOrder>(lds, g, S, E); }
        { pg8::Gemm g{MEMN, Wt_ckv, nullptr, nullptr, MROWS, 1024, DM}; pg8::StaticOrder S; S.init(MROWS, 1024, G, (bx + G / 2) % G);
          pg8::EpiBf16 E{MEMKV, 1024};
          pg8::gemm_phase<pg8::EpiBf16, pg8::StaticOrder>(lds, g, S, E); }
        { pg8::Gemm g{Wt_cq, WOB, nullptr, nullptr, 512, DM, DM}; pg8::StaticOrder S; S.init(512, DM, G, (bx + G / 2 - 32 + G) % G);
          pg8::EpiBf16 E{WOQ, DM};
          pg8::gemm_phase<pg8::EpiBf16, pg8::StaticOrder>(lds, g, S, E); }
        if (G == 256 ? bx >= 176 : true) {
            __syncthreads();
            LAS float* scr = (LAS float*)(lds + wave * 16384);
            constexpr int I_G = (DM / 64) * (DFF / 32), I_D = (DFF / 64) * (DM / 32), NF = 2 * I_G + I_D;
            const int fw = (G == 256 ? (bx - 176) : bx) * NWAVES + wave, NFW = (G == 256 ? 80 : G) * NWAVES;
#define P1_PICK(t, itx) do { int r = (itx); \
            if (r < I_G) { t = TItem{w_gate, Wt_gu, g_ffn, DM, DFF, 1, r}; break; } r -= I_G; \
            if (r < I_G) { t = TItem{w_up, Wt_gu, g_ffn, DM, DFF, 2, r}; break; } r -= I_G; \
            t = TItem{w_down, Wt_dn, nullptr, DFF, DM, 0, r}; } while (0)
            for (int it = fw; it < NF; it += 4 * NFW) {
                TItem t0, t1, t2, t3; f32x4 v0[8], v1[8], v2[8], v3[8]; const bool h1 = it + NFW < NF, h2 = it + 2 * NFW < NF, h3 = it + 3 * NFW < NF;
                P1_PICK(t0, it); p0_t_load(t0, v0, lane);
                if (h1) { P1_PICK(t1, it + NFW); p0_t_load(t1, v1, lane); }
                if (h2) { P1_PICK(t2, it + 2 * NFW); p0_t_load(t2, v2, lane); }
                if (h3) { P1_PICK(t3, it + 3 * NFW); p0_t_load(t3, v3, lane); }
                p0_t_store(t0, v0, scr, lane);
                if (h1) p0_t_store(t1, v1, scr, lane);
                if (h2) p0_t_store(t2, v2, scr, lane);
                if (h3) p0_t_store(t3, v3, scr, lane);
            }
#undef P1_PICK
        }
    }
    SEAM(1);

    if (IN(2)) {
        for (int it = 2 * bx; it < 512; it += 2 * G)
            for (int hp = 0; hp < 2; ++hp) { const int kvh = it >> 1 & 1, nb = (it >> 2) & 15, b = it >> 6;
                const int hq = kvh * 4 + hp * 2 + (wave >> 2), t0 = b * SEQ + nb * 128 + (wave & 3) * 32;
                const int kb0 = nb > 0 ? nb - 1 : 0, kb1 = nb < 15 ? nb + 1 : 15; const size_t kt0 = (size_t)b * SEQ + kb0 * 128;
                attn_unit<true>(lds, ZA + (size_t)t0 * ZAW + hq * 128, ZAW, ZA + kt0 * ZAW + 1024 + kvh * 128, ZA + kt0 * ZAW + 1280 + kvh * 128, ZAW, kb1 - kb0 + 1,
                                nb * 128 + (wave & 3) * 32, kb0 * 128, sink[hq], 1.0f, 1.0f, AO + (size_t)t0 * 1024 + hq * 128, 1024, tid, lane); }
        __syncthreads();
        for (int idx = bx * NTHR + tid; idx < (M / 16) * 128; idx += G * NTHR) { const int run = idx >> 7, c8 = (idx & 127) * 8, t0 = run * 16, s0 = t0 & (SEQ - 1);
            const f32x4 w0a = *(const f32x4*)(conv_w + c8), w0b = *(const f32x4*)(conv_w + c8 + 4), w1a = *(const f32x4*)(conv_w + 1024 + c8), w1b = *(const f32x4*)(conv_w + 1024 + c8 + 4),
                        w2a = *(const f32x4*)(conv_w + 2048 + c8), w2b = *(const f32x4*)(conv_w + 2048 + c8 + 4);
            const bf16* zr = ZA + (size_t)t0 * ZAW + c8;
            f32x4 pa = {0.f, 0.f, 0.f, 0.f}, pb = pa, ca, cb, ta, tb;
            if (s0 > 0) { pg8::unpack8(*(const v4u*)(zr - ZAW + 1536), pa, pb); pg8::unpack8(*(const v4u*)(zr - ZAW + 3584), ta, tb); pa = pa * ta; pb = pb * tb; }
            pg8::unpack8(*(const v4u*)(zr + 1536), ca, cb); pg8::unpack8(*(const v4u*)(zr + 3584), ta, tb); ca = ca * ta; cb = cb * tb;
#pragma unroll
            for (int i = 0; i < 16; ++i) { f32x4 na = {0.f, 0.f, 0.f, 0.f}, nbv = na, ga, gb;
                if (i < 15 || s0 + 16 < SEQ) { pg8::unpack8(*(const v4u*)(zr + (size_t)(i + 1) * ZAW + 1536), na, nbv); pg8::unpack8(*(const v4u*)(zr + (size_t)(i + 1) * ZAW + 3584), ta, tb); na = na * ta; nbv = nbv * tb; }
                pg8::unpack8(*(const v4u*)(zr + (size_t)i * ZAW + 2560), ga, gb);
                *(v4u*)(CV + (size_t)(t0 + i) * 1024 + c8) = pg8::pack8(ga * (w0a * pa + w1a * ca + w2a * na), gb * (w0b * pb + w1b * cb + w2b * nbv));
                pa = ca; pb = cb; ca = na; cb = nbv; }
        }
    }
    SEAM(2);

    if (IN(3)) {
        pg8::Gemm g{AO, Wt_a, CV, Wt_c, M, DM, 1024}; pg8::StaticOrder S; S.init(M, DM, G, bx, 2);
        pg8::EpiMerge E{ZG, MG};
        pg8::gemm_phase<pg8::EpiMerge, pg8::StaticOrder>(lds, g, S, E);
    }
    SEAM(3);

    if (IN(4)) {
        { pg8::Gemm g{XB, Wt_cq, MG, WOQ, M, 512, DM}; pg8::ListOrder S{bx, bx < 128 ? 1 : 0, 2, 2};
          pg8::EpiAcc2 E{QC, 512};
          pg8::gemm_phase<pg8::EpiAcc2, pg8::ListOrder>(lds, g, S, E); }
        { pg8::Gemm g{MG, Wt_o, nullptr, nullptr, M, DM, DM}; pg8::ListOrder S{bx < 128 ? bx : 128 + (bx - 128) * 3, bx < 128 ? 1 : 3, 8, 1};
          pg8::EpiResB E{XB, X1B, ssq2, xch};
          pg8::gemm_phase<pg8::EpiResB, pg8::ListOrder>(lds, g, S, E); }
    }
    SEAM(4);

    if (IN(6)) {
        for (int it = bx; it < 256; it += G) { const int rb = it & 7, hh = (it >> 3) & 3, b = it >> 5; const int t0 = b * SEQ + rb * 256 + wave * 32;
            attn_unit<false>(lds, QC + (size_t)t0 * 512 + hh * 128, 512, MEMKV + (size_t)(b * NMEM) * 1024 + hh * 128, MEMKV + (size_t)(b * NMEM) * 1024 + 512 + hh * 128, 1024, 2,
                             0, 0, -1e30f, 0.0f, pg8::row_rs(ssq2, t0 + (lane & 31)) * 0.08838834764831845f, CO + (size_t)t0 * 512 + hh * 128, 512, tid, lane); }
    }
    SEAM(6);

    if (IN(7)) {
        pg8::Gemm g{CO, Wt_co, nullptr, nullptr, M, DM, 512}; pg8::StaticOrder S; S.init(M, DM, G, bx);
        pg8::EpiResB E{X1B, X2B, ssq3, xch};
        pg8::gemm_phase<pg8::EpiResB, pg8::StaticOrder>(lds, g, S, E);
    }
    SEAM(7);

    if (IN(8)) {
        pg8::Gemm g{X2B, Wt_gu, nullptr, nullptr, M, 2 * DFF, DM}; pg8::StaticOrder S; S.init(M, 2 * DFF, G, bx);
        pg8::EpiSwiGLU E{ACT, ssq3};
        pg8::gemm_phase<pg8::EpiSwiGLU, pg8::StaticOrder>(lds, g, S, E);
    }
    SEAM(8);

    if (IN(9)) {
        pg8::Gemm g{ACT, Wt_dn, nullptr, nullptr, M, DM, DFF}; pg8::PanelOrder S{bx};
        pg8::EpiFinal E{X2B, out, g_final, ssq4, (unsigned*)(ws + WS_PCNT), xch};
        pg8::gemm_phase<pg8::EpiFinal, pg8::PanelOrder>(lds, g, S, E);
    }
#if defined(MK_DUMP_OFF)
    if (hi == MK_CUT && MK_CUT < 11) {
        asm volatile("s_waitcnt vmcnt(0) lgkmcnt(0)" ::: "memory"); __syncthreads(); grid.sync();
        const bf16* src = (const bf16*)(ws + (size_t)(MK_DUMP_OFF));
        for (size_t i = (size_t)bx * NTHR + tid; i < (size_t)M * 2048; i += (size_t)G * NTHR) { const size_t r = i >> 11, c = i & 2047; out[i] = __uint_as_float((unsigned)src[r * (MK_DUMP_LD) + (c % (MK_DUMP_W)) + (c / (MK_DUMP_W)) * (size_t)(MK_DUMP_OFF2)] << 16); }
    }
#endif
#undef IN
#undef SEAM
}

extern "C" void kernel_launch(void* const* d_in, const int* in_sizes, int n_in, void* d_out, int out_size, void* d_ws, size_t ws_size, hipStream_t stream) {
    static int grid = 0;
    if (grid == 0) {
        if (n_in != 20 || in_sizes[0] != M * DM || out_size != M * DM || ws_size < WS_END) { fprintf(stderr, "kernel_launch: unexpected shapes / workspace (n_in %d, ws %zu)\n", n_in, ws_size); grid = -1; return; }
        int dev = 0, cus = 0, per_cu = 0;
        if (hipGetDevice(&dev) != hipSuccess || hipDeviceGetAttribute(&cus, hipDeviceAttributeMultiprocessorCount, dev) != hipSuccess) { grid = -1; return; }
        if (hipFuncSetAttribute((const void*)mk_fwd, hipFuncAttributeMaxDynamicSharedMemorySize, LDS_BYTES) != hipSuccess) { fprintf(stderr, "kernel_launch: hipFuncSetAttribute failed\n"); grid = -1; return; }
        if (hipOccupancyMaxActiveBlocksPerMultiprocessor(&per_cu, (const void*)mk_fwd, NTHR, LDS_BYTES) != hipSuccess || per_cu < 1) { fprintf(stderr, "kernel_launch: occupancy query says %d\n", per_cu); (void)hipGetLastError(); grid = -1; return; }
        grid = cus;
    }
    if (grid < 0) return;
    Args a{};
    for (int i = 0; i < 20; ++i) a.in[i] = (const float*)d_in[i];
    a.out = (float*)d_out; a.ws = (unsigned char*)d_ws;
    if (hipMemsetAsync((char*)d_ws + WS_BAR, 0, WS_BAR_BYTES, stream) != hipSuccess) { fprintf(stderr, "kernel_launch: hipMemsetAsync of the barrier words failed\n"); return; }
#if defined(MK_PROBE_DUP)
    { void* kargs[] = {&a}; a.ph_lo = 0; a.ph_hi = MK_PROBE_DUP + 1; hipLaunchCooperativeKernel((const void*)mk_fwd, dim3(grid), dim3(NTHR), kargs, LDS_BYTES, stream);
      a.ph_lo = MK_PROBE_DUP; a.ph_hi = 11; a.li = 1; hipLaunchCooperativeKernel((const void*)mk_fwd, dim3(grid), dim3(NTHR), kargs, LDS_BYTES, stream); }
#elif MK_N_LAUNCHES == 1
    a.ph_lo = 0; a.ph_hi = MK_CUT;
    void* kargs[] = {&a};
    hipError_t e = hipLaunchCooperativeKernel((const void*)mk_fwd, dim3(grid), dim3(NTHR), kargs, LDS_BYTES, stream);
    if (e != hipSuccess) fprintf(stderr, "kernel_launch: cooperative launch failed: %s (grid %d)\n", hipGetErrorString(e), grid);
#else
    for (int p = 0; p < 11; ++p) { a.ph_lo = p; a.ph_hi = p + 1; hipLaunchKernelGGL(mk_fwd, dim3(grid), dim3(NTHR), LDS_BYTES, stream, a); }
#endif
}
```

```cpp
#include <hip/hip_runtime.h>
#include <hip/hip_cooperative_groups.h>
#include <cstdio>
#include <cstdint>
namespace cg = cooperative_groups;

#ifndef MK_CUT
#define MK_CUT 11
#endif
#ifndef MK_N_LAUNCHES
#define MK_N_LAUNCHES 1
#endif

namespace pg8 {
#define PG8_LAS __attribute__((address_space(3)))
typedef unsigned short bf16_t;
typedef short bf16x8 __attribute__((ext_vector_type(8)));
typedef float f32x4 __attribute__((ext_vector_type(4)));
typedef unsigned u32x4 __attribute__((ext_vector_type(4)));
constexpr int BM = 256, BK = 64, HALF = 128, HTB = HALF * BK * 2, STAGE_BYTES = 8 * HTB, NXCD = 8, WGM = 8;

__host__ __device__ __forceinline__ int lds_byte(int r, int c) { const int st = (r >> 4) * 2 + (c >> 5), rr = r & 15, cc = c & 31, ob = rr * 64 + cc * 2; return st * 1024 + (ob ^ (((ob >> 9) & 1) << 5)); }
__host__ __device__ __forceinline__ void stage_rc(int b, int& R, int& C) { const int st = b / 1024, sb = b % 1024, swz = sb ^ (((sb >> 9) & 1) << 5); R = (st >> 1) * 16 + swz / 64; C = (st & 1) * 32 + (swz % 64) / 2; }
__host__ __device__ __forceinline__ int perm32(int rho) { const int n = rho >> 4, i = rho & 15; return 8 * (i >> 2) + 4 * n + (i & 3); }

struct Unit { int pm, pn, seg; };
struct Gemm { const bf16_t* A0; const bf16_t* B0; const bf16_t* A1; const bf16_t* B1; int M, N, K; };

struct StaticOrder {
    int nM, nN, nwg, G, c, nseg;
    __device__ void init(int M, int N, int G_, int c_, int nseg_ = 1) { nM = M / BM; nN = N / BM; nwg = nM * nN; G = G_; c = c_; nseg = nseg_; }
    __device__ bool next(int i, Unit& u) const {
        const int j = (nseg == 2) ? (i >> 1) : i; u.seg = (nseg == 2) ? (i & 1) : 0;
        const long L = (long)j * G + c; if (L >= nwg) return false;
        int wgid = (int)L; { const int q = nwg / NXCD, r = nwg % NXCD, xcd = wgid % NXCD, off = wgid / NXCD; wgid = (xcd < r ? xcd * (q + 1) : r * (q + 1) + (xcd - r) * q) + off; }
        const int nig = WGM * nN, gid = wgid / nig, fm = gid * WGM, gsz = (nM - fm) < WGM ? (nM - fm) : WGM;
        u.pm = fm + ((wgid % nig) % gsz); u.pn = (wgid % nig) / gsz; return true;
    }
};

typedef __bf16 bf16x2_t __attribute__((ext_vector_type(2)));
typedef float f32x2_t __attribute__((ext_vector_type(2)));
struct ListOrder {
    int first, count, nN, nseg;
    __device__ bool next(int i, Unit& u) const { const int j = (nseg == 2) ? (i >> 1) : i; u.seg = (nseg == 2) ? (i & 1) : 0; if (j >= count) return false; const int L = first + j; u.pm = L / nN; u.pn = L % nN; return true; }
};
struct PanelOrder {
    int c;
    __device__ bool next(int i, Unit& u) const { u.seg = 0; if (i >= 2) return false; const int q = c >> 3; u.pm = i * 32 + (c & 7) * 4 + (q >> 3); u.pn = q & 7; return true; }
};
__device__ __forceinline__ unsigned cvt_pk_bf16(float lo, float hi) { const f32x2_t v = {lo, hi}; const bf16x2_t r = __builtin_convertvector(v, bf16x2_t); return __builtin_bit_cast(unsigned, r); }
__device__ __forceinline__ u32x4 pack8(const f32x4 a, const f32x4 b) { u32x4 w; w.x = cvt_pk_bf16(a[0], a[1]); w.y = cvt_pk_bf16(a[2], a[3]); w.z = cvt_pk_bf16(b[0], b[1]); w.w = cvt_pk_bf16(b[2], b[3]); return w; }
__device__ __forceinline__ void unpack8(const u32x4 w, f32x4& a, f32x4& b) {
    a[0] = __uint_as_float(w.x << 16); a[1] = __uint_as_float(w.x & 0xffff0000u); a[2] = __uint_as_float(w.y << 16); a[3] = __uint_as_float(w.y & 0xffff0000u);
    b[0] = __uint_as_float(w.z << 16); b[1] = __uint_as_float(w.z & 0xffff0000u); b[2] = __uint_as_float(w.w << 16); b[3] = __uint_as_float(w.w & 0xffff0000u); }
__device__ __forceinline__ f32x4 sigmoid4(const f32x4 v) { f32x4 o;
#pragma unroll
    for (int i = 0; i < 4; ++i) o[i] = __builtin_amdgcn_rcpf(1.0f + __expf(-v[i]));
    return o; }

typedef f32x4 Acc[2][2][4][2];

struct EpiBf16 {
    static constexpr bool PERM = true, KEEP_ACC = false;
    bf16_t* O; int ldc;
    __device__ __forceinline__ void operator()(Acc& acc, const Unit& u, int wr, int wc, int fr, int fq) const {
        const int row0 = u.pm * BM + wr * 64 + fr, col0 = u.pn * BM + wc * 32 + 8 * fq;
#pragma unroll
        for (int ai = 0; ai < 2; ++ai)
#pragma unroll
            for (int m = 0; m < 4; ++m) { bf16_t* rowp = O + (size_t)(row0 + ai * HALF + m * 16) * ldc + col0;
#pragma unroll
                for (int bj = 0; bj < 2; ++bj) *(u32x4*)(rowp + bj * HALF) = pack8(acc[ai][bj][m][0], acc[ai][bj][m][1]); }
    }
};
struct EpiIn {
    static constexpr bool PERM = true, KEEP_ACC = false;
    bf16_t* ZA; bf16_t* ZG; const float* cosT; const float* sinT; const float* bgate; float qscale; const float* rs1;
    __device__ __forceinline__ void operator()(Acc& acc, const Unit& u, int wr, int wc, int fr, int fq) const {
        const int row0 = u.pm * BM + wr * 64 + fr;
#pragma unroll
        for (int ai = 0; ai < 2; ++ai)
#pragma unroll
            for (int m = 0; m < 4; ++m) { const float rs = rs1[row0 + ai * HALF + m * 16];
#pragma unroll
                for (int bj = 0; bj < 2; ++bj) { acc[ai][bj][m][0] = acc[ai][bj][m][0] * rs; acc[ai][bj][m][1] = acc[ai][bj][m][1] * rs; } }
        if (u.pn < 5) {
            const int p = wc * 32 + 8 * fq, hb = p >> 6, j0 = p & 63, c1 = u.pn * 256 + hb * 128 + j0;
            const float sc = u.pn < 4 ? qscale : 1.0f;
#pragma unroll
            for (int ai = 0; ai < 2; ++ai)
#pragma unroll
                for (int m = 0; m < 4; ++m) { const int row = row0 + ai * HALF + m * 16, pos = row & 2047;
                    const f32x4 ca = *(const f32x4*)(cosT + pos * 64 + j0), cb = *(const f32x4*)(cosT + pos * 64 + j0 + 4);
                    const f32x4 sa = *(const f32x4*)(sinT + pos * 64 + j0), sb = *(const f32x4*)(sinT + pos * 64 + j0 + 4);
                    const f32x4 t1a = acc[ai][0][m][0], t1b = acc[ai][0][m][1], t2a = acc[ai][1][m][0], t2b = acc[ai][1][m][1];
                    const f32x4 o1a = (t1a * ca - t2a * sa) * sc, o1b = (t1b * cb - t2b * sb) * sc, o2a = (t2a * ca + t1a * sa) * sc, o2b = (t2b * cb + t1b * sb) * sc;
                    bf16_t* rp = ZA + (size_t)row * 4608 + c1;
                    *(u32x4*)rp = pack8(o1a, o1b); *(u32x4*)(rp + 64) = pack8(o2a, o2b); }
        } else if (u.pn == 5 || u.pn >= 14 && u.pn < 18) {
            const int col0 = (u.pn == 5 ? 1280 : 2560 + (u.pn - 14) * BM) + wc * 32 + 8 * fq;
#pragma unroll
            for (int ai = 0; ai < 2; ++ai)
#pragma unroll
                for (int m = 0; m < 4; ++m) { bf16_t* rowp = ZA + (size_t)(row0 + ai * HALF + m * 16) * 4608 + col0;
#pragma unroll
                    for (int bj = 0; bj < 2; ++bj) *(u32x4*)(rowp + bj * HALF) = pack8(acc[ai][bj][m][0], acc[ai][bj][m][1]); }
        } else if (u.pn < 14) {
            const int col0 = 1536 + (u.pn - 6) * HALF + wc * 32 + 8 * fq;
#pragma unroll
            for (int ai = 0; ai < 2; ++ai)
#pragma unroll
                for (int m = 0; m < 4; ++m) *(u32x4*)(ZA + (size_t)(row0 + ai * HALF + m * 16) * 4608 + col0) = pack8(acc[ai][0][m][0] * acc[ai][1][m][0], acc[ai][0][m][1] * acc[ai][1][m][1]);
        } else {
            const int ch0 = (u.pn - 18) * HALF + wc * 32 + 8 * fq;
            const f32x4 ba0 = *(const f32x4*)(bgate + ch0), ba1 = *(const f32x4*)(bgate + ch0 + 4), bc0 = *(const f32x4*)(bgate + 2048 + ch0), bc1 = *(const f32x4*)(bgate + 2048 + ch0 + 4);
#pragma unroll
            for (int ai = 0; ai < 2; ++ai)
#pragma unroll
                for (int m = 0; m < 4; ++m) { bf16_t* rowp = ZG + (size_t)(row0 + ai * HALF + m * 16) * 4096 + ch0;
                    const f32x4 a0 = acc[ai][0][m][0] + ba0, a1 = acc[ai][0][m][1] + ba1, c0 = acc[ai][1][m][0] + bc0, c1 = acc[ai][1][m][1] + bc1;
                    f32x4 r0, r1, g0, g1;
#pragma unroll
                    for (int i = 0; i < 4; ++i) { const float ec0 = 1.0f + __expf(-c0[i]), ec1 = 1.0f + __expf(-c1[i]);
                        g0[i] = __builtin_amdgcn_rcpf(ec0); g1[i] = __builtin_amdgcn_rcpf(ec1);
                        r0[i] = ec0 * __builtin_amdgcn_rcpf(1.0f + __expf(-a0[i])); r1[i] = ec1 * __builtin_amdgcn_rcpf(1.0f + __expf(-a1[i])); }
                    *(u32x4*)rowp = pack8(r0, r1); *(u32x4*)(rowp + 2048) = pack8(g0, g1); }
        }
    }
};
struct EpiAcc2 {
    static constexpr bool PERM = true, KEEP_ACC = true;
    bf16_t* O; int ldc;
    __device__ __forceinline__ void operator()(Acc& acc, const Unit& u, int wr, int wc, int fr, int fq) const {
        if (u.seg == 0) return;
        const int row0 = u.pm * BM + wr * 64 + fr, col0 = u.pn * BM + wc * 32 + 8 * fq;
#pragma unroll
        for (int ai = 0; ai < 2; ++ai)
#pragma unroll
            for (int m = 0; m < 4; ++m) { bf16_t* rowp = O + (size_t)(row0 + ai * HALF + m * 16) * ldc + col0;
#pragma unroll
                for (int bj = 0; bj < 2; ++bj) *(u32x4*)(rowp + bj * HALF) = pack8(acc[ai][bj][m][0], acc[ai][bj][m][1]); }
    }
};
struct EpiMerge {
    static constexpr bool PERM = true, KEEP_ACC = true;
    const bf16_t* ZG; bf16_t* O;
    __device__ __forceinline__ void operator()(Acc& acc, const Unit& u, int wr, int wc, int fr, int fq) const {
        const int row0 = u.pm * BM + wr * 64 + fr, col0 = u.pn * BM + wc * 32 + 8 * fq;
#pragma unroll
        for (int ai = 0; ai < 2; ++ai)
#pragma unroll
            for (int m = 0; m < 4; ++m) { const int row = row0 + ai * HALF + m * 16;
#pragma unroll
                for (int bj = 0; bj < 2; ++bj) { const bf16_t* gp = ZG + (size_t)row * 4096 + col0 + bj * HALF;
                    if (u.seg == 0) { f32x4 a0, a1; unpack8(*(const u32x4*)gp, a0, a1); acc[ai][bj][m][0] = acc[ai][bj][m][0] * a0; acc[ai][bj][m][1] = acc[ai][bj][m][1] * a1; }
                    else { f32x4 c0, c1; unpack8(*(const u32x4*)(gp + 2048), c0, c1); *(u32x4*)(O + (size_t)row * 2048 + col0 + bj * HALF) = pack8(acc[ai][bj][m][0] * c0, acc[ai][bj][m][1] * c1); } } }
    }
};
struct EpiRes {
    static constexpr bool PERM = true, KEEP_ACC = false;
    const float* base; float* out; bf16_t* outb; float* part; PG8_LAS float* xch;
    __device__ __forceinline__ void operator()(Acc& acc, const Unit& u, int wr, int wc, int fr, int fq) const {
        const int row0 = u.pm * BM + wr * 64 + fr, col0 = u.pn * BM + wc * 32 + 8 * fq;
#pragma unroll
        for (int ai = 0; ai < 2; ++ai)
#pragma unroll
            for (int m = 0; m < 4; ++m) { const int row = row0 + ai * HALF + m * 16; float ss = 0.f;
#pragma unroll
                for (int bj = 0; bj < 2; ++bj) { const size_t off = (size_t)row * 2048 + col0 + bj * HALF;
                    const f32x4 o0 = *(const f32x4*)(base + off) + acc[ai][bj][m][0], o1 = *(const f32x4*)(base + off + 4) + acc[ai][bj][m][1];
                    *(f32x4*)(out + off) = o0; *(f32x4*)(out + off + 4) = o1;
                    if (outb) *(u32x4*)(outb + off) = pack8(o0, o1);
                    ss += (o0[0] * o0[0] + o0[1] * o0[1]) + (o0[2] * o0[2] + o0[3] * o0[3]) + (o1[0] * o1[0] + o1[1] * o1[1]) + (o1[2] * o1[2] + o1[3] * o1[3]); }
                ss += __shfl_xor(ss, 16); ss += __shfl_xor(ss, 32);
                if (fq == 0) xch[(ai * HALF + wr * 64 + m * 16 + fr) * 4 + wc] = ss; }
        asm volatile("s_waitcnt lgkmcnt(0)" ::: "memory"); __builtin_amdgcn_s_barrier(); asm volatile("" ::: "memory");
        { const int t = threadIdx.x; if (t < 256) { const f32x4 v = *(const PG8_LAS f32x4*)(xch + t * 4); part[(size_t)(u.pm * BM + t) * 8 + u.pn] = (v[0] + v[1]) + (v[2] + v[3]); } }
        asm volatile("s_waitcnt lgkmcnt(0)" ::: "memory"); __builtin_amdgcn_s_barrier(); asm volatile("" ::: "memory");
    }
};
struct EpiResB {
    static constexpr bool PERM = true, KEEP_ACC = false;
    const bf16_t* base; bf16_t* outb; float* part; PG8_LAS float* xch;
    __device__ __forceinline__ void operator()(Acc& acc, const Unit& u, int wr, int wc, int fr, int fq) const {
        const int row0 = u.pm * BM + wr * 64 + fr, col0 = u.pn * BM + wc * 32 + 8 * fq;
#pragma unroll
        for (int ai = 0; ai < 2; ++ai)
#pragma unroll
            for (int m = 0; m < 4; ++m) { const int row = row0 + ai * HALF + m * 16; float ss = 0.f;
#pragma unroll
                for (int bj = 0; bj < 2; ++bj) { const size_t off = (size_t)row * 2048 + col0 + bj * HALF;
                    f32x4 b0, b1; unpack8(*(const u32x4*)(base + off), b0, b1);
                    const f32x4 o0 = b0 + acc[ai][bj][m][0], o1 = b1 + acc[ai][bj][m][1];
                    *(u32x4*)(outb + off) = pack8(o0, o1);
                    ss += (o0[0] * o0[0] + o0[1] * o0[1]) + (o0[2] * o0[2] + o0[3] * o0[3]) + (o1[0] * o1[0] + o1[1] * o1[1]) + (o1[2] * o1[2] + o1[3] * o1[3]); }
                ss += __shfl_xor(ss, 16); ss += __shfl_xor(ss, 32);
                if (fq == 0) xch[(ai * HALF + wr * 64 + m * 16 + fr) * 4 + wc] = ss; }
        asm volatile("s_waitcnt lgkmcnt(0)" ::: "memory"); __builtin_amdgcn_s_barrier(); asm volatile("" ::: "memory");
        { const int t = threadIdx.x; if (t < 256) { const f32x4 v = *(const PG8_LAS f32x4*)(xch + t * 4); part[(size_t)(u.pm * BM + t) * 8 + u.pn] = (v[0] + v[1]) + (v[2] + v[3]); } }
        asm volatile("s_waitcnt lgkmcnt(0)" ::: "memory"); __builtin_amdgcn_s_barrier(); asm volatile("" ::: "memory");
    }
};
struct EpiFinal {
    static constexpr bool PERM = true, KEEP_ACC = false;
    const bf16_t* base; float* out; const float* gfin; float* part; unsigned* cnt; PG8_LAS float* xch;
    __device__ __forceinline__ void operator()(Acc& acc, const Unit& u, int wr, int wc, int fr, int fq) const {
        const int row0 = u.pm * BM + wr * 64 + fr, col0 = u.pn * BM + wc * 32 + 8 * fq;
        const int tid = threadIdx.x, wid = __builtin_amdgcn_readfirstlane(tid >> 6), lane = tid & 63;
        PG8_LAS float* S = xch + 1024; PG8_LAS unsigned* flag = (PG8_LAS unsigned*)(xch + 1024 + 256);
#pragma unroll
        for (int ai = 0; ai < 2; ++ai)
#pragma unroll
            for (int m = 0; m < 4; ++m) { const int row = row0 + ai * HALF + m * 16; float ss = 0.f;
#pragma unroll
                for (int bj = 0; bj < 2; ++bj) { f32x4 b0, b1; unpack8(*(const u32x4*)(base + (size_t)row * 2048 + col0 + bj * HALF), b0, b1);
                    const f32x4 o0 = b0 + acc[ai][bj][m][0], o1 = b1 + acc[ai][bj][m][1]; acc[ai][bj][m][0] = o0; acc[ai][bj][m][1] = o1;
                    ss += (o0[0] * o0[0] + o0[1] * o0[1]) + (o0[2] * o0[2] + o0[3] * o0[3]) + (o1[0] * o1[0] + o1[1] * o1[1]) + (o1[2] * o1[2] + o1[3] * o1[3]); }
                ss += __shfl_xor(ss, 16); ss += __shfl_xor(ss, 32);
                if (fq == 0) xch[(ai * HALF + wr * 64 + m * 16 + fr) * 4 + wc] = ss; }
        asm volatile("s_waitcnt lgkmcnt(0)" ::: "memory"); __builtin_amdgcn_s_barrier(); asm volatile("" ::: "memory");
        if (tid < 256) { const f32x4 v = *(const PG8_LAS f32x4*)(xch + tid * 4);
            __hip_atomic_store(part + (size_t)(u.pm * BM + tid) * 8 + u.pn, (v[0] + v[1]) + (v[2] + v[3]), __ATOMIC_RELAXED, __HIP_MEMORY_SCOPE_AGENT);
            asm volatile("s_waitcnt vmcnt(0)" ::: "memory");
            if (lane == 0) __hip_atomic_fetch_add(cnt + 64 * u.pm, 1u, __ATOMIC_RELAXED, __HIP_MEMORY_SCOPE_AGENT); }
        if (wid == 0) { unsigned dead = 0u, sp = 0u;
            while ((unsigned)__builtin_amdgcn_readfirstlane(__hip_atomic_load(cnt + 64 * u.pm, __ATOMIC_RELAXED, __HIP_MEMORY_SCOPE_AGENT)) < 32u) { __builtin_amdgcn_s_sleep(2); if (++sp > (1u << 20)) { dead = 1u; break; } }
            __builtin_amdgcn_fence(__ATOMIC_ACQUIRE, "agent");
            if (lane == 0) flag[0] = dead; }
        asm volatile("s_waitcnt vmcnt(0) lgkmcnt(0)" ::: "memory"); __builtin_amdgcn_s_barrier(); asm volatile("" ::: "memory");
        if (tid < 256) { const float* p = part + (size_t)(u.pm * BM + tid) * 8; float t = 0.f;
#pragma unroll
            for (int j = 0; j < 8; ++j) t += __hip_atomic_load(p + j, __ATOMIC_RELAXED, __HIP_MEMORY_SCOPE_AGENT);
            S[tid] = (flag[0] != 0u) ? __builtin_nanf("") : __builtin_amdgcn_rsqf(t * (1.0f / 2048.0f) + 1e-6f); }
        asm volatile("s_waitcnt vmcnt(0) lgkmcnt(0)" ::: "memory"); __builtin_amdgcn_s_barrier(); asm volatile("" ::: "memory");
        f32x4 gv[2][2];
#pragma unroll
        for (int bj = 0; bj < 2; ++bj) { gv[bj][0] = *(const f32x4*)(gfin + col0 + bj * HALF); gv[bj][1] = *(const f32x4*)(gfin + col0 + bj * HALF + 4); }
#pragma unroll
        for (int ai = 0; ai < 2; ++ai)
#pragma unroll
            for (int m = 0; m < 4; ++m) { const int rl = ai * HALF + wr * 64 + m * 16 + fr; const float rs = S[rl]; float* orow = out + (size_t)(u.pm * BM + rl) * 2048 + col0;
#pragma unroll
                for (int bj = 0; bj < 2; ++bj) { *(f32x4*)(orow + bj * HALF) = acc[ai][bj][m][0] * rs * gv[bj][0]; *(f32x4*)(orow + bj * HALF + 4) = acc[ai][bj][m][1] * rs * gv[bj][1]; } }
        asm volatile("s_waitcnt lgkmcnt(0)" ::: "memory"); __builtin_amdgcn_s_barrier(); asm volatile("" ::: "memory");
    }
};
__device__ __forceinline__ float row_rs(const float* part, int row) { const f32x4 a = *(const f32x4*)(part + (size_t)row * 8), b = *(const f32x4*)(part + (size_t)row * 8 + 4);
    return __builtin_amdgcn_rsqf((((a[0] + a[1]) + (a[2] + a[3])) + ((b[0] + b[1]) + (b[2] + b[3]))) * (1.0f / 2048.0f) + 1e-6f); }
struct EpiRowScale {
    static constexpr bool PERM = true, KEEP_ACC = false;
    bf16_t* O; int ldc; const float* ssq; float scale;
    __device__ __forceinline__ void operator()(Acc& acc, const Unit& u, int wr, int wc, int fr, int fq) const {
        const int row0 = u.pm * BM + wr * 64 + fr, col0 = u.pn * BM + wc * 32 + 8 * fq;
#pragma unroll
        for (int ai = 0; ai < 2; ++ai)
#pragma unroll
            for (int m = 0; m < 4; ++m) { const int row = row0 + ai * HALF + m * 16; const float rs = row_rs(ssq, row) * scale;
                bf16_t* rowp = O + (size_t)row * ldc + col0;
#pragma unroll
                for (int bj = 0; bj < 2; ++bj) *(u32x4*)(rowp + bj * HALF) = pack8(acc[ai][bj][m][0] * rs, acc[ai][bj][m][1] * rs); }
    }
};
struct EpiSwiGLU {
    static constexpr bool PERM = true, KEEP_ACC = false;
    bf16_t* O; const float* ssq;
    __device__ __forceinline__ void operator()(Acc& acc, const Unit& u, int wr, int wc, int fr, int fq) const {
        const int row0 = u.pm * BM + wr * 64 + fr, col0 = u.pn * HALF + wc * 32 + 8 * fq;
#pragma unroll
        for (int ai = 0; ai < 2; ++ai)
#pragma unroll
            for (int m = 0; m < 4; ++m) { const int row = row0 + ai * HALF + m * 16; const float rs = row_rs(ssq, row);
                const f32x4 g0 = acc[ai][0][m][0] * rs, g1 = acc[ai][0][m][1] * rs, u0 = acc[ai][1][m][0] * rs, u1 = acc[ai][1][m][1] * rs;
                *(u32x4*)(O + (size_t)row * 5632 + col0) = pack8(g0 * sigmoid4(g0) * u0, g1 * sigmoid4(g1) * u1); }
    }
};

template <class Epi, class Sched, bool ALIGN_EPI = true>
__device__ __forceinline__ void gemm_phase(PG8_LAS unsigned char* lds, const Gemm g, const Sched& S, const Epi& E) {
    const int tid = threadIdx.x, wid = __builtin_amdgcn_readfirstlane(tid >> 6), lane = tid & 63, wr = wid >> 2, wc = wid & 3, fr = lane & 15, fq = lane >> 4;
    const int K = g.K, nt = K / BK;
    unsigned voffA[2], voffB[2];
#pragma unroll
    for (int i = 0; i < 2; ++i) { int R, C; stage_rc(tid * 16 + i * 8192, R, C); const int Rb = Epi::PERM ? ((R & ~31) + perm32(R & 31)) : R;
        voffA[i] = (unsigned)(R * K + C) * 2u; voffB[i] = (unsigned)(Rb * K + C) * 2u; }
    const size_t kstep = (size_t)(BK * 2);
    const size_t hstep = (size_t)HALF * K * 2;
    const size_t tstep = 2 * hstep;
    const unsigned ldsw = (unsigned)wid * 1024u;
    const int aoff = lds_byte(wr * 64 + fr, fq * 8), boff = lds_byte(wc * 32 + fr, fq * 8);
#define PG8_SA(b, h) (((b) * 2 + (h)) * HTB)
#define PG8_SB(b, h) ((4 + (b) * 2 + (h)) * HTB)
#define PG8_STAGE(bufoff, gbase, voff) do { _Pragma("unroll") for (int _i = 0; _i < 2; ++_i) \
        __builtin_amdgcn_global_load_lds((const unsigned*)((const char*)(gbase) + (voff)[_i]), (PG8_LAS unsigned*)(lds + (bufoff) + ldsw + _i * 8192), 16, 0, 0); } while (0)
#define PG8_LDA(dst, b, h) do { _Pragma("unroll") for (int m = 0; m < 4; ++m) _Pragma("unroll") for (int k = 0; k < 2; ++k) dst[m][k] = *(const PG8_LAS bf16x8*)(lds + PG8_SA(b, h) + aoff + m * 2048 + k * 1024); } while (0)
#define PG8_LDB(dst, b, h) do { _Pragma("unroll") for (int n = 0; n < 2; ++n) _Pragma("unroll") for (int k = 0; k < 2; ++k) dst[n][k] = *(const PG8_LAS bf16x8*)(lds + PG8_SB(b, h) + boff + n * 2048 + k * 1024); } while (0)
#define PG8_MMA(ai, bj, At, Bt) do { __builtin_amdgcn_s_setprio(1); _Pragma("unroll") for (int m = 0; m < 4; ++m) _Pragma("unroll") for (int n = 0; n < 2; ++n) _Pragma("unroll") for (int k = 0; k < 2; ++k) \
        acc[ai][bj][m][n] = __builtin_amdgcn_mfma_f32_16x16x32_bf16(Bt[n][k], At[m][k], acc[ai][bj][m][n], 0, 0, 0); __builtin_amdgcn_s_setprio(0); } while (0)
#define PG8_WAIT_V(n) asm volatile("s_waitcnt vmcnt(" #n ")" ::: "memory")
#define PG8_WAIT_L(n) asm volatile("s_waitcnt lgkmcnt(" #n ")" ::: "memory")
#define PG8_BAR __builtin_amdgcn_s_barrier()
#define PG8_SCHED __builtin_amdgcn_sched_barrier(0)
#define PG8_UA(u) ((const char*)((u).seg ? g.A1 : g.A0) + (size_t)(u).pm * tstep)
#define PG8_UB(u) ((const char*)((u).seg ? g.B1 : g.B0) + (size_t)(u).pn * tstep)
    Unit cur, nxt; int ui = 0;
    if (!S.next(0, cur)) return;
    Acc acc;
#pragma unroll
    for (int a = 0; a < 2; ++a)
#pragma unroll
        for (int b = 0; b < 2; ++b)
#pragma unroll
            for (int m = 0; m < 4; ++m)
#pragma unroll
                for (int n = 0; n < 2; ++n) acc[a][b][m][n] = (f32x4){0.f, 0.f, 0.f, 0.f};
    bf16x8 At[4][2], B0[2][2], B1[2][2];
    const char* cA = PG8_UA(cur); const char* cB = PG8_UB(cur);
    PG8_STAGE(PG8_SB(0, 0), cB, voffB); PG8_STAGE(PG8_SB(0, 1), cB + hstep, voffB); PG8_STAGE(PG8_SA(0, 0), cA, voffA); PG8_STAGE(PG8_SA(0, 1), cA + hstep, voffA);
    if (wr == 1) PG8_BAR;
    PG8_WAIT_V(2); PG8_BAR;
    PG8_STAGE(PG8_SB(1, 0), cB + kstep, voffB); PG8_STAGE(PG8_SA(1, 0), cA + kstep, voffA); PG8_STAGE(PG8_SB(1, 1), cB + hstep + kstep, voffB);
    PG8_WAIT_V(6); PG8_BAR;
    for (;;) {
        const bool has_next = S.next(ui + 1, nxt);
        const char* nA = has_next ? PG8_UA(nxt) : cA; const char* nB = has_next ? PG8_UB(nxt) : cB;
        for (int t = 0; t < nt; t += 2) {
            const bool last = (t == nt - 2);
            const char* a1 = cA + (size_t)(t + 1) * kstep;
            const char* a2 = last ? nA : cA + (size_t)(t + 2) * kstep; const char* b2 = last ? nB : cB + (size_t)(t + 2) * kstep;
            const char* a3 = a2 + kstep; const char* b3 = b2 + kstep;
            PG8_LDB(B0, 0, 0); PG8_LDB(B1, 0, 1); PG8_SCHED; PG8_LDA(At, 0, 0); PG8_STAGE(PG8_SA(1, 1), a1 + hstep, voffA);
            PG8_WAIT_V(8); PG8_WAIT_L(0); PG8_BAR; PG8_MMA(0, 0, At, B0); PG8_MMA(0, 1, At, B1); PG8_BAR; PG8_SCHED;
            PG8_LDA(At, 0, 1); PG8_STAGE(PG8_SB(0, 0), b2, voffB); PG8_STAGE(PG8_SB(0, 1), b2 + hstep, voffB); PG8_STAGE(PG8_SA(0, 0), a2, voffA);
            PG8_WAIT_V(8); PG8_WAIT_L(0); PG8_BAR; PG8_MMA(1, 0, At, B0); PG8_MMA(1, 1, At, B1); PG8_BAR; PG8_SCHED;
            PG8_LDB(B0, 1, 0); PG8_LDB(B1, 1, 1); PG8_SCHED; PG8_LDA(At, 1, 0); PG8_STAGE(PG8_SA(0, 1), a2 + hstep, voffA);
            PG8_WAIT_V(8); PG8_WAIT_L(0); PG8_BAR; PG8_MMA(0, 0, At, B0); PG8_MMA(0, 1, At, B1); PG8_BAR; PG8_SCHED;
            PG8_LDA(At, 1, 1); PG8_STAGE(PG8_SB(1, 0), b3, voffB); PG8_STAGE(PG8_SB(1, 1), b3 + hstep, voffB); PG8_STAGE(PG8_SA(1, 0), a3, voffA);
            PG8_WAIT_V(8); PG8_WAIT_L(0); PG8_BAR; PG8_MMA(1, 0, At, B0); PG8_MMA(1, 1, At, B1); PG8_BAR; PG8_SCHED;
        }
        if constexpr (ALIGN_EPI) { if (wr == 0) PG8_BAR; }
        E(acc, cur, wr, wc, fr, fq);
        if (!has_next) break;
        if (!(Epi::KEEP_ACC && cur.seg == 0)) {
#pragma unroll
        for (int a = 0; a < 2; ++a)
#pragma unroll
            for (int b = 0; b < 2; ++b)
#pragma unroll
                for (int m = 0; m < 4; ++m)
#pragma unroll
                    for (int n = 0; n < 2; ++n) acc[a][b][m][n] = (f32x4){0.f, 0.f, 0.f, 0.f};
        }
        cur = nxt; cA = nA; cB = nB; ++ui;
        if constexpr (ALIGN_EPI) { if (wr == 1) PG8_BAR; }
    }
    PG8_WAIT_V(0);
    if constexpr (!ALIGN_EPI) { if (wr == 0) PG8_BAR; }
    PG8_BAR;
#undef PG8_SA
#undef PG8_SB
#undef PG8_STAGE
#undef PG8_LDA
#undef PG8_LDB
#undef PG8_MMA
#undef PG8_WAIT_V
#undef PG8_WAIT_L
#undef PG8_BAR
#undef PG8_SCHED
#undef PG8_UA
#undef PG8_UB
}
}

constexpr int NWAVES = 8, NTHR = NWAVES * 64;
constexpr int DM = 2048, BATCH = 8, SEQ = 2048, M = BATCH * SEQ;
constexpr int INW = 8704, ZAW = 4608, ZGW = 4096;
constexpr int NMEM = 256, MROWS = BATCH * NMEM;
constexpr int DFF = 5632;
constexpr float RMS_EPS = 1e-6f;

constexpr size_t MiB = 1u << 20;
constexpr size_t WS_BAR = 256 * 1024, WS_BAR_BYTES = 128 * 1024, WS_PCNT = WS_BAR + 64 * 1024;
constexpr size_t WS_RS1 = 0;
constexpr size_t WS_SSQ = 506 * MiB;
constexpr size_t WS_ROPE = 1 * MiB;
constexpr size_t WS_WIN = 2 * MiB;
constexpr size_t WS_WA = 36 * MiB;
constexpr size_t WS_WC = 40 * MiB;
constexpr size_t WS_WO = 44 * MiB;
constexpr size_t WS_WCQ = 52 * MiB;
constexpr size_t WS_WCKV = 54 * MiB;
constexpr size_t WS_WCO = 58 * MiB;
constexpr size_t WS_WGU = 60 * MiB;
constexpr size_t WS_WDN = 104 * MiB;
constexpr size_t WS_MEMN = 126 * MiB;
constexpr size_t WS_MEMKV = 134 * MiB;
constexpr size_t WS_ZA = 138 * MiB;
constexpr size_t WS_ZG = 282 * MiB;
constexpr size_t WS_AO = 2 * MiB;
constexpr size_t WS_CV = 410 * MiB;
constexpr size_t WS_WOB = 410 * MiB;
constexpr size_t WS_XB = 442 * MiB;
constexpr size_t WS_WOQ = 508 * MiB;
constexpr size_t WS_END = 510 * MiB;
constexpr size_t WS_MG = WS_ZA;
constexpr size_t WS_X1B = WS_ZG + 32 * MiB;
constexpr size_t WS_X3B = WS_XB;
constexpr size_t WS_QC = WS_ZG;
constexpr size_t WS_CO = WS_ZG + 16 * MiB;
constexpr size_t WS_X2B = WS_ZA;
constexpr size_t WS_ACT = WS_ZA + 64 * MiB;
static_assert(WS_ACT + (size_t)M * DFF * 2 <= WS_CV, "ACT overlay");

constexpr int LDS_BYTES = 147456;

#define GAS __attribute__((address_space(1)))
#define LAS __attribute__((address_space(3)))
typedef unsigned short bf16;
typedef unsigned v4u __attribute__((ext_vector_type(4)));
typedef float f32x4 __attribute__((ext_vector_type(4)));
#define LDS_WAIT() asm volatile("s_waitcnt lgkmcnt(0)" ::: "memory")
__device__ __forceinline__ unsigned f2bf(float f) { unsigned u = __builtin_bit_cast(unsigned, f); return (u + 0x7fffu + ((u >> 16) & 1u)) >> 16; }
__device__ __forceinline__ unsigned pk2(float lo, float hi) { return f2bf(lo) | (f2bf(hi) << 16); }
__device__ __forceinline__ float bflo(unsigned w) { return __uint_as_float(w << 16); }
__device__ __forceinline__ float bfhi(unsigned w) { return __uint_as_float(w & 0xffff0000u); }
__device__ __forceinline__ float wave_sum(float v) {
#pragma unroll
    for (int o = 1; o < 64; o <<= 1) v += __shfl_xor(v, o);
    return v;
}
__device__ __forceinline__ float wave_max(float v) {
#pragma unroll
    for (int o = 1; o < 64; o <<= 1) v = fmaxf(v, __shfl_xor(v, o));
    return v;
}

__device__ __forceinline__ int dest_row(int n0, int mode) {
    if (mode == 1) return (n0 >> 7) * 256 + (n0 & 127);
    if (mode == 2) return (n0 >> 7) * 256 + 128 + (n0 & 127);
    if (mode == 3 && n0 < 1280) return (n0 >> 8) * 256 + ((n0 >> 6) & 1) * 128 + ((n0 >> 7) & 1) * 64 + (n0 & 63);
    if (mode == 3 && n0 >= 1536 && n0 < 2560) { const int ch = n0 - 1536; return 1536 + (ch >> 7) * 256 + (ch & 127); }
    if (mode == 3 && n0 >= 3584 && n0 < 4608) { const int ch = n0 - 3584; return 1536 + (ch >> 7) * 256 + 128 + (ch & 127); }
    if (mode == 3 && n0 >= 2560 && n0 < 3584) return n0 + 1024;
    if (mode == 3 && n0 >= 4608) { const int g = n0 - 4608, br = g >> 11, ch = g & 2047; return 4608 + (ch >> 7) * 256 + br * 128 + (ch & 127); }
    return n0;
}
struct TItem { const float* W; bf16* WT; const float* gk; int K, N, mode, item; };
__device__ __forceinline__ void p0_t_load(const TItem& t, f32x4 (&v)[8], int lane) {
    const int nblk = t.N / 32, kb = t.item / nblk, nb = t.item % nblk, k0 = 64 * kb, n0 = 32 * nb, kr2 = lane >> 3, nq = lane & 7;
#pragma unroll
    for (int i = 0; i < 4; ++i) { const float* p = t.W + (size_t)(k0 + 16 * i + 2 * kr2) * t.N + n0 + 4 * nq; v[2 * i] = *(const f32x4*)p; v[2 * i + 1] = *(const f32x4*)(p + t.N); }
}
__device__ __forceinline__ void p0_t_store(const TItem& t, const f32x4 (&v)[8], LAS float* scrf, int lane) {
    LAS unsigned* scr = (LAS unsigned*)scrf;
    const int nblk = t.N / 32, kb = t.item / nblk, nb = t.item % nblk, k0 = 64 * kb, n0 = 32 * nb, kr2 = lane >> 3, nq = lane & 7;
#pragma unroll
    for (int i = 0; i < 4; ++i) { float g0 = 1.0f, g1 = 1.0f; if (t.gk) { g0 = t.gk[k0 + 16 * i + 2 * kr2]; g1 = t.gk[k0 + 16 * i + 2 * kr2 + 1]; }
        LAS unsigned* p = scr + (4 * nq) * 36 + 8 * i + kr2;
        p[0 * 36] = pk2(v[2 * i].x * g0, v[2 * i + 1].x * g1); p[1 * 36] = pk2(v[2 * i].y * g0, v[2 * i + 1].y * g1);
        p[2 * 36] = pk2(v[2 * i].z * g0, v[2 * i + 1].z * g1); p[3 * 36] = pk2(v[2 * i].w * g0, v[2 * i + 1].w * g1); }
    LDS_WAIT(); asm volatile("" ::: "memory");
    const int c = lane & 7, r0 = dest_row(n0, t.mode);
#pragma unroll
    for (int j = 0; j < 4; ++j) { const int n = (lane >> 3) + 8 * j; *(v4u*)(t.WT + (size_t)(r0 + n) * t.K + k0 + 8 * c) = *(const LAS v4u*)(scr + n * 36 + 4 * c); }
    LDS_WAIT(); asm volatile("" ::: "memory");
}
__device__ __forceinline__ void row_to_bf16_rs(const float* xrow, bf16* orow, float* rs_out, int lane) {
    const f32x4* xr = (const f32x4*)xrow + lane;
    f32x4 v[8]; float s = 0.f;
#pragma unroll
    for (int j = 0; j < 8; ++j) { v[j] = xr[64 * j]; s += (v[j].x * v[j].x + v[j].y * v[j].y) + (v[j].z * v[j].z + v[j].w * v[j].w); }
    const float rs = 1.0f / sqrtf(wave_sum(s) * (1.0f / DM) + RMS_EPS);
    if (lane == 0) *rs_out = rs;
    unsigned long long* o8 = (unsigned long long*)orow + lane;
#pragma unroll
    for (int j = 0; j < 8; ++j) o8[64 * j] = (unsigned long long)pk2(v[j].x, v[j].y) | ((unsigned long long)pk2(v[j].z, v[j].w) << 32);
}
__device__ __forceinline__ void rms_row_to_bf16(const float* xrow, const float* g, bf16* orow, int lane) {
    const f32x4* xr = (const f32x4*)xrow + lane; const f32x4* gr = (const f32x4*)g + lane;
    f32x4 v[8]; float s = 0.f;
#pragma unroll
    for (int j = 0; j < 8; ++j) { v[j] = xr[64 * j]; s += (v[j].x * v[j].x + v[j].y * v[j].y) + (v[j].z * v[j].z + v[j].w * v[j].w); }
    const float rs = 1.0f / sqrtf(wave_sum(s) * (1.0f / DM) + RMS_EPS);
    unsigned long long* o8 = (unsigned long long*)orow + lane;
#pragma unroll
    for (int j = 0; j < 8; ++j) { const f32x4 gg = gr[64 * j];
        o8[64 * j] = (unsigned long long)pk2(v[j].x * rs * gg.x, v[j].y * rs * gg.y) | ((unsigned long long)pk2(v[j].z * rs * gg.z, v[j].w * rs * gg.w) << 32); }
}

typedef float f32x16 __attribute__((ext_vector_type(16)));
typedef short s16x8 __attribute__((ext_vector_type(8)));
typedef short s16x4 __attribute__((ext_vector_type(4)));
constexpr int ATT_KP = 272, ATT_VP = 264, ATT_V_OFF = 128 * ATT_KP, ATT_LDS = ATT_V_OFF + 128 * ATT_VP;
constexpr float LOG2E = 1.4426950408889634f;
template <bool WINDOW>
__device__ __forceinline__ void attn_unit(LAS unsigned char* lds, const bf16* qw, int qpitch, const bf16* kg, const bf16* vg, int kvpitch, int nblk,
                                          int qpos, int kpos, float m_init, float l_init, float qs, bf16* ow, int opitch, int tid, int lane) {
    const int r = lane & 31, h = lane >> 5;
    s16x8 qf[8];
#pragma unroll
    for (int kk = 0; kk < 8; ++kk) qf[kk] = *(const s16x8*)(qw + (size_t)r * qpitch + 16 * kk + 8 * h);
    f32x16 o[4];
#pragma unroll
    for (int dt = 0; dt < 4; ++dt)
#pragma unroll
        for (int i = 0; i < 16; ++i) o[dt][i] = 0.f;
    float m = m_init, l = (h == 0) ? l_init : 0.f;
    const int kkey = tid >> 4, kc = tid & 15, vkey = tid & 127, vcg = tid >> 7;
    for (int blk = 0; blk < nblk; ++blk) {
        v4u kreg[4], vreg[4];
#pragma unroll
        for (int it = 0; it < 4; ++it) { kreg[it] = *(const v4u*)(kg + (size_t)(blk * 128 + kkey + 32 * it) * kvpitch + kc * 8); vreg[it] = *(const v4u*)(vg + (size_t)(blk * 128 + vkey) * kvpitch + (vcg * 4 + it) * 8); }
        __syncthreads();
#pragma unroll
        for (int it = 0; it < 4; ++it) { *(LAS v4u*)(lds + (kkey + 32 * it) * ATT_KP + kc * 16) = kreg[it];
            LAS unsigned short* vt = (LAS unsigned short*)(lds + ATT_V_OFF) + (size_t)((vcg * 4 + it) * 8) * (ATT_VP / 2) + vkey;
            const v4u w = vreg[it];
            vt[0 * (ATT_VP / 2)] = (unsigned short)(w.x & 0xffffu); vt[1 * (ATT_VP / 2)] = (unsigned short)(w.x >> 16); vt[2 * (ATT_VP / 2)] = (unsigned short)(w.y & 0xffffu); vt[3 * (ATT_VP / 2)] = (unsigned short)(w.y >> 16);
            vt[4 * (ATT_VP / 2)] = (unsigned short)(w.z & 0xffffu); vt[5 * (ATT_VP / 2)] = (unsigned short)(w.z >> 16); vt[6 * (ATT_VP / 2)] = (unsigned short)(w.w & 0xffffu); vt[7 * (ATT_VP / 2)] = (unsigned short)(w.w >> 16); }
        __syncthreads();
#pragma unroll 1
        for (int hf = 0; hf < 2; ++hf) {
        const int thr0 = WINDOW ? (qpos - (kpos + blk * 128 + 64 * hf)) : 0;
        if (WINDOW && (thr0 - 63 > 128 || thr0 + 31 < -128)) continue;
        const bool need_mask = WINDOW && (thr0 + 31 > 128 || thr0 - 63 < -128);
        const int thr = thr0 + r - 4 * h;
        f32x16 sc[2];
#pragma unroll
        for (int kt = 0; kt < 2; ++kt) {
#pragma unroll
            for (int i = 0; i < 16; ++i) sc[kt][i] = 0.f;
#pragma unroll
            for (int kk = 0; kk < 8; ++kk) { const s16x8 kf = *(const LAS s16x8*)(lds + (64 * hf + 32 * kt + r) * ATT_KP + (16 * kk + 8 * h) * 2); sc[kt] = __builtin_amdgcn_mfma_f32_32x32x16_bf16(kf, qf[kk], sc[kt], 0, 0, 0); }
        }
        float mb = -1e30f;
#pragma unroll
        for (int kt = 0; kt < 2; ++kt)
#pragma unroll
            for (int i = 0; i < 16; ++i) {
                if (!WINDOW) sc[kt][i] *= qs;
                if (WINDOW) { if (need_mask && (unsigned)((32 * kt + (i & 3) + 8 * (i >> 2)) - thr + 128) > 256u) sc[kt][i] = -1e30f; }
                mb = fmaxf(mb, sc[kt][i]); }
        mb = fmaxf(mb, __shfl_xor(mb, 32));
        const float mn = fmaxf(m, mb), alpha = __builtin_amdgcn_exp2f((m - mn) * LOG2E), mo = mn * LOG2E;
        m = mn; l *= alpha;
#pragma unroll
        for (int dt = 0; dt < 4; ++dt) o[dt] = o[dt] * alpha;
        float ls = 0.f;
#pragma unroll
        for (int kt = 0; kt < 2; ++kt)
#pragma unroll
            for (int i = 0; i < 16; ++i) { const float p = __builtin_amdgcn_exp2f(sc[kt][i] * LOG2E - mo); sc[kt][i] = p; ls += p; }
        l += ls;
#pragma unroll
        for (int kt = 0; kt < 2; ++kt)
#pragma unroll
            for (int st = 0; st < 2; ++st) {
                v4u pw; pw.x = pg8::cvt_pk_bf16(sc[kt][8 * st + 0], sc[kt][8 * st + 1]); pw.y = pg8::cvt_pk_bf16(sc[kt][8 * st + 2], sc[kt][8 * st + 3]);
                pw.z = pg8::cvt_pk_bf16(sc[kt][8 * st + 4], sc[kt][8 * st + 5]); pw.w = pg8::cvt_pk_bf16(sc[kt][8 * st + 6], sc[kt][8 * st + 7]);
                const s16x8 pf = __builtin_bit_cast(s16x8, pw);
#pragma unroll
                for (int dt = 0; dt < 4; ++dt) { const LAS unsigned char* vp = lds + ATT_V_OFF + (32 * dt + r) * ATT_VP + (64 * hf + 32 * kt + 16 * st + 4 * h) * 2;
                    const s16x4 lo = *(const LAS s16x4*)vp, hi = *(const LAS s16x4*)(vp + 16);
                    const s16x8 vf = __builtin_shufflevector(lo, hi, 0, 1, 2, 3, 4, 5, 6, 7);
                    o[dt] = __builtin_amdgcn_mfma_f32_32x32x16_bf16(vf, pf, o[dt], 0, 0, 0); }
            }
        }
    }
    l += __shfl_xor(l, 32);
    const float inv = 1.0f / l;
    bf16* orow = ow + (size_t)r * opitch + 4 * h;
#pragma unroll
    for (int dt = 0; dt < 4; ++dt)
#pragma unroll
        for (int g = 0; g < 4; ++g) { unsigned long long w = (unsigned long long)pg8::cvt_pk_bf16(o[dt][4 * g] * inv, o[dt][4 * g + 1] * inv) | ((unsigned long long)pg8::cvt_pk_bf16(o[dt][4 * g + 2] * inv, o[dt][4 * g + 3] * inv) << 32);
            *(unsigned long long*)(orow + 32 * dt + 8 * g) = w; }
}

#define RLX_AGENT __ATOMIC_RELAXED, __HIP_MEMORY_SCOPE_AGENT
#define XB_TMO      128
#define XB_XCNT(j)  (256  + 64 * (j))
#define XB_XSUB(j)  (1280 + 64 * (j))
#define XB_XGEN(j)  (2304 + 64 * (j))
#define XB_TOP      3328
#define XB_TOPGEN   3392
#define XCD_BAR_WORDS 3456
#define XB_SPIN_CAP (1u << 18)

__device__ __forceinline__ unsigned xb_ld(unsigned* p)              { return __hip_atomic_load(p, __ATOMIC_RELAXED, __HIP_MEMORY_SCOPE_AGENT); }
__device__ __forceinline__ unsigned xb_add(unsigned* p, unsigned v) { return __hip_atomic_fetch_add(p, v, __ATOMIC_RELAXED, __HIP_MEMORY_SCOPE_AGENT); }
__device__ __forceinline__ unsigned xb_xcc_id() { return (unsigned)__builtin_amdgcn_s_getreg((3 << 11) | 20) & 0xFu; }
#define XB_SPIN(cond, bar) do { unsigned _sp = 0; while (cond) { __builtin_amdgcn_s_sleep(1); \
    if ((++_sp & 255u) == 0u) { if (xb_ld(&(bar)[XB_TMO])) break; if (_sp > XB_SPIN_CAP) { atomicAdd(&(bar)[XB_TMO], 1u); break; } } } } while (0)

struct XcdBarrier {
    unsigned* bar; unsigned x;
    volatile LAS unsigned* st;
};

__device__ __forceinline__ XcdBarrier xcd_barrier_post(unsigned* bar, volatile LAS unsigned* st) {
    XcdBarrier b; b.bar = bar; b.x = xb_xcc_id(); b.st = st;
    if (threadIdx.x == 0) (void)xb_add(&bar[XB_XCNT(b.x)], 1u);
    return b;
}
__device__ __forceinline__ void xcd_barrier_complete(unsigned* bar, unsigned x, unsigned& nloc, unsigned& nx) {
    const unsigned G = gridDim.x * gridDim.y * gridDim.z;
    unsigned sum, cnt, mine, sp = 0u;
    for (;;) {
        sum = 0u; cnt = 0u; mine = 0u;
#pragma unroll
        for (unsigned j = 0; j < 16; ++j) { const unsigned c = xb_ld(&bar[XB_XCNT(j)]); sum += c; cnt += (c > 0u) ? 1u : 0u; mine = (j == x) ? c : mine; }
        if (sum == G) break;
        __builtin_amdgcn_s_sleep(1);
        if ((++sp & 255u) == 0u) { if (xb_ld(&bar[XB_TMO])) break; if (sp > XB_SPIN_CAP) { atomicAdd(&bar[XB_TMO], 1u); break; } }
    }
    nloc = mine > 0u ? mine : 1u; nx = cnt > 0u ? cnt : 1u;
}

__device__ __forceinline__ void xcd_barrier(const XcdBarrier& b) {
    asm volatile("s_waitcnt vmcnt(0)" ::: "memory");
    __syncthreads();
    if (threadIdx.x == 0) {
        unsigned* bar = b.bar;
        __builtin_amdgcn_s_waitcnt(0);
        unsigned nloc = b.st[0], nx = b.st[1];
        if (nloc == 0u) { xcd_barrier_complete(bar, b.x, nloc, nx); b.st[0] = nloc; b.st[1] = nx; }
        const unsigned old = xb_add(&bar[XB_XSUB(b.x)], 1u);
        const unsigned gen = old / nloc;
        if (old + 1u == (gen + 1u) * nloc) {
            __builtin_amdgcn_fence(__ATOMIC_RELEASE, "agent");
            asm volatile("s_waitcnt vmcnt(0)" ::: "memory");
            const unsigned og = xb_add(&bar[XB_TOP], 1u);
            const unsigned tg = og / nx;
            if (og + 1u == (tg + 1u) * nx) xb_add(&bar[XB_TOPGEN], 1u);
            else XB_SPIN(xb_ld(&bar[XB_TOPGEN]) == tg, bar);
            __builtin_amdgcn_fence(__ATOMIC_ACQUIRE, "agent");
            xb_add(&bar[XB_XGEN(b.x)], 1u);
            asm volatile("s_waitcnt vmcnt(0)" ::: "memory");
        } else {
            XB_SPIN(xb_ld(&bar[XB_XGEN(b.x)]) == gen, bar);
            __builtin_amdgcn_fence(__ATOMIC_ACQUIRE, "agent");
            asm volatile("s_waitcnt vmcnt(0)" ::: "memory");
        }
    }
    __syncthreads();
}

struct Args { const float* in[20]; float* out; unsigned char* ws; int ph_lo, ph_hi, li, pad; };

__global__ void __launch_bounds__(NTHR, 2) mk_fwd(Args args) {
    extern __shared__ __attribute__((aligned(16))) unsigned char lds_raw[];
    LAS unsigned char* lds = (LAS unsigned char*)lds_raw;
    const int tid = threadIdx.x, lane = tid & 63, wave = __builtin_amdgcn_readfirstlane(tid >> 6);
    const int G = gridDim.x, bx = blockIdx.x;
    const int gw = bx * NWAVES + wave, NGW = G * NWAVES;
    unsigned char* ws = args.ws;
    const float* x = args.in[0]; const float* mem = args.in[1]; const float* g_mix = args.in[2]; const float* w_in = args.in[3]; const float* sink = args.in[4];
    const float* conv_w = args.in[5]; const float* b_gate = args.in[6]; const float* w_attn_out = args.in[7]; const float* w_conv_out = args.in[8]; const float* w_o = args.in[9];
    const float* g_cross = args.in[10]; const float* g_mem = args.in[11]; const float* w_cq = args.in[12]; const float* w_ckv = args.in[13]; const float* w_co = args.in[14];
    const float* g_ffn = args.in[15]; const float* w_gate = args.in[16]; const float* w_up = args.in[17]; const float* w_down = args.in[18]; const float* g_final = args.in[19];
    float* out = args.out;
    float* ssq2 = (float*)(ws + WS_SSQ); float* ssq3 = ssq2 + M * 8; float* ssq4 = ssq3 + M * 8;
    PG8_LAS float* xch = (PG8_LAS float*)(lds + pg8::STAGE_BYTES);
    float* cosT = (float*)(ws + WS_ROPE); float* sinT = cosT + SEQ * 64;
    bf16* Wt_in = (bf16*)(ws + WS_WIN); bf16* Wt_a = (bf16*)(ws + WS_WA); bf16* Wt_c = (bf16*)(ws + WS_WC); bf16* Wt_o = (bf16*)(ws + WS_WO);
    bf16* Wt_cq = (bf16*)(ws + WS_WCQ); bf16* Wt_ckv = (bf16*)(ws + WS_WCKV); bf16* Wt_co = (bf16*)(ws + WS_WCO); bf16* Wt_gu = (bf16*)(ws + WS_WGU); bf16* Wt_dn = (bf16*)(ws + WS_WDN);
    bf16* MEMN = (bf16*)(ws + WS_MEMN); bf16* MEMKV = (bf16*)(ws + WS_MEMKV);
    bf16* ZA = (bf16*)(ws + WS_ZA); bf16* ZG = (bf16*)(ws + WS_ZG); bf16* AO = (bf16*)(ws + WS_AO); bf16* CV = (bf16*)(ws + WS_CV);
    bf16* MG = (bf16*)(ws + WS_MG); bf16* X1B = (bf16*)(ws + WS_X1B); bf16* X3B = (bf16*)(ws + WS_X3B); bf16* XB = (bf16*)(ws + WS_XB); bf16* WOB = (bf16*)(ws + WS_WOB); bf16* WOQ = (bf16*)(ws + WS_WOQ); float* rs1 = (float*)(ws + WS_RS1); bf16* QC = (bf16*)(ws + WS_QC); bf16* CO = (bf16*)(ws + WS_CO);
    bf16* X2B = (bf16*)(ws + WS_X2B); bf16* ACT = (bf16*)(ws + WS_ACT);
    cg::grid_group grid = cg::this_grid();
    const int lo = args.ph_lo, hi = args.ph_hi;
#define IN(k) (lo <= (k) && (k) < hi)
#define SEAM(k) do { if (IN(k) && IN((k) + 1)) { if (args.ph_hi > 1000) { asm volatile("s_waitcnt vmcnt(0) lgkmcnt(0)" ::: "memory"); __syncthreads(); grid.sync(); } else xcd_barrier(xbar); } } while (0)
    if (tid < 4) ((LAS unsigned*)(lds + pg8::STAGE_BYTES + 8192))[tid] = 0u;
    __syncthreads();
    const XcdBarrier xbar = xcd_barrier_post((unsigned*)(ws + WS_BAR) + args.li * 4096, (volatile LAS unsigned*)(lds + pg8::STAGE_BYTES + 8192));

    if (IN(0)) {
        LAS float* scr = (LAS float*)(lds + wave * 16384);
        constexpr int I_IN = (DM / 64) * (INW / 32), I_A = (1024 / 64) * (DM / 32), I_O = (DM / 64) * (DM / 32), I_CQ = (DM / 64) * (512 / 32), I_CKV = (DM / 64) * (1024 / 32),
                      I_CO = (512 / 64) * (DM / 32), I_G = (DM / 64) * (DFF / 32), I_D = (DFF / 64) * (DM / 32);
        constexpr int NITEMS = I_IN + 2 * I_A + I_O + I_CQ + I_CKV + I_CO;
#define P0_PICK(t, itx) do { int r = (itx); \
            if (r < I_IN) { t = TItem{w_in, Wt_in, g_mix, DM, INW, 3, r}; break; } r -= I_IN; \
            if (r < I_A) { t = TItem{w_attn_out, Wt_a, nullptr, 1024, DM, 0, r}; break; } r -= I_A; \
            if (r < I_A) { t = TItem{w_conv_out, Wt_c, nullptr, 1024, DM, 0, r}; break; } r -= I_A; \
            if (r < I_O) { t = TItem{w_o, Wt_o, nullptr, DM, DM, 0, r}; break; } r -= I_O; \
            if (r < I_CQ) { t = TItem{w_cq, Wt_cq, g_cross, DM, 512, 0, r}; break; } r -= I_CQ; \
            if (r < I_CKV) { t = TItem{w_ckv, Wt_ckv, nullptr, DM, 1024, 0, r}; break; } r -= I_CKV; \
            t = TItem{w_co, Wt_co, nullptr, 512, DM, 0, r}; } while (0)
        for (int it = gw; it < NITEMS; it += 2 * NGW) {
            TItem t0, t1; f32x4 v0[8], v1[8]; const bool two = it + NGW < NITEMS;
            P0_PICK(t0, it); p0_t_load(t0, v0, lane);
            if (two) { P0_PICK(t1, it + NGW); p0_t_load(t1, v1, lane); }
            p0_t_store(t0, v0, scr, lane);
            if (two) p0_t_store(t1, v1, scr, lane);
        }
#undef P0_PICK
        for (int m = gw * 2; m < M; m += NGW * 2) {
            f32x4 va[8], vb[8]; const f32x4* xa = (const f32x4*)(x + (size_t)m * DM) + lane; const f32x4* xb2 = xa + DM / 4;
#pragma unroll
            for (int j = 0; j < 8; ++j) { va[j] = xa[64 * j]; vb[j] = xb2[64 * j]; }
            float sa = 0.f, sb = 0.f;
#pragma unroll
            for (int j = 0; j < 8; ++j) { sa += (va[j].x * va[j].x + va[j].y * va[j].y) + (va[j].z * va[j].z + va[j].w * va[j].w); sb += (vb[j].x * vb[j].x + vb[j].y * vb[j].y) + (vb[j].z * vb[j].z + vb[j].w * vb[j].w); }
            sa = wave_sum(sa); sb = wave_sum(sb);
            if (lane == 0) { rs1[m] = 1.0f / sqrtf(sa * (1.0f / DM) + RMS_EPS); rs1[m + 1] = 1.0f / sqrtf(sb * (1.0f / DM) + RMS_EPS); }
            unsigned long long* oa = (unsigned long long*)(XB + (size_t)m * DM) + lane; unsigned long long* ob = oa + DM / 4;
#pragma unroll
            for (int j = 0; j < 8; ++j) { oa[64 * j] = (unsigned long long)pk2(va[j].x, va[j].y) | ((unsigned long long)pk2(va[j].z, va[j].w) << 32);
                ob[64 * j] = (unsigned long long)pk2(vb[j].x, vb[j].y) | ((unsigned long long)pk2(vb[j].z, vb[j].w) << 32); }
        }
        for (int i = bx * NTHR + tid; i < DM * DM / 8; i += G * NTHR) { const f32x4 a = *(const f32x4*)(w_o + (size_t)i * 8), b = *(const f32x4*)(w_o + (size_t)i * 8 + 4); *(v4u*)(WOB + (size_t)i * 8) = pg8::pack8(a, b); }
        for (int m = gw; m < MROWS; m += NGW) rms_row_to_bf16(mem + (size_t)m * DM, g_mem, MEMN + (size_t)m * DM, lane);
        for (int i = bx * NTHR + tid; i < SEQ * 64; i += G * NTHR) { const int pos = i >> 6, j = i & 63;
            const float inv = exp2f(-(float)j * (13.287712379549449f / 64.0f)); const float ang = (float)pos * inv;
            cosT[i] = cosf(ang); sinT[i] = sinf(ang); }
    }
    SEAM(0);

    if (IN(1)) {
        { pg8::Gemm g{XB, Wt_in, nullptr, nullptr, M, INW, DM}; pg8::StaticOrder S; S.init(M, INW, G, bx);
          pg8::EpiIn E{ZA, ZG, cosT, sinT, b_gate, 0.08838834764831845f, rs1};
          pg8::gemm_phase<pg8::EpiIn, pg8::StaticOrder>(lds, g, S, E); }
        { pg8::Gemm g{MEMN, Wt_ckv, nullptr, nullptr, MROWS, 1024, DM}; pg8::StaticOrder S; S.init(MROWS, 1024, G, (bx + G / 2) % G);
          pg8::EpiBf16 E{MEMKV, 1024};
          pg8::gemm_phase<pg8::EpiBf16, pg8::StaticOrder>(lds, g, S, E); }
        { pg8::Gemm g{Wt_cq, WOB, nullptr, nullptr, 512, DM, DM}; pg8::StaticOrder S; S.init(512, DM, G, (bx + G / 2 - 32 + G) % G);
          pg8::EpiBf16 E{WOQ, DM};
          pg8::gemm_phase<pg8::EpiBf16, pg8::StaticOrder>(lds, g, S, E); }
        if (G == 256 ? bx >= 176 : true) {
            __syncthreads();
            LAS float* scr = (LAS float*)(lds + wave * 16384);
            constexpr int I_G = (DM / 64) * (DFF / 32), I_D = (DFF / 64) * (DM / 32), NF = 2 * I_G + I_D;
            const int fw = (G == 256 ? (bx - 176) : bx) * NWAVES + wave, NFW = (G == 256 ? 80 : G) * NWAVES;
#define P1_PICK(t, itx) do { int r = (itx); \
            if (r < I_G) { t = TItem{w_gate, Wt_gu, g_ffn, DM, DFF, 1, r}; break; } r -= I_G; \
            if (r < I_G) { t = TItem{w_up, Wt_gu, g_ffn, DM, DFF, 2, r}; break; } r -= I_G; \
            t = TItem{w_down, Wt_dn, nullptr, DFF, DM, 0, r}; } while (0)
            for (int it = fw; it < NF; it += 4 * NFW) {
                TItem t0, t1, t2, t3; f32x4 v0[8], v1[8], v2[8], v3[8]; const bool h1 = it + NFW < NF, h2 = it + 2 * NFW < NF, h3 = it + 3 * NFW < NF;
                P1_PICK(t0, it); p0_t_load(t0, v0, lane);
                if (h1) { P1_PICK(t1, it + NFW); p0_t_load(t1, v1, lane); }
                if (h2) { P1_PICK(t2, it + 2 * NFW); p0_t_load(t2, v2, lane); }
                if (h3) { P1_PICK(t3, it + 3 * NFW); p0_t_load(t3, v3, lane); }
                p0_t_store(t0, v0, scr, lane);
                if (h1) p0_t_store(t1, v1, scr, lane);
                if (h2) p0_t_store(t2, v2, scr, lane);
                if (h3) p0_t_store(t3, v3, scr, lane);
            }
#undef P1_PICK
        }
    }
    SEAM(1);

    if (IN(2)) {
        for (int it = 2 * bx; it < 512; it += 2 * G)
            for (int hp = 0; hp < 2; ++hp) { const int kvh = it >> 1 & 1, nb = (it >> 2) & 15, b = it >> 6;
                const int hq = kvh * 4 + hp * 2 + (wave >> 2), t0 = b * SEQ + nb * 128 + (wave & 3) * 32;
                const int kb0 = nb > 0 ? nb - 1 : 0, kb1 = nb < 15 ? nb + 1 : 15; const size_t kt0 = (size_t)b * SEQ + kb0 * 128;
                attn_unit<true>(lds, ZA + (size_t)t0 * ZAW + hq * 128, ZAW, ZA + kt0 * ZAW + 1024 + kvh * 128, ZA + kt0 * ZAW + 1280 + kvh * 128, ZAW, kb1 - kb0 + 1,
                                nb * 128 + (wave & 3) * 32, kb0 * 128, sink[hq], 1.0f, 1.0f, AO + (size_t)t0 * 1024 + hq * 128, 1024, tid, lane); }
        __syncthreads();
        for (int idx = bx * NTHR + tid; idx < (M / 16) * 128; idx += G * NTHR) { const int run = idx >> 7, c8 = (idx & 127) * 8, t0 = run * 16, s0 = t0 & (SEQ - 1);
            const f32x4 w0a = *(const f32x4*)(conv_w + c8), w0b = *(const f32x4*)(conv_w + c8 + 4), w1a = *(const f32x4*)(conv_w + 1024 + c8), w1b = *(const f32x4*)(conv_w + 1024 + c8 + 4),
                        w2a = *(const f32x4*)(conv_w + 2048 + c8), w2b = *(const f32x4*)(conv_w + 2048 + c8 + 4);
            const bf16* zr = ZA + (size_t)t0 * ZAW + c8;
            f32x4 pa = {0.f, 0.f, 0.f, 0.f}, pb = pa, ca, cb;
            if (s0 > 0) pg8::unpack8(*(const v4u*)(zr - ZAW + 1536), pa, pb);
            pg8::unpack8(*(const v4u*)(zr + 1536), ca, cb);
#pragma unroll
            for (int i = 0; i < 16; ++i) { f32x4 na = {0.f, 0.f, 0.f, 0.f}, nbv = na, ga, gb;
                if (i < 15 || s0 + 16 < SEQ) pg8::unpack8(*(const v4u*)(zr + (size_t)(i + 1) * ZAW + 1536), na, nbv);
                pg8::unpack8(*(const v4u*)(zr + (size_t)i * ZAW + 2560), ga, gb);
                *(v4u*)(CV + (size_t)(t0 + i) * 1024 + c8) = pg8::pack8(ga * (w0a * pa + w1a * ca + w2a * na), gb * (w0b * pb + w1b * cb + w2b * nbv));
                pa = ca; pb = cb; ca = na; cb = nbv; }
        }
    }
    SEAM(2);

    if (IN(3)) {
        pg8::Gemm g{AO, Wt_a, CV, Wt_c, M, DM, 1024}; pg8::StaticOrder S; S.init(M, DM, G, bx, 2);
        pg8::EpiMerge E{ZG, MG};
        pg8::gemm_phase<pg8::EpiMerge, pg8::StaticOrder>(lds, g, S, E);
    }
    SEAM(3);

    if (IN(4)) {
        { pg8::Gemm g{XB, Wt_cq, MG, WOQ, M, 512, DM}; pg8::ListOrder S{bx, bx < 128 ? 1 : 0, 2, 2};
          pg8::EpiAcc2 E{QC, 512};
          pg8::gemm_phase<pg8::EpiAcc2, pg8::ListOrder>(lds, g, S, E); }
        { pg8::Gemm g{MG, Wt_o, nullptr, nullptr, M, DM, DM}; pg8::ListOrder S{bx < 128 ? bx : 128 + (bx - 128) * 3, bx < 128 ? 1 : 3, 8, 1};
          pg8::EpiResB E{XB, X1B, ssq2, xch};
          pg8::gemm_phase<pg8::EpiResB, pg8::ListOrder>(lds, g, S, E); }
    }
    SEAM(4);

    if (IN(6)) {
        for (int it = bx; it < 256; it += G) { const int rb = it & 7, hh = (it >> 3) & 3, b = it >> 5; const int t0 = b * SEQ + rb * 256 + wave * 32;
            attn_unit<false>(lds, QC + (size_t)t0 * 512 + hh * 128, 512, MEMKV + (size_t)(b * NMEM) * 1024 + hh * 128, MEMKV + (size_t)(b * NMEM) * 1024 + 512 + hh * 128, 1024, 2,
                             0, 0, -1e30f, 0.0f, pg8::row_rs(ssq2, t0 + (lane & 31)) * 0.08838834764831845f, CO + (size_t)t0 * 512 + hh * 128, 512, tid, lane); }
    }
    SEAM(6);

    if (IN(7)) {
        pg8::Gemm g{CO, Wt_co, nullptr, nullptr, M, DM, 512}; pg8::StaticOrder S; S.init(M, DM, G, bx);
        pg8::EpiResB E{X1B, X2B, ssq3, xch};
        pg8::gemm_phase<pg8::EpiResB, pg8::StaticOrder>(lds, g, S, E);
    }
    SEAM(7);

    if (IN(8)) {
        pg8::Gemm g{X2B, Wt_gu, nullptr, nullptr, M, 2 * DFF, DM}; pg8::StaticOrder S; S.init(M, 2 * DFF, G, bx);
        pg8::EpiSwiGLU E{ACT, ssq3};
        pg8::gemm_phase<pg8::EpiSwiGLU, pg8::StaticOrder>(lds, g, S, E);
    }
    SEAM(8);

    if (IN(9)) {
        pg8::Gemm g{ACT, Wt_dn, nullptr, nullptr, M, DM, DFF}; pg8::PanelOrder S{bx};
        pg8::EpiFinal E{X2B, out, g_final, ssq4, (unsigned*)(ws + WS_PCNT), xch};
        pg8::gemm_phase<pg8::EpiFinal, pg8::PanelOrder>(lds, g, S, E);
    }
#if defined(MK_DUMP_OFF)
    if (hi == MK_CUT && MK_CUT < 11) {
        asm volatile("s_waitcnt vmcnt(0) lgkmcnt(0)" ::: "memory"); __syncthreads(); grid.sync();
        const bf16* src = (const bf16*)(ws + (size_t)(MK_DUMP_OFF));
        for (size_t i = (size_t)bx * NTHR + tid; i < (size_t)M * 2048; i += (size_t)G * NTHR) { const size_t r = i >> 11, c = i & 2047; out[i] = __uint_as_float((unsigned)src[r * (MK_DUMP_LD) + (c % (MK_DUMP_W)) + (c / (MK_DUMP_W)) * (size_t)(MK_DUMP_OFF2)] << 16); }
    }
#endif
#undef IN
#undef SEAM
}

extern "C" void kernel_launch(void* const* d_in, const int* in_sizes, int n_in, void* d_out, int out_size, void* d_ws, size_t ws_size, hipStream_t stream) {
    static int grid = 0;
    if (grid == 0) {
        if (n_in != 20 || in_sizes[0] != M * DM || out_size != M * DM || ws_size < WS_END) { fprintf(stderr, "kernel_launch: unexpected shapes / workspace (n_in %d, ws %zu)\n", n_in, ws_size); grid = -1; return; }
        int dev = 0, cus = 0, per_cu = 0;
        if (hipGetDevice(&dev) != hipSuccess || hipDeviceGetAttribute(&cus, hipDeviceAttributeMultiprocessorCount, dev) != hipSuccess) { grid = -1; return; }
        if (hipFuncSetAttribute((const void*)mk_fwd, hipFuncAttributeMaxDynamicSharedMemorySize, LDS_BYTES) != hipSuccess) { fprintf(stderr, "kernel_launch: hipFuncSetAttribute failed\n"); grid = -1; return; }
        if (hipOccupancyMaxActiveBlocksPerMultiprocessor(&per_cu, (const void*)mk_fwd, NTHR, LDS_BYTES) != hipSuccess || per_cu < 1) { fprintf(stderr, "kernel_launch: occupancy query says %d\n", per_cu); (void)hipGetLastError(); grid = -1; return; }
        grid = cus;
    }
    if (grid < 0) return;
    Args a{};
    for (int i = 0; i < 20; ++i) a.in[i] = (const float*)d_in[i];
    a.out = (float*)d_out; a.ws = (unsigned char*)d_ws;
    if (hipMemsetAsync((char*)d_ws + WS_BAR, 0, WS_BAR_BYTES, stream) != hipSuccess) { fprintf(stderr, "kernel_launch: hipMemsetAsync of the barrier words failed\n"); return; }
#if defined(MK_PROBE_DUP)
    { void* kargs[] = {&a}; a.ph_lo = 0; a.ph_hi = MK_PROBE_DUP + 1; hipLaunchCooperativeKernel((const void*)mk_fwd, dim3(grid), dim3(NTHR), kargs, LDS_BYTES, stream);
      a.ph_lo = MK_PROBE_DUP; a.ph_hi = 11; a.li = 1; hipLaunchCooperativeKernel((const void*)mk_fwd, dim3(grid), dim3(NTHR), kargs, LDS_BYTES, stream); }
#elif MK_N_LAUNCHES == 1
    a.ph_lo = 0; a.ph_hi = MK_CUT;
    void* kargs[] = {&a};
    hipError_t e = hipLaunchCooperativeKernel((const void*)mk_fwd, dim3(grid), dim3(NTHR), kargs, LDS_BYTES, stream);
    if (e != hipSuccess) fprintf(stderr, "kernel_launch: cooperative launch failed: %s (grid %d)\n", hipGetErrorString(e), grid);
#else
    for (int p = 0; p < 11; ++p) { a.ph_lo = p; a.ph_hi = p + 1; hipLaunchKernelGGL(mk_fwd, dim3(grid), dim3(NTHR), LDS_BYTES, stream, a); }
#endif
}
```

```cpp
#include <hip/hip_runtime.h>
#include <hip/hip_cooperative_groups.h>
#include <cstdio>
#include <cstdint>
namespace cg = cooperative_groups;

#ifndef MK_CUT
#define MK_CUT 11
#endif
#ifndef MK_N_LAUNCHES
#define MK_N_LAUNCHES 1
#endif

namespace pg8 {
#define PG8_LAS __attribute__((address_space(3)))
typedef unsigned short bf16_t;
typedef short bf16x8 __attribute__((ext_vector_type(8)));
typedef float f32x4 __attribute__((ext_vector_type(4)));
typedef unsigned u32x4 __attribute__((ext_vector_type(4)));
constexpr int BM = 256, BK = 64, HALF = 128, HTB = HALF * BK * 2, STAGE_BYTES = 8 * HTB, NXCD = 8, WGM = 8;

__host__ __device__ __forceinline__ int lds_byte(int r, int c) { const int st = (r >> 4) * 2 + (c >> 5), rr = r & 15, cc = c & 31, ob = rr * 64 + cc * 2; return st * 1024 + (ob ^ (((ob >> 9) & 1) << 5)); }
__host__ __device__ __forceinline__ void stage_rc(int b, int& R, int& C) { const int st = b / 1024, sb = b % 1024, swz = sb ^ (((sb >> 9) & 1) << 5); R = (st >> 1) * 16 + swz / 64; C = (st & 1) * 32 + (swz % 64) / 2; }
__host__ __device__ __forceinline__ int perm32(int rho) { const int n = rho >> 4, i = rho & 15; return 8 * (i >> 2) + 4 * n + (i & 3); }

struct Unit { int pm, pn, seg; };
struct Gemm { const bf16_t* A0; const bf16_t* B0; const bf16_t* A1; const bf16_t* B1; int M, N, K; };

struct StaticOrder {
    int nM, nN, nwg, G, c, nseg;
    __device__ void init(int M, int N, int G_, int c_, int nseg_ = 1) { nM = M / BM; nN = N / BM; nwg = nM * nN; G = G_; c = c_; nseg = nseg_; }
    __device__ bool next(int i, Unit& u) const {
        const int j = (nseg == 2) ? (i >> 1) : i; u.seg = (nseg == 2) ? (i & 1) : 0;
        const long L = (long)j * G + c; if (L >= nwg) return false;
        int wgid = (int)L; { const int q = nwg / NXCD, r = nwg % NXCD, xcd = wgid % NXCD, off = wgid / NXCD; wgid = (xcd < r ? xcd * (q + 1) : r * (q + 1) + (xcd - r) * q) + off; }
        const int nig = WGM * nN, gid = wgid / nig, fm = gid * WGM, gsz = (nM - fm) < WGM ? (nM - fm) : WGM;
        u.pm = fm + ((wgid % nig) % gsz); u.pn = (wgid % nig) / gsz; return true;
    }
};

typedef __bf16 bf16x2_t __attribute__((ext_vector_type(2)));
typedef float f32x2_t __attribute__((ext_vector_type(2)));
struct ListOrder {
    int first, count, nN, nseg;
    __device__ bool next(int i, Unit& u) const { const int j = (nseg == 2) ? (i >> 1) : i; u.seg = (nseg == 2) ? (i & 1) : 0; if (j >= count) return false; const int L = first + j; u.pm = L / nN; u.pn = L % nN; return true; }
};
struct PanelOrder {
    int c;
    __device__ bool next(int i, Unit& u) const { u.seg = 0; if (i >= 2) return false; const int q = c >> 3; u.pm = i * 32 + (c & 7) * 4 + (q >> 3); u.pn = q & 7; return true; }
};
__device__ __forceinline__ unsigned cvt_pk_bf16(float lo, float hi) { const f32x2_t v = {lo, hi}; const bf16x2_t r = __builtin_convertvector(v, bf16x2_t); return __builtin_bit_cast(unsigned, r); }
__device__ __forceinline__ u32x4 pack8(const f32x4 a, const f32x4 b) { u32x4 w; w.x = cvt_pk_bf16(a[0], a[1]); w.y = cvt_pk_bf16(a[2], a[3]); w.z = cvt_pk_bf16(b[0], b[1]); w.w = cvt_pk_bf16(b[2], b[3]); return w; }
__device__ __forceinline__ void unpack8(const u32x4 w, f32x4& a, f32x4& b) {
    a[0] = __uint_as_float(w.x << 16); a[1] = __uint_as_float(w.x & 0xffff0000u); a[2] = __uint_as_float(w.y << 16); a[3] = __uint_as_float(w.y & 0xffff0000u);
    b[0] = __uint_as_float(w.z << 16); b[1] = __uint_as_float(w.z & 0xffff0000u); b[2] = __uint_as_float(w.w << 16); b[3] = __uint_as_float(w.w & 0xffff0000u); }
__device__ __forceinline__ f32x4 sigmoid4(const f32x4 v) { f32x4 o;
#pragma unroll
    for (int i = 0; i < 4; ++i) o[i] = __builtin_amdgcn_rcpf(1.0f + __expf(-v[i]));
    return o; }

typedef f32x4 Acc[2][2][4][2];

struct EpiBf16 {
    static constexpr bool PERM = true, KEEP_ACC = false;
    bf16_t* O; int ldc;
    __device__ __forceinline__ void operator()(Acc& acc, const Unit& u, int wr, int wc, int fr, int fq) const {
        const int row0 = u.pm * BM + wr * 64 + fr, col0 = u.pn * BM + wc * 32 + 8 * fq;
#pragma unroll
        for (int ai = 0; ai < 2; ++ai)
#pragma unroll
            for (int m = 0; m < 4; ++m) { bf16_t* rowp = O + (size_t)(row0 + ai * HALF + m * 16) * ldc + col0;
#pragma unroll
                for (int bj = 0; bj < 2; ++bj) *(u32x4*)(rowp + bj * HALF) = pack8(acc[ai][bj][m][0], acc[ai][bj][m][1]); }
    }
};
struct EpiIn {
    static constexpr bool PERM = true, KEEP_ACC = false;
    bf16_t* ZA; bf16_t* ZG; const float* cosT; const float* sinT; const float* bgate; float qscale; const float* rs1;
    __device__ __forceinline__ void operator()(Acc& acc, const Unit& u, int wr, int wc, int fr, int fq) const {
        const int row0 = u.pm * BM + wr * 64 + fr;
#pragma unroll
        for (int ai = 0; ai < 2; ++ai)
#pragma unroll
            for (int m = 0; m < 4; ++m) { const float rs = rs1[row0 + ai * HALF + m * 16];
#pragma unroll
                for (int bj = 0; bj < 2; ++bj) { acc[ai][bj][m][0] = acc[ai][bj][m][0] * rs; acc[ai][bj][m][1] = acc[ai][bj][m][1] * rs; } }
        if (u.pn < 5) {
            const int p = wc * 32 + 8 * fq, hb = p >> 6, j0 = p & 63, c1 = u.pn * 256 + hb * 128 + j0;
            const float sc = u.pn < 4 ? qscale : 1.0f;
#pragma unroll
            for (int ai = 0; ai < 2; ++ai)
#pragma unroll
                for (int m = 0; m < 4; ++m) { const int row = row0 + ai * HALF + m * 16, pos = row & 2047;
                    const f32x4 ca = *(const f32x4*)(cosT + pos * 64 + j0), cb = *(const f32x4*)(cosT + pos * 64 + j0 + 4);
                    const f32x4 sa = *(const f32x4*)(sinT + pos * 64 + j0), sb = *(const f32x4*)(sinT + pos * 64 + j0 + 4);
                    const f32x4 t1a = acc[ai][0][m][0], t1b = acc[ai][0][m][1], t2a = acc[ai][1][m][0], t2b = acc[ai][1][m][1];
                    const f32x4 o1a = (t1a * ca - t2a * sa) * sc, o1b = (t1b * cb - t2b * sb) * sc, o2a = (t2a * ca + t1a * sa) * sc, o2b = (t2b * cb + t1b * sb) * sc;
                    bf16_t* rp = ZA + (size_t)row * 4608 + c1;
                    *(u32x4*)rp = pack8(o1a, o1b); *(u32x4*)(rp + 64) = pack8(o2a, o2b); }
        } else if (u.pn == 5 || u.pn >= 14 && u.pn < 18) {
            const int col0 = (u.pn == 5 ? 1280 : 2560 + (u.pn - 14) * BM) + wc * 32 + 8 * fq;
#pragma unroll
            for (int ai = 0; ai < 2; ++ai)
#pragma unroll
                for (int m = 0; m < 4; ++m) { bf16_t* rowp = ZA + (size_t)(row0 + ai * HALF + m * 16) * 4608 + col0;
#pragma unroll
                    for (int bj = 0; bj < 2; ++bj) *(u32x4*)(rowp + bj * HALF) = pack8(acc[ai][bj][m][0], acc[ai][bj][m][1]); }
        } else if (u.pn < 14) {
            const int col0 = 1536 + (u.pn - 6) * HALF + wc * 32 + 8 * fq;
#pragma unroll
            for (int ai = 0; ai < 2; ++ai)
#pragma unroll
                for (int m = 0; m < 4; ++m) *(u32x4*)(ZA + (size_t)(row0 + ai * HALF + m * 16) * 4608 + col0) = pack8(acc[ai][0][m][0] * acc[ai][1][m][0], acc[ai][0][m][1] * acc[ai][1][m][1]);
        } else {
            const int ch0 = (u.pn - 18) * HALF + wc * 32 + 8 * fq;
            const f32x4 ba0 = *(const f32x4*)(bgate + ch0), ba1 = *(const f32x4*)(bgate + ch0 + 4), bc0 = *(const f32x4*)(bgate + 2048 + ch0), bc1 = *(const f32x4*)(bgate + 2048 + ch0 + 4);
#pragma unroll
            for (int ai = 0; ai < 2; ++ai)
#pragma unroll
                for (int m = 0; m < 4; ++m) { bf16_t* rowp = ZG + (size_t)(row0 + ai * HALF + m * 16) * 4096 + ch0;
                    const f32x4 a0 = acc[ai][0][m][0] + ba0, a1 = acc[ai][0][m][1] + ba1, c0 = acc[ai][1][m][0] + bc0, c1 = acc[ai][1][m][1] + bc1;
                    f32x4 r0, r1, g0, g1;
#pragma unroll
                    for (int i = 0; i < 4; ++i) { const float ec0 = 1.0f + __expf(-c0[i]), ec1 = 1.0f + __expf(-c1[i]);
                        g0[i] = __builtin_amdgcn_rcpf(ec0); g1[i] = __builtin_amdgcn_rcpf(ec1);
                        r0[i] = ec0 * __builtin_amdgcn_rcpf(1.0f + __expf(-a0[i])); r1[i] = ec1 * __builtin_amdgcn_rcpf(1.0f + __expf(-a1[i])); }
                    *(u32x4*)rowp = pack8(r0, r1); *(u32x4*)(rowp + 2048) = pack8(g0, g1); }
        }
    }
};
struct EpiAcc2 {
    static constexpr bool PERM = true, KEEP_ACC = true;
    bf16_t* O; int ldc;
    __device__ __forceinline__ void operator()(Acc& acc, const Unit& u, int wr, int wc, int fr, int fq) const {
        if (u.seg == 0) return;
        const int row0 = u.pm * BM + wr * 64 + fr, col0 = u.pn * BM + wc * 32 + 8 * fq;
#pragma unroll
        for (int ai = 0; ai < 2; ++ai)
#pragma unroll
            for (int m = 0; m < 4; ++m) { bf16_t* rowp = O + (size_t)(row0 + ai * HALF + m * 16) * ldc + col0;
#pragma unroll
                for (int bj = 0; bj < 2; ++bj) *(u32x4*)(rowp + bj * HALF) = pack8(acc[ai][bj][m][0], acc[ai][bj][m][1]); }
    }
};
struct EpiMerge {
    static constexpr bool PERM = true, KEEP_ACC = true;
    const bf16_t* ZG; bf16_t* O;
    __device__ __forceinline__ void operator()(Acc& acc, const Unit& u, int wr, int wc, int fr, int fq) const {
        const int row0 = u.pm * BM + wr * 64 + fr, col0 = u.pn * BM + wc * 32 + 8 * fq;
#pragma unroll
        for (int ai = 0; ai < 2; ++ai)
#pragma unroll
            for (int m = 0; m < 4; ++m) { const int row = row0 + ai * HALF + m * 16;
#pragma unroll
                for (int bj = 0; bj < 2; ++bj) { const bf16_t* gp = ZG + (size_t)row * 4096 + col0 + bj * HALF;
                    if (u.seg == 0) { f32x4 a0, a1; unpack8(*(const u32x4*)gp, a0, a1); acc[ai][bj][m][0] = acc[ai][bj][m][0] * a0; acc[ai][bj][m][1] = acc[ai][bj][m][1] * a1; }
                    else { f32x4 c0, c1; unpack8(*(const u32x4*)(gp + 2048), c0, c1); *(u32x4*)(O + (size_t)row * 2048 + col0 + bj * HALF) = pack8(acc[ai][bj][m][0] * c0, acc[ai][bj][m][1] * c1); } } }
    }
};
struct EpiRes {
    static constexpr bool PERM = true, KEEP_ACC = false;
    const float* base; float* out; bf16_t* outb; float* part; PG8_LAS float* xch;
    __device__ __forceinline__ void operator()(Acc& acc, const Unit& u, int wr, int wc, int fr, int fq) const {
        const int row0 = u.pm * BM + wr * 64 + fr, col0 = u.pn * BM + wc * 32 + 8 * fq;
#pragma unroll
        for (int ai = 0; ai < 2; ++ai)
#pragma unroll
            for (int m = 0; m < 4; ++m) { const int row = row0 + ai * HALF + m * 16; float ss = 0.f;
#pragma unroll
                for (int bj = 0; bj < 2; ++bj) { const size_t off = (size_t)row * 2048 + col0 + bj * HALF;
                    const f32x4 o0 = *(const f32x4*)(base + off) + acc[ai][bj][m][0], o1 = *(const f32x4*)(base + off + 4) + acc[ai][bj][m][1];
                    *(f32x4*)(out + off) = o0; *(f32x4*)(out + off + 4) = o1;
                    if (outb) *(u32x4*)(outb + off) = pack8(o0, o1);
                    ss += (o0[0] * o0[0] + o0[1] * o0[1]) + (o0[2] * o0[2] + o0[3] * o0[3]) + (o1[0] * o1[0] + o1[1] * o1[1]) + (o1[2] * o1[2] + o1[3] * o1[3]); }
                ss += __shfl_xor(ss, 16); ss += __shfl_xor(ss, 32);
                if (fq == 0) xch[(ai * HALF + wr * 64 + m * 16 + fr) * 4 + wc] = ss; }
        asm volatile("s_waitcnt lgkmcnt(0)" ::: "memory"); __builtin_amdgcn_s_barrier(); asm volatile("" ::: "memory");
        { const int t = threadIdx.x; if (t < 256) { const f32x4 v = *(const PG8_LAS f32x4*)(xch + t * 4); part[(size_t)(u.pm * BM + t) * 8 + u.pn] = (v[0] + v[1]) + (v[2] + v[3]); } }
        asm volatile("s_waitcnt lgkmcnt(0)" ::: "memory"); __builtin_amdgcn_s_barrier(); asm volatile("" ::: "memory");
    }
};
struct EpiResB {
    static constexpr bool PERM = true, KEEP_ACC = false;
    const bf16_t* base; bf16_t* outb; float* part; PG8_LAS float* xch;
    __device__ __forceinline__ void operator()(Acc& acc, const Unit& u, int wr, int wc, int fr, int fq) const {
        const int row0 = u.pm * BM + wr * 64 + fr, col0 = u.pn * BM + wc * 32 + 8 * fq;
#pragma unroll
        for (int ai = 0; ai < 2; ++ai)
#pragma unroll
            for (int m = 0; m < 4; ++m) { const int row = row0 + ai * HALF + m * 16; float ss = 0.f;
#pragma unroll
                for (int bj = 0; bj < 2; ++bj) { const size_t off = (size_t)row * 2048 + col0 + bj * HALF;
                    f32x4 b0, b1; unpack8(*(const u32x4*)(base + off), b0, b1);
                    const f32x4 o0 = b0 + acc[ai][bj][m][0], o1 = b1 + acc[ai][bj][m][1];
                    *(u32x4*)(outb + off) = pack8(o0, o1);
                    ss += (o0[0] * o0[0] + o0[1] * o0[1]) + (o0[2] * o0[2] + o0[3] * o0[3]) + (o1[0] * o1[0] + o1[1] * o1[1]) + (o1[2] * o1[2] + o1[3] * o1[3]); }
                ss += __shfl_xor(ss, 16); ss += __shfl_xor(ss, 32);
                if (fq == 0) xch[(ai * HALF + wr * 64 + m * 16 + fr) * 4 + wc] = ss; }
        asm volatile("s_waitcnt lgkmcnt(0)" ::: "memory"); __builtin_amdgcn_s_barrier(); asm volatile("" ::: "memory");
        { const int t = threadIdx.x; if (t < 256) { const f32x4 v = *(const PG8_LAS f32x4*)(xch + t * 4); part[(size_t)(u.pm * BM + t) * 8 + u.pn] = (v[0] + v[1]) + (v[2] + v[3]); } }
        asm volatile("s_waitcnt lgkmcnt(0)" ::: "memory"); __builtin_amdgcn_s_barrier(); asm volatile("" ::: "memory");
    }
};
struct EpiFinal {
    static constexpr bool PERM = true, KEEP_ACC = false;
    const bf16_t* base; float* out; const float* gfin; float* part; unsigned* cnt; PG8_LAS float* xch;
    __device__ __forceinline__ void operator()(Acc& acc, const Unit& u, int wr, int wc, int fr, int fq) const {
        const int row0 = u.pm * BM + wr * 64 + fr, col0 = u.pn * BM + wc * 32 + 8 * fq;
        const int tid = threadIdx.x, wid = __builtin_amdgcn_readfirstlane(tid >> 6), lane = tid & 63;
        PG8_LAS float* S = xch + 1024; PG8_LAS unsigned* flag = (PG8_LAS unsigned*)(xch + 1024 + 256);
#pragma unroll
        for (int ai = 0; ai < 2; ++ai)
#pragma unroll
            for (int m = 0; m < 4; ++m) { const int row = row0 + ai * HALF + m * 16; float ss = 0.f;
#pragma unroll
                for (int bj = 0; bj < 2; ++bj) { f32x4 b0, b1; unpack8(*(const u32x4*)(base + (size_t)row * 2048 + col0 + bj * HALF), b0, b1);
                    const f32x4 o0 = b0 + acc[ai][bj][m][0], o1 = b1 + acc[ai][bj][m][1]; acc[ai][bj][m][0] = o0; acc[ai][bj][m][1] = o1;
                    ss += (o0[0] * o0[0] + o0[1] * o0[1]) + (o0[2] * o0[2] + o0[3] * o0[3]) + (o1[0] * o1[0] + o1[1] * o1[1]) + (o1[2] * o1[2] + o1[3] * o1[3]); }
                ss += __shfl_xor(ss, 16); ss += __shfl_xor(ss, 32);
                if (fq == 0) xch[(ai * HALF + wr * 64 + m * 16 + fr) * 4 + wc] = ss; }
        asm volatile("s_waitcnt lgkmcnt(0)" ::: "memory"); __builtin_amdgcn_s_barrier(); asm volatile("" ::: "memory");
        if (tid < 256) { const f32x4 v = *(const PG8_LAS f32x4*)(xch + tid * 4);
            __hip_atomic_store(part + (size_t)(u.pm * BM + tid) * 8 + u.pn, (v[0] + v[1]) + (v[2] + v[3]), __ATOMIC_RELAXED, __HIP_MEMORY_SCOPE_AGENT);
            asm volatile("s_waitcnt vmcnt(0)" ::: "memory");
            if (lane == 0) __hip_atomic_fetch_add(cnt + 64 * u.pm, 1u, __ATOMIC_RELAXED, __HIP_MEMORY_SCOPE_AGENT); }
        if (wid == 0) { unsigned dead = 0u, sp = 0u;
            while ((unsigned)__builtin_amdgcn_readfirstlane(__hip_atomic_load(cnt + 64 * u.pm, __ATOMIC_RELAXED, __HIP_MEMORY_SCOPE_AGENT)) < 32u) { __builtin_amdgcn_s_sleep(2); if (++sp > (1u << 20)) { dead = 1u; break; } }
            __builtin_amdgcn_fence(__ATOMIC_ACQUIRE, "agent");
            if (lane == 0) flag[0] = dead; }
        asm volatile("s_waitcnt vmcnt(0) lgkmcnt(0)" ::: "memory"); __builtin_amdgcn_s_barrier(); asm volatile("" ::: "memory");
        if (tid < 256) { const float* p = part + (size_t)(u.pm * BM + tid) * 8; float t = 0.f;
#pragma unroll
            for (int j = 0; j < 8; ++j) t += __hip_atomic_load(p + j, __ATOMIC_RELAXED, __HIP_MEMORY_SCOPE_AGENT);
            S[tid] = (flag[0] != 0u) ? __builtin_nanf("") : __builtin_amdgcn_rsqf(t * (1.0f / 2048.0f) + 1e-6f); }
        asm volatile("s_waitcnt vmcnt(0) lgkmcnt(0)" ::: "memory"); __builtin_amdgcn_s_barrier(); asm volatile("" ::: "memory");
        f32x4 gv[2][2];
#pragma unroll
        for (int bj = 0; bj < 2; ++bj) { gv[bj][0] = *(const f32x4*)(gfin + col0 + bj * HALF); gv[bj][1] = *(const f32x4*)(gfin + col0 + bj * HALF + 4); }
#pragma unroll
        for (int ai = 0; ai < 2; ++ai)
#pragma unroll
            for (int m = 0; m < 4; ++m) { const int rl = ai * HALF + wr * 64 + m * 16 + fr; const float rs = S[rl]; float* orow = out + (size_t)(u.pm * BM + rl) * 2048 + col0;
#pragma unroll
                for (int bj = 0; bj < 2; ++bj) { *(f32x4*)(orow + bj * HALF) = acc[ai][bj][m][0] * rs * gv[bj][0]; *(f32x4*)(orow + bj * HALF + 4) = acc[ai][bj][m][1] * rs * gv[bj][1]; } }
        asm volatile("s_waitcnt lgkmcnt(0)" ::: "memory"); __builtin_amdgcn_s_barrier(); asm volatile("" ::: "memory");
    }
};
__device__ __forceinline__ float row_rs(const float* part, int row) { const f32x4 a = *(const f32x4*)(part + (size_t)row * 8), b = *(const f32x4*)(part + (size_t)row * 8 + 4);
    return __builtin_amdgcn_rsqf((((a[0] + a[1]) + (a[2] + a[3])) + ((b[0] + b[1]) + (b[2] + b[3]))) * (1.0f / 2048.0f) + 1e-6f); }
struct EpiRowScale {
    static constexpr bool PERM = true, KEEP_ACC = false;
    bf16_t* O; int ldc; const float* ssq; float scale;
    __device__ __forceinline__ void operator()(Acc& acc, const Unit& u, int wr, int wc, int fr, int fq) const {
        const int row0 = u.pm * BM + wr * 64 + fr, col0 = u.pn * BM + wc * 32 + 8 * fq;
#pragma unroll
        for (int ai = 0; ai < 2; ++ai)
#pragma unroll
            for (int m = 0; m < 4; ++m) { const int row = row0 + ai * HALF + m * 16; const float rs = row_rs(ssq, row) * scale;
                bf16_t* rowp = O + (size_t)row * ldc + col0;
#pragma unroll
                for (int bj = 0; bj < 2; ++bj) *(u32x4*)(rowp + bj * HALF) = pack8(acc[ai][bj][m][0] * rs, acc[ai][bj][m][1] * rs); }
    }
};
struct EpiSwiGLU {
    static constexpr bool PERM = true, KEEP_ACC = false;
    bf16_t* O; const float* ssq;
    __device__ __forceinline__ void operator()(Acc& acc, const Unit& u, int wr, int wc, int fr, int fq) const {
        const int row0 = u.pm * BM + wr * 64 + fr, col0 = u.pn * HALF + wc * 32 + 8 * fq;
#pragma unroll
        for (int ai = 0; ai < 2; ++ai)
#pragma unroll
            for (int m = 0; m < 4; ++m) { const int row = row0 + ai * HALF + m * 16; const float rs = row_rs(ssq, row);
                const f32x4 g0 = acc[ai][0][m][0] * rs, g1 = acc[ai][0][m][1] * rs, u0 = acc[ai][1][m][0] * rs, u1 = acc[ai][1][m][1] * rs;
                *(u32x4*)(O + (size_t)row * 5632 + col0) = pack8(g0 * sigmoid4(g0) * u0, g1 * sigmoid4(g1) * u1); }
    }
};

template <class Epi, class Sched, bool ALIGN_EPI = true>
__device__ __forceinline__ void gemm_phase(PG8_LAS unsigned char* lds, const Gemm g, const Sched& S, const Epi& E) {
    const int tid = threadIdx.x, wid = __builtin_amdgcn_readfirstlane(tid >> 6), lane = tid & 63, wr = wid >> 2, wc = wid & 3, fr = lane & 15, fq = lane >> 4;
    const int K = g.K, nt = K / BK;
    unsigned voffA[2], voffB[2];
#pragma unroll
    for (int i = 0; i < 2; ++i) { int R, C; stage_rc(tid * 16 + i * 8192, R, C); const int Rb = Epi::PERM ? ((R & ~31) + perm32(R & 31)) : R;
        voffA[i] = (unsigned)(R * K + C) * 2u; voffB[i] = (unsigned)(Rb * K + C) * 2u; }
    const size_t kstep = (size_t)(BK * 2);
    const size_t hstep = (size_t)HALF * K * 2;
    const size_t tstep = 2 * hstep;
    const unsigned ldsw = (unsigned)wid * 1024u;
    const int aoff = lds_byte(wr * 64 + fr, fq * 8), boff = lds_byte(wc * 32 + fr, fq * 8);
#define PG8_SA(b, h) (((b) * 2 + (h)) * HTB)
#define PG8_SB(b, h) ((4 + (b) * 2 + (h)) * HTB)
#define PG8_STAGE(bufoff, gbase, voff) do { _Pragma("unroll") for (int _i = 0; _i < 2; ++_i) \
        __builtin_amdgcn_global_load_lds((const unsigned*)((const char*)(gbase) + (voff)[_i]), (PG8_LAS unsigned*)(lds + (bufoff) + ldsw + _i * 8192), 16, 0, 0); } while (0)
#define PG8_LDA(dst, b, h) do { _Pragma("unroll") for (int m = 0; m < 4; ++m) _Pragma("unroll") for (int k = 0; k < 2; ++k) dst[m][k] = *(const PG8_LAS bf16x8*)(lds + PG8_SA(b, h) + aoff + m * 2048 + k * 1024); } while (0)
#define PG8_LDB(dst, b, h) do { _Pragma("unroll") for (int n = 0; n < 2; ++n) _Pragma("unroll") for (int k = 0; k < 2; ++k) dst[n][k] = *(const PG8_LAS bf16x8*)(lds + PG8_SB(b, h) + boff + n * 2048 + k * 1024); } while (0)
#define PG8_MMA(ai, bj, At, Bt) do { __builtin_amdgcn_s_setprio(1); _Pragma("unroll") for (int m = 0; m < 4; ++m) _Pragma("unroll") for (int n = 0; n < 2; ++n) _Pragma("unroll") for (int k = 0; k < 2; ++k) \
        acc[ai][bj][m][n] = __builtin_amdgcn_mfma_f32_16x16x32_bf16(Bt[n][k], At[m][k], acc[ai][bj][m][n], 0, 0, 0); __builtin_amdgcn_s_setprio(0); } while (0)
#define PG8_WAIT_V(n) asm volatile("s_waitcnt vmcnt(" #n ")" ::: "memory")
#define PG8_WAIT_L(n) asm volatile("s_waitcnt lgkmcnt(" #n ")" ::: "memory")
#define PG8_BAR __builtin_amdgcn_s_barrier()
#define PG8_SCHED __builtin_amdgcn_sched_barrier(0)
#define PG8_UA(u) ((const char*)((u).seg ? g.A1 : g.A0) + (size_t)(u).pm * tstep)
#define PG8_UB(u) ((const char*)((u).seg ? g.B1 : g.B0) + (size_t)(u).pn * tstep)
    Unit cur, nxt; int ui = 0;
    if (!S.next(0, cur)) return;
    Acc acc;
#pragma unroll
    for (int a = 0; a < 2; ++a)
#pragma unroll
        for (int b = 0; b < 2; ++b)
#pragma unroll
            for (int m = 0; m < 4; ++m)
#pragma unroll
                for (int n = 0; n < 2; ++n) acc[a][b][m][n] = (f32x4){0.f, 0.f, 0.f, 0.f};
    bf16x8 At[4][2], B0[2][2], B1[2][2];
    const char* cA = PG8_UA(cur); const char* cB = PG8_UB(cur);
    PG8_STAGE(PG8_SB(0, 0), cB, voffB); PG8_STAGE(PG8_SB(0, 1), cB + hstep, voffB); PG8_STAGE(PG8_SA(0, 0), cA, voffA); PG8_STAGE(PG8_SA(0, 1), cA + hstep, voffA);
    if (wr == 1) PG8_BAR;
    PG8_WAIT_V(2); PG8_BAR;
    PG8_STAGE(PG8_SB(1, 0), cB + kstep, voffB); PG8_STAGE(PG8_SA(1, 0), cA + kstep, voffA); PG8_STAGE(PG8_SB(1, 1), cB + hstep + kstep, voffB);
    PG8_WAIT_V(6); PG8_BAR;
    for (;;) {
        const bool has_next = S.next(ui + 1, nxt);
        const char* nA = has_next ? PG8_UA(nxt) : cA; const char* nB = has_next ? PG8_UB(nxt) : cB;
        for (int t = 0; t < nt; t += 2) {
            const bool last = (t == nt - 2);
            const char* a1 = cA + (size_t)(t + 1) * kstep;
            const char* a2 = last ? nA : cA + (size_t)(t + 2) * kstep; const char* b2 = last ? nB : cB + (size_t)(t + 2) * kstep;
            const char* a3 = a2 + kstep; const char* b3 = b2 + kstep;
            PG8_LDB(B0, 0, 0); PG8_LDB(B1, 0, 1); PG8_SCHED; PG8_LDA(At, 0, 0); PG8_STAGE(PG8_SA(1, 1), a1 + hstep, voffA);
            PG8_WAIT_V(8); PG8_WAIT_L(0); PG8_BAR; PG8_MMA(0, 0, At, B0); PG8_MMA(0, 1, At, B1); PG8_BAR; PG8_SCHED;
            PG8_LDA(At, 0, 1); PG8_STAGE(PG8_SB(0, 0), b2, voffB); PG8_STAGE(PG8_SB(0, 1), b2 + hstep, voffB); PG8_STAGE(PG8_SA(0, 0), a2, voffA);
            PG8_WAIT_V(8); PG8_WAIT_L(0); PG8_BAR; PG8_MMA(1, 0, At, B0); PG8_MMA(1, 1, At, B1); PG8_BAR; PG8_SCHED;
            PG8_LDB(B0, 1, 0); PG8_LDB(B1, 1, 1); PG8_SCHED; PG8_LDA(At, 1, 0); PG8_STAGE(PG8_SA(0, 1), a2 + hstep, voffA);
            PG8_WAIT_V(8); PG8_WAIT_L(0); PG8_BAR; PG8_MMA(0, 0, At, B0); PG8_MMA(0, 1, At, B1); PG8_BAR; PG8_SCHED;
            PG8_LDA(At, 1, 1); PG8_STAGE(PG8_SB(1, 0), b3, voffB); PG8_STAGE(PG8_SB(1, 1), b3 + hstep, voffB); PG8_STAGE(PG8_SA(1, 0), a3, voffA);
            PG8_WAIT_V(8); PG8_WAIT_L(0); PG8_BAR; PG8_MMA(1, 0, At, B0); PG8_MMA(1, 1, At, B1); PG8_BAR; PG8_SCHED;
        }
        if constexpr (ALIGN_EPI) { if (wr == 0) PG8_BAR; }
        E(acc, cur, wr, wc, fr, fq);
        if (!has_next) break;
        if (!(Epi::KEEP_ACC && cur.seg == 0)) {
#pragma unroll
        for (int a = 0; a < 2; ++a)
#pragma unroll
            for (int b = 0; b < 2; ++b)
#pragma unroll
                for (int m = 0; m < 4; ++m)
#pragma unroll
                    for (int n = 0; n < 2; ++n) acc[a][b][m][n] = (f32x4){0.f, 0.f, 0.f, 0.f};
        }
        cur = nxt; cA = nA; cB = nB; ++ui;
        if constexpr (ALIGN_EPI) { if (wr == 1) PG8_BAR; }
    }
    PG8_WAIT_V(0);
    if constexpr (!ALIGN_EPI) { if (wr == 0) PG8_BAR; }
    PG8_BAR;
#undef PG8_SA
#undef PG8_SB
#undef PG8_STAGE
#undef PG8_LDA
#undef PG8_LDB
#undef PG8_MMA
#undef PG8_WAIT_V
#undef PG8_WAIT_L
#undef PG8_BAR
#undef PG8_SCHED
#undef PG8_UA
#undef PG8_UB
}
}

constexpr int NWAVES = 8, NTHR = NWAVES * 64;
constexpr int DM = 2048, BATCH = 8, SEQ = 2048, M = BATCH * SEQ;
constexpr int INW = 8704, ZAW = 4608, ZGW = 4096;
constexpr int NMEM = 256, MROWS = BATCH * NMEM;
constexpr int DFF = 5632;
constexpr float RMS_EPS = 1e-6f;

constexpr size_t MiB = 1u << 20;
constexpr size_t WS_BAR = 256 * 1024, WS_BAR_BYTES = 128 * 1024, WS_PCNT = WS_BAR + 64 * 1024;
constexpr size_t WS_RS1 = 0;
constexpr size_t WS_SSQ = 506 * MiB;
constexpr size_t WS_ROPE = 1 * MiB;
constexpr size_t WS_WIN = 2 * MiB;
constexpr size_t WS_WA = 36 * MiB;
constexpr size_t WS_WC = 40 * MiB;
constexpr size_t WS_WO = 44 * MiB;
constexpr size_t WS_WCQ = 52 * MiB;
constexpr size_t WS_WCKV = 54 * MiB;
constexpr size_t WS_WCO = 58 * MiB;
constexpr size_t WS_WGU = 60 * MiB;
constexpr size_t WS_WDN = 104 * MiB;
constexpr size_t WS_MEMN = 126 * MiB;
constexpr size_t WS_MEMKV = 134 * MiB;
constexpr size_t WS_ZA = 138 * MiB;
constexpr size_t WS_ZG = 282 * MiB;
constexpr size_t WS_AO = 2 * MiB;
constexpr size_t WS_CV = 410 * MiB;
constexpr size_t WS_WOB = 410 * MiB;
constexpr size_t WS_XB = 442 * MiB;
constexpr size_t WS_WOQ = 508 * MiB;
constexpr size_t WS_END = 510 * MiB;
constexpr size_t WS_MG = WS_ZA;
constexpr size_t WS_X1B = WS_ZG + 32 * MiB;
constexpr size_t WS_X3B = WS_XB;
constexpr size_t WS_QC = WS_ZG;
constexpr size_t WS_CO = WS_ZG + 16 * MiB;
constexpr size_t WS_X2B = WS_ZA;
constexpr size_t WS_ACT = WS_ZA + 64 * MiB;
static_assert(WS_ACT + (size_t)M * DFF * 2 <= WS_CV, "ACT overlay");

constexpr int LDS_BYTES = 147456;

#define GAS __attribute__((address_space(1)))
#define LAS __attribute__((address_space(3)))
typedef unsigned short bf16;
typedef unsigned v4u __attribute__((ext_vector_type(4)));
typedef float f32x4 __attribute__((ext_vector_type(4)));
#define LDS_WAIT() asm volatile("s_waitcnt lgkmcnt(0)" ::: "memory")
__device__ __forceinline__ unsigned f2bf(float f) { unsigned u = __builtin_bit_cast(unsigned, f); return (u + 0x7fffu + ((u >> 16) & 1u)) >> 16; }
__device__ __forceinline__ unsigned pk2(float lo, float hi) { return f2bf(lo) | (f2bf(hi) << 16); }
__device__ __forceinline__ float bflo(unsigned w) { return __uint_as_float(w << 16); }
__device__ __forceinline__ float bfhi(unsigned w) { return __uint_as_float(w & 0xffff0000u); }
__device__ __forceinline__ float wave_sum(float v) {
#pragma unroll
    for (int o = 1; o < 64; o <<= 1) v += __shfl_xor(v, o);
    return v;
}
__device__ __forceinline__ float wave_max(float v) {
#pragma unroll
    for (int o = 1; o < 64; o <<= 1) v = fmaxf(v, __shfl_xor(v, o));
    return v;
}

__device__ __forceinline__ int dest_row(int n0, int mode) {
    if (mode == 1) return (n0 >> 7) * 256 + (n0 & 127);
    if (mode == 2) return (n0 >> 7) * 256 + 128 + (n0 & 127);
    if (mode == 3 && n0 < 1280) return (n0 >> 8) * 256 + ((n0 >> 6) & 1) * 128 + ((n0 >> 7) & 1) * 64 + (n0 & 63);
    if (mode == 3 && n0 >= 1536 && n0 < 2560) { const int ch = n0 - 1536; return 1536 + (ch >> 7) * 256 + (ch & 127); }
    if (mode == 3 && n0 >= 3584 && n0 < 4608) { const int ch = n0 - 3584; return 1536 + (ch >> 7) * 256 + 128 + (ch & 127); }
    if (mode == 3 && n0 >= 2560 && n0 < 3584) return n0 + 1024;
    if (mode == 3 && n0 >= 4608) { const int g = n0 - 4608, br = g >> 11, ch = g & 2047; return 4608 + (ch >> 7) * 256 + br * 128 + (ch & 127); }
    return n0;
}
struct TItem { const float* W; bf16* WT; const float* gk; int K, N, mode, item; };
__device__ __forceinline__ void p0_t_load(const TItem& t, f32x4 (&v)[8], int lane) {
    const int nblk = t.N / 32, kb = t.item / nblk, nb = t.item % nblk, k0 = 64 * kb, n0 = 32 * nb, kr2 = lane >> 3, nq = lane & 7;
#pragma unroll
    for (int i = 0; i < 4; ++i) { const float* p = t.W + (size_t)(k0 + 16 * i + 2 * kr2) * t.N + n0 + 4 * nq; v[2 * i] = __builtin_nontemporal_load((const f32x4*)p); v[2 * i + 1] = __builtin_nontemporal_load((const f32x4*)(p + t.N)); }
}
__device__ __forceinline__ void p0_t_store(const TItem& t, const f32x4 (&v)[8], LAS float* scrf, int lane) {
    LAS unsigned* scr = (LAS unsigned*)scrf;
    const int nblk = t.N / 32, kb = t.item / nblk, nb = t.item % nblk, k0 = 64 * kb, n0 = 32 * nb, kr2 = lane >> 3, nq = lane & 7;
#pragma unroll
    for (int i = 0; i < 4; ++i) { float g0 = 1.0f, g1 = 1.0f; if (t.gk) { g0 = t.gk[k0 + 16 * i + 2 * kr2]; g1 = t.gk[k0 + 16 * i + 2 * kr2 + 1]; }
        LAS unsigned* p = scr + (4 * nq) * 36 + 8 * i + kr2;
        p[0 * 36] = pk2(v[2 * i].x * g0, v[2 * i + 1].x * g1); p[1 * 36] = pk2(v[2 * i].y * g0, v[2 * i + 1].y * g1);
        p[2 * 36] = pk2(v[2 * i].z * g0, v[2 * i + 1].z * g1); p[3 * 36] = pk2(v[2 * i].w * g0, v[2 * i + 1].w * g1); }
    LDS_WAIT(); asm volatile("" ::: "memory");
    const int c = lane & 7, r0 = dest_row(n0, t.mode);
#pragma unroll
    for (int j = 0; j < 4; ++j) { const int n = (lane >> 3) + 8 * j; *(v4u*)(t.WT + (size_t)(r0 + n) * t.K + k0 + 8 * c) = *(const LAS v4u*)(scr + n * 36 + 4 * c); }
    LDS_WAIT(); asm volatile("" ::: "memory");
}
__device__ __forceinline__ void row_to_bf16_rs(const float* xrow, bf16* orow, float* rs_out, int lane) {
    const f32x4* xr = (const f32x4*)xrow + lane;
    f32x4 v[8]; float s = 0.f;
#pragma unroll
    for (int j = 0; j < 8; ++j) { v[j] = xr[64 * j]; s += (v[j].x * v[j].x + v[j].y * v[j].y) + (v[j].z * v[j].z + v[j].w * v[j].w); }
    const float rs = 1.0f / sqrtf(wave_sum(s) * (1.0f / DM) + RMS_EPS);
    if (lane == 0) *rs_out = rs;
    unsigned long long* o8 = (unsigned long long*)orow + lane;
#pragma unroll
    for (int j = 0; j < 8; ++j) o8[64 * j] = (unsigned long long)pk2(v[j].x, v[j].y) | ((unsigned long long)pk2(v[j].z, v[j].w) << 32);
}
__device__ __forceinline__ void rms_row_to_bf16(const float* xrow, const float* g, bf16* orow, int lane) {
    const f32x4* xr = (const f32x4*)xrow + lane; const f32x4* gr = (const f32x4*)g + lane;
    f32x4 v[8]; float s = 0.f;
#pragma unroll
    for (int j = 0; j < 8; ++j) { v[j] = xr[64 * j]; s += (v[j].x * v[j].x + v[j].y * v[j].y) + (v[j].z * v[j].z + v[j].w * v[j].w); }
    const float rs = 1.0f / sqrtf(wave_sum(s) * (1.0f / DM) + RMS_EPS);
    unsigned long long* o8 = (unsigned long long*)orow + lane;
#pragma unroll
    for (int j = 0; j < 8; ++j) { const f32x4 gg = gr[64 * j];
        o8[64 * j] = (unsigned long long)pk2(v[j].x * rs * gg.x, v[j].y * rs * gg.y) | ((unsigned long long)pk2(v[j].z * rs * gg.z, v[j].w * rs * gg.w) << 32); }
}

typedef float f32x16 __attribute__((ext_vector_type(16)));
typedef short s16x8 __attribute__((ext_vector_type(8)));
typedef short s16x4 __attribute__((ext_vector_type(4)));
constexpr int ATT_KP = 272, ATT_VP = 264, ATT_V_OFF = 128 * ATT_KP, ATT_LDS = ATT_V_OFF + 128 * ATT_VP;
constexpr float LOG2E = 1.4426950408889634f;
template <bool WINDOW>
__device__ __forceinline__ void attn_unit(LAS unsigned char* lds, const bf16* qw, int qpitch, const bf16* kg, const bf16* vg, int kvpitch, int nblk,
                                          int qpos, int kpos, float m_init, float l_init, float qs, bf16* ow, int opitch, int tid, int lane) {
    const int r = lane & 31, h = lane >> 5;
    s16x8 qf[8];
#pragma unroll
    for (int kk = 0; kk < 8; ++kk) qf[kk] = *(const s16x8*)(qw + (size_t)r * qpitch + 16 * kk + 8 * h);
    f32x16 o[4];
#pragma unroll
    for (int dt = 0; dt < 4; ++dt)
#pragma unroll
        for (int i = 0; i < 16; ++i) o[dt][i] = 0.f;
    float m = m_init, l = (h == 0) ? l_init : 0.f;
    const int kkey = tid >> 4, kc = tid & 15, vkey = tid & 127, vcg = tid >> 7;
    for (int blk = 0; blk < nblk; ++blk) {
        v4u kreg[4], vreg[4];
#pragma unroll
        for (int it = 0; it < 4; ++it) { kreg[it] = *(const v4u*)(kg + (size_t)(blk * 128 + kkey + 32 * it) * kvpitch + kc * 8); vreg[it] = *(const v4u*)(vg + (size_t)(blk * 128 + vkey) * kvpitch + (vcg * 4 + it) * 8); }
        __syncthreads();
#pragma unroll
        for (int it = 0; it < 4; ++it) { *(LAS v4u*)(lds + (kkey + 32 * it) * ATT_KP + kc * 16) = kreg[it];
            LAS unsigned short* vt = (LAS unsigned short*)(lds + ATT_V_OFF) + (size_t)((vcg * 4 + it) * 8) * (ATT_VP / 2) + vkey;
            const v4u w = vreg[it];
            vt[0 * (ATT_VP / 2)] = (unsigned short)(w.x & 0xffffu); vt[1 * (ATT_VP / 2)] = (unsigned short)(w.x >> 16); vt[2 * (ATT_VP / 2)] = (unsigned short)(w.y & 0xffffu); vt[3 * (ATT_VP / 2)] = (unsigned short)(w.y >> 16);
            vt[4 * (ATT_VP / 2)] = (unsigned short)(w.z & 0xffffu); vt[5 * (ATT_VP / 2)] = (unsigned short)(w.z >> 16); vt[6 * (ATT_VP / 2)] = (unsigned short)(w.w & 0xffffu); vt[7 * (ATT_VP / 2)] = (unsigned short)(w.w >> 16); }
        __syncthreads();
#pragma unroll 1
        for (int hf = 0; hf < 2; ++hf) {
        const int thr0 = WINDOW ? (qpos - (kpos + blk * 128 + 64 * hf)) : 0;
        if (WINDOW && (thr0 - 63 > 128 || thr0 + 31 < -128)) continue;
        const bool need_mask = WINDOW && (thr0 + 31 > 128 || thr0 - 63 < -128);
        const int thr = thr0 + r - 4 * h;
        f32x16 sc[2];
#pragma unroll
        for (int kt = 0; kt < 2; ++kt) {
#pragma unroll
            for (int i = 0; i < 16; ++i) sc[kt][i] = 0.f;
#pragma unroll
            for (int kk = 0; kk < 8; ++kk) { const s16x8 kf = *(const LAS s16x8*)(lds + (64 * hf + 32 * kt + r) * ATT_KP + (16 * kk + 8 * h) * 2); sc[kt] = __builtin_amdgcn_mfma_f32_32x32x16_bf16(kf, qf[kk], sc[kt], 0, 0, 0); }
        }
        float mb = -1e30f;
#pragma unroll
        for (int kt = 0; kt < 2; ++kt)
#pragma unroll
            for (int i = 0; i < 16; ++i) {
                if (!WINDOW) sc[kt][i] *= qs;
                if (WINDOW) { if (need_mask && (unsigned)((32 * kt + (i & 3) + 8 * (i >> 2)) - thr + 128) > 256u) sc[kt][i] = -1e30f; }
                mb = fmaxf(mb, sc[kt][i]); }
        mb = fmaxf(mb, __shfl_xor(mb, 32));
        const float mn = fmaxf(m, mb), alpha = __builtin_amdgcn_exp2f((m - mn) * LOG2E), mo = mn * LOG2E;
        m = mn; l *= alpha;
#pragma unroll
        for (int dt = 0; dt < 4; ++dt) o[dt] = o[dt] * alpha;
        float ls = 0.f;
#pragma unroll
        for (int kt = 0; kt < 2; ++kt)
#pragma unroll
            for (int i = 0; i < 16; ++i) { const float p = __builtin_amdgcn_exp2f(sc[kt][i] * LOG2E - mo); sc[kt][i] = p; ls += p; }
        l += ls;
#pragma unroll
        for (int kt = 0; kt < 2; ++kt)
#pragma unroll
            for (int st = 0; st < 2; ++st) {
                v4u pw; pw.x = pg8::cvt_pk_bf16(sc[kt][8 * st + 0], sc[kt][8 * st + 1]); pw.y = pg8::cvt_pk_bf16(sc[kt][8 * st + 2], sc[kt][8 * st + 3]);
                pw.z = pg8::cvt_pk_bf16(sc[kt][8 * st + 4], sc[kt][8 * st + 5]); pw.w = pg8::cvt_pk_bf16(sc[kt][8 * st + 6], sc[kt][8 * st + 7]);
                const s16x8 pf = __builtin_bit_cast(s16x8, pw);
#pragma unroll
                for (int dt = 0; dt < 4; ++dt) { const LAS unsigned char* vp = lds + ATT_V_OFF + (32 * dt + r) * ATT_VP + (64 * hf + 32 * kt + 16 * st + 4 * h) * 2;
                    const s16x4 lo = *(const LAS s16x4*)vp, hi = *(const LAS s16x4*)(vp + 16);
                    const s16x8 vf = __builtin_shufflevector(lo, hi, 0, 1, 2, 3, 4, 5, 6, 7);
                    o[dt] = __builtin_amdgcn_mfma_f32_32x32x16_bf16(vf, pf, o[dt], 0, 0, 0); }
            }
        }
    }
    l += __shfl_xor(l, 32);
    const float inv = 1.0f / l;
    bf16* orow = ow + (size_t)r * opitch + 4 * h;
#pragma unroll
    for (int dt = 0; dt < 4; ++dt)
#pragma unroll
        for (int g = 0; g < 4; ++g) { unsigned long long w = (unsigned long long)pg8::cvt_pk_bf16(o[dt][4 * g] * inv, o[dt][4 * g + 1] * inv) | ((unsigned long long)pg8::cvt_pk_bf16(o[dt][4 * g + 2] * inv, o[dt][4 * g + 3] * inv) << 32);
            *(unsigned long long*)(orow + 32 * dt + 8 * g) = w; }
}

#define RLX_AGENT __ATOMIC_RELAXED, __HIP_MEMORY_SCOPE_AGENT
#define XB_TMO      128
#define XB_XCNT(j)  (256  + 64 * (j))
#define XB_XSUB(j)  (1280 + 64 * (j))
#define XB_XGEN(j)  (2304 + 64 * (j))
#define XB_TOP      3328
#define XB_TOPGEN   3392
#define XCD_BAR_WORDS 3456
#define XB_SPIN_CAP (1u << 18)

__device__ __forceinline__ unsigned xb_ld(unsigned* p)              { return __hip_atomic_load(p, __ATOMIC_RELAXED, __HIP_MEMORY_SCOPE_AGENT); }
__device__ __forceinline__ unsigned xb_add(unsigned* p, unsigned v) { return __hip_atomic_fetch_add(p, v, __ATOMIC_RELAXED, __HIP_MEMORY_SCOPE_AGENT); }
__device__ __forceinline__ unsigned xb_xcc_id() { return (unsigned)__builtin_amdgcn_s_getreg((3 << 11) | 20) & 0xFu; }
#define XB_SPIN(cond, bar) do { unsigned _sp = 0; while (cond) { __builtin_amdgcn_s_sleep(1); \
    if ((++_sp & 255u) == 0u) { if (xb_ld(&(bar)[XB_TMO])) break; if (_sp > XB_SPIN_CAP) { atomicAdd(&(bar)[XB_TMO], 1u); break; } } } } while (0)

struct XcdBarrier {
    unsigned* bar; unsigned x;
    volatile LAS unsigned* st;
};

__device__ __forceinline__ XcdBarrier xcd_barrier_post(unsigned* bar, volatile LAS unsigned* st) {
    XcdBarrier b; b.bar = bar; b.x = xb_xcc_id(); b.st = st;
    if (threadIdx.x == 0) (void)xb_add(&bar[XB_XCNT(b.x)], 1u);
    return b;
}
__device__ __forceinline__ void xcd_barrier_complete(unsigned* bar, unsigned x, unsigned& nloc, unsigned& nx) {
    const unsigned G = gridDim.x * gridDim.y * gridDim.z;
    unsigned sum, cnt, mine, sp = 0u;
    for (;;) {
        sum = 0u; cnt = 0u; mine = 0u;
#pragma unroll
        for (unsigned j = 0; j < 16; ++j) { const unsigned c = xb_ld(&bar[XB_XCNT(j)]); sum += c; cnt += (c > 0u) ? 1u : 0u; mine = (j == x) ? c : mine; }
        if (sum == G) break;
        __builtin_amdgcn_s_sleep(1);
        if ((++sp & 255u) == 0u) { if (xb_ld(&bar[XB_TMO])) break; if (sp > XB_SPIN_CAP) { atomicAdd(&bar[XB_TMO], 1u); break; } }
    }
    nloc = mine > 0u ? mine : 1u; nx = cnt > 0u ? cnt : 1u;
}

__device__ __forceinline__ void xcd_barrier(const XcdBarrier& b) {
    asm volatile("s_waitcnt vmcnt(0)" ::: "memory");
    __syncthreads();
    if (threadIdx.x == 0) {
        unsigned* bar = b.bar;
        __builtin_amdgcn_s_waitcnt(0);
        unsigned nloc = b.st[0], nx = b.st[1];
        if (nloc == 0u) { xcd_barrier_complete(bar, b.x, nloc, nx); b.st[0] = nloc; b.st[1] = nx; }
        const unsigned old = xb_add(&bar[XB_XSUB(b.x)], 1u);
        const unsigned gen = old / nloc;
        if (old + 1u == (gen + 1u) * nloc) {
            __builtin_amdgcn_fence(__ATOMIC_RELEASE, "agent");
            asm volatile("s_waitcnt vmcnt(0)" ::: "memory");
            const unsigned og = xb_add(&bar[XB_TOP], 1u);
            const unsigned tg = og / nx;
            if (og + 1u == (tg + 1u) * nx) xb_add(&bar[XB_TOPGEN], 1u);
            else XB_SPIN(xb_ld(&bar[XB_TOPGEN]) == tg, bar);
            __builtin_amdgcn_fence(__ATOMIC_ACQUIRE, "agent");
            xb_add(&bar[XB_XGEN(b.x)], 1u);
            asm volatile("s_waitcnt vmcnt(0)" ::: "memory");
        } else {
            XB_SPIN(xb_ld(&bar[XB_XGEN(b.x)]) == gen, bar);
            __builtin_amdgcn_fence(__ATOMIC_ACQUIRE, "agent");
            asm volatile("s_waitcnt vmcnt(0)" ::: "memory");
        }
    }
    __syncthreads();
}

struct Args { const float* in[20]; float* out; unsigned char* ws; int ph_lo, ph_hi, li, pad; };

__global__ void __launch_bounds__(NTHR, 2) mk_fwd(Args args) {
    extern __shared__ __attribute__((aligned(16))) unsigned char lds_raw[];
    LAS unsigned char* lds = (LAS unsigned char*)lds_raw;
    const int tid = threadIdx.x, lane = tid & 63, wave = __builtin_amdgcn_readfirstlane(tid >> 6);
    const int G = gridDim.x, bx = blockIdx.x;
    const int gw = bx * NWAVES + wave, NGW = G * NWAVES;
    unsigned char* ws = args.ws;
    const float* x = args.in[0]; const float* mem = args.in[1]; const float* g_mix = args.in[2]; const float* w_in = args.in[3]; const float* sink = args.in[4];
    const float* conv_w = args.in[5]; const float* b_gate = args.in[6]; const float* w_attn_out = args.in[7]; const float* w_conv_out = args.in[8]; const float* w_o = args.in[9];
    const float* g_cross = args.in[10]; const float* g_mem = args.in[11]; const float* w_cq = args.in[12]; const float* w_ckv = args.in[13]; const float* w_co = args.in[14];
    const float* g_ffn = args.in[15]; const float* w_gate = args.in[16]; const float* w_up = args.in[17]; const float* w_down = args.in[18]; const float* g_final = args.in[19];
    float* out = args.out;
    float* ssq2 = (float*)(ws + WS_SSQ); float* ssq3 = ssq2 + M * 8; float* ssq4 = ssq3 + M * 8;
    PG8_LAS float* xch = (PG8_LAS float*)(lds + pg8::STAGE_BYTES);
    float* cosT = (float*)(ws + WS_ROPE); float* sinT = cosT + SEQ * 64;
    bf16* Wt_in = (bf16*)(ws + WS_WIN); bf16* Wt_a = (bf16*)(ws + WS_WA); bf16* Wt_c = (bf16*)(ws + WS_WC); bf16* Wt_o = (bf16*)(ws + WS_WO);
    bf16* Wt_cq = (bf16*)(ws + WS_WCQ); bf16* Wt_ckv = (bf16*)(ws + WS_WCKV); bf16* Wt_co = (bf16*)(ws + WS_WCO); bf16* Wt_gu = (bf16*)(ws + WS_WGU); bf16* Wt_dn = (bf16*)(ws + WS_WDN);
    bf16* MEMN = (bf16*)(ws + WS_MEMN); bf16* MEMKV = (bf16*)(ws + WS_MEMKV);
    bf16* ZA = (bf16*)(ws + WS_ZA); bf16* ZG = (bf16*)(ws + WS_ZG); bf16* AO = (bf16*)(ws + WS_AO); bf16* CV = (bf16*)(ws + WS_CV);
    bf16* MG = (bf16*)(ws + WS_MG); bf16* X1B = (bf16*)(ws + WS_X1B); bf16* X3B = (bf16*)(ws + WS_X3B); bf16* XB = (bf16*)(ws + WS_XB); bf16* WOB = (bf16*)(ws + WS_WOB); bf16* WOQ = (bf16*)(ws + WS_WOQ); float* rs1 = (float*)(ws + WS_RS1); bf16* QC = (bf16*)(ws + WS_QC); bf16* CO = (bf16*)(ws + WS_CO);
    bf16* X2B = (bf16*)(ws + WS_X2B); bf16* ACT = (bf16*)(ws + WS_ACT);
    cg::grid_group grid = cg::this_grid();
    const int lo = args.ph_lo, hi = args.ph_hi;
#define IN(k) (lo <= (k) && (k) < hi)
#define SEAM(k) do { if (IN(k) && IN((k) + 1)) { if (args.ph_hi > 1000) { asm volatile("s_waitcnt vmcnt(0) lgkmcnt(0)" ::: "memory"); __syncthreads(); grid.sync(); } else xcd_barrier(xbar); } } while (0)
    if (tid < 4) ((LAS unsigned*)(lds + pg8::STAGE_BYTES + 8192))[tid] = 0u;
    __syncthreads();
    const XcdBarrier xbar = xcd_barrier_post((unsigned*)(ws + WS_BAR) + args.li * 4096, (volatile LAS unsigned*)(lds + pg8::STAGE_BYTES + 8192));

    if (IN(0)) {
        LAS float* scr = (LAS float*)(lds + wave * 16384);
        constexpr int I_IN = (DM / 64) * (INW / 32), I_A = (1024 / 64) * (DM / 32), I_O = (DM / 64) * (DM / 32), I_CQ = (DM / 64) * (512 / 32), I_CKV = (DM / 64) * (1024 / 32),
                      I_CO = (512 / 64) * (DM / 32), I_G = (DM / 64) * (DFF / 32), I_D = (DFF / 64) * (DM / 32);
        constexpr int NITEMS = I_IN + 2 * I_A + I_O + I_CQ + I_CKV + I_CO;
#define P0_PICK(t, itx) do { int r = (itx); \
            if (r < I_IN) { t = TItem{w_in, Wt_in, g_mix, DM, INW, 3, r}; break; } r -= I_IN; \
            if (r < I_A) { t = TItem{w_attn_out, Wt_a, nullptr, 1024, DM, 0, r}; break; } r -= I_A; \
            if (r < I_A) { t = TItem{w_conv_out, Wt_c, nullptr, 1024, DM, 0, r}; break; } r -= I_A; \
            if (r < I_O) { t = TItem{w_o, Wt_o, nullptr, DM, DM, 0, r}; break; } r -= I_O; \
            if (r < I_CQ) { t = TItem{w_cq, Wt_cq, g_cross, DM, 512, 0, r}; break; } r -= I_CQ; \
            if (r < I_CKV) { t = TItem{w_ckv, Wt_ckv, nullptr, DM, 1024, 0, r}; break; } r -= I_CKV; \
            t = TItem{w_co, Wt_co, nullptr, 512, DM, 0, r}; } while (0)
        for (int it = gw; it < NITEMS; it += 2 * NGW) {
            TItem t0, t1; f32x4 v0[8], v1[8]; const bool two = it + NGW < NITEMS;
            P0_PICK(t0, it); p0_t_load(t0, v0, lane);
            if (two) { P0_PICK(t1, it + NGW); p0_t_load(t1, v1, lane); }
            p0_t_store(t0, v0, scr, lane);
            if (two) p0_t_store(t1, v1, scr, lane);
        }
#undef P0_PICK
        for (int m = gw * 2; m < M; m += NGW * 2) {
            f32x4 va[8], vb[8]; const f32x4* xa = (const f32x4*)(x + (size_t)m * DM) + lane; const f32x4* xb2 = xa + DM / 4;
#pragma unroll
            for (int j = 0; j < 8; ++j) { va[j] = __builtin_nontemporal_load(xa + 64 * j); vb[j] = __builtin_nontemporal_load(xb2 + 64 * j); }
            float sa = 0.f, sb = 0.f;
#pragma unroll
            for (int j = 0; j < 8; ++j) { sa += (va[j].x * va[j].x + va[j].y * va[j].y) + (va[j].z * va[j].z + va[j].w * va[j].w); sb += (vb[j].x * vb[j].x + vb[j].y * vb[j].y) + (vb[j].z * vb[j].z + vb[j].w * vb[j].w); }
            sa = wave_sum(sa); sb = wave_sum(sb);
            if (lane == 0) { rs1[m] = 1.0f / sqrtf(sa * (1.0f / DM) + RMS_EPS); rs1[m + 1] = 1.0f / sqrtf(sb * (1.0f / DM) + RMS_EPS); }
            unsigned long long* oa = (unsigned long long*)(XB + (size_t)m * DM) + lane; unsigned long long* ob = oa + DM / 4;
#pragma unroll
            for (int j = 0; j < 8; ++j) { oa[64 * j] = (unsigned long long)pk2(va[j].x, va[j].y) | ((unsigned long long)pk2(va[j].z, va[j].w) << 32);
                ob[64 * j] = (unsigned long long)pk2(vb[j].x, vb[j].y) | ((unsigned long long)pk2(vb[j].z, vb[j].w) << 32); }
        }
        for (int i = bx * NTHR + tid; i < DM * DM / 8; i += G * NTHR) { const f32x4 a = *(const f32x4*)(w_o + (size_t)i * 8), b = *(const f32x4*)(w_o + (size_t)i * 8 + 4); *(v4u*)(WOB + (size_t)i * 8) = pg8::pack8(a, b); }
        for (int m = gw; m < MROWS; m += NGW) rms_row_to_bf16(mem + (size_t)m * DM, g_mem, MEMN + (size_t)m * DM, lane);
        for (int i = bx * NTHR + tid; i < SEQ * 64; i += G * NTHR) { const int pos = i >> 6, j = i & 63;
            const float inv = exp2f(-(float)j * (13.287712379549449f / 64.0f)); const float ang = (float)pos * inv;
            cosT[i] = cosf(ang); sinT[i] = sinf(ang); }
    }
    SEAM(0);

    if (IN(1)) {
        { pg8::Gemm g{XB, Wt_in, nullptr, nullptr, M, INW, DM}; pg8::StaticOrder S; S.init(M, INW, G, bx);
          pg8::EpiIn E{ZA, ZG, cosT, sinT, b_gate, 0.08838834764831845f, rs1};
          pg8::gemm_phase<pg8::EpiIn, pg8::StaticOrder>(lds, g, S, E); }
        { pg8::Gemm g{MEMN, Wt_ckv, nullptr, nullptr, MROWS, 1024, DM}; pg8::StaticOrder S; S.init(MROWS, 1024, G, (bx + G / 2) % G);
          pg8::EpiBf16 E{MEMKV, 1024};
          pg8::gemm_phase<pg8::EpiBf16, pg8::StaticOrder>(lds, g, S, E); }
        { pg8::Gemm g{Wt_cq, WOB, nullptr, nullptr, 512, DM, DM}; pg8::StaticOrder S; S.init(512, DM, G, (bx + G / 2 - 32 + G) % G);
          pg8::EpiBf16 E{WOQ, DM};
          pg8::gemm_phase<pg8::EpiBf16, pg8::StaticOrder>(lds, g, S, E); }
        if (G == 256 ? bx >= 176 : true) {
            __syncthreads();
            LAS float* scr = (LAS float*)(lds + wave * 16384);
            constexpr int I_G = (DM / 64) * (DFF / 32), I_D = (DFF / 64) * (DM / 32), NF = 2 * I_G + I_D;
            const int fw = (G == 256 ? (bx - 176) : bx) * NWAVES + wave, NFW = (G == 256 ? 80 : G) * NWAVES;
#define P1_PICK(t, itx) do { int r = (itx); \
            if (r < I_G) { t = TItem{w_gate, Wt_gu, g_ffn, DM, DFF, 1, r}; break; } r -= I_G; \
            if (r < I_G) { t = TItem{w_up, Wt_gu, g_ffn, DM, DFF, 2, r}; break; } r -= I_G; \
            t = TItem{w_down, Wt_dn, nullptr, DFF, DM, 0, r}; } while (0)
            for (int it = fw; it < NF; it += 4 * NFW) {
                TItem t0, t1, t2, t3; f32x4 v0[8], v1[8], v2[8], v3[8]; const bool h1 = it + NFW < NF, h2 = it + 2 * NFW < NF, h3 = it + 3 * NFW < NF;
                P1_PICK(t0, it); p0_t_load(t0, v0, lane);
                if (h1) { P1_PICK(t1, it + NFW); p0_t_load(t1, v1, lane); }
                if (h2) { P1_PICK(t2, it + 2 * NFW); p0_t_load(t2, v2, lane); }
                if (h3) { P1_PICK(t3, it + 3 * NFW); p0_t_load(t3, v3, lane); }
                p0_t_store(t0, v0, scr, lane);
                if (h1) p0_t_store(t1, v1, scr, lane);
                if (h2) p0_t_store(t2, v2, scr, lane);
                if (h3) p0_t_store(t3, v3, scr, lane);
            }
#undef P1_PICK
        }
    }
    SEAM(1);

    if (IN(2)) {
        for (int it = 2 * bx; it < 512; it += 2 * G)
            for (int hp = 0; hp < 2; ++hp) { const int kvh = it >> 1 & 1, nb = (it >> 2) & 15, b = it >> 6;
                const int hq = kvh * 4 + hp * 2 + (wave >> 2), t0 = b * SEQ + nb * 128 + (wave & 3) * 32;
                const int kb0 = nb > 0 ? nb - 1 : 0, kb1 = nb < 15 ? nb + 1 : 15; const size_t kt0 = (size_t)b * SEQ + kb0 * 128;
                attn_unit<true>(lds, ZA + (size_t)t0 * ZAW + hq * 128, ZAW, ZA + kt0 * ZAW + 1024 + kvh * 128, ZA + kt0 * ZAW + 1280 + kvh * 128, ZAW, kb1 - kb0 + 1,
                                nb * 128 + (wave & 3) * 32, kb0 * 128, sink[hq], 1.0f, 1.0f, AO + (size_t)t0 * 1024 + hq * 128, 1024, tid, lane); }
        __syncthreads();
        for (int idx = bx * NTHR + tid; idx < (M / 16) * 128; idx += G * NTHR) { const int run = idx >> 7, c8 = (idx & 127) * 8, t0 = run * 16, s0 = t0 & (SEQ - 1);
            const f32x4 w0a = *(const f32x4*)(conv_w + c8), w0b = *(const f32x4*)(conv_w + c8 + 4), w1a = *(const f32x4*)(conv_w + 1024 + c8), w1b = *(const f32x4*)(conv_w + 1024 + c8 + 4),
                        w2a = *(const f32x4*)(conv_w + 2048 + c8), w2b = *(const f32x4*)(conv_w + 2048 + c8 + 4);
            const bf16* zr = ZA + (size_t)t0 * ZAW + c8;
            f32x4 pa = {0.f, 0.f, 0.f, 0.f}, pb = pa, ca, cb;
            if (s0 > 0) pg8::unpack8(*(const v4u*)(zr - ZAW + 1536), pa, pb);
            pg8::unpack8(*(const v4u*)(zr + 1536), ca, cb);
#pragma unroll
            for (int i = 0; i < 16; ++i) { f32x4 na = {0.f, 0.f, 0.f, 0.f}, nbv = na, ga, gb;
                if (i < 15 || s0 + 16 < SEQ) pg8::unpack8(*(const v4u*)(zr + (size_t)(i + 1) * ZAW + 1536), na, nbv);
                pg8::unpack8(*(const v4u*)(zr + (size_t)i * ZAW + 2560), ga, gb);
                *(v4u*)(CV + (size_t)(t0 + i) * 1024 + c8) = pg8::pack8(ga * (w0a * pa + w1a * ca + w2a * na), gb * (w0b * pb + w1b * cb + w2b * nbv));
                pa = ca; pb = cb; ca = na; cb = nbv; }
        }
    }
    SEAM(2);

    if (IN(3)) {
        pg8::Gemm g{AO, Wt_a, CV, Wt_c, M, DM, 1024}; pg8::StaticOrder S; S.init(M, DM, G, bx, 2);
        pg8::EpiMerge E{ZG, MG};
        pg8::gemm_phase<pg8::EpiMerge, pg8::StaticOrder>(lds, g, S, E);
    }
    SEAM(3);

    if (IN(4)) {
        { pg8::Gemm g{XB, Wt_cq, MG, WOQ, M, 512, DM}; pg8::ListOrder S{bx, bx < 128 ? 1 : 0, 2, 2};
          pg8::EpiAcc2 E{QC, 512};
          pg8::gemm_phase<pg8::EpiAcc2, pg8::ListOrder>(lds, g, S, E); }
        { pg8::Gemm g{MG, Wt_o, nullptr, nullptr, M, DM, DM}; pg8::ListOrder S{bx < 128 ? bx : 128 + (bx - 128) * 3, bx < 128 ? 1 : 3, 8, 1};
          pg8::EpiResB E{XB, X1B, ssq2, xch};
          pg8::gemm_phase<pg8::EpiResB, pg8::ListOrder>(lds, g, S, E); }
    }
    SEAM(4);

    if (IN(6)) {
        for (int it = bx; it < 256; it += G) { const int rb = it & 7, hh = (it >> 3) & 3, b = it >> 5; const int t0 = b * SEQ + rb * 256 + wave * 32;
            attn_unit<false>(lds, QC + (size_t)t0 * 512 + hh * 128, 512, MEMKV + (size_t)(b * NMEM) * 1024 + hh * 128, MEMKV + (size_t)(b * NMEM) * 1024 + 512 + hh * 128, 1024, 2,
                             0, 0, -1e30f, 0.0f, pg8::row_rs(ssq2, t0 + (lane & 31)) * 0.08838834764831845f, CO + (size_t)t0 * 512 + hh * 128, 512, tid, lane); }
    }
    SEAM(6);

    if (IN(7)) {
        pg8::Gemm g{CO, Wt_co, nullptr, nullptr, M, DM, 512}; pg8::StaticOrder S; S.init(M, DM, G, bx);
        pg8::EpiResB E{X1B, X2B, ssq3, xch};
        pg8::gemm_phase<pg8::EpiResB, pg8::StaticOrder>(lds, g, S, E);
    }
    SEAM(7);

    if (IN(8)) {
        pg8::Gemm g{X2B, Wt_gu, nullptr, nullptr, M, 2 * DFF, DM}; pg8::StaticOrder S; S.init(M, 2 * DFF, G, bx);
        pg8::EpiSwiGLU E{ACT, ssq3};
        pg8::gemm_phase<pg8::EpiSwiGLU, pg8::StaticOrder>(lds, g, S, E);
    }
    SEAM(8);

    if (IN(9)) {
        pg8::Gemm g{ACT, Wt_dn, nullptr, nullptr, M, DM, DFF}; pg8::PanelOrder S{bx};
        pg8::EpiFinal E{X2B, out, g_final, ssq4, (unsigned*)(ws + WS_PCNT), xch};
        pg8::gemm_phase<pg8::EpiFinal, pg8::PanelOrder>(lds, g, S, E);
    }
#if defined(MK_DUMP_OFF)
    if (hi == MK_CUT && MK_CUT < 11) {
        asm volatile("s_waitcnt vmcnt(0) lgkmcnt(0)" ::: "memory"); __syncthreads(); grid.sync();
        const bf16* src = (const bf16*)(ws + (size_t)(MK_DUMP_OFF));
        for (size_t i = (size_t)bx * NTHR + tid; i < (size_t)M * 2048; i += (size_t)G * NTHR) { const size_t r = i >> 11, c = i & 2047; out[i] = __uint_as_float((unsigned)src[r * (MK_DUMP_LD) + (c % (MK_DUMP_W)) + (c / (MK_DUMP_W)) * (size_t)(MK_DUMP_OFF2)] << 16); }
    }
#endif
#undef IN
#undef SEAM
}

extern "C" void kernel_launch(void* const* d_in, const int* in_sizes, int n_in, void* d_out, int out_size, void* d_ws, size_t ws_size, hipStream_t stream) {
    static int grid = 0;
    if (grid == 0) {
        if (n_in != 20 || in_sizes[0] != M * DM || out_size != M * DM || ws_size < WS_END) { fprintf(stderr, "kernel_launch: unexpected shapes / workspace (n_in %d, ws %zu)\n", n_in, ws_size); grid = -1; return; }
        int dev = 0, cus = 0, per_cu = 0;
        if (hipGetDevice(&dev) != hipSuccess || hipDeviceGetAttribute(&cus, hipDeviceAttributeMultiprocessorCount, dev) != hipSuccess) { grid = -1; return; }
        if (hipFuncSetAttribute((const void*)mk_fwd, hipFuncAttributeMaxDynamicSharedMemorySize, LDS_BYTES) != hipSuccess) { fprintf(stderr, "kernel_launch: hipFuncSetAttribute failed\n"); grid = -1; return; }
        if (hipOccupancyMaxActiveBlocksPerMultiprocessor(&per_cu, (const void*)mk_fwd, NTHR, LDS_BYTES) != hipSuccess || per_cu < 1) { fprintf(stderr, "kernel_launch: occupancy query says %d\n", per_cu); (void)hipGetLastError(); grid = -1; return; }
        grid = cus;
    }
    if (grid < 0) return;
    Args a{};
    for (int i = 0; i < 20; ++i) a.in[i] = (const float*)d_in[i];
    a.out = (float*)d_out; a.ws = (unsigned char*)d_ws;
    if (hipMemsetAsync((char*)d_ws + WS_BAR, 0, WS_BAR_BYTES, stream) != hipSuccess) { fprintf(stderr, "kernel_launch: hipMemsetAsync of the barrier words failed\n"); return; }
#if defined(MK_PROBE_DUP)
    { void* kargs[] = {&a}; a.ph_lo = 0; a.ph_hi = MK_PROBE_DUP + 1; hipLaunchCooperativeKernel((const void*)mk_fwd, dim3(grid), dim3(NTHR), kargs, LDS_BYTES, stream);
      a.ph_lo = MK_PROBE_DUP; a.ph_hi = 11; a.li = 1; hipLaunchCooperativeKernel((const void*)mk_fwd, dim3(grid), dim3(NTHR), kargs, LDS_BYTES, stream); }
#elif MK_N_LAUNCHES == 1
    a.ph_lo = 0; a.ph_hi = MK_CUT;
    void* kargs[] = {&a};
    hipError_t e = hipLaunchCooperativeKernel((const void*)mk_fwd, dim3(grid), dim3(NTHR), kargs, LDS_BYTES, stream);
    if (e != hipSuccess) fprintf(stderr, "kernel_launch: cooperative launch failed: %s (grid %d)\n", hipGetErrorString(e), grid);
#else
    for (int p = 0; p < 11; ++p) { a.ph_lo = p; a.ph_hi = p + 1; hipLaunchKernelGGL(mk_fwd, dim3(grid), dim3(NTHR), LDS_BYTES, stream, a); }
#endif
}
```

```cpp
#include <hip/hip_runtime.h>
#include <hip/hip_cooperative_groups.h>
#include <cstdio>
#include <cstdint>
namespace cg = cooperative_groups;

#ifndef MK_CUT
#define MK_CUT 11
#endif
#ifndef MK_N_LAUNCHES
#define MK_N_LAUNCHES 1
#endif

namespace pg8 {
#define PG8_LAS __attribute__((address_space(3)))
typedef unsigned short bf16_t;
typedef short bf16x8 __attribute__((ext_vector_type(8)));
typedef float f32x4 __attribute__((ext_vector_type(4)));
typedef unsigned u32x4 __attribute__((ext_vector_type(4)));
constexpr int BM = 256, BK = 64, HALF = 128, HTB = HALF * BK * 2, STAGE_BYTES = 8 * HTB, NXCD = 8, WGM = 8;

__host__ __device__ __forceinline__ int lds_byte(int r, int c) { const int st = (r >> 4) * 2 + (c >> 5), rr = r & 15, cc = c & 31, ob = rr * 64 + cc * 2; return st * 1024 + (ob ^ (((ob >> 9) & 1) << 5)); }
__host__ __device__ __forceinline__ void stage_rc(int b, int& R, int& C) { const int st = b / 1024, sb = b % 1024, swz = sb ^ (((sb >> 9) & 1) << 5); R = (st >> 1) * 16 + swz / 64; C = (st & 1) * 32 + (swz % 64) / 2; }
__host__ __device__ __forceinline__ int perm32(int rho) { const int n = rho >> 4, i = rho & 15; return 8 * (i >> 2) + 4 * n + (i & 3); }

struct Unit { int pm, pn, seg; };
struct Gemm { const bf16_t* A0; const bf16_t* B0; const bf16_t* A1; const bf16_t* B1; int M, N, K; };

struct StaticOrder {
    int nM, nN, nwg, G, c, nseg;
    __device__ void init(int M, int N, int G_, int c_, int nseg_ = 1) { nM = M / BM; nN = N / BM; nwg = nM * nN; G = G_; c = c_; nseg = nseg_; }
    __device__ bool next(int i, Unit& u) const {
        const int j = (nseg == 2) ? (i >> 1) : i; u.seg = (nseg == 2) ? (i & 1) : 0;
        const long L = (long)j * G + c; if (L >= nwg) return false;
        int wgid = (int)L; { const int q = nwg / NXCD, r = nwg % NXCD, xcd = wgid % NXCD, off = wgid / NXCD; wgid = (xcd < r ? xcd * (q + 1) : r * (q + 1) + (xcd - r) * q) + off; }
        const int nig = WGM * nN, gid = wgid / nig, fm = gid * WGM, gsz = (nM - fm) < WGM ? (nM - fm) : WGM;
        u.pm = fm + ((wgid % nig) % gsz); u.pn = (wgid % nig) / gsz; return true;
    }
};

typedef __bf16 bf16x2_t __attribute__((ext_vector_type(2)));
typedef float f32x2_t __attribute__((ext_vector_type(2)));
struct ListOrder {
    int first, count, nN, nseg;
    __device__ bool next(int i, Unit& u) const { const int j = (nseg == 2) ? (i >> 1) : i; u.seg = (nseg == 2) ? (i & 1) : 0; if (j >= count) return false; const int L = first + j; u.pm = L / nN; u.pn = L % nN; return true; }
};
struct PanelOrder {
    int c;
    __device__ bool next(int i, Unit& u) const { u.seg = 0; if (i >= 2) return false; const int q = c >> 3; u.pm = i * 32 + (c & 7) * 4 + (q >> 3); u.pn = q & 7; return true; }
};
__device__ __forceinline__ unsigned cvt_pk_bf16(float lo, float hi) { const f32x2_t v = {lo, hi}; const bf16x2_t r = __builtin_convertvector(v, bf16x2_t); return __builtin_bit_cast(unsigned, r); }
__device__ __forceinline__ u32x4 pack8(const f32x4 a, const f32x4 b) { u32x4 w; w.x = cvt_pk_bf16(a[0], a[1]); w.y = cvt_pk_bf16(a[2], a[3]); w.z = cvt_pk_bf16(b[0], b[1]); w.w = cvt_pk_bf16(b[2], b[3]); return w; }
__device__ __forceinline__ void unpack8(const u32x4 w, f32x4& a, f32x4& b) {
    a[0] = __uint_as_float(w.x << 16); a[1] = __uint_as_float(w.x & 0xffff0000u); a[2] = __uint_as_float(w.y << 16); a[3] = __uint_as_float(w.y & 0xffff0000u);
    b[0] = __uint_as_float(w.z << 16); b[1] = __uint_as_float(w.z & 0xffff0000u); b[2] = __uint_as_float(w.w << 16); b[3] = __uint_as_float(w.w & 0xffff0000u); }
__device__ __forceinline__ f32x4 sigmoid4(const f32x4 v) { f32x4 o;
#pragma unroll
    for (int i = 0; i < 4; ++i) o[i] = __builtin_amdgcn_rcpf(1.0f + __expf(-v[i]));
    return o; }

typedef f32x4 Acc[2][2][4][2];

struct EpiBf16 {
    static constexpr bool PERM = true, KEEP_ACC = false;
    bf16_t* O; int ldc;
    __device__ __forceinline__ void operator()(Acc& acc, const Unit& u, int wr, int wc, int fr, int fq) const {
        const int row0 = u.pm * BM + wr * 64 + fr, col0 = u.pn * BM + wc * 32 + 8 * fq;
#pragma unroll
        for (int ai = 0; ai < 2; ++ai)
#pragma unroll
            for (int m = 0; m < 4; ++m) { bf16_t* rowp = O + (size_t)(row0 + ai * HALF + m * 16) * ldc + col0;
#pragma unroll
                for (int bj = 0; bj < 2; ++bj) *(u32x4*)(rowp + bj * HALF) = pack8(acc[ai][bj][m][0], acc[ai][bj][m][1]); }
    }
};
struct EpiIn {
    static constexpr bool PERM = true, KEEP_ACC = false;
    bf16_t* ZA; bf16_t* ZG; const float* cosT; const float* sinT; const float* bgate; float qscale; const float* rs1;
    __device__ __forceinline__ void operator()(Acc& acc, const Unit& u, int wr, int wc, int fr, int fq) const {
        const int row0 = u.pm * BM + wr * 64 + fr;
#pragma unroll
        for (int ai = 0; ai < 2; ++ai)
#pragma unroll
            for (int m = 0; m < 4; ++m) { const float rs = rs1[row0 + ai * HALF + m * 16];
#pragma unroll
                for (int bj = 0; bj < 2; ++bj) { acc[ai][bj][m][0] = acc[ai][bj][m][0] * rs; acc[ai][bj][m][1] = acc[ai][bj][m][1] * rs; } }
        if (u.pn < 5) {
            const int p = wc * 32 + 8 * fq, hb = p >> 6, j0 = p & 63, c1 = u.pn * 256 + hb * 128 + j0;
            const float sc = u.pn < 4 ? qscale : 1.0f;
#pragma unroll
            for (int ai = 0; ai < 2; ++ai)
#pragma unroll
                for (int m = 0; m < 4; ++m) { const int row = row0 + ai * HALF + m * 16, pos = row & 2047;
                    const f32x4 ca = *(const f32x4*)(cosT + pos * 64 + j0), cb = *(const f32x4*)(cosT + pos * 64 + j0 + 4);
                    const f32x4 sa = *(const f32x4*)(sinT + pos * 64 + j0), sb = *(const f32x4*)(sinT + pos * 64 + j0 + 4);
                    const f32x4 t1a = acc[ai][0][m][0], t1b = acc[ai][0][m][1], t2a = acc[ai][1][m][0], t2b = acc[ai][1][m][1];
                    const f32x4 o1a = (t1a * ca - t2a * sa) * sc, o1b = (t1b * cb - t2b * sb) * sc, o2a = (t2a * ca + t1a * sa) * sc, o2b = (t2b * cb + t1b * sb) * sc;
                    bf16_t* rp = ZA + (size_t)row * 4608 + c1;
                    __builtin_nontemporal_store(pack8(o1a, o1b), (u32x4*)(rp)); __builtin_nontemporal_store(pack8(o2a, o2b), (u32x4*)(rp + 64)); }
        } else if (u.pn == 5 || u.pn >= 14 && u.pn < 18) {
            const int col0 = (u.pn == 5 ? 1280 : 2560 + (u.pn - 14) * BM) + wc * 32 + 8 * fq;
#pragma unroll
            for (int ai = 0; ai < 2; ++ai)
#pragma unroll
                for (int m = 0; m < 4; ++m) { bf16_t* rowp = ZA + (size_t)(row0 + ai * HALF + m * 16) * 4608 + col0;
#pragma unroll
                    for (int bj = 0; bj < 2; ++bj) __builtin_nontemporal_store(pack8(acc[ai][bj][m][0], acc[ai][bj][m][1]), (u32x4*)(rowp + bj * HALF)); }
        } else if (u.pn < 14) {
            const int col0 = 1536 + (u.pn - 6) * HALF + wc * 32 + 8 * fq;
#pragma unroll
            for (int ai = 0; ai < 2; ++ai)
#pragma unroll
                for (int m = 0; m < 4; ++m) __builtin_nontemporal_store(pack8(acc[ai][0][m][0] * acc[ai][1][m][0], acc[ai][0][m][1] * acc[ai][1][m][1]), (u32x4*)(ZA + (size_t)(row0 + ai * HALF + m * 16) * 4608 + col0));
        } else {
            const int ch0 = (u.pn - 18) * HALF + wc * 32 + 8 * fq;
            const f32x4 ba0 = *(const f32x4*)(bgate + ch0), ba1 = *(const f32x4*)(bgate + ch0 + 4), bc0 = *(const f32x4*)(bgate + 2048 + ch0), bc1 = *(const f32x4*)(bgate + 2048 + ch0 + 4);
#pragma unroll
            for (int ai = 0; ai < 2; ++ai)
#pragma unroll
                for (int m = 0; m < 4; ++m) { bf16_t* rowp = ZG + (size_t)(row0 + ai * HALF + m * 16) * 4096 + ch0;
                    const f32x4 a0 = acc[ai][0][m][0] + ba0, a1 = acc[ai][0][m][1] + ba1, c0 = acc[ai][1][m][0] + bc0, c1 = acc[ai][1][m][1] + bc1;
                    f32x4 r0, r1, g0, g1;
#pragma unroll
                    for (int i = 0; i < 4; ++i) { const float ec0 = 1.0f + __expf(-c0[i]), ec1 = 1.0f + __expf(-c1[i]);
                        g0[i] = __builtin_amdgcn_rcpf(ec0); g1[i] = __builtin_amdgcn_rcpf(ec1);
                        r0[i] = ec0 * __builtin_amdgcn_rcpf(1.0f + __expf(-a0[i])); r1[i] = ec1 * __builtin_amdgcn_rcpf(1.0f + __expf(-a1[i])); }
                    __builtin_nontemporal_store(pack8(r0, r1), (u32x4*)(rowp)); __builtin_nontemporal_store(pack8(g0, g1), (u32x4*)(rowp + 2048)); }
        }
    }
};
struct EpiAcc2 {
    static constexpr bool PERM = true, KEEP_ACC = true;
    bf16_t* O; int ldc;
    __device__ __forceinline__ void operator()(Acc& acc, const Unit& u, int wr, int wc, int fr, int fq) const {
        if (u.seg == 0) return;
        const int row0 = u.pm * BM + wr * 64 + fr, col0 = u.pn * BM + wc * 32 + 8 * fq;
#pragma unroll
        for (int ai = 0; ai < 2; ++ai)
#pragma unroll
            for (int m = 0; m < 4; ++m) { bf16_t* rowp = O + (size_t)(row0 + ai * HALF + m * 16) * ldc + col0;
#pragma unroll
                for (int bj = 0; bj < 2; ++bj) *(u32x4*)(rowp + bj * HALF) = pack8(acc[ai][bj][m][0], acc[ai][bj][m][1]); }
    }
};
struct EpiMerge {
    static constexpr bool PERM = true, KEEP_ACC = true;
    const bf16_t* ZG; bf16_t* O;
    __device__ __forceinline__ void operator()(Acc& acc, const Unit& u, int wr, int wc, int fr, int fq) const {
        const int row0 = u.pm * BM + wr * 64 + fr, col0 = u.pn * BM + wc * 32 + 8 * fq;
#pragma unroll
        for (int ai = 0; ai < 2; ++ai)
#pragma unroll
            for (int m = 0; m < 4; ++m) { const int row = row0 + ai * HALF + m * 16;
#pragma unroll
                for (int bj = 0; bj < 2; ++bj) { const bf16_t* gp = ZG + (size_t)row * 4096 + col0 + bj * HALF;
                    if (u.seg == 0) { f32x4 a0, a1; unpack8(*(const u32x4*)gp, a0, a1); acc[ai][bj][m][0] = acc[ai][bj][m][0] * a0; acc[ai][bj][m][1] = acc[ai][bj][m][1] * a1; }
                    else { f32x4 c0, c1; unpack8(*(const u32x4*)(gp + 2048), c0, c1); *(u32x4*)(O + (size_t)row * 2048 + col0 + bj * HALF) = pack8(acc[ai][bj][m][0] * c0, acc[ai][bj][m][1] * c1); } } }
    }
};
struct EpiRes {
    static constexpr bool PERM = true, KEEP_ACC = false;
    const float* base; float* out; bf16_t* outb; float* part; PG8_LAS float* xch;
    __device__ __forceinline__ void operator()(Acc& acc, const Unit& u, int wr, int wc, int fr, int fq) const {
        const int row0 = u.pm * BM + wr * 64 + fr, col0 = u.pn * BM + wc * 32 + 8 * fq;
#pragma unroll
        for (int ai = 0; ai < 2; ++ai)
#pragma unroll
            for (int m = 0; m < 4; ++m) { const int row = row0 + ai * HALF + m * 16; float ss = 0.f;
#pragma unroll
                for (int bj = 0; bj < 2; ++bj) { const size_t off = (size_t)row * 2048 + col0 + bj * HALF;
                    const f32x4 o0 = *(const f32x4*)(base + off) + acc[ai][bj][m][0], o1 = *(const f32x4*)(base + off + 4) + acc[ai][bj][m][1];
                    *(f32x4*)(out + off) = o0; *(f32x4*)(out + off + 4) = o1;
                    if (outb) *(u32x4*)(outb + off) = pack8(o0, o1);
                    ss += (o0[0] * o0[0] + o0[1] * o0[1]) + (o0[2] * o0[2] + o0[3] * o0[3]) + (o1[0] * o1[0] + o1[1] * o1[1]) + (o1[2] * o1[2] + o1[3] * o1[3]); }
                ss += __shfl_xor(ss, 16); ss += __shfl_xor(ss, 32);
                if (fq == 0) xch[(ai * HALF + wr * 64 + m * 16 + fr) * 4 + wc] = ss; }
        asm volatile("s_waitcnt lgkmcnt(0)" ::: "memory"); __builtin_amdgcn_s_barrier(); asm volatile("" ::: "memory");
        { const int t = threadIdx.x; if (t < 256) { const f32x4 v = *(const PG8_LAS f32x4*)(xch + t * 4); part[(size_t)(u.pm * BM + t) * 8 + u.pn] = (v[0] + v[1]) + (v[2] + v[3]); } }
        asm volatile("s_waitcnt lgkmcnt(0)" ::: "memory"); __builtin_amdgcn_s_barrier(); asm volatile("" ::: "memory");
    }
};
struct EpiResB {
    static constexpr bool PERM = true, KEEP_ACC = false;
    const bf16_t* base; bf16_t* outb; float* part; PG8_LAS float* xch;
    __device__ __forceinline__ void operator()(Acc& acc, const Unit& u, int wr, int wc, int fr, int fq) const {
        const int row0 = u.pm * BM + wr * 64 + fr, col0 = u.pn * BM + wc * 32 + 8 * fq;
#pragma unroll
        for (int ai = 0; ai < 2; ++ai)
#pragma unroll
            for (int m = 0; m < 4; ++m) { const int row = row0 + ai * HALF + m * 16; float ss = 0.f;
#pragma unroll
                for (int bj = 0; bj < 2; ++bj) { const size_t off = (size_t)row * 2048 + col0 + bj * HALF;
                    f32x4 b0, b1; unpack8(*(const u32x4*)(base + off), b0, b1);
                    const f32x4 o0 = b0 + acc[ai][bj][m][0], o1 = b1 + acc[ai][bj][m][1];
                    *(u32x4*)(outb + off) = pack8(o0, o1);
                    ss += (o0[0] * o0[0] + o0[1] * o0[1]) + (o0[2] * o0[2] + o0[3] * o0[3]) + (o1[0] * o1[0] + o1[1] * o1[1]) + (o1[2] * o1[2] + o1[3] * o1[3]); }
                ss += __shfl_xor(ss, 16); ss += __shfl_xor(ss, 32);
                if (fq == 0) xch[(ai * HALF + wr * 64 + m * 16 + fr) * 4 + wc] = ss; }
        asm volatile("s_waitcnt lgkmcnt(0)" ::: "memory"); __builtin_amdgcn_s_barrier(); asm volatile("" ::: "memory");
        { const int t = threadIdx.x; if (t < 256) { const f32x4 v = *(const PG8_LAS f32x4*)(xch + t * 4); part[(size_t)(u.pm * BM + t) * 8 + u.pn] = (v[0] + v[1]) + (v[2] + v[3]); } }
        asm volatile("s_waitcnt lgkmcnt(0)" ::: "memory"); __builtin_amdgcn_s_barrier(); asm volatile("" ::: "memory");
    }
};
struct EpiFinal {
    static constexpr bool PERM = true, KEEP_ACC = false;
    const bf16_t* base; float* out; const float* gfin; float* part; unsigned* cnt; PG8_LAS float* xch;
    __device__ __forceinline__ void operator()(Acc& acc, const Unit& u, int wr, int wc, int fr, int fq) const {
        const int row0 = u.pm * BM + wr * 64 + fr, col0 = u.pn * BM + wc * 32 + 8 * fq;
        const int tid = threadIdx.x, wid = __builtin_amdgcn_readfirstlane(tid >> 6), lane = tid & 63;
        PG8_LAS float* S = xch + 1024; PG8_LAS unsigned* flag = (PG8_LAS unsigned*)(xch + 1024 + 256);
#pragma unroll
        for (int ai = 0; ai < 2; ++ai)
#pragma unroll
            for (int m = 0; m < 4; ++m) { const int row = row0 + ai * HALF + m * 16; float ss = 0.f;
#pragma unroll
                for (int bj = 0; bj < 2; ++bj) { f32x4 b0, b1; unpack8(*(const u32x4*)(base + (size_t)row * 2048 + col0 + bj * HALF), b0, b1);
                    const f32x4 o0 = b0 + acc[ai][bj][m][0], o1 = b1 + acc[ai][bj][m][1]; acc[ai][bj][m][0] = o0; acc[ai][bj][m][1] = o1;
                    ss += (o0[0] * o0[0] + o0[1] * o0[1]) + (o0[2] * o0[2] + o0[3] * o0[3]) + (o1[0] * o1[0] + o1[1] * o1[1]) + (o1[2] * o1[2] + o1[3] * o1[3]); }
                ss += __shfl_xor(ss, 16); ss += __shfl_xor(ss, 32);
                if (fq == 0) xch[(ai * HALF + wr * 64 + m * 16 + fr) * 4 + wc] = ss; }
        asm volatile("s_waitcnt lgkmcnt(0)" ::: "memory"); __builtin_amdgcn_s_barrier(); asm volatile("" ::: "memory");
        if (tid < 256) { const f32x4 v = *(const PG8_LAS f32x4*)(xch + tid * 4);
            __hip_atomic_store(part + (size_t)(u.pm * BM + tid) * 8 + u.pn, (v[0] + v[1]) + (v[2] + v[3]), __ATOMIC_RELAXED, __HIP_MEMORY_SCOPE_AGENT);
            asm volatile("s_waitcnt vmcnt(0)" ::: "memory");
            if (lane == 0) __hip_atomic_fetch_add(cnt + 64 * u.pm, 1u, __ATOMIC_RELAXED, __HIP_MEMORY_SCOPE_AGENT); }
        if (wid == 0) { unsigned dead = 0u, sp = 0u;
            while ((unsigned)__builtin_amdgcn_readfirstlane(__hip_atomic_load(cnt + 64 * u.pm, __ATOMIC_RELAXED, __HIP_MEMORY_SCOPE_AGENT)) < 32u) { __builtin_amdgcn_s_sleep(2); if (++sp > (1u << 20)) { dead = 1u; break; } }
            __builtin_amdgcn_fence(__ATOMIC_ACQUIRE, "agent");
            if (lane == 0) flag[0] = dead; }
        asm volatile("s_waitcnt vmcnt(0) lgkmcnt(0)" ::: "memory"); __builtin_amdgcn_s_barrier(); asm volatile("" ::: "memory");
        if (tid < 256) { const float* p = part + (size_t)(u.pm * BM + tid) * 8; float t = 0.f;
#pragma unroll
            for (int j = 0; j < 8; ++j) t += __hip_atomic_load(p + j, __ATOMIC_RELAXED, __HIP_MEMORY_SCOPE_AGENT);
            S[tid] = (flag[0] != 0u) ? __builtin_nanf("") : __builtin_amdgcn_rsqf(t * (1.0f / 2048.0f) + 1e-6f); }
        asm volatile("s_waitcnt vmcnt(0) lgkmcnt(0)" ::: "memory"); __builtin_amdgcn_s_barrier(); asm volatile("" ::: "memory");
        f32x4 gv[2][2];
#pragma unroll
        for (int bj = 0; bj < 2; ++bj) { gv[bj][0] = *(const f32x4*)(gfin + col0 + bj * HALF); gv[bj][1] = *(const f32x4*)(gfin + col0 + bj * HALF + 4); }
#pragma unroll
        for (int ai = 0; ai < 2; ++ai)
#pragma unroll
            for (int m = 0; m < 4; ++m) { const int rl = ai * HALF + wr * 64 + m * 16 + fr; const float rs = S[rl]; float* orow = out + (size_t)(u.pm * BM + rl) * 2048 + col0;
#pragma unroll
                for (int bj = 0; bj < 2; ++bj) { *(f32x4*)(orow + bj * HALF) = acc[ai][bj][m][0] * rs * gv[bj][0]; *(f32x4*)(orow + bj * HALF + 4) = acc[ai][bj][m][1] * rs * gv[bj][1]; } }
        asm volatile("s_waitcnt lgkmcnt(0)" ::: "memory"); __builtin_amdgcn_s_barrier(); asm volatile("" ::: "memory");
    }
};
__device__ __forceinline__ float row_rs(const float* part, int row) { const f32x4 a = *(const f32x4*)(part + (size_t)row * 8), b = *(const f32x4*)(part + (size_t)row * 8 + 4);
    return __builtin_amdgcn_rsqf((((a[0] + a[1]) + (a[2] + a[3])) + ((b[0] + b[1]) + (b[2] + b[3]))) * (1.0f / 2048.0f) + 1e-6f); }
struct EpiRowScale {
    static constexpr bool PERM = true, KEEP_ACC = false;
    bf16_t* O; int ldc; const float* ssq; float scale;
    __device__ __forceinline__ void operator()(Acc& acc, const Unit& u, int wr, int wc, int fr, int fq) const {
        const int row0 = u.pm * BM + wr * 64 + fr, col0 = u.pn * BM + wc * 32 + 8 * fq;
#pragma unroll
        for (int ai = 0; ai < 2; ++ai)
#pragma unroll
            for (int m = 0; m < 4; ++m) { const int row = row0 + ai * HALF + m * 16; const float rs = row_rs(ssq, row) * scale;
                bf16_t* rowp = O + (size_t)row * ldc + col0;
#pragma unroll
                for (int bj = 0; bj < 2; ++bj) *(u32x4*)(rowp + bj * HALF) = pack8(acc[ai][bj][m][0] * rs, acc[ai][bj][m][1] * rs); }
    }
};
struct EpiSwiGLU {
    static constexpr bool PERM = true, KEEP_ACC = false;
    bf16_t* O; const float* ssq;
    __device__ __forceinline__ void operator()(Acc& acc, const Unit& u, int wr, int wc, int fr, int fq) const {
        const int row0 = u.pm * BM + wr * 64 + fr, col0 = u.pn * HALF + wc * 32 + 8 * fq;
#pragma unroll
        for (int ai = 0; ai < 2; ++ai)
#pragma unroll
            for (int m = 0; m < 4; ++m) { const int row = row0 + ai * HALF + m * 16; const float rs = row_rs(ssq, row);
                const f32x4 g0 = acc[ai][0][m][0] * rs, g1 = acc[ai][0][m][1] * rs, u0 = acc[ai][1][m][0] * rs, u1 = acc[ai][1][m][1] * rs;
                __builtin_nontemporal_store(pack8(g0 * sigmoid4(g0) * u0, g1 * sigmoid4(g1) * u1), (u32x4*)(O + (size_t)row * 5632 + col0)); }
    }
};

template <class Epi, class Sched, bool ALIGN_EPI = true>
__device__ __forceinline__ void gemm_phase(PG8_LAS unsigned char* lds, const Gemm g, const Sched& S, const Epi& E) {
    const int tid = threadIdx.x, wid = __builtin_amdgcn_readfirstlane(tid >> 6), lane = tid & 63, wr = wid >> 2, wc = wid & 3, fr = lane & 15, fq = lane >> 4;
    const int K = g.K, nt = K / BK;
    unsigned voffA[2], voffB[2];
#pragma unroll
    for (int i = 0; i < 2; ++i) { int R, C; stage_rc(tid * 16 + i * 8192, R, C); const int Rb = Epi::PERM ? ((R & ~31) + perm32(R & 31)) : R;
        voffA[i] = (unsigned)(R * K + C) * 2u; voffB[i] = (unsigned)(Rb * K + C) * 2u; }
    const size_t kstep = (size_t)(BK * 2);
    const size_t hstep = (size_t)HALF * K * 2;
    const size_t tstep = 2 * hstep;
    const unsigned ldsw = (unsigned)wid * 1024u;
    const int aoff = lds_byte(wr * 64 + fr, fq * 8), boff = lds_byte(wc * 32 + fr, fq * 8);
#define PG8_SA(b, h) (((b) * 2 + (h)) * HTB)
#define PG8_SB(b, h) ((4 + (b) * 2 + (h)) * HTB)
#define PG8_STAGE(bufoff, gbase, voff) do { _Pragma("unroll") for (int _i = 0; _i < 2; ++_i) \
        __builtin_amdgcn_global_load_lds((const unsigned*)((const char*)(gbase) + (voff)[_i]), (PG8_LAS unsigned*)(lds + (bufoff) + ldsw + _i * 8192), 16, 0, 0); } while (0)
#define PG8_LDA(dst, b, h) do { _Pragma("unroll") for (int m = 0; m < 4; ++m) _Pragma("unroll") for (int k = 0; k < 2; ++k) dst[m][k] = *(const PG8_LAS bf16x8*)(lds + PG8_SA(b, h) + aoff + m * 2048 + k * 1024); } while (0)
#define PG8_LDB(dst, b, h) do { _Pragma("unroll") for (int n = 0; n < 2; ++n) _Pragma("unroll") for (int k = 0; k < 2; ++k) dst[n][k] = *(const PG8_LAS bf16x8*)(lds + PG8_SB(b, h) + boff + n * 2048 + k * 1024); } while (0)
#define PG8_MMA(ai, bj, At, Bt) do { __builtin_amdgcn_s_setprio(1); _Pragma("unroll") for (int m = 0; m < 4; ++m) _Pragma("unroll") for (int n = 0; n < 2; ++n) _Pragma("unroll") for (int k = 0; k < 2; ++k) \
        acc[ai][bj][m][n] = __builtin_amdgcn_mfma_f32_16x16x32_bf16(Bt[n][k], At[m][k], acc[ai][bj][m][n], 0, 0, 0); __builtin_amdgcn_s_setprio(0); } while (0)
#define PG8_WAIT_V(n) asm volatile("s_waitcnt vmcnt(" #n ")" ::: "memory")
#define PG8_WAIT_L(n) asm volatile("s_waitcnt lgkmcnt(" #n ")" ::: "memory")
#define PG8_BAR __builtin_amdgcn_s_barrier()
#define PG8_SCHED __builtin_amdgcn_sched_barrier(0)
#define PG8_UA(u) ((const char*)((u).seg ? g.A1 : g.A0) + (size_t)(u).pm * tstep)
#define PG8_UB(u) ((const char*)((u).seg ? g.B1 : g.B0) + (size_t)(u).pn * tstep)
    Unit cur, nxt; int ui = 0;
    if (!S.next(0, cur)) return;
    Acc acc;
#pragma unroll
    for (int a = 0; a < 2; ++a)
#pragma unroll
        for (int b = 0; b < 2; ++b)
#pragma unroll
            for (int m = 0; m < 4; ++m)
#pragma unroll
                for (int n = 0; n < 2; ++n) acc[a][b][m][n] = (f32x4){0.f, 0.f, 0.f, 0.f};
    bf16x8 At[4][2], B0[2][2], B1[2][2];
    const char* cA = PG8_UA(cur); const char* cB = PG8_UB(cur);
    PG8_STAGE(PG8_SB(0, 0), cB, voffB); PG8_STAGE(PG8_SB(0, 1), cB + hstep, voffB); PG8_STAGE(PG8_SA(0, 0), cA, voffA); PG8_STAGE(PG8_SA(0, 1), cA + hstep, voffA);
    if (wr == 1) PG8_BAR;
    PG8_WAIT_V(2); PG8_BAR;
    PG8_STAGE(PG8_SB(1, 0), cB + kstep, voffB); PG8_STAGE(PG8_SA(1, 0), cA + kstep, voffA); PG8_STAGE(PG8_SB(1, 1), cB + hstep + kstep, voffB);
    PG8_WAIT_V(6); PG8_BAR;
    for (;;) {
        const bool has_next = S.next(ui + 1, nxt);
        const char* nA = has_next ? PG8_UA(nxt) : cA; const char* nB = has_next ? PG8_UB(nxt) : cB;
        for (int t = 0; t < nt; t += 2) {
            const bool last = (t == nt - 2);
            const char* a1 = cA + (size_t)(t + 1) * kstep;
            const char* a2 = last ? nA : cA + (size_t)(t + 2) * kstep; const char* b2 = last ? nB : cB + (size_t)(t + 2) * kstep;
            const char* a3 = a2 + kstep; const char* b3 = b2 + kstep;
            PG8_LDB(B0, 0, 0); PG8_LDB(B1, 0, 1); PG8_SCHED; PG8_LDA(At, 0, 0); PG8_STAGE(PG8_SA(1, 1), a1 + hstep, voffA);
            PG8_WAIT_V(8); PG8_WAIT_L(0); PG8_BAR; PG8_MMA(0, 0, At, B0); PG8_MMA(0, 1, At, B1); PG8_BAR; PG8_SCHED;
            PG8_LDA(At, 0, 1); PG8_STAGE(PG8_SB(0, 0), b2, voffB); PG8_STAGE(PG8_SB(0, 1), b2 + hstep, voffB); PG8_STAGE(PG8_SA(0, 0), a2, voffA);
            PG8_WAIT_V(8); PG8_WAIT_L(0); PG8_BAR; PG8_MMA(1, 0, At, B0); PG8_MMA(1, 1, At, B1); PG8_BAR; PG8_SCHED;
            PG8_LDB(B0, 1, 0); PG8_LDB(B1, 1, 1); PG8_SCHED; PG8_LDA(At, 1, 0); PG8_STAGE(PG8_SA(0, 1), a2 + hstep, voffA);
            PG8_WAIT_V(8); PG8_WAIT_L(0); PG8_BAR; PG8_MMA(0, 0, At, B0); PG8_MMA(0, 1, At, B1); PG8_BAR; PG8_SCHED;
            PG8_LDA(At, 1, 1); PG8_STAGE(PG8_SB(1, 0), b3, voffB); PG8_STAGE(PG8_SB(1, 1), b3 + hstep, voffB); PG8_STAGE(PG8_SA(1, 0), a3, voffA);
            PG8_WAIT_V(8); PG8_WAIT_L(0); PG8_BAR; PG8_MMA(1, 0, At, B0); PG8_MMA(1, 1, At, B1); PG8_BAR; PG8_SCHED;
        }
        if constexpr (ALIGN_EPI) { if (wr == 0) PG8_BAR; }
        E(acc, cur, wr, wc, fr, fq);
        if (!has_next) break;
        if (!(Epi::KEEP_ACC && cur.seg == 0)) {
#pragma unroll
        for (int a = 0; a < 2; ++a)
#pragma unroll
            for (int b = 0; b < 2; ++b)
#pragma unroll
                for (int m = 0; m < 4; ++m)
#pragma unroll
                    for (int n = 0; n < 2; ++n) acc[a][b][m][n] = (f32x4){0.f, 0.f, 0.f, 0.f};
        }
        cur = nxt; cA = nA; cB = nB; ++ui;
        if constexpr (ALIGN_EPI) { if (wr == 1) PG8_BAR; }
    }
    PG8_WAIT_V(0);
    if constexpr (!ALIGN_EPI) { if (wr == 0) PG8_BAR; }
    PG8_BAR;
#undef PG8_SA
#undef PG8_SB
#undef PG8_STAGE
#undef PG8_LDA
#undef PG8_LDB
#undef PG8_MMA
#undef PG8_WAIT_V
#undef PG8_WAIT_L
#undef PG8_BAR
#undef PG8_SCHED
#undef PG8_UA
#undef PG8_UB
}
}

constexpr int NWAVES = 8, NTHR = NWAVES * 64;
constexpr int DM = 2048, BATCH = 8, SEQ = 2048, M = BATCH * SEQ;
constexpr int INW = 8704, ZAW = 4608, ZGW = 4096;
constexpr int NMEM = 256, MROWS = BATCH * NMEM;
constexpr int DFF = 5632;
constexpr float RMS_EPS = 1e-6f;

constexpr size_t MiB = 1u << 20;
constexpr size_t WS_BAR = 256 * 1024, WS_BAR_BYTES = 128 * 1024, WS_PCNT = WS_BAR + 64 * 1024;
constexpr size_t WS_RS1 = 0;
constexpr size_t WS_SSQ = 506 * MiB;
constexpr size_t WS_ROPE = 1 * MiB;
constexpr size_t WS_WIN = 2 * MiB;
constexpr size_t WS_WA = 36 * MiB;
constexpr size_t WS_WC = 40 * MiB;
constexpr size_t WS_WO = 44 * MiB;
constexpr size_t WS_WCQ = 52 * MiB;
constexpr size_t WS_WCKV = 54 * MiB;
constexpr size_t WS_WCO = 58 * MiB;
constexpr size_t WS_WGU = 60 * MiB;
constexpr size_t WS_WDN = 104 * MiB;
constexpr size_t WS_MEMN = 126 * MiB;
constexpr size_t WS_MEMKV = 134 * MiB;
constexpr size_t WS_ZA = 138 * MiB;
constexpr size_t WS_ZG = 282 * MiB;
constexpr size_t WS_AO = 2 * MiB;
constexpr size_t WS_CV = 410 * MiB;
constexpr size_t WS_WOB = 410 * MiB;
constexpr size_t WS_XB = 442 * MiB;
constexpr size_t WS_WOQ = 508 * MiB;
constexpr size_t WS_END = 510 * MiB;
constexpr size_t WS_MG = WS_ZA;
constexpr size_t WS_X1B = WS_ZG + 32 * MiB;
constexpr size_t WS_X3B = WS_XB;
constexpr size_t WS_QC = WS_ZG;
constexpr size_t WS_CO = WS_ZG + 16 * MiB;
constexpr size_t WS_X2B = WS_ZA;
constexpr size_t WS_ACT = WS_ZA + 64 * MiB;
static_assert(WS_ACT + (size_t)M * DFF * 2 <= WS_CV, "ACT overlay");

constexpr int LDS_BYTES = 147456;

#define GAS __attribute__((address_space(1)))
#define LAS __attribute__((address_space(3)))
typedef unsigned short bf16;
typedef unsigned v4u __attribute__((ext_vector_type(4)));
typedef float f32x4 __attribute__((ext_vector_type(4)));
#define LDS_WAIT() asm volatile("s_waitcnt lgkmcnt(0)" ::: "memory")
__device__ __forceinline__ unsigned f2bf(float f) { unsigned u = __builtin_bit_cast(unsigned, f); return (u + 0x7fffu + ((u >> 16) & 1u)) >> 16; }
__device__ __forceinline__ unsigned pk2(float lo, float hi) { return f2bf(lo) | (f2bf(hi) << 16); }
__device__ __forceinline__ float bflo(unsigned w) { return __uint_as_float(w << 16); }
__device__ __forceinline__ float bfhi(unsigned w) { return __uint_as_float(w & 0xffff0000u); }
__device__ __forceinline__ float wave_sum(float v) {
#pragma unroll
    for (int o = 1; o < 64; o <<= 1) v += __shfl_xor(v, o);
    return v;
}
__device__ __forceinline__ float wave_max(float v) {
#pragma unroll
    for (int o = 1; o < 64; o <<= 1) v = fmaxf(v, __shfl_xor(v, o));
    return v;
}

__device__ __forceinline__ int dest_row(int n0, int mode) {
    if (mode == 1) return (n0 >> 7) * 256 + (n0 & 127);
    if (mode == 2) return (n0 >> 7) * 256 + 128 + (n0 & 127);
    if (mode == 3 && n0 < 1280) return (n0 >> 8) * 256 + ((n0 >> 6) & 1) * 128 + ((n0 >> 7) & 1) * 64 + (n0 & 63);
    if (mode == 3 && n0 >= 1536 && n0 < 2560) { const int ch = n0 - 1536; return 1536 + (ch >> 7) * 256 + (ch & 127); }
    if (mode == 3 && n0 >= 3584 && n0 < 4608) { const int ch = n0 - 3584; return 1536 + (ch >> 7) * 256 + 128 + (ch & 127); }
    if (mode == 3 && n0 >= 2560 && n0 < 3584) return n0 + 1024;
    if (mode == 3 && n0 >= 4608) { const int g = n0 - 4608, br = g >> 11, ch = g & 2047; return 4608 + (ch >> 7) * 256 + br * 128 + (ch & 127); }
    return n0;
}
struct TItem { const float* W; bf16* WT; const float* gk; int K, N, mode, item; };
__device__ __forceinline__ void p0_t_load(const TItem& t, f32x4 (&v)[8], int lane) {
    const int nblk = t.N / 32, kb = t.item / nblk, nb = t.item % nblk, k0 = 64 * kb, n0 = 32 * nb, kr2 = lane >> 3, nq = lane & 7;
#pragma unroll
    for (int i = 0; i < 4; ++i) { const float* p = t.W + (size_t)(k0 + 16 * i + 2 * kr2) * t.N + n0 + 4 * nq; v[2 * i] = __builtin_nontemporal_load((const f32x4*)p); v[2 * i + 1] = __builtin_nontemporal_load((const f32x4*)(p + t.N)); }
}
__device__ __forceinline__ void p0_t_store(const TItem& t, const f32x4 (&v)[8], LAS float* scrf, int lane) {
    LAS unsigned* scr = (LAS unsigned*)scrf;
    const int nblk = t.N / 32, kb = t.item / nblk, nb = t.item % nblk, k0 = 64 * kb, n0 = 32 * nb, kr2 = lane >> 3, nq = lane & 7;
#pragma unroll
    for (int i = 0; i < 4; ++i) { float g0 = 1.0f, g1 = 1.0f; if (t.gk) { g0 = t.gk[k0 + 16 * i + 2 * kr2]; g1 = t.gk[k0 + 16 * i + 2 * kr2 + 1]; }
        LAS unsigned* p = scr + (4 * nq) * 36 + 8 * i + kr2;
        p[0 * 36] = pk2(v[2 * i].x * g0, v[2 * i + 1].x * g1); p[1 * 36] = pk2(v[2 * i].y * g0, v[2 * i + 1].y * g1);
        p[2 * 36] = pk2(v[2 * i].z * g0, v[2 * i + 1].z * g1); p[3 * 36] = pk2(v[2 * i].w * g0, v[2 * i + 1].w * g1); }
    LDS_WAIT(); asm volatile("" ::: "memory");
    const int c = lane & 7, r0 = dest_row(n0, t.mode);
#pragma unroll
    for (int j = 0; j < 4; ++j) { const int n = (lane >> 3) + 8 * j; *(v4u*)(t.WT + (size_t)(r0 + n) * t.K + k0 + 8 * c) = *(const LAS v4u*)(scr + n * 36 + 4 * c); }
    LDS_WAIT(); asm volatile("" ::: "memory");
}
__device__ __forceinline__ void row_to_bf16_rs(const float* xrow, bf16* orow, float* rs_out, int lane) {
    const f32x4* xr = (const f32x4*)xrow + lane;
    f32x4 v[8]; float s = 0.f;
#pragma unroll
    for (int j = 0; j < 8; ++j) { v[j] = xr[64 * j]; s += (v[j].x * v[j].x + v[j].y * v[j].y) + (v[j].z * v[j].z + v[j].w * v[j].w); }
    const float rs = 1.0f / sqrtf(wave_sum(s) * (1.0f / DM) + RMS_EPS);
    if (lane == 0) *rs_out = rs;
    unsigned long long* o8 = (unsigned long long*)orow + lane;
#pragma unroll
    for (int j = 0; j < 8; ++j) o8[64 * j] = (unsigned long long)pk2(v[j].x, v[j].y) | ((unsigned long long)pk2(v[j].z, v[j].w) << 32);
}
__device__ __forceinline__ void rms_row_to_bf16(const float* xrow, const float* g, bf16* orow, int lane) {
    const f32x4* xr = (const f32x4*)xrow + lane; const f32x4* gr = (const f32x4*)g + lane;
    f32x4 v[8]; float s = 0.f;
#pragma unroll
    for (int j = 0; j < 8; ++j) { v[j] = xr[64 * j]; s += (v[j].x * v[j].x + v[j].y * v[j].y) + (v[j].z * v[j].z + v[j].w * v[j].w); }
    const float rs = 1.0f / sqrtf(wave_sum(s) * (1.0f / DM) + RMS_EPS);
    unsigned long long* o8 = (unsigned long long*)orow + lane;
#pragma unroll
    for (int j = 0; j < 8; ++j) { const f32x4 gg = gr[64 * j];
        o8[64 * j] = (unsigned long long)pk2(v[j].x * rs * gg.x, v[j].y * rs * gg.y) | ((unsigned long long)pk2(v[j].z * rs * gg.z, v[j].w * rs * gg.w) << 32); }
}

typedef float f32x16 __attribute__((ext_vector_type(16)));
typedef short s16x8 __attribute__((ext_vector_type(8)));
typedef short s16x4 __attribute__((ext_vector_type(4)));
constexpr int ATT_KP = 272, ATT_VP = 264, ATT_V_OFF = 128 * ATT_KP, ATT_LDS = ATT_V_OFF + 128 * ATT_VP;
constexpr float LOG2E = 1.4426950408889634f;
template <bool WINDOW>
__device__ __forceinline__ void attn_unit(LAS unsigned char* lds, const bf16* qw, int qpitch, const bf16* kg, const bf16* vg, int kvpitch, int nblk,
                                          int qpos, int kpos, float m_init, float l_init, float qs, bf16* ow, int opitch, int tid, int lane) {
    const int r = lane & 31, h = lane >> 5;
    s16x8 qf[8];
#pragma unroll
    for (int kk = 0; kk < 8; ++kk) qf[kk] = *(const s16x8*)(qw + (size_t)r * qpitch + 16 * kk + 8 * h);
    f32x16 o[4];
#pragma unroll
    for (int dt = 0; dt < 4; ++dt)
#pragma unroll
        for (int i = 0; i < 16; ++i) o[dt][i] = 0.f;
    float m = m_init, l = (h == 0) ? l_init : 0.f;
    const int kkey = tid >> 4, kc = tid & 15, vkey = tid & 127, vcg = tid >> 7;
    for (int blk = 0; blk < nblk; ++blk) {
        v4u kreg[4], vreg[4];
#pragma unroll
        for (int it = 0; it < 4; ++it) { kreg[it] = *(const v4u*)(kg + (size_t)(blk * 128 + kkey + 32 * it) * kvpitch + kc * 8); vreg[it] = *(const v4u*)(vg + (size_t)(blk * 128 + vkey) * kvpitch + (vcg * 4 + it) * 8); }
        __syncthreads();
#pragma unroll
        for (int it = 0; it < 4; ++it) { *(LAS v4u*)(lds + (kkey + 32 * it) * ATT_KP + kc * 16) = kreg[it];
            LAS unsigned short* vt = (LAS unsigned short*)(lds + ATT_V_OFF) + (size_t)((vcg * 4 + it) * 8) * (ATT_VP / 2) + vkey;
            const v4u w = vreg[it];
            vt[0 * (ATT_VP / 2)] = (unsigned short)(w.x & 0xffffu); vt[1 * (ATT_VP / 2)] = (unsigned short)(w.x >> 16); vt[2 * (ATT_VP / 2)] = (unsigned short)(w.y & 0xffffu); vt[3 * (ATT_VP / 2)] = (unsigned short)(w.y >> 16);
            vt[4 * (ATT_VP / 2)] = (unsigned short)(w.z & 0xffffu); vt[5 * (ATT_VP / 2)] = (unsigned short)(w.z >> 16); vt[6 * (ATT_VP / 2)] = (unsigned short)(w.w & 0xffffu); vt[7 * (ATT_VP / 2)] = (unsigned short)(w.w >> 16); }
        __syncthreads();
#pragma unroll 1
        for (int hf = 0; hf < 2; ++hf) {
        const int thr0 = WINDOW ? (qpos - (kpos + blk * 128 + 64 * hf)) : 0;
        if (WINDOW && (thr0 - 63 > 128 || thr0 + 31 < -128)) continue;
        const bool need_mask = WINDOW && (thr0 + 31 > 128 || thr0 - 63 < -128);
        const int thr = thr0 + r - 4 * h;
        f32x16 sc[2];
#pragma unroll
        for (int kt = 0; kt < 2; ++kt) {
#pragma unroll
            for (int i = 0; i < 16; ++i) sc[kt][i] = 0.f;
#pragma unroll
            for (int kk = 0; kk < 8; ++kk) { const s16x8 kf = *(const LAS s16x8*)(lds + (64 * hf + 32 * kt + r) * ATT_KP + (16 * kk + 8 * h) * 2); sc[kt] = __builtin_amdgcn_mfma_f32_32x32x16_bf16(kf, qf[kk], sc[kt], 0, 0, 0); }
        }
        float mb = -1e30f;
#pragma unroll
        for (int kt = 0; kt < 2; ++kt)
#pragma unroll
            for (int i = 0; i < 16; ++i) {
                if (!WINDOW) sc[kt][i] *= qs;
                if (WINDOW) { if (need_mask && (unsigned)((32 * kt + (i & 3) + 8 * (i >> 2)) - thr + 128) > 256u) sc[kt][i] = -1e30f; }
                mb = fmaxf(mb, sc[kt][i]); }
        mb = fmaxf(mb, __shfl_xor(mb, 32));
        const float mn = fmaxf(m, mb), alpha = __builtin_amdgcn_exp2f((m - mn) * LOG2E), mo = mn * LOG2E;
        m = mn; l *= alpha;
#pragma unroll
        for (int dt = 0; dt < 4; ++dt) o[dt] = o[dt] * alpha;
        float ls = 0.f;
#pragma unroll
        for (int kt = 0; kt < 2; ++kt)
#pragma unroll
            for (int i = 0; i < 16; ++i) { const float p = __builtin_amdgcn_exp2f(sc[kt][i] * LOG2E - mo); sc[kt][i] = p; ls += p; }
        l += ls;
#pragma unroll
        for (int kt = 0; kt < 2; ++kt)
#pragma unroll
            for (int st = 0; st < 2; ++st) {
                v4u pw; pw.x = pg8::cvt_pk_bf16(sc[kt][8 * st + 0], sc[kt][8 * st + 1]); pw.y = pg8::cvt_pk_bf16(sc[kt][8 * st + 2], sc[kt][8 * st + 3]);
                pw.z = pg8::cvt_pk_bf16(sc[kt][8 * st + 4], sc[kt][8 * st + 5]); pw.w = pg8::cvt_pk_bf16(sc[kt][8 * st + 6], sc[kt][8 * st + 7]);
                const s16x8 pf = __builtin_bit_cast(s16x8, pw);
#pragma unroll
                for (int dt = 0; dt < 4; ++dt) { const LAS unsigned char* vp = lds + ATT_V_OFF + (32 * dt + r) * ATT_VP + (64 * hf + 32 * kt + 16 * st + 4 * h) * 2;
                    const s16x4 lo = *(const LAS s16x4*)vp, hi = *(const LAS s16x4*)(vp + 16);
                    const s16x8 vf = __builtin_shufflevector(lo, hi, 0, 1, 2, 3, 4, 5, 6, 7);
                    o[dt] = __builtin_amdgcn_mfma_f32_32x32x16_bf16(vf, pf, o[dt], 0, 0, 0); }
            }
        }
    }
    l += __shfl_xor(l, 32);
    const float inv = 1.0f / l;
    bf16* orow = ow + (size_t)r * opitch + 4 * h;
#pragma unroll
    for (int dt = 0; dt < 4; ++dt)
#pragma unroll
        for (int g = 0; g < 4; ++g) { unsigned long long w = (unsigned long long)pg8::cvt_pk_bf16(o[dt][4 * g] * inv, o[dt][4 * g + 1] * inv) | ((unsigned long long)pg8::cvt_pk_bf16(o[dt][4 * g + 2] * inv, o[dt][4 * g + 3] * inv) << 32);
            *(unsigned long long*)(orow + 32 * dt + 8 * g) = w; }
}

#define RLX_AGENT __ATOMIC_RELAXED, __HIP_MEMORY_SCOPE_AGENT
#define XB_TMO      128
#define XB_XCNT(j)  (256  + 64 * (j))
#define XB_XSUB(j)  (1280 + 64 * (j))
#define XB_XGEN(j)  (2304 + 64 * (j))
#define XB_TOP      3328
#define XB_TOPGEN   3392
#define XCD_BAR_WORDS 3456
#define XB_SPIN_CAP (1u << 18)

__device__ __forceinline__ unsigned xb_ld(unsigned* p)              { return __hip_atomic_load(p, __ATOMIC_RELAXED, __HIP_MEMORY_SCOPE_AGENT); }
__device__ __forceinline__ unsigned xb_add(unsigned* p, unsigned v) { return __hip_atomic_fetch_add(p, v, __ATOMIC_RELAXED, __HIP_MEMORY_SCOPE_AGENT); }
__device__ __forceinline__ unsigned xb_xcc_id() { return (unsigned)__builtin_amdgcn_s_getreg((3 << 11) | 20) & 0xFu; }
#define XB_SPIN(cond, bar) do { unsigned _sp = 0; while (cond) { __builtin_amdgcn_s_sleep(1); \
    if ((++_sp & 255u) == 0u) { if (xb_ld(&(bar)[XB_TMO])) break; if (_sp > XB_SPIN_CAP) { atomicAdd(&(bar)[XB_TMO], 1u); break; } } } } while (0)

struct XcdBarrier {
    unsigned* bar; unsigned x;
    volatile LAS unsigned* st;
};

__device__ __forceinline__ XcdBarrier xcd_barrier_post(unsigned* bar, volatile LAS unsigned* st) {
    XcdBarrier b; b.bar = bar; b.x = xb_xcc_id(); b.st = st;
    if (threadIdx.x == 0) (void)xb_add(&bar[XB_XCNT(b.x)], 1u);
    return b;
}
__device__ __forceinline__ void xcd_barrier_complete(unsigned* bar, unsigned x, unsigned& nloc, unsigned& nx) {
    const unsigned G = gridDim.x * gridDim.y * gridDim.z;
    unsigned sum, cnt, mine, sp = 0u;
    for (;;) {
        sum = 0u; cnt = 0u; mine = 0u;
#pragma unroll
        for (unsigned j = 0; j < 16; ++j) { const unsigned c = xb_ld(&bar[XB_XCNT(j)]); sum += c; cnt += (c > 0u) ? 1u : 0u; mine = (j == x) ? c : mine; }
        if (sum == G) break;
        __builtin_amdgcn_s_sleep(1);
        if ((++sp & 255u) == 0u) { if (xb_ld(&bar[XB_TMO])) break; if (sp > XB_SPIN_CAP) { atomicAdd(&bar[XB_TMO], 1u); break; } }
    }
    nloc = mine > 0u ? mine : 1u; nx = cnt > 0u ? cnt : 1u;
}

__device__ __forceinline__ void xcd_barrier(const XcdBarrier& b) {
    asm volatile("s_waitcnt vmcnt(0)" ::: "memory");
    __syncthreads();
    if (threadIdx.x == 0) {
        unsigned* bar = b.bar;
        __builtin_amdgcn_s_waitcnt(0);
        unsigned nloc = b.st[0], nx = b.st[1];
        if (nloc == 0u) { xcd_barrier_complete(bar, b.x, nloc, nx); b.st[0] = nloc; b.st[1] = nx; }
        const unsigned old = xb_add(&bar[XB_XSUB(b.x)], 1u);
        const unsigned gen = old / nloc;
        if (old + 1u == (gen + 1u) * nloc) {
            __builtin_amdgcn_fence(__ATOMIC_RELEASE, "agent");
            asm volatile("s_waitcnt vmcnt(0)" ::: "memory");
            const unsigned og = xb_add(&bar[XB_TOP], 1u);
            const unsigned tg = og / nx;
            if (og + 1u == (tg + 1u) * nx) xb_add(&bar[XB_TOPGEN], 1u);
            else XB_SPIN(xb_ld(&bar[XB_TOPGEN]) == tg, bar);
            __builtin_amdgcn_fence(__ATOMIC_ACQUIRE, "agent");
            xb_add(&bar[XB_XGEN(b.x)], 1u);
            asm volatile("s_waitcnt vmcnt(0)" ::: "memory");
        } else {
            XB_SPIN(xb_ld(&bar[XB_XGEN(b.x)]) == gen, bar);
            __builtin_amdgcn_fence(__ATOMIC_ACQUIRE, "agent");
            asm volatile("s_waitcnt vmcnt(0)" ::: "memory");
        }
    }
    __syncthreads();
}

struct Args { const float* in[20]; float* out; unsigned char* ws; int ph_lo, ph_hi, li, pad; };

__global__ void __launch_bounds__(NTHR, 2) mk_fwd(Args args) {
    extern __shared__ __attribute__((aligned(16))) unsigned char lds_raw[];
    LAS unsigned char* lds = (LAS unsigned char*)lds_raw;
    const int tid = threadIdx.x, lane = tid & 63, wave = __builtin_amdgcn_readfirstlane(tid >> 6);
    const int G = gridDim.x, bx = blockIdx.x;
    const int gw = bx * NWAVES + wave, NGW = G * NWAVES;
    unsigned char* ws = args.ws;
    const float* x = args.in[0]; const float* mem = args.in[1]; const float* g_mix = args.in[2]; const float* w_in = args.in[3]; const float* sink = args.in[4];
    const float* conv_w = args.in[5]; const float* b_gate = args.in[6]; const float* w_attn_out = args.in[7]; const float* w_conv_out = args.in[8]; const float* w_o = args.in[9];
    const float* g_cross = args.in[10]; const float* g_mem = args.in[11]; const float* w_cq = args.in[12]; const float* w_ckv = args.in[13]; const float* w_co = args.in[14];
    const float* g_ffn = args.in[15]; const float* w_gate = args.in[16]; const float* w_up = args.in[17]; const float* w_down = args.in[18]; const float* g_final = args.in[19];
    float* out = args.out;
    float* ssq2 = (float*)(ws + WS_SSQ); float* ssq3 = ssq2 + M * 8; float* ssq4 = ssq3 + M * 8;
    PG8_LAS float* xch = (PG8_LAS float*)(lds + pg8::STAGE_BYTES);
    float* cosT = (float*)(ws + WS_ROPE); float* sinT = cosT + SEQ * 64;
    bf16* Wt_in = (bf16*)(ws + WS_WIN); bf16* Wt_a = (bf16*)(ws + WS_WA); bf16* Wt_c = (bf16*)(ws + WS_WC); bf16* Wt_o = (bf16*)(ws + WS_WO);
    bf16* Wt_cq = (bf16*)(ws + WS_WCQ); bf16* Wt_ckv = (bf16*)(ws + WS_WCKV); bf16* Wt_co = (bf16*)(ws + WS_WCO); bf16* Wt_gu = (bf16*)(ws + WS_WGU); bf16* Wt_dn = (bf16*)(ws + WS_WDN);
    bf16* MEMN = (bf16*)(ws + WS_MEMN); bf16* MEMKV = (bf16*)(ws + WS_MEMKV);
    bf16* ZA = (bf16*)(ws + WS_ZA); bf16* ZG = (bf16*)(ws + WS_ZG); bf16* AO = (bf16*)(ws + WS_AO); bf16* CV = (bf16*)(ws + WS_CV);
    bf16* MG = (bf16*)(ws + WS_MG); bf16* X1B = (bf16*)(ws + WS_X1B); bf16* X3B = (bf16*)(ws + WS_X3B); bf16* XB = (bf16*)(ws + WS_XB); bf16* WOB = (bf16*)(ws + WS_WOB); bf16* WOQ = (bf16*)(ws + WS_WOQ); float* rs1 = (float*)(ws + WS_RS1); bf16* QC = (bf16*)(ws + WS_QC); bf16* CO = (bf16*)(ws + WS_CO);
    bf16* X2B = (bf16*)(ws + WS_X2B); bf16* ACT = (bf16*)(ws + WS_ACT);
    cg::grid_group grid = cg::this_grid();
    const int lo = args.ph_lo, hi = args.ph_hi;
#define IN(k) (lo <= (k) && (k) < hi)
#define SEAM(k) do { if (IN(k) && IN((k) + 1)) { if (args.ph_hi > 1000) { asm volatile("s_waitcnt vmcnt(0) lgkmcnt(0)" ::: "memory"); __syncthreads(); grid.sync(); } else xcd_barrier(xbar); } } while (0)
    if (tid < 4) ((LAS unsigned*)(lds + pg8::STAGE_BYTES + 8192))[tid] = 0u;
    __syncthreads();
    const XcdBarrier xbar = xcd_barrier_post((unsigned*)(ws + WS_BAR) + args.li * 4096, (volatile LAS unsigned*)(lds + pg8::STAGE_BYTES + 8192));

    if (IN(0)) {
        LAS float* scr = (LAS float*)(lds + wave * 16384);
        constexpr int I_IN = (DM / 64) * (INW / 32), I_A = (1024 / 64) * (DM / 32), I_O = (DM / 64) * (DM / 32), I_CQ = (DM / 64) * (512 / 32), I_CKV = (DM / 64) * (1024 / 32),
                      I_CO = (512 / 64) * (DM / 32), I_G = (DM / 64) * (DFF / 32), I_D = (DFF / 64) * (DM / 32);
        constexpr int NITEMS = I_IN + 2 * I_A + I_O + I_CQ + I_CKV + I_CO;
#define P0_PICK(t, itx) do { int r = (itx); \
            if (r < I_IN) { t = TItem{w_in, Wt_in, g_mix, DM, INW, 3, r}; break; } r -= I_IN; \
            if (r < I_A) { t = TItem{w_attn_out, Wt_a, nullptr, 1024, DM, 0, r}; break; } r -= I_A; \
            if (r < I_A) { t = TItem{w_conv_out, Wt_c, nullptr, 1024, DM, 0, r}; break; } r -= I_A; \
            if (r < I_O) { t = TItem{w_o, Wt_o, nullptr, DM, DM, 0, r}; break; } r -= I_O; \
            if (r < I_CQ) { t = TItem{w_cq, Wt_cq, g_cross, DM, 512, 0, r}; break; } r -= I_CQ; \
            if (r < I_CKV) { t = TItem{w_ckv, Wt_ckv, nullptr, DM, 1024, 0, r}; break; } r -= I_CKV; \
            t = TItem{w_co, Wt_co, nullptr, 512, DM, 0, r}; } while (0)
        for (int it = gw; it < NITEMS; it += 2 * NGW) {
            TItem t0, t1; f32x4 v0[8], v1[8]; const bool two = it + NGW < NITEMS;
            P0_PICK(t0, it); p0_t_load(t0, v0, lane);
            if (two) { P0_PICK(t1, it + NGW); p0_t_load(t1, v1, lane); }
            p0_t_store(t0, v0, scr, lane);
            if (two) p0_t_store(t1, v1, scr, lane);
        }
#undef P0_PICK
        for (int m = gw * 2; m < M; m += NGW * 2) {
            f32x4 va[8], vb[8]; const f32x4* xa = (const f32x4*)(x + (size_t)m * DM) + lane; const f32x4* xb2 = xa + DM / 4;
#pragma unroll
            for (int j = 0; j < 8; ++j) { va[j] = __builtin_nontemporal_load(xa + 64 * j); vb[j] = __builtin_nontemporal_load(xb2 + 64 * j); }
            float sa = 0.f, sb = 0.f;
#pragma unroll
            for (int j = 0; j < 8; ++j) { sa += (va[j].x * va[j].x + va[j].y * va[j].y) + (va[j].z * va[j].z + va[j].w * va[j].w); sb += (vb[j].x * vb[j].x + vb[j].y * vb[j].y) + (vb[j].z * vb[j].z + vb[j].w * vb[j].w); }
            sa = wave_sum(sa); sb = wave_sum(sb);
            if (lane == 0) { rs1[m] = 1.0f / sqrtf(sa * (1.0f / DM) + RMS_EPS); rs1[m + 1] = 1.0f / sqrtf(sb * (1.0f / DM) + RMS_EPS); }
            unsigned long long* oa = (unsigned long long*)(XB + (size_t)m * DM) + lane; unsigned long long* ob = oa + DM / 4;
#pragma unroll
            for (int j = 0; j < 8; ++j) { oa[64 * j] = (unsigned long long)pk2(va[j].x, va[j].y) | ((unsigned long long)pk2(va[j].z, va[j].w) << 32);
                ob[64 * j] = (unsigned long long)pk2(vb[j].x, vb[j].y) | ((unsigned long long)pk2(vb[j].z, vb[j].w) << 32); }
        }
        for (int i = bx * NTHR + tid; i < DM * DM / 8; i += G * NTHR) { const f32x4 a = *(const f32x4*)(w_o + (size_t)i * 8), b = *(const f32x4*)(w_o + (size_t)i * 8 + 4); *(v4u*)(WOB + (size_t)i * 8) = pg8::pack8(a, b); }
        for (int m = gw; m < MROWS; m += NGW) rms_row_to_bf16(mem + (size_t)m * DM, g_mem, MEMN + (size_t)m * DM, lane);
        for (int i = bx * NTHR + tid; i < SEQ * 64; i += G * NTHR) { const int pos = i >> 6, j = i & 63;
            const float inv = exp2f(-(float)j * (13.287712379549449f / 64.0f)); const float ang = (float)pos * inv;
            cosT[i] = cosf(ang); sinT[i] = sinf(ang); }
    }
    SEAM(0);

    if (IN(1)) {
        { pg8::Gemm g{XB, Wt_in, nullptr, nullptr, M, INW, DM}; pg8::StaticOrder S; S.init(M, INW, G, bx);
          pg8::EpiIn E{ZA, ZG, cosT, sinT, b_gate, 0.08838834764831845f, rs1};
          pg8::gemm_phase<pg8::EpiIn, pg8::StaticOrder>(lds, g, S, E); }
        { pg8::Gemm g{MEMN, Wt_ckv, nullptr, nullptr, MROWS, 1024, DM}; pg8::StaticOrder S; S.init(MROWS, 1024, G, (bx + G / 2) % G);
          pg8::EpiBf16 E{MEMKV, 1024};
          pg8::gemm_phase<pg8::EpiBf16, pg8::StaticOrder>(lds, g, S, E); }
        { pg8::Gemm g{Wt_cq, WOB, nullptr, nullptr, 512, DM, DM}; pg8::StaticOrder S; S.init(512, DM, G, (bx + G / 2 - 32 + G) % G);
          pg8::EpiBf16 E{WOQ, DM};
          pg8::gemm_phase<pg8::EpiBf16, pg8::StaticOrder>(lds, g, S, E); }
        if (G == 256 ? bx >= 176 : true) {
            __syncthreads();
            LAS float* scr = (LAS float*)(lds + wave * 16384);
            constexpr int I_G = (DM / 64) * (DFF / 32), I_D = (DFF / 64) * (DM / 32), NF = 2 * I_G + I_D;
            const int fw = (G == 256 ? (bx - 176) : bx) * NWAVES + wave, NFW = (G == 256 ? 80 : G) * NWAVES;
#define P1_PICK(t, itx) do { int r = (itx); \
            if (r < I_G) { t = TItem{w_gate, Wt_gu, g_ffn, DM, DFF, 1, r}; break; } r -= I_G; \
            if (r < I_G) { t = TItem{w_up, Wt_gu, g_ffn, DM, DFF, 2, r}; break; } r -= I_G; \
            t = TItem{w_down, Wt_dn, nullptr, DFF, DM, 0, r}; } while (0)
            for (int it = fw; it < NF; it += 4 * NFW) {
                TItem t0, t1, t2, t3; f32x4 v0[8], v1[8], v2[8], v3[8]; const bool h1 = it + NFW < NF, h2 = it + 2 * NFW < NF, h3 = it + 3 * NFW < NF;
                P1_PICK(t0, it); p0_t_load(t0, v0, lane);
                if (h1) { P1_PICK(t1, it + NFW); p0_t_load(t1, v1, lane); }
                if (h2) { P1_PICK(t2, it + 2 * NFW); p0_t_load(t2, v2, lane); }
                if (h3) { P1_PICK(t3, it + 3 * NFW); p0_t_load(t3, v3, lane); }
                p0_t_store(t0, v0, scr, lane);
                if (h1) p0_t_store(t1, v1, scr, lane);
                if (h2) p0_t_store(t2, v2, scr, lane);
                if (h3) p0_t_store(t3, v3, scr, lane);
            }
#undef P1_PICK
        }
    }
    SEAM(1);

    if (IN(2)) {
        for (int it = 2 * bx; it < 512; it += 2 * G)
            for (int hp = 0; hp < 2; ++hp) { const int kvh = it >> 1 & 1, nb = (it >> 2) & 15, b = it >> 6;
                const int hq = kvh * 4 + hp * 2 + (wave >> 2), t0 = b * SEQ + nb * 128 + (wave & 3) * 32;
                const int kb0 = nb > 0 ? nb - 1 : 0, kb1 = nb < 15 ? nb + 1 : 15; const size_t kt0 = (size_t)b * SEQ + kb0 * 128;
                attn_unit<true>(lds, ZA + (size_t)t0 * ZAW + hq * 128, ZAW, ZA + kt0 * ZAW + 1024 + kvh * 128, ZA + kt0 * ZAW + 1280 + kvh * 128, ZAW, kb1 - kb0 + 1,
                                nb * 128 + (wave & 3) * 32, kb0 * 128, sink[hq], 1.0f, 1.0f, AO + (size_t)t0 * 1024 + hq * 128, 1024, tid, lane); }
        __syncthreads();
        for (int idx = bx * NTHR + tid; idx < (M / 16) * 128; idx += G * NTHR) { const int run = idx >> 7, c8 = (idx & 127) * 8, t0 = run * 16, s0 = t0 & (SEQ - 1);
            const f32x4 w0a = *(const f32x4*)(conv_w + c8), w0b = *(const f32x4*)(conv_w + c8 + 4), w1a = *(const f32x4*)(conv_w + 1024 + c8), w1b = *(const f32x4*)(conv_w + 1024 + c8 + 4),
                        w2a = *(const f32x4*)(conv_w + 2048 + c8), w2b = *(const f32x4*)(conv_w + 2048 + c8 + 4);
            const bf16* zr = ZA + (size_t)t0 * ZAW + c8;
            f32x4 pa = {0.f, 0.f, 0.f, 0.f}, pb = pa, ca, cb;
            if (s0 > 0) pg8::unpack8(*(const v4u*)(zr - ZAW + 1536), pa, pb);
            pg8::unpack8(*(const v4u*)(zr + 1536), ca, cb);
#pragma unroll
            for (int i = 0; i < 16; ++i) { f32x4 na = {0.f, 0.f, 0.f, 0.f}, nbv = na, ga, gb;
                if (i < 15 || s0 + 16 < SEQ) pg8::unpack8(*(const v4u*)(zr + (size_t)(i + 1) * ZAW + 1536), na, nbv);
                pg8::unpack8(*(const v4u*)(zr + (size_t)i * ZAW + 2560), ga, gb);
                *(v4u*)(CV + (size_t)(t0 + i) * 1024 + c8) = pg8::pack8(ga * (w0a * pa + w1a * ca + w2a * na), gb * (w0b * pb + w1b * cb + w2b * nbv));
                pa = ca; pb = cb; ca = na; cb = nbv; }
        }
    }
    SEAM(2);

    if (IN(3)) {
        pg8::Gemm g{AO, Wt_a, CV, Wt_c, M, DM, 1024}; pg8::StaticOrder S; S.init(M, DM, G, bx, 2);
        pg8::EpiMerge E{ZG, MG};
        pg8::gemm_phase<pg8::EpiMerge, pg8::StaticOrder>(lds, g, S, E);
    }
    SEAM(3);

    if (IN(4)) {
        { pg8::Gemm g{XB, Wt_cq, MG, WOQ, M, 512, DM}; pg8::ListOrder S{bx, bx < 128 ? 1 : 0, 2, 2};
          pg8::EpiAcc2 E{QC, 512};
          pg8::gemm_phase<pg8::EpiAcc2, pg8::ListOrder>(lds, g, S, E); }
        { pg8::Gemm g{MG, Wt_o, nullptr, nullptr, M, DM, DM}; pg8::ListOrder S{bx < 128 ? bx : 128 + (bx - 128) * 3, bx < 128 ? 1 : 3, 8, 1};
          pg8::EpiResB E{XB, X1B, ssq2, xch};
          pg8::gemm_phase<pg8::EpiResB, pg8::ListOrder>(lds, g, S, E); }
    }
    SEAM(4);

    if (IN(6)) {
        for (int it = bx; it < 256; it += G) { const int rb = it & 7, hh = (it >> 3) & 3, b = it >> 5; const int t0 = b * SEQ + rb * 256 + wave * 32;
            attn_unit<false>(lds, QC + (size_t)t0 * 512 + hh * 128, 512, MEMKV + (size_t)(b * NMEM) * 1024 + hh * 128, MEMKV + (size_t)(b * NMEM) * 1024 + 512 + hh * 128, 1024, 2,
                             0, 0, -1e30f, 0.0f, pg8::row_rs(ssq2, t0 + (lane & 31)) * 0.08838834764831845f, CO + (size_t)t0 * 512 + hh * 128, 512, tid, lane); }
    }
    SEAM(6);

    if (IN(7)) {
        pg8::Gemm g{CO, Wt_co, nullptr, nullptr, M, DM, 512}; pg8::StaticOrder S; S.init(M, DM, G, bx);
        pg8::EpiResB E{X1B, X2B, ssq3, xch};
        pg8::gemm_phase<pg8::EpiResB, pg8::StaticOrder>(lds, g, S, E);
    }
    SEAM(7);

    if (IN(8)) {
        pg8::Gemm g{X2B, Wt_gu, nullptr, nullptr, M, 2 * DFF, DM}; pg8::StaticOrder S; S.init(M, 2 * DFF, G, bx);
        pg8::EpiSwiGLU E{ACT, ssq3};
        pg8::gemm_phase<pg8::EpiSwiGLU, pg8::StaticOrder>(lds, g, S, E);
    }
    SEAM(8);

    if (IN(9)) {
        pg8::Gemm g{ACT, Wt_dn, nullptr, nullptr, M, DM, DFF}; pg8::PanelOrder S{bx};
        pg8::EpiFinal E{X2B, out, g_final, ssq4, (unsigned*)(ws + WS_PCNT), xch};
        pg8::gemm_phase<pg8::EpiFinal, pg8::PanelOrder>(lds, g, S, E);
    }
#if defined(MK_DUMP_OFF)
    if (hi == MK_CUT && MK_CUT < 11) {
        asm volatile("s_waitcnt vmcnt(0) lgkmcnt(0)" ::: "memory"); __syncthreads(); grid.sync();
        const bf16* src = (const bf16*)(ws + (size_t)(MK_DUMP_OFF));
        for (size_t i = (size_t)bx * NTHR + tid; i < (size_t)M * 2048; i += (size_t)G * NTHR) { const size_t r = i >> 11, c = i & 2047; out[i] = __uint_as_float((unsigned)src[r * (MK_DUMP_LD) + (c % (MK_DUMP_W)) + (c / (MK_DUMP_W)) * (size_t)(MK_DUMP_OFF2)] << 16); }
    }
#endif
#undef IN
#undef SEAM
}

extern "C" void kernel_launch(void* const* d_in, const int* in_sizes, int n_in, void* d_out, int out_size, void* d_ws, size_t ws_size, hipStream_t stream) {
    static int grid = 0;
    if (grid == 0) {
        if (n_in != 20 || in_sizes[0] != M * DM || out_size != M * DM || ws_size < WS_END) { fprintf(stderr, "kernel_launch: unexpected shapes / workspace (n_in %d, ws %zu)\n", n_in, ws_size); grid = -1; return; }
        int dev = 0, cus = 0, per_cu = 0;
        if (hipGetDevice(&dev) != hipSuccess || hipDeviceGetAttribute(&cus, hipDeviceAttributeMultiprocessorCount, dev) != hipSuccess) { grid = -1; return; }
        if (hipFuncSetAttribute((const void*)mk_fwd, hipFuncAttributeMaxDynamicSharedMemorySize, LDS_BYTES) != hipSuccess) { fprintf(stderr, "kernel_launch: hipFuncSetAttribute failed\n"); grid = -1; return; }
        if (hipOccupancyMaxActiveBlocksPerMultiprocessor(&per_cu, (const void*)mk_fwd, NTHR, LDS_BYTES) != hipSuccess || per_cu < 1) { fprintf(stderr, "kernel_launch: occupancy query says %d\n", per_cu); (void)hipGetLastError(); grid = -1; return; }
        grid = cus;
    }
    if (grid < 0) return;
    Args a{};
    for (int i = 0; i < 20; ++i) a.in[i] = (const float*)d_in[i];
    a.out = (float*)d_out; a.ws = (unsigned char*)d_ws;
    if (hipMemsetAsync((char*)d_ws + WS_BAR, 0, WS_BAR_BYTES, stream) != hipSuccess) { fprintf(stderr, "kernel_launch: hipMemsetAsync of the barrier words failed\n"); return; }
#if defined(MK_PROBE_DUP)
    { void* kargs[] = {&a}; a.ph_lo = 0; a.ph_hi = MK_PROBE_DUP + 1; hipLaunchCooperativeKernel((const void*)mk_fwd, dim3(grid), dim3(NTHR), kargs, LDS_BYTES, stream);
      a.ph_lo = MK_PROBE_DUP; a.ph_hi = 11; a.li = 1; hipLaunchCooperativeKernel((const void*)mk_fwd, dim3(grid), dim3(NTHR), kargs, LDS_BYTES, stream); }
#elif MK_N_LAUNCHES == 1
    a.ph_lo = 0; a.ph_hi = MK_CUT;
    void* kargs[] = {&a};
    hipError_t e = hipLaunchCooperativeKernel((const void*)mk_fwd, dim3(grid), dim3(NTHR), kargs, LDS_BYTES, stream);
    if (e != hipSuccess) fprintf(stderr, "kernel_launch: cooperative launch failed: %s (grid %d)\n", hipGetErrorString(e), grid);
#else
    for (int p = 0; p < 11; ++p) { a.ph_lo = p; a.ph_hi = p + 1; hipLaunchKernelGGL(mk_fwd, dim3(grid), dim3(NTHR), LDS_BYTES, stream, a); }
#endif
}
```

```cpp
#include <hip/hip_runtime.h>
#include <hip/hip_cooperative_groups.h>
#include <cstdio>
#include <cstdint>
namespace cg = cooperative_groups;

#ifndef MK_CUT
#define MK_CUT 11
#endif
#ifndef MK_N_LAUNCHES
#define MK_N_LAUNCHES 1
#endif

namespace pg8 {
#define PG8_LAS __attribute__((address_space(3)))
typedef unsigned short bf16_t;
typedef short bf16x8 __attribute__((ext_vector_type(8)));
typedef float f32x4 __attribute__((ext_vector_type(4)));
typedef unsigned u32x4 __attribute__((ext_vector_type(4)));
constexpr int BM = 256, BK = 64, HALF = 128, HTB = HALF * BK * 2, STAGE_BYTES = 8 * HTB, NXCD = 8, WGM = 8;

__host__ __device__ __forceinline__ int lds_byte(int r, int c) { const int st = (r >> 4) * 2 + (c >> 5), rr = r & 15, cc = c & 31, ob = rr * 64 + cc * 2; return st * 1024 + (ob ^ (((ob >> 9) & 1) << 5)); }
__host__ __device__ __forceinline__ void stage_rc(int b, int& R, int& C) { const int st = b / 1024, sb = b % 1024, swz = sb ^ (((sb >> 9) & 1) << 5); R = (st >> 1) * 16 + swz / 64; C = (st & 1) * 32 + (swz % 64) / 2; }
__host__ __device__ __forceinline__ int perm32(int rho) { const int n = rho >> 4, i = rho & 15; return 8 * (i >> 2) + 4 * n + (i & 3); }

struct Unit { int pm, pn, seg; };
struct Gemm { const bf16_t* A0; const bf16_t* B0; const bf16_t* A1; const bf16_t* B1; int M, N, K; };

struct StaticOrder {
    int nM, nN, nwg, G, c, nseg;
    __device__ void init(int M, int N, int G_, int c_, int nseg_ = 1) { nM = M / BM; nN = N / BM; nwg = nM * nN; G = G_; c = c_; nseg = nseg_; }
    __device__ bool next(int i, Unit& u) const {
        const int j = (nseg == 2) ? (i >> 1) : i; u.seg = (nseg == 2) ? (i & 1) : 0;
        const long L = (long)j * G + c; if (L >= nwg) return false;
        int wgid = (int)L; { const int q = nwg / NXCD, r = nwg % NXCD, xcd = wgid % NXCD, off = wgid / NXCD; wgid = (xcd < r ? xcd * (q + 1) : r * (q + 1) + (xcd - r) * q) + off; }
        const int nig = WGM * nN, gid = wgid / nig, fm = gid * WGM, gsz = (nM - fm) < WGM ? (nM - fm) : WGM;
        u.pm = fm + ((wgid % nig) % gsz); u.pn = (wgid % nig) / gsz; return true;
    }
};

typedef __bf16 bf16x2_t __attribute__((ext_vector_type(2)));
typedef float f32x2_t __attribute__((ext_vector_type(2)));
struct ListOrder {
    int first, count, nN, nseg;
    __device__ bool next(int i, Unit& u) const { const int j = (nseg == 2) ? (i >> 1) : i; u.seg = (nseg == 2) ? (i & 1) : 0; if (j >= count) return false; const int L = first + j; u.pm = L / nN; u.pn = L % nN; return true; }
};
struct PanelOrder {
    int c;
    __device__ bool next(int i, Unit& u) const { u.seg = 0; if (i >= 2) return false; const int q = c >> 3; u.pm = i * 32 + (c & 7) * 4 + (q >> 3); u.pn = q & 7; return true; }
};
__device__ __forceinline__ unsigned cvt_pk_bf16(float lo, float hi) { const f32x2_t v = {lo, hi}; const bf16x2_t r = __builtin_convertvector(v, bf16x2_t); return __builtin_bit_cast(unsigned, r); }
__device__ __forceinline__ u32x4 pack8(const f32x4 a, const f32x4 b) { u32x4 w; w.x = cvt_pk_bf16(a[0], a[1]); w.y = cvt_pk_bf16(a[2], a[3]); w.z = cvt_pk_bf16(b[0], b[1]); w.w = cvt_pk_bf16(b[2], b[3]); return w; }
__device__ __forceinline__ void unpack8(const u32x4 w, f32x4& a, f32x4& b) {
    a[0] = __uint_as_float(w.x << 16); a[1] = __uint_as_float(w.x & 0xffff0000u); a[2] = __uint_as_float(w.y << 16); a[3] = __uint_as_float(w.y & 0xffff0000u);
    b[0] = __uint_as_float(w.z << 16); b[1] = __uint_as_float(w.z & 0xffff0000u); b[2] = __uint_as_float(w.w << 16); b[3] = __uint_as_float(w.w & 0xffff0000u); }
__device__ __forceinline__ f32x4 sigmoid4(const f32x4 v) { f32x4 o;
#pragma unroll
    for (int i = 0; i < 4; ++i) o[i] = __builtin_amdgcn_rcpf(1.0f + __expf(-v[i]));
    return o; }

typedef f32x4 Acc[2][2][4][2];

struct EpiBf16 {
    static constexpr bool PERM = true, KEEP_ACC = false;
    bf16_t* O; int ldc;
    __device__ __forceinline__ void operator()(Acc& acc, const Unit& u, int wr, int wc, int fr, int fq) const {
        const int row0 = u.pm * BM + wr * 64 + fr, col0 = u.pn * BM + wc * 32 + 8 * fq;
#pragma unroll
        for (int ai = 0; ai < 2; ++ai)
#pragma unroll
            for (int m = 0; m < 4; ++m) { bf16_t* rowp = O + (size_t)(row0 + ai * HALF + m * 16) * ldc + col0;
#pragma unroll
                for (int bj = 0; bj < 2; ++bj) *(u32x4*)(rowp + bj * HALF) = pack8(acc[ai][bj][m][0], acc[ai][bj][m][1]); }
    }
};
struct EpiIn {
    static constexpr bool PERM = true, KEEP_ACC = false;
    bf16_t* ZA; bf16_t* ZG; const float* cosT; const float* sinT; const float* bgate; float qscale; const float* rs1;
    __device__ __forceinline__ void operator()(Acc& acc, const Unit& u, int wr, int wc, int fr, int fq) const {
        const int row0 = u.pm * BM + wr * 64 + fr;
#pragma unroll
        for (int ai = 0; ai < 2; ++ai)
#pragma unroll
            for (int m = 0; m < 4; ++m) { const float rs = rs1[row0 + ai * HALF + m * 16];
#pragma unroll
                for (int bj = 0; bj < 2; ++bj) { acc[ai][bj][m][0] = acc[ai][bj][m][0] * rs; acc[ai][bj][m][1] = acc[ai][bj][m][1] * rs; } }
        if (u.pn < 5) {
            const int p = wc * 32 + 8 * fq, hb = p >> 6, j0 = p & 63, c1 = u.pn * 256 + hb * 128 + j0;
            const float sc = u.pn < 4 ? qscale : 1.0f;
#pragma unroll
            for (int ai = 0; ai < 2; ++ai)
#pragma unroll
                for (int m = 0; m < 4; ++m) { const int row = row0 + ai * HALF + m * 16, pos = row & 2047;
                    const f32x4 ca = *(const f32x4*)(cosT + pos * 64 + j0), cb = *(const f32x4*)(cosT + pos * 64 + j0 + 4);
                    const f32x4 sa = *(const f32x4*)(sinT + pos * 64 + j0), sb = *(const f32x4*)(sinT + pos * 64 + j0 + 4);
                    const f32x4 t1a = acc[ai][0][m][0], t1b = acc[ai][0][m][1], t2a = acc[ai][1][m][0], t2b = acc[ai][1][m][1];
                    const f32x4 o1a = (t1a * ca - t2a * sa) * sc, o1b = (t1b * cb - t2b * sb) * sc, o2a = (t2a * ca + t1a * sa) * sc, o2b = (t2b * cb + t1b * sb) * sc;
                    bf16_t* rp = ZA + (size_t)row * 4608 + c1;
                    __builtin_nontemporal_store(pack8(o1a, o1b), (u32x4*)(rp)); __builtin_nontemporal_store(pack8(o2a, o2b), (u32x4*)(rp + 64)); }
        } else if (u.pn == 5 || u.pn >= 14 && u.pn < 18) {
            const int col0 = (u.pn == 5 ? 1280 : 2560 + (u.pn - 14) * BM) + wc * 32 + 8 * fq;
#pragma unroll
            for (int ai = 0; ai < 2; ++ai)
#pragma unroll
                for (int m = 0; m < 4; ++m) { bf16_t* rowp = ZA + (size_t)(row0 + ai * HALF + m * 16) * 4608 + col0;
#pragma unroll
                    for (int bj = 0; bj < 2; ++bj) __builtin_nontemporal_store(pack8(acc[ai][bj][m][0], acc[ai][bj][m][1]), (u32x4*)(rowp + bj * HALF)); }
        } else if (u.pn < 14) {
            const int col0 = 1536 + (u.pn - 6) * HALF + wc * 32 + 8 * fq;
#pragma unroll
            for (int ai = 0; ai < 2; ++ai)
#pragma unroll
                for (int m = 0; m < 4; ++m) __builtin_nontemporal_store(pack8(acc[ai][0][m][0] * acc[ai][1][m][0], acc[ai][0][m][1] * acc[ai][1][m][1]), (u32x4*)(ZA + (size_t)(row0 + ai * HALF + m * 16) * 4608 + col0));
        } else {
            const int ch0 = (u.pn - 18) * HALF + wc * 32 + 8 * fq;
            const f32x4 ba0 = *(const f32x4*)(bgate + ch0), ba1 = *(const f32x4*)(bgate + ch0 + 4), bc0 = *(const f32x4*)(bgate + 2048 + ch0), bc1 = *(const f32x4*)(bgate + 2048 + ch0 + 4);
#pragma unroll
            for (int ai = 0; ai < 2; ++ai)
#pragma unroll
                for (int m = 0; m < 4; ++m) { bf16_t* rowp = ZG + (size_t)(row0 + ai * HALF + m * 16) * 4096 + ch0;
                    const f32x4 a0 = acc[ai][0][m][0] + ba0, a1 = acc[ai][0][m][1] + ba1, c0 = acc[ai][1][m][0] + bc0, c1 = acc[ai][1][m][1] + bc1;
                    f32x4 r0, r1, g0, g1;
#pragma unroll
                    for (int i = 0; i < 4; ++i) { const float ec0 = 1.0f + __expf(-c0[i]), ec1 = 1.0f + __expf(-c1[i]), ea0 = 1.0f + __expf(-a0[i]), ea1 = 1.0f + __expf(-a1[i]);
                        const float q0 = __builtin_amdgcn_rcpf(ea0 * ec0), q1 = __builtin_amdgcn_rcpf(ea1 * ec1);
                        g0[i] = ea0 * q0; g1[i] = ea1 * q1; r0[i] = ec0 * ec0 * q0; r1[i] = ec1 * ec1 * q1; }
                    __builtin_nontemporal_store(pack8(r0, r1), (u32x4*)(rowp)); __builtin_nontemporal_store(pack8(g0, g1), (u32x4*)(rowp + 2048)); }
        }
    }
};
struct EpiAcc2 {
    static constexpr bool PERM = true, KEEP_ACC = true;
    bf16_t* O; int ldc;
    __device__ __forceinline__ void operator()(Acc& acc, const Unit& u, int wr, int wc, int fr, int fq) const {
        if (u.seg == 0) return;
        const int row0 = u.pm * BM + wr * 64 + fr, col0 = u.pn * BM + wc * 32 + 8 * fq;
#pragma unroll
        for (int ai = 0; ai < 2; ++ai)
#pragma unroll
            for (int m = 0; m < 4; ++m) { bf16_t* rowp = O + (size_t)(row0 + ai * HALF + m * 16) * ldc + col0;
#pragma unroll
                for (int bj = 0; bj < 2; ++bj) *(u32x4*)(rowp + bj * HALF) = pack8(acc[ai][bj][m][0], acc[ai][bj][m][1]); }
    }
};
struct EpiMerge {
    static constexpr bool PERM = true, KEEP_ACC = true;
    const bf16_t* ZG; bf16_t* O;
    __device__ __forceinline__ void operator()(Acc& acc, const Unit& u, int wr, int wc, int fr, int fq) const {
        const int row0 = u.pm * BM + wr * 64 + fr, col0 = u.pn * BM + wc * 32 + 8 * fq;
#pragma unroll
        for (int ai = 0; ai < 2; ++ai)
#pragma unroll
            for (int m = 0; m < 4; ++m) { const int row = row0 + ai * HALF + m * 16;
#pragma unroll
                for (int bj = 0; bj < 2; ++bj) { const bf16_t* gp = ZG + (size_t)row * 4096 + col0 + bj * HALF;
                    if (u.seg == 0) { f32x4 a0, a1; unpack8(*(const u32x4*)gp, a0, a1); acc[ai][bj][m][0] = acc[ai][bj][m][0] * a0; acc[ai][bj][m][1] = acc[ai][bj][m][1] * a1; }
                    else { f32x4 c0, c1; unpack8(*(const u32x4*)(gp + 2048), c0, c1); *(u32x4*)(O + (size_t)row * 2048 + col0 + bj * HALF) = pack8(acc[ai][bj][m][0] * c0, acc[ai][bj][m][1] * c1); } } }
    }
};
struct EpiRes {
    static constexpr bool PERM = true, KEEP_ACC = false;
    const float* base; float* out; bf16_t* outb; float* part; PG8_LAS float* xch;
    __device__ __forceinline__ void operator()(Acc& acc, const Unit& u, int wr, int wc, int fr, int fq) const {
        const int row0 = u.pm * BM + wr * 64 + fr, col0 = u.pn * BM + wc * 32 + 8 * fq;
#pragma unroll
        for (int ai = 0; ai < 2; ++ai)
#pragma unroll
            for (int m = 0; m < 4; ++m) { const int row = row0 + ai * HALF + m * 16; float ss = 0.f;
#pragma unroll
                for (int bj = 0; bj < 2; ++bj) { const size_t off = (size_t)row * 2048 + col0 + bj * HALF;
                    const f32x4 o0 = *(const f32x4*)(base + off) + acc[ai][bj][m][0], o1 = *(const f32x4*)(base + off + 4) + acc[ai][bj][m][1];
                    *(f32x4*)(out + off) = o0; *(f32x4*)(out + off + 4) = o1;
                    if (outb) *(u32x4*)(outb + off) = pack8(o0, o1);
                    ss += (o0[0] * o0[0] + o0[1] * o0[1]) + (o0[2] * o0[2] + o0[3] * o0[3]) + (o1[0] * o1[0] + o1[1] * o1[1]) + (o1[2] * o1[2] + o1[3] * o1[3]); }
                ss += __shfl_xor(ss, 16); ss += __shfl_xor(ss, 32);
                if (fq == 0) xch[(ai * HALF + wr * 64 + m * 16 + fr) * 4 + wc] = ss; }
        asm volatile("s_waitcnt lgkmcnt(0)" ::: "memory"); __builtin_amdgcn_s_barrier(); asm volatile("" ::: "memory");
        { const int t = threadIdx.x; if (t < 256) { const f32x4 v = *(const PG8_LAS f32x4*)(xch + t * 4); part[(size_t)(u.pm * BM + t) * 8 + u.pn] = (v[0] + v[1]) + (v[2] + v[3]); } }
        asm volatile("s_waitcnt lgkmcnt(0)" ::: "memory"); __builtin_amdgcn_s_barrier(); asm volatile("" ::: "memory");
    }
};
struct EpiResB {
    static constexpr bool PERM = true, KEEP_ACC = false;
    const bf16_t* base; bf16_t* outb; float* part; PG8_LAS float* xch;
    __device__ __forceinline__ void operator()(Acc& acc, const Unit& u, int wr, int wc, int fr, int fq) const {
        const int row0 = u.pm * BM + wr * 64 + fr, col0 = u.pn * BM + wc * 32 + 8 * fq;
#pragma unroll
        for (int ai = 0; ai < 2; ++ai)
#pragma unroll
            for (int m = 0; m < 4; ++m) { const int row = row0 + ai * HALF + m * 16; float ss = 0.f;
#pragma unroll
                for (int bj = 0; bj < 2; ++bj) { const size_t off = (size_t)row * 2048 + col0 + bj * HALF;
                    f32x4 b0, b1; unpack8(*(const u32x4*)(base + off), b0, b1);
                    const f32x4 o0 = b0 + acc[ai][bj][m][0], o1 = b1 + acc[ai][bj][m][1];
                    *(u32x4*)(outb + off) = pack8(o0, o1);
                    ss += (o0[0] * o0[0] + o0[1] * o0[1]) + (o0[2] * o0[2] + o0[3] * o0[3]) + (o1[0] * o1[0] + o1[1] * o1[1]) + (o1[2] * o1[2] + o1[3] * o1[3]); }
                ss += __shfl_xor(ss, 16); ss += __shfl_xor(ss, 32);
                if (fq == 0) xch[(ai * HALF + wr * 64 + m * 16 + fr) * 4 + wc] = ss; }
        asm volatile("s_waitcnt lgkmcnt(0)" ::: "memory"); __builtin_amdgcn_s_barrier(); asm volatile("" ::: "memory");
        { const int t = threadIdx.x; if (t < 256) { const f32x4 v = *(const PG8_LAS f32x4*)(xch + t * 4); part[(size_t)(u.pm * BM + t) * 8 + u.pn] = (v[0] + v[1]) + (v[2] + v[3]); } }
        asm volatile("s_waitcnt lgkmcnt(0)" ::: "memory"); __builtin_amdgcn_s_barrier(); asm volatile("" ::: "memory");
    }
};
struct EpiFinal {
    static constexpr bool PERM = true, KEEP_ACC = false;
    const bf16_t* base; float* out; const float* gfin; float* part; unsigned* cnt; PG8_LAS float* xch;
    __device__ __forceinline__ void operator()(Acc& acc, const Unit& u, int wr, int wc, int fr, int fq) const {
        const int row0 = u.pm * BM + wr * 64 + fr, col0 = u.pn * BM + wc * 32 + 8 * fq;
        const int tid = threadIdx.x, wid = __builtin_amdgcn_readfirstlane(tid >> 6), lane = tid & 63;
        PG8_LAS float* S = xch + 1024; PG8_LAS unsigned* flag = (PG8_LAS unsigned*)(xch + 1024 + 256);
#pragma unroll
        for (int ai = 0; ai < 2; ++ai)
#pragma unroll
            for (int m = 0; m < 4; ++m) { const int row = row0 + ai * HALF + m * 16; float ss = 0.f;
#pragma unroll
                for (int bj = 0; bj < 2; ++bj) { f32x4 b0, b1; unpack8(*(const u32x4*)(base + (size_t)row * 2048 + col0 + bj * HALF), b0, b1);
                    const f32x4 o0 = b0 + acc[ai][bj][m][0], o1 = b1 + acc[ai][bj][m][1]; acc[ai][bj][m][0] = o0; acc[ai][bj][m][1] = o1;
                    ss += (o0[0] * o0[0] + o0[1] * o0[1]) + (o0[2] * o0[2] + o0[3] * o0[3]) + (o1[0] * o1[0] + o1[1] * o1[1]) + (o1[2] * o1[2] + o1[3] * o1[3]); }
                ss += __shfl_xor(ss, 16); ss += __shfl_xor(ss, 32);
                if (fq == 0) xch[(ai * HALF + wr * 64 + m * 16 + fr) * 4 + wc] = ss; }
        asm volatile("s_waitcnt lgkmcnt(0)" ::: "memory"); __builtin_amdgcn_s_barrier(); asm volatile("" ::: "memory");
        if (tid < 256) { const f32x4 v = *(const PG8_LAS f32x4*)(xch + tid * 4);
            __hip_atomic_store(part + (size_t)(u.pm * BM + tid) * 8 + u.pn, (v[0] + v[1]) + (v[2] + v[3]), __ATOMIC_RELAXED, __HIP_MEMORY_SCOPE_AGENT);
            asm volatile("s_waitcnt vmcnt(0)" ::: "memory");
            if (lane == 0) __hip_atomic_fetch_add(cnt + 64 * u.pm, 1u, __ATOMIC_RELAXED, __HIP_MEMORY_SCOPE_AGENT); }
        if (wid == 0) { unsigned dead = 0u, sp = 0u;
            while ((unsigned)__builtin_amdgcn_readfirstlane(__hip_atomic_load(cnt + 64 * u.pm, __ATOMIC_RELAXED, __HIP_MEMORY_SCOPE_AGENT)) < 32u) { __builtin_amdgcn_s_sleep(2); if (++sp > (1u << 20)) { dead = 1u; break; } }
            __builtin_amdgcn_fence(__ATOMIC_ACQUIRE, "agent");
            if (lane == 0) flag[0] = dead; }
        asm volatile("s_waitcnt vmcnt(0) lgkmcnt(0)" ::: "memory"); __builtin_amdgcn_s_barrier(); asm volatile("" ::: "memory");
        if (tid < 256) { const float* p = part + (size_t)(u.pm * BM + tid) * 8; float t = 0.f;
#pragma unroll
            for (int j = 0; j < 8; ++j) t += __hip_atomic_load(p + j, __ATOMIC_RELAXED, __HIP_MEMORY_SCOPE_AGENT);
            S[tid] = (flag[0] != 0u) ? __builtin_nanf("") : __builtin_amdgcn_rsqf(t * (1.0f / 2048.0f) + 1e-6f); }
        asm volatile("s_waitcnt vmcnt(0) lgkmcnt(0)" ::: "memory"); __builtin_amdgcn_s_barrier(); asm volatile("" ::: "memory");
        f32x4 gv[2][2];
#pragma unroll
        for (int bj = 0; bj < 2; ++bj) { gv[bj][0] = *(const f32x4*)(gfin + col0 + bj * HALF); gv[bj][1] = *(const f32x4*)(gfin + col0 + bj * HALF + 4); }
#pragma unroll
        for (int ai = 0; ai < 2; ++ai)
#pragma unroll
            for (int m = 0; m < 4; ++m) { const int rl = ai * HALF + wr * 64 + m * 16 + fr; const float rs = S[rl]; float* orow = out + (size_t)(u.pm * BM + rl) * 2048 + col0;
#pragma unroll
                for (int bj = 0; bj < 2; ++bj) { *(f32x4*)(orow + bj * HALF) = acc[ai][bj][m][0] * rs * gv[bj][0]; *(f32x4*)(orow + bj * HALF + 4) = acc[ai][bj][m][1] * rs * gv[bj][1]; } }
        asm volatile("s_waitcnt lgkmcnt(0)" ::: "memory"); __builtin_amdgcn_s_barrier(); asm volatile("" ::: "memory");
    }
};
__device__ __forceinline__ float row_rs(const float* part, int row) { const f32x4 a = *(const f32x4*)(part + (size_t)row * 8), b = *(const f32x4*)(part + (size_t)row * 8 + 4);
    return __builtin_amdgcn_rsqf((((a[0] + a[1]) + (a[2] + a[3])) + ((b[0] + b[1]) + (b[2] + b[3]))) * (1.0f / 2048.0f) + 1e-6f); }
struct EpiRowScale {
    static constexpr bool PERM = true, KEEP_ACC = false;
    bf16_t* O; int ldc; const float* ssq; float scale;
    __device__ __forceinline__ void operator()(Acc& acc, const Unit& u, int wr, int wc, int fr, int fq) const {
        const int row0 = u.pm * BM + wr * 64 + fr, col0 = u.pn * BM + wc * 32 + 8 * fq;
#pragma unroll
        for (int ai = 0; ai < 2; ++ai)
#pragma unroll
            for (int m = 0; m < 4; ++m) { const int row = row0 + ai * HALF + m * 16; const float rs = row_rs(ssq, row) * scale;
                bf16_t* rowp = O + (size_t)row * ldc + col0;
#pragma unroll
                for (int bj = 0; bj < 2; ++bj) *(u32x4*)(rowp + bj * HALF) = pack8(acc[ai][bj][m][0] * rs, acc[ai][bj][m][1] * rs); }
    }
};
struct EpiSwiGLU {
    static constexpr bool PERM = true, KEEP_ACC = false;
    bf16_t* O; const float* ssq;
    __device__ __forceinline__ void operator()(Acc& acc, const Unit& u, int wr, int wc, int fr, int fq) const {
        const int row0 = u.pm * BM + wr * 64 + fr, col0 = u.pn * HALF + wc * 32 + 8 * fq;
#pragma unroll
        for (int ai = 0; ai < 2; ++ai)
#pragma unroll
            for (int m = 0; m < 4; ++m) { const int row = row0 + ai * HALF + m * 16; const float rs = row_rs(ssq, row);
                const f32x4 g0 = acc[ai][0][m][0] * rs, g1 = acc[ai][0][m][1] * rs, u0 = acc[ai][1][m][0] * rs, u1 = acc[ai][1][m][1] * rs;
                __builtin_nontemporal_store(pack8(g0 * sigmoid4(g0) * u0, g1 * sigmoid4(g1) * u1), (u32x4*)(O + (size_t)row * 5632 + col0)); }
    }
};

template <class Epi, class Sched, bool ALIGN_EPI = true>
__device__ __forceinline__ void gemm_phase(PG8_LAS unsigned char* lds, const Gemm g, const Sched& S, const Epi& E) {
    const int tid = threadIdx.x, wid = __builtin_amdgcn_readfirstlane(tid >> 6), lane = tid & 63, wr = wid >> 2, wc = wid & 3, fr = lane & 15, fq = lane >> 4;
    const int K = g.K, nt = K / BK;
    unsigned voffA[2], voffB[2];
#pragma unroll
    for (int i = 0; i < 2; ++i) { int R, C; stage_rc(tid * 16 + i * 8192, R, C); const int Rb = Epi::PERM ? ((R & ~31) + perm32(R & 31)) : R;
        voffA[i] = (unsigned)(R * K + C) * 2u; voffB[i] = (unsigned)(Rb * K + C) * 2u; }
    const size_t kstep = (size_t)(BK * 2);
    const size_t hstep = (size_t)HALF * K * 2;
    const size_t tstep = 2 * hstep;
    const unsigned ldsw = (unsigned)wid * 1024u;
    const int aoff = lds_byte(wr * 64 + fr, fq * 8), boff = lds_byte(wc * 32 + fr, fq * 8);
#define PG8_SA(b, h) (((b) * 2 + (h)) * HTB)
#define PG8_SB(b, h) ((4 + (b) * 2 + (h)) * HTB)
#define PG8_STAGE(bufoff, gbase, voff) do { _Pragma("unroll") for (int _i = 0; _i < 2; ++_i) \
        __builtin_amdgcn_global_load_lds((const unsigned*)((const char*)(gbase) + (voff)[_i]), (PG8_LAS unsigned*)(lds + (bufoff) + ldsw + _i * 8192), 16, 0, 0); } while (0)
#define PG8_LDA(dst, b, h) do { _Pragma("unroll") for (int m = 0; m < 4; ++m) _Pragma("unroll") for (int k = 0; k < 2; ++k) dst[m][k] = *(const PG8_LAS bf16x8*)(lds + PG8_SA(b, h) + aoff + m * 2048 + k * 1024); } while (0)
#define PG8_LDB(dst, b, h) do { _Pragma("unroll") for (int n = 0; n < 2; ++n) _Pragma("unroll") for (int k = 0; k < 2; ++k) dst[n][k] = *(const PG8_LAS bf16x8*)(lds + PG8_SB(b, h) + boff + n * 2048 + k * 1024); } while (0)
#define PG8_MMA(ai, bj, At, Bt) do { __builtin_amdgcn_s_setprio(1); _Pragma("unroll") for (int m = 0; m < 4; ++m) _Pragma("unroll") for (int n = 0; n < 2; ++n) _Pragma("unroll") for (int k = 0; k < 2; ++k) \
        acc[ai][bj][m][n] = __builtin_amdgcn_mfma_f32_16x16x32_bf16(Bt[n][k], At[m][k], acc[ai][bj][m][n], 0, 0, 0); __builtin_amdgcn_s_setprio(0); } while (0)
#define PG8_WAIT_V(n) asm volatile("s_waitcnt vmcnt(" #n ")" ::: "memory")
#define PG8_WAIT_L(n) asm volatile("s_waitcnt lgkmcnt(" #n ")" ::: "memory")
#define PG8_BAR __builtin_amdgcn_s_barrier()
#define PG8_SCHED __builtin_amdgcn_sched_barrier(0)
#define PG8_UA(u) ((const char*)((u).seg ? g.A1 : g.A0) + (size_t)(u).pm * tstep)
#define PG8_UB(u) ((const char*)((u).seg ? g.B1 : g.B0) + (size_t)(u).pn * tstep)
    Unit cur, nxt; int ui = 0;
    if (!S.next(0, cur)) return;
    Acc acc;
#pragma unroll
    for (int a = 0; a < 2; ++a)
#pragma unroll
        for (int b = 0; b < 2; ++b)
#pragma unroll
            for (int m = 0; m < 4; ++m)
#pragma unroll
                for (int n = 0; n < 2; ++n) acc[a][b][m][n] = (f32x4){0.f, 0.f, 0.f, 0.f};
    bf16x8 At[4][2], B0[2][2], B1[2][2];
    const char* cA = PG8_UA(cur); const char* cB = PG8_UB(cur);
    PG8_STAGE(PG8_SB(0, 0), cB, voffB); PG8_STAGE(PG8_SB(0, 1), cB + hstep, voffB); PG8_STAGE(PG8_SA(0, 0), cA, voffA); PG8_STAGE(PG8_SA(0, 1), cA + hstep, voffA);
    if (wr == 1) PG8_BAR;
    PG8_WAIT_V(2); PG8_BAR;
    PG8_STAGE(PG8_SB(1, 0), cB + kstep, voffB); PG8_STAGE(PG8_SA(1, 0), cA + kstep, voffA); PG8_STAGE(PG8_SB(1, 1), cB + hstep + kstep, voffB);
    PG8_WAIT_V(6); PG8_BAR;
    for (;;) {
        const bool has_next = S.next(ui + 1, nxt);
        const char* nA = has_next ? PG8_UA(nxt) : cA; const char* nB = has_next ? PG8_UB(nxt) : cB;
        for (int t = 0; t < nt; t += 2) {
            const bool last = (t == nt - 2);
            const char* a1 = cA + (size_t)(t + 1) * kstep;
            const char* a2 = last ? nA : cA + (size_t)(t + 2) * kstep; const char* b2 = last ? nB : cB + (size_t)(t + 2) * kstep;
            const char* a3 = a2 + kstep; const char* b3 = b2 + kstep;
            PG8_LDB(B0, 0, 0); PG8_LDB(B1, 0, 1); PG8_SCHED; PG8_LDA(At, 0, 0); PG8_STAGE(PG8_SA(1, 1), a1 + hstep, voffA);
            PG8_WAIT_V(8); PG8_WAIT_L(0); PG8_BAR; PG8_MMA(0, 0, At, B0); PG8_MMA(0, 1, At, B1); PG8_BAR; PG8_SCHED;
            PG8_LDA(At, 0, 1); PG8_STAGE(PG8_SB(0, 0), b2, voffB); PG8_STAGE(PG8_SB(0, 1), b2 + hstep, voffB); PG8_STAGE(PG8_SA(0, 0), a2, voffA);
            PG8_WAIT_V(8); PG8_WAIT_L(0); PG8_BAR; PG8_MMA(1, 0, At, B0); PG8_MMA(1, 1, At, B1); PG8_BAR; PG8_SCHED;
            PG8_LDB(B0, 1, 0); PG8_LDB(B1, 1, 1); PG8_SCHED; PG8_LDA(At, 1, 0); PG8_STAGE(PG8_SA(0, 1), a2 + hstep, voffA);
            PG8_WAIT_V(8); PG8_WAIT_L(0); PG8_BAR; PG8_MMA(0, 0, At, B0); PG8_MMA(0, 1, At, B1); PG8_BAR; PG8_SCHED;
            PG8_LDA(At, 1, 1); PG8_STAGE(PG8_SB(1, 0), b3, voffB); PG8_STAGE(PG8_SB(1, 1), b3 + hstep, voffB); PG8_STAGE(PG8_SA(1, 0), a3, voffA);
            PG8_WAIT_V(8); PG8_WAIT_L(0); PG8_BAR; PG8_MMA(1, 0, At, B0); PG8_MMA(1, 1, At, B1); PG8_BAR; PG8_SCHED;
        }
        if constexpr (ALIGN_EPI) { if (wr == 0) PG8_BAR; }
        E(acc, cur, wr, wc, fr, fq);
        if (!has_next) break;
        if (!(Epi::KEEP_ACC && cur.seg == 0)) {
#pragma unroll
        for (int a = 0; a < 2; ++a)
#pragma unroll
            for (int b = 0; b < 2; ++b)
#pragma unroll
                for (int m = 0; m < 4; ++m)
#pragma unroll
                    for (int n = 0; n < 2; ++n) acc[a][b][m][n] = (f32x4){0.f, 0.f, 0.f, 0.f};
        }
        cur = nxt; cA = nA; cB = nB; ++ui;
        if constexpr (ALIGN_EPI) { if (wr == 1) PG8_BAR; }
    }
    PG8_WAIT_V(0);
    if constexpr (!ALIGN_EPI) { if (wr == 0) PG8_BAR; }
    PG8_BAR;
#undef PG8_SA
#undef PG8_SB
#undef PG8_STAGE
#undef PG8_LDA
#undef PG8_LDB
#undef PG8_MMA
#undef PG8_WAIT_V
#undef PG8_WAIT_L
#undef PG8_BAR
#undef PG8_SCHED
#undef PG8_UA
#undef PG8_UB
}
}

constexpr int NWAVES = 8, NTHR = NWAVES * 64;
constexpr int DM = 2048, BATCH = 8, SEQ = 2048, M = BATCH * SEQ;
constexpr int INW = 8704, ZAW = 4608, ZGW = 4096;
constexpr int NMEM = 256, MROWS = BATCH * NMEM;
constexpr int DFF = 5632;
constexpr float RMS_EPS = 1e-6f;

constexpr size_t MiB = 1u << 20;
constexpr size_t WS_BAR = 256 * 1024, WS_BAR_BYTES = 128 * 1024, WS_PCNT = WS_BAR + 64 * 1024;
constexpr size_t WS_RS1 = 0;
constexpr size_t WS_SSQ = 506 * MiB;
constexpr size_t WS_ROPE = 1 * MiB;
constexpr size_t WS_WIN = 2 * MiB;
constexpr size_t WS_WA = 36 * MiB;
constexpr size_t WS_WC = 40 * MiB;
constexpr size_t WS_WO = 44 * MiB;
constexpr size_t WS_WCQ = 52 * MiB;
constexpr size_t WS_WCKV = 54 * MiB;
constexpr size_t WS_WCO = 58 * MiB;
constexpr size_t WS_WGU = 60 * MiB;
constexpr size_t WS_WDN = 104 * MiB;
constexpr size_t WS_MEMN = 126 * MiB;
constexpr size_t WS_MEMKV = 134 * MiB;
constexpr size_t WS_ZA = 138 * MiB;
constexpr size_t WS_ZG = 282 * MiB;
constexpr size_t WS_AO = 2 * MiB;
constexpr size_t WS_CV = 410 * MiB;
constexpr size_t WS_WOB = 410 * MiB;
constexpr size_t WS_XB = 442 * MiB;
constexpr size_t WS_WOQ = 508 * MiB;
constexpr size_t WS_END = 510 * MiB;
constexpr size_t WS_MG = WS_ZA;
constexpr size_t WS_X1B = WS_ZG + 32 * MiB;
constexpr size_t WS_X3B = WS_XB;
constexpr size_t WS_QC = WS_ZG;
constexpr size_t WS_CO = WS_ZG + 16 * MiB;
constexpr size_t WS_X2B = WS_ZA;
constexpr size_t WS_ACT = WS_ZA + 64 * MiB;
static_assert(WS_ACT + (size_t)M * DFF * 2 <= WS_CV, "ACT overlay");

constexpr int LDS_BYTES = 147456;

#define GAS __attribute__((address_space(1)))
#define LAS __attribute__((address_space(3)))
typedef unsigned short bf16;
typedef unsigned v4u __attribute__((ext_vector_type(4)));
typedef float f32x4 __attribute__((ext_vector_type(4)));
#define LDS_WAIT() asm volatile("s_waitcnt lgkmcnt(0)" ::: "memory")
__device__ __forceinline__ unsigned f2bf(float f) { unsigned u = __builtin_bit_cast(unsigned, f); return (u + 0x7fffu + ((u >> 16) & 1u)) >> 16; }
__device__ __forceinline__ unsigned pk2(float lo, float hi) { return f2bf(lo) | (f2bf(hi) << 16); }
__device__ __forceinline__ float bflo(unsigned w) { return __uint_as_float(w << 16); }
__device__ __forceinline__ float bfhi(unsigned w) { return __uint_as_float(w & 0xffff0000u); }
__device__ __forceinline__ float wave_sum(float v) {
#pragma unroll
    for (int o = 1; o < 64; o <<= 1) v += __shfl_xor(v, o);
    return v;
}
__device__ __forceinline__ float wave_max(float v) {
#pragma unroll
    for (int o = 1; o < 64; o <<= 1) v = fmaxf(v, __shfl_xor(v, o));
    return v;
}

__device__ __forceinline__ int dest_row(int n0, int mode) {
    if (mode == 1) return (n0 >> 7) * 256 + (n0 & 127);
    if (mode == 2) return (n0 >> 7) * 256 + 128 + (n0 & 127);
    if (mode == 3 && n0 < 1280) return (n0 >> 8) * 256 + ((n0 >> 6) & 1) * 128 + ((n0 >> 7) & 1) * 64 + (n0 & 63);
    if (mode == 3 && n0 >= 1536 && n0 < 2560) { const int ch = n0 - 1536; return 1536 + (ch >> 7) * 256 + (ch & 127); }
    if (mode == 3 && n0 >= 3584 && n0 < 4608) { const int ch = n0 - 3584; return 1536 + (ch >> 7) * 256 + 128 + (ch & 127); }
    if (mode == 3 && n0 >= 2560 && n0 < 3584) return n0 + 1024;
    if (mode == 3 && n0 >= 4608) { const int g = n0 - 4608, br = g >> 11, ch = g & 2047; return 4608 + (ch >> 7) * 256 + br * 128 + (ch & 127); }
    return n0;
}
struct TItem { const float* W; bf16* WT; const float* gk; int K, N, mode, item; };
__device__ __forceinline__ void p0_t_load(const TItem& t, f32x4 (&v)[8], int lane) {
    const int nblk = t.N / 32, kb = t.item / nblk, nb = t.item % nblk, k0 = 64 * kb, n0 = 32 * nb, kr2 = lane >> 3, nq = lane & 7;
#pragma unroll
    for (int i = 0; i < 4; ++i) { const float* p = t.W + (size_t)(k0 + 16 * i + 2 * kr2) * t.N + n0 + 4 * nq; v[2 * i] = __builtin_nontemporal_load((const f32x4*)p); v[2 * i + 1] = __builtin_nontemporal_load((const f32x4*)(p + t.N)); }
}
__device__ __forceinline__ void p0_t_store(const TItem& t, const f32x4 (&v)[8], LAS float* scrf, int lane) {
    LAS unsigned* scr = (LAS unsigned*)scrf;
    const int nblk = t.N / 32, kb = t.item / nblk, nb = t.item % nblk, k0 = 64 * kb, n0 = 32 * nb, kr2 = lane >> 3, nq = lane & 7;
#pragma unroll
    for (int i = 0; i < 4; ++i) { float g0 = 1.0f, g1 = 1.0f; if (t.gk) { g0 = t.gk[k0 + 16 * i + 2 * kr2]; g1 = t.gk[k0 + 16 * i + 2 * kr2 + 1]; }
        LAS unsigned* p = scr + (4 * nq) * 36 + 8 * i + kr2;
        p[0 * 36] = pk2(v[2 * i].x * g0, v[2 * i + 1].x * g1); p[1 * 36] = pk2(v[2 * i].y * g0, v[2 * i + 1].y * g1);
        p[2 * 36] = pk2(v[2 * i].z * g0, v[2 * i + 1].z * g1); p[3 * 36] = pk2(v[2 * i].w * g0, v[2 * i + 1].w * g1); }
    LDS_WAIT(); asm volatile("" ::: "memory");
    const int c = lane & 7, r0 = dest_row(n0, t.mode);
#pragma unroll
    for (int j = 0; j < 4; ++j) { const int n = (lane >> 3) + 8 * j; *(v4u*)(t.WT + (size_t)(r0 + n) * t.K + k0 + 8 * c) = *(const LAS v4u*)(scr + n * 36 + 4 * c); }
    LDS_WAIT(); asm volatile("" ::: "memory");
}
__device__ __forceinline__ void row_to_bf16_rs(const float* xrow, bf16* orow, float* rs_out, int lane) {
    const f32x4* xr = (const f32x4*)xrow + lane;
    f32x4 v[8]; float s = 0.f;
#pragma unroll
    for (int j = 0; j < 8; ++j) { v[j] = xr[64 * j]; s += (v[j].x * v[j].x + v[j].y * v[j].y) + (v[j].z * v[j].z + v[j].w * v[j].w); }
    const float rs = 1.0f / sqrtf(wave_sum(s) * (1.0f / DM) + RMS_EPS);
    if (lane == 0) *rs_out = rs;
    unsigned long long* o8 = (unsigned long long*)orow + lane;
#pragma unroll
    for (int j = 0; j < 8; ++j) o8[64 * j] = (unsigned long long)pk2(v[j].x, v[j].y) | ((unsigned long long)pk2(v[j].z, v[j].w) << 32);
}
__device__ __forceinline__ void rms_row_to_bf16(const float* xrow, const float* g, bf16* orow, int lane) {
    const f32x4* xr = (const f32x4*)xrow + lane; const f32x4* gr = (const f32x4*)g + lane;
    f32x4 v[8]; float s = 0.f;
#pragma unroll
    for (int j = 0; j < 8; ++j) { v[j] = xr[64 * j]; s += (v[j].x * v[j].x + v[j].y * v[j].y) + (v[j].z * v[j].z + v[j].w * v[j].w); }
    const float rs = 1.0f / sqrtf(wave_sum(s) * (1.0f / DM) + RMS_EPS);
    unsigned long long* o8 = (unsigned long long*)orow + lane;
#pragma unroll
    for (int j = 0; j < 8; ++j) { const f32x4 gg = gr[64 * j];
        o8[64 * j] = (unsigned long long)pk2(v[j].x * rs * gg.x, v[j].y * rs * gg.y) | ((unsigned long long)pk2(v[j].z * rs * gg.z, v[j].w * rs * gg.w) << 32); }
}

typedef float f32x16 __attribute__((ext_vector_type(16)));
typedef short s16x8 __attribute__((ext_vector_type(8)));
typedef short s16x4 __attribute__((ext_vector_type(4)));
constexpr int ATT_KP = 272, ATT_VP = 264, ATT_V_OFF = 128 * ATT_KP, ATT_LDS = ATT_V_OFF + 128 * ATT_VP;
constexpr float LOG2E = 1.4426950408889634f;
template <bool WINDOW>
__device__ __forceinline__ void attn_unit(LAS unsigned char* lds, const bf16* qw, int qpitch, const bf16* kg, const bf16* vg, int kvpitch, int nblk,
                                          int qpos, int kpos, float m_init, float l_init, float qs, bf16* ow, int opitch, int tid, int lane) {
    const int r = lane & 31, h = lane >> 5;
    s16x8 qf[8];
#pragma unroll
    for (int kk = 0; kk < 8; ++kk) qf[kk] = *(const s16x8*)(qw + (size_t)r * qpitch + 16 * kk + 8 * h);
    f32x16 o[4];
#pragma unroll
    for (int dt = 0; dt < 4; ++dt)
#pragma unroll
        for (int i = 0; i < 16; ++i) o[dt][i] = 0.f;
    float m = m_init, l = (h == 0) ? l_init : 0.f;
    const int kkey = tid >> 4, kc = tid & 15, vkey = tid & 127, vcg = tid >> 7;
    for (int blk = 0; blk < nblk; ++blk) {
        v4u kreg[4], vreg[4];
#pragma unroll
        for (int it = 0; it < 4; ++it) { kreg[it] = *(const v4u*)(kg + (size_t)(blk * 128 + kkey + 32 * it) * kvpitch + kc * 8); vreg[it] = *(const v4u*)(vg + (size_t)(blk * 128 + vkey) * kvpitch + (vcg * 4 + it) * 8); }
        __syncthreads();
#pragma unroll
        for (int it = 0; it < 4; ++it) { *(LAS v4u*)(lds + (kkey + 32 * it) * ATT_KP + kc * 16) = kreg[it];
            LAS unsigned short* vt = (LAS unsigned short*)(lds + ATT_V_OFF) + (size_t)((vcg * 4 + it) * 8) * (ATT_VP / 2) + vkey;
            const v4u w = vreg[it];
            vt[0 * (ATT_VP / 2)] = (unsigned short)(w.x & 0xffffu); vt[1 * (ATT_VP / 2)] = (unsigned short)(w.x >> 16); vt[2 * (ATT_VP / 2)] = (unsigned short)(w.y & 0xffffu); vt[3 * (ATT_VP / 2)] = (unsigned short)(w.y >> 16);
            vt[4 * (ATT_VP / 2)] = (unsigned short)(w.z & 0xffffu); vt[5 * (ATT_VP / 2)] = (unsigned short)(w.z >> 16); vt[6 * (ATT_VP / 2)] = (unsigned short)(w.w & 0xffffu); vt[7 * (ATT_VP / 2)] = (unsigned short)(w.w >> 16); }
        __syncthreads();
#pragma unroll 1
        for (int hf = 0; hf < 2; ++hf) {
        const int thr0 = WINDOW ? (qpos - (kpos + blk * 128 + 64 * hf)) : 0;
        if (WINDOW && (thr0 - 63 > 128 || thr0 + 31 < -128)) continue;
        const bool need_mask = WINDOW && (thr0 + 31 > 128 || thr0 - 63 < -128);
        const int thr = thr0 + r - 4 * h;
        f32x16 sc[2];
#pragma unroll
        for (int kt = 0; kt < 2; ++kt) {
#pragma unroll
            for (int i = 0; i < 16; ++i) sc[kt][i] = 0.f;
#pragma unroll
            for (int kk = 0; kk < 8; ++kk) { const s16x8 kf = *(const LAS s16x8*)(lds + (64 * hf + 32 * kt + r) * ATT_KP + (16 * kk + 8 * h) * 2); sc[kt] = __builtin_amdgcn_mfma_f32_32x32x16_bf16(kf, qf[kk], sc[kt], 0, 0, 0); }
        }
        float mb = -1e30f;
#pragma unroll
        for (int kt = 0; kt < 2; ++kt)
#pragma unroll
            for (int i = 0; i < 16; ++i) {
                if (!WINDOW) sc[kt][i] *= qs;
                if (WINDOW) { if (need_mask && (unsigned)((32 * kt + (i & 3) + 8 * (i >> 2)) - thr + 128) > 256u) sc[kt][i] = -1e30f; }
                mb = fmaxf(mb, sc[kt][i]); }
        mb = fmaxf(mb, __shfl_xor(mb, 32));
        const float mn = fmaxf(m, mb), alpha = __builtin_amdgcn_exp2f((m - mn) * LOG2E), mo = mn * LOG2E;
        m = mn; l *= alpha;
#pragma unroll
        for (int dt = 0; dt < 4; ++dt) o[dt] = o[dt] * alpha;
        float ls = 0.f;
#pragma unroll
        for (int kt = 0; kt < 2; ++kt)
#pragma unroll
            for (int i = 0; i < 16; ++i) { const float p = __builtin_amdgcn_exp2f(sc[kt][i] * LOG2E - mo); sc[kt][i] = p; ls += p; }
        l += ls;
#pragma unroll
        for (int kt = 0; kt < 2; ++kt)
#pragma unroll
            for (int st = 0; st < 2; ++st) {
                v4u pw; pw.x = pg8::cvt_pk_bf16(sc[kt][8 * st + 0], sc[kt][8 * st + 1]); pw.y = pg8::cvt_pk_bf16(sc[kt][8 * st + 2], sc[kt][8 * st + 3]);
                pw.z = pg8::cvt_pk_bf16(sc[kt][8 * st + 4], sc[kt][8 * st + 5]); pw.w = pg8::cvt_pk_bf16(sc[kt][8 * st + 6], sc[kt][8 * st + 7]);
                const s16x8 pf = __builtin_bit_cast(s16x8, pw);
#pragma unroll
                for (int dt = 0; dt < 4; ++dt) { const LAS unsigned char* vp = lds + ATT_V_OFF + (32 * dt + r) * ATT_VP + (64 * hf + 32 * kt + 16 * st + 4 * h) * 2;
                    const s16x4 lo = *(const LAS s16x4*)vp, hi = *(const LAS s16x4*)(vp + 16);
                    const s16x8 vf = __builtin_shufflevector(lo, hi, 0, 1, 2, 3, 4, 5, 6, 7);
                    o[dt] = __builtin_amdgcn_mfma_f32_32x32x16_bf16(vf, pf, o[dt], 0, 0, 0); }
            }
        }
    }
    l += __shfl_xor(l, 32);
    const float inv = 1.0f / l;
    bf16* orow = ow + (size_t)r * opitch + 4 * h;
#pragma unroll
    for (int dt = 0; dt < 4; ++dt)
#pragma unroll
        for (int g = 0; g < 4; ++g) { unsigned long long w = (unsigned long long)pg8::cvt_pk_bf16(o[dt][4 * g] * inv, o[dt][4 * g + 1] * inv) | ((unsigned long long)pg8::cvt_pk_bf16(o[dt][4 * g + 2] * inv, o[dt][4 * g + 3] * inv) << 32);
            *(unsigned long long*)(orow + 32 * dt + 8 * g) = w; }
}

#define RLX_AGENT __ATOMIC_RELAXED, __HIP_MEMORY_SCOPE_AGENT
#define XB_TMO      128
#define XB_XCNT(j)  (256  + 64 * (j))
#define XB_XSUB(j)  (1280 + 64 * (j))
#define XB_XGEN(j)  (2304 + 64 * (j))
#define XB_TOP      3328
#define XB_TOPGEN   3392
#define XCD_BAR_WORDS 3456
#define XB_SPIN_CAP (1u << 18)

__device__ __forceinline__ unsigned xb_ld(unsigned* p)              { return __hip_atomic_load(p, __ATOMIC_RELAXED, __HIP_MEMORY_SCOPE_AGENT); }
__device__ __forceinline__ unsigned xb_add(unsigned* p, unsigned v) { return __hip_atomic_fetch_add(p, v, __ATOMIC_RELAXED, __HIP_MEMORY_SCOPE_AGENT); }
__device__ __forceinline__ unsigned xb_xcc_id() { return (unsigned)__builtin_amdgcn_s_getreg((3 << 11) | 20) & 0xFu; }
#define XB_SPIN(cond, bar) do { unsigned _sp = 0; while (cond) { __builtin_amdgcn_s_sleep(1); \
    if ((++_sp & 255u) == 0u) { if (xb_ld(&(bar)[XB_TMO])) break; if (_sp > XB_SPIN_CAP) { atomicAdd(&(bar)[XB_TMO], 1u); break; } } } } while (0)

struct XcdBarrier {
    unsigned* bar; unsigned x;
    volatile LAS unsigned* st;
};

__device__ __forceinline__ XcdBarrier xcd_barrier_post(unsigned* bar, volatile LAS unsigned* st) {
    XcdBarrier b; b.bar = bar; b.x = xb_xcc_id(); b.st = st;
    if (threadIdx.x == 0) (void)xb_add(&bar[XB_XCNT(b.x)], 1u);
    return b;
}
__device__ __forceinline__ void xcd_barrier_complete(unsigned* bar, unsigned x, unsigned& nloc, unsigned& nx) {
    const unsigned G = gridDim.x * gridDim.y * gridDim.z;
    unsigned sum, cnt, mine, sp = 0u;
    for (;;) {
        sum = 0u; cnt = 0u; mine = 0u;
#pragma unroll
        for (unsigned j = 0; j < 16; ++j) { const unsigned c = xb_ld(&bar[XB_XCNT(j)]); sum += c; cnt += (c > 0u) ? 1u : 0u; mine = (j == x) ? c : mine; }
        if (sum == G) break;
        __builtin_amdgcn_s_sleep(1);
        if ((++sp & 255u) == 0u) { if (xb_ld(&bar[XB_TMO])) break; if (sp > XB_SPIN_CAP) { atomicAdd(&bar[XB_TMO], 1u); break; } }
    }
    nloc = mine > 0u ? mine : 1u; nx = cnt > 0u ? cnt : 1u;
}

__device__ __forceinline__ void xcd_barrier(const XcdBarrier& b) {
    asm volatile("s_waitcnt vmcnt(0)" ::: "memory");
    __syncthreads();
    if (threadIdx.x == 0) {
        unsigned* bar = b.bar;
        __builtin_amdgcn_s_waitcnt(0);
        unsigned nloc = b.st[0], nx = b.st[1];
        if (nloc == 0u) { xcd_barrier_complete(bar, b.x, nloc, nx); b.st[0] = nloc; b.st[1] = nx; }
        const unsigned old = xb_add(&bar[XB_XSUB(b.x)], 1u);
        const unsigned gen = old / nloc;
        if (old + 1u == (gen + 1u) * nloc) {
            __builtin_amdgcn_fence(__ATOMIC_RELEASE, "agent");
            asm volatile("s_waitcnt vmcnt(0)" ::: "memory");
            const unsigned og = xb_add(&bar[XB_TOP], 1u);
            const unsigned tg = og / nx;
            if (og + 1u == (tg + 1u) * nx) xb_add(&bar[XB_TOPGEN], 1u);
            else XB_SPIN(xb_ld(&bar[XB_TOPGEN]) == tg, bar);
            __builtin_amdgcn_fence(__ATOMIC_ACQUIRE, "agent");
            xb_add(&bar[XB_XGEN(b.x)], 1u);
            asm volatile("s_waitcnt vmcnt(0)" ::: "memory");
        } else {
            XB_SPIN(xb_ld(&bar[XB_XGEN(b.x)]) == gen, bar);
            __builtin_amdgcn_fence(__ATOMIC_ACQUIRE, "agent");
            asm volatile("s_waitcnt vmcnt(0)" ::: "memory");
        }
    }
    __syncthreads();
}

struct Args { const float* in[20]; float* out; unsigned char* ws; int ph_lo, ph_hi, li, pad; };

__global__ void __launch_bounds__(NTHR, 2) mk_fwd(Args args) {
    extern __shared__ __attribute__((aligned(16))) unsigned char lds_raw[];
    LAS unsigned char* lds = (LAS unsigned char*)lds_raw;
    const int tid = threadIdx.x, lane = tid & 63, wave = __builtin_amdgcn_readfirstlane(tid >> 6);
    const int G = gridDim.x, bx = blockIdx.x;
    const int gw = bx * NWAVES + wave, NGW = G * NWAVES;
    unsigned char* ws = args.ws;
    const float* x = args.in[0]; const float* mem = args.in[1]; const float* g_mix = args.in[2]; const float* w_in = args.in[3]; const float* sink = args.in[4];
    const float* conv_w = args.in[5]; const float* b_gate = args.in[6]; const float* w_attn_out = args.in[7]; const float* w_conv_out = args.in[8]; const float* w_o = args.in[9];
    const float* g_cross = args.in[10]; const float* g_mem = args.in[11]; const float* w_cq = args.in[12]; const float* w_ckv = args.in[13]; const float* w_co = args.in[14];
    const float* g_ffn = args.in[15]; const float* w_gate = args.in[16]; const float* w_up = args.in[17]; const float* w_down = args.in[18]; const float* g_final = args.in[19];
    float* out = args.out;
    float* ssq2 = (float*)(ws + WS_SSQ); float* ssq3 = ssq2 + M * 8; float* ssq4 = ssq3 + M * 8;
    PG8_LAS float* xch = (PG8_LAS float*)(lds + pg8::STAGE_BYTES);
    float* cosT = (float*)(ws + WS_ROPE); float* sinT = cosT + SEQ * 64;
    bf16* Wt_in = (bf16*)(ws + WS_WIN); bf16* Wt_a = (bf16*)(ws + WS_WA); bf16* Wt_c = (bf16*)(ws + WS_WC); bf16* Wt_o = (bf16*)(ws + WS_WO);
    bf16* Wt_cq = (bf16*)(ws + WS_WCQ); bf16* Wt_ckv = (bf16*)(ws + WS_WCKV); bf16* Wt_co = (bf16*)(ws + WS_WCO); bf16* Wt_gu = (bf16*)(ws + WS_WGU); bf16* Wt_dn = (bf16*)(ws + WS_WDN);
    bf16* MEMN = (bf16*)(ws + WS_MEMN); bf16* MEMKV = (bf16*)(ws + WS_MEMKV);
    bf16* ZA = (bf16*)(ws + WS_ZA); bf16* ZG = (bf16*)(ws + WS_ZG); bf16* AO = (bf16*)(ws + WS_AO); bf16* CV = (bf16*)(ws + WS_CV);
    bf16* MG = (bf16*)(ws + WS_MG); bf16* X1B = (bf16*)(ws + WS_X1B); bf16* X3B = (bf16*)(ws + WS_X3B); bf16* XB = (bf16*)(ws + WS_XB); bf16* WOB = (bf16*)(ws + WS_WOB); bf16* WOQ = (bf16*)(ws + WS_WOQ); float* rs1 = (float*)(ws + WS_RS1); bf16* QC = (bf16*)(ws + WS_QC); bf16* CO = (bf16*)(ws + WS_CO);
    bf16* X2B = (bf16*)(ws + WS_X2B); bf16* ACT = (bf16*)(ws + WS_ACT);
    cg::grid_group grid = cg::this_grid();
    const int lo = args.ph_lo, hi = args.ph_hi;
#define IN(k) (lo <= (k) && (k) < hi)
#define SEAM(k) do { if (IN(k) && IN((k) + 1)) { if (args.ph_hi > 1000) { asm volatile("s_waitcnt vmcnt(0) lgkmcnt(0)" ::: "memory"); __syncthreads(); grid.sync(); } else xcd_barrier(xbar); } } while (0)
    if (tid < 4) ((LAS unsigned*)(lds + pg8::STAGE_BYTES + 8192))[tid] = 0u;
    __syncthreads();
    const XcdBarrier xbar = xcd_barrier_post((unsigned*)(ws + WS_BAR) + args.li * 4096, (volatile LAS unsigned*)(lds + pg8::STAGE_BYTES + 8192));

    if (IN(0)) {
        LAS float* scr = (LAS float*)(lds + wave * 16384);
        constexpr int I_IN = (DM / 64) * (INW / 32), I_A = (1024 / 64) * (DM / 32), I_O = (DM / 64) * (DM / 32), I_CQ = (DM / 64) * (512 / 32), I_CKV = (DM / 64) * (1024 / 32),
                      I_CO = (512 / 64) * (DM / 32), I_G = (DM / 64) * (DFF / 32), I_D = (DFF / 64) * (DM / 32);
        constexpr int NITEMS = I_IN + 2 * I_A + I_O + I_CQ + I_CKV + I_CO;
#define P0_PICK(t, itx) do { int r = (itx); \
            if (r < I_IN) { t = TItem{w_in, Wt_in, g_mix, DM, INW, 3, r}; break; } r -= I_IN; \
            if (r < I_A) { t = TItem{w_attn_out, Wt_a, nullptr, 1024, DM, 0, r}; break; } r -= I_A; \
            if (r < I_A) { t = TItem{w_conv_out, Wt_c, nullptr, 1024, DM, 0, r}; break; } r -= I_A; \
            if (r < I_O) { t = TItem{w_o, Wt_o, nullptr, DM, DM, 0, r}; break; } r -= I_O; \
            if (r < I_CQ) { t = TItem{w_cq, Wt_cq, g_cross, DM, 512, 0, r}; break; } r -= I_CQ; \
            if (r < I_CKV) { t = TItem{w_ckv, Wt_ckv, nullptr, DM, 1024, 0, r}; break; } r -= I_CKV; \
            t = TItem{w_co, Wt_co, nullptr, 512, DM, 0, r}; } while (0)
        for (int it = gw; it < NITEMS; it += 2 * NGW) {
            TItem t0, t1; f32x4 v0[8], v1[8]; const bool two = it + NGW < NITEMS;
            P0_PICK(t0, it); p0_t_load(t0, v0, lane);
            if (two) { P0_PICK(t1, it + NGW); p0_t_load(t1, v1, lane); }
            p0_t_store(t0, v0, scr, lane);
            if (two) p0_t_store(t1, v1, scr, lane);
        }
#undef P0_PICK
        for (int m = gw * 2; m < M; m += NGW * 2) {
            f32x4 va[8], vb[8]; const f32x4* xa = (const f32x4*)(x + (size_t)m * DM) + lane; const f32x4* xb2 = xa + DM / 4;
#pragma unroll
            for (int j = 0; j < 8; ++j) { va[j] = __builtin_nontemporal_load(xa + 64 * j); vb[j] = __builtin_nontemporal_load(xb2 + 64 * j); }
            float sa = 0.f, sb = 0.f;
#pragma unroll
            for (int j = 0; j < 8; ++j) { sa += (va[j].x * va[j].x + va[j].y * va[j].y) + (va[j].z * va[j].z + va[j].w * va[j].w); sb += (vb[j].x * vb[j].x + vb[j].y * vb[j].y) + (vb[j].z * vb[j].z + vb[j].w * vb[j].w); }
            sa = wave_sum(sa); sb = wave_sum(sb);
            if (lane == 0) { rs1[m] = 1.0f / sqrtf(sa * (1.0f / DM) + RMS_EPS); rs1[m + 1] = 1.0f / sqrtf(sb * (1.0f / DM) + RMS_EPS); }
            unsigned long long* oa = (unsigned long long*)(XB + (size_t)m * DM) + lane; unsigned long long* ob = oa + DM / 4;
#pragma unroll
            for (int j = 0; j < 8; ++j) { oa[64 * j] = (unsigned long long)pk2(va[j].x, va[j].y) | ((unsigned long long)pk2(va[j].z, va[j].w) << 32);
                ob[64 * j] = (unsigned long long)pk2(vb[j].x, vb[j].y) | ((unsigned long long)pk2(vb[j].z, vb[j].w) << 32); }
        }
        for (int i = bx * NTHR + tid; i < DM * DM / 8; i += G * NTHR) { const f32x4 a = *(const f32x4*)(w_o + (size_t)i * 8), b = *(const f32x4*)(w_o + (size_t)i * 8 + 4); *(v4u*)(WOB + (size_t)i * 8) = pg8::pack8(a, b); }
        for (int m = gw; m < MROWS; m += NGW) rms_row_to_bf16(mem + (size_t)m * DM, g_mem, MEMN + (size_t)m * DM, lane);
        for (int i = bx * NTHR + tid; i < SEQ * 64; i += G * NTHR) { const int pos = i >> 6, j = i & 63;
            const float inv = exp2f(-(float)j * (13.287712379549449f / 64.0f)); const float ang = (float)pos * inv;
            cosT[i] = cosf(ang); sinT[i] = sinf(ang); }
    }
    SEAM(0);

    if (IN(1)) {
        { pg8::Gemm g{XB, Wt_in, nullptr, nullptr, M, INW, DM}; pg8::StaticOrder S; S.init(M, INW, G, bx);
          pg8::EpiIn E{ZA, ZG, cosT, sinT, b_gate, 0.08838834764831845f, rs1};
          pg8::gemm_phase<pg8::EpiIn, pg8::StaticOrder>(lds, g, S, E); }
        { pg8::Gemm g{MEMN, Wt_ckv, nullptr, nullptr, MROWS, 1024, DM}; pg8::StaticOrder S; S.init(MROWS, 1024, G, (bx + G / 2) % G);
          pg8::EpiBf16 E{MEMKV, 1024};
          pg8::gemm_phase<pg8::EpiBf16, pg8::StaticOrder>(lds, g, S, E); }
        { pg8::Gemm g{Wt_cq, WOB, nullptr, nullptr, 512, DM, DM}; pg8::StaticOrder S; S.init(512, DM, G, (bx + G / 2 - 32 + G) % G);
          pg8::EpiBf16 E{WOQ, DM};
          pg8::gemm_phase<pg8::EpiBf16, pg8::StaticOrder>(lds, g, S, E); }
        if (G == 256 ? bx >= 176 : true) {
            __syncthreads();
            LAS float* scr = (LAS float*)(lds + wave * 16384);
            constexpr int I_G = (DM / 64) * (DFF / 32), I_D = (DFF / 64) * (DM / 32), NF = 2 * I_G + I_D;
            const int fw = (G == 256 ? (bx - 176) : bx) * NWAVES + wave, NFW = (G == 256 ? 80 : G) * NWAVES;
#define P1_PICK(t, itx) do { int r = (itx); \
            if (r < I_G) { t = TItem{w_gate, Wt_gu, g_ffn, DM, DFF, 1, r}; break; } r -= I_G; \
            if (r < I_G) { t = TItem{w_up, Wt_gu, g_ffn, DM, DFF, 2, r}; break; } r -= I_G; \
            t = TItem{w_down, Wt_dn, nullptr, DFF, DM, 0, r}; } while (0)
            for (int it = fw; it < NF; it += 4 * NFW) {
                TItem t0, t1, t2, t3; f32x4 v0[8], v1[8], v2[8], v3[8]; const bool h1 = it + NFW < NF, h2 = it + 2 * NFW < NF, h3 = it + 3 * NFW < NF;
                P1_PICK(t0, it); p0_t_load(t0, v0, lane);
                if (h1) { P1_PICK(t1, it + NFW); p0_t_load(t1, v1, lane); }
                if (h2) { P1_PICK(t2, it + 2 * NFW); p0_t_load(t2, v2, lane); }
                if (h3) { P1_PICK(t3, it + 3 * NFW); p0_t_load(t3, v3, lane); }
                p0_t_store(t0, v0, scr, lane);
                if (h1) p0_t_store(t1, v1, scr, lane);
                if (h2) p0_t_store(t2, v2, scr, lane);
                if (h3) p0_t_store(t3, v3, scr, lane);
            }
#undef P1_PICK
        }
    }
    SEAM(1);

    if (IN(2)) {
        for (int it = 2 * bx; it < 512; it += 2 * G)
            for (int hp = 0; hp < 2; ++hp) { const int kvh = it >> 1 & 1, nb = (it >> 2) & 15, b = it >> 6;
                const int hq = kvh * 4 + hp * 2 + (wave >> 2), t0 = b * SEQ + nb * 128 + (wave & 3) * 32;
                const int kb0 = nb > 0 ? nb - 1 : 0, kb1 = nb < 15 ? nb + 1 : 15; const size_t kt0 = (size_t)b * SEQ + kb0 * 128;
                attn_unit<true>(lds, ZA + (size_t)t0 * ZAW + hq * 128, ZAW, ZA + kt0 * ZAW + 1024 + kvh * 128, ZA + kt0 * ZAW + 1280 + kvh * 128, ZAW, kb1 - kb0 + 1,
                                nb * 128 + (wave & 3) * 32, kb0 * 128, sink[hq], 1.0f, 1.0f, AO + (size_t)t0 * 1024 + hq * 128, 1024, tid, lane); }
        __syncthreads();
        for (int idx = bx * NTHR + tid; idx < (M / 16) * 128; idx += G * NTHR) { const int run = idx >> 7, c8 = (idx & 127) * 8, t0 = run * 16, s0 = t0 & (SEQ - 1);
            const f32x4 w0a = *(const f32x4*)(conv_w + c8), w0b = *(const f32x4*)(conv_w + c8 + 4), w1a = *(const f32x4*)(conv_w + 1024 + c8), w1b = *(const f32x4*)(conv_w + 1024 + c8 + 4),
                        w2a = *(const f32x4*)(conv_w + 2048 + c8), w2b = *(const f32x4*)(conv_w + 2048 + c8 + 4);
            const bf16* zr = ZA + (size_t)t0 * ZAW + c8;
            f32x4 pa = {0.f, 0.f, 0.f, 0.f}, pb = pa, ca, cb;
            if (s0 > 0) pg8::unpack8(*(const v4u*)(zr - ZAW + 1536), pa, pb);
            pg8::unpack8(*(const v4u*)(zr + 1536), ca, cb);
#pragma unroll
            for (int i = 0; i < 16; ++i) { f32x4 na = {0.f, 0.f, 0.f, 0.f}, nbv = na, ga, gb;
                if (i < 15 || s0 + 16 < SEQ) pg8::unpack8(*(const v4u*)(zr + (size_t)(i + 1) * ZAW + 1536), na, nbv);
                pg8::unpack8(*(const v4u*)(zr + (size_t)i * ZAW + 2560), ga, gb);
                *(v4u*)(CV + (size_t)(t0 + i) * 1024 + c8) = pg8::pack8(ga * (w0a * pa + w1a * ca + w2a * na), gb * (w0b * pb + w1b * cb + w2b * nbv));
                pa = ca; pb = cb; ca = na; cb = nbv; }
        }
    }
    SEAM(2);

    if (IN(3)) {
        pg8::Gemm g{AO, Wt_a, CV, Wt_c, M, DM, 1024}; pg8::StaticOrder S; S.init(M, DM, G, bx, 2);
        pg8::EpiMerge E{ZG, MG};
        pg8::gemm_phase<pg8::EpiMerge, pg8::StaticOrder>(lds, g, S, E);
    }
    SEAM(3);

    if (IN(4)) {
        { pg8::Gemm g{MG, Wt_o, nullptr, nullptr, M, DM, DM}; pg8::ListOrder S{bx < 128 ? bx : 128 + (bx - 128) * 3, bx < 128 ? 1 : 3, 8, 1};
          pg8::EpiResB E{XB, X1B, ssq2, xch};
          pg8::gemm_phase<pg8::EpiResB, pg8::ListOrder>(lds, g, S, E); }
        { pg8::Gemm g{XB, Wt_cq, MG, WOQ, M, 512, DM}; pg8::ListOrder S{bx, bx < 128 ? 1 : 0, 2, 2};
          pg8::EpiAcc2 E{QC, 512};
          pg8::gemm_phase<pg8::EpiAcc2, pg8::ListOrder>(lds, g, S, E); }
    }
    SEAM(4);

    if (IN(6)) {
        for (int it = bx; it < 256; it += G) { const int rb = it & 7, hh = (it >> 3) & 3, b = it >> 5; const int t0 = b * SEQ + rb * 256 + wave * 32;
            attn_unit<false>(lds, QC + (size_t)t0 * 512 + hh * 128, 512, MEMKV + (size_t)(b * NMEM) * 1024 + hh * 128, MEMKV + (size_t)(b * NMEM) * 1024 + 512 + hh * 128, 1024, 2,
                             0, 0, -1e30f, 0.0f, pg8::row_rs(ssq2, t0 + (lane & 31)) * 0.08838834764831845f, CO + (size_t)t0 * 512 + hh * 128, 512, tid, lane); }
    }
    SEAM(6);

    if (IN(7)) {
        pg8::Gemm g{CO, Wt_co, nullptr, nullptr, M, DM, 512}; pg8::StaticOrder S; S.init(M, DM, G, bx);
        pg8::EpiResB E{X1B, X2B, ssq3, xch};
        pg8::gemm_phase<pg8::EpiResB, pg8::StaticOrder>(lds, g, S, E);
    }
    SEAM(7);

    if (IN(8)) {
        pg8::Gemm g{X2B, Wt_gu, nullptr, nullptr, M, 2 * DFF, DM}; pg8::StaticOrder S; S.init(M, 2 * DFF, G, bx);
        pg8::EpiSwiGLU E{ACT, ssq3};
        pg8::gemm_phase<pg8::EpiSwiGLU, pg8::StaticOrder>(lds, g, S, E);
    }
    SEAM(8);

    if (IN(9)) {
        pg8::Gemm g{ACT, Wt_dn, nullptr, nullptr, M, DM, DFF}; pg8::PanelOrder S{bx};
        pg8::EpiFinal E{X2B, out, g_final, ssq4, (unsigned*)(ws + WS_PCNT), xch};
        pg8::gemm_phase<pg8::EpiFinal, pg8::PanelOrder>(lds, g, S, E);
    }
#if defined(MK_DUMP_OFF)
    if (hi == MK_CUT && MK_CUT < 11) {
        asm volatile("s_waitcnt vmcnt(0) lgkmcnt(0)" ::: "memory"); __syncthreads(); grid.sync();
        const bf16* src = (const bf16*)(ws + (size_t)(MK_DUMP_OFF));
        for (size_t i = (size_t)bx * NTHR + tid; i < (size_t)M * 2048; i += (size_t)G * NTHR) { const size_t r = i >> 11, c = i & 2047; out[i] = __uint_as_float((unsigned)src[r * (MK_DUMP_LD) + (c % (MK_DUMP_W)) + (c / (MK_DUMP_W)) * (size_t)(MK_DUMP_OFF2)] << 16); }
    }
#endif
#undef IN
#undef SEAM
}

extern "C" void kernel_launch(void* const* d_in, const int* in_sizes, int n_in, void* d_out, int out_size, void* d_ws, size_t ws_size, hipStream_t stream) {
    static int grid = 0;
    if (grid == 0) {
        if (n_in != 20 || in_sizes[0] != M * DM || out_size != M * DM || ws_size < WS_END) { fprintf(stderr, "kernel_launch: unexpected shapes / workspace (n_in %d, ws %zu)\n", n_in, ws_size); grid = -1; return; }
        int dev = 0, cus = 0, per_cu = 0;
        if (hipGetDevice(&dev) != hipSuccess || hipDeviceGetAttribute(&cus, hipDeviceAttributeMultiprocessorCount, dev) != hipSuccess) { grid = -1; return; }
        if (hipFuncSetAttribute((const void*)mk_fwd, hipFuncAttributeMaxDynamicSharedMemorySize, LDS_BYTES) != hipSuccess) { fprintf(stderr, "kernel_launch: hipFuncSetAttribute failed\n"); grid = -1; return; }
        if (hipOccupancyMaxActiveBlocksPerMultiprocessor(&per_cu, (const void*)mk_fwd, NTHR, LDS_BYTES) != hipSuccess || per_cu < 1) { fprintf(stderr, "kernel_launch: occupancy query says %d\n", per_cu); (void)hipGetLastError(); grid = -1; return; }
        grid = cus;
    }
    if (grid < 0) return;
    Args a{};
    for (int i = 0; i < 20; ++i) a.in[i] = (const float*)d_in[i];
    a.out = (float*)d_out; a.ws = (unsigned char*)d_ws;
    if (hipMemsetAsync((char*)d_ws + WS_BAR, 0, WS_BAR_BYTES, stream) != hipSuccess) { fprintf(stderr, "kernel_launch: hipMemsetAsync of the barrier words failed\n"); return; }
#if defined(MK_PROBE_DUP)
    { void* kargs[] = {&a}; a.ph_lo = 0; a.ph_hi = MK_PROBE_DUP + 1; hipLaunchCooperativeKernel((const void*)mk_fwd, dim3(grid), dim3(NTHR), kargs, LDS_BYTES, stream);
      a.ph_lo = MK_PROBE_DUP; a.ph_hi = 11; a.li = 1; hipLaunchCooperativeKernel((const void*)mk_fwd, dim3(grid), dim3(NTHR), kargs, LDS_BYTES, stream); }
#elif MK_N_LAUNCHES == 1
    a.ph_lo = 0; a.ph_hi = MK_CUT;
    void* kargs[] = {&a};
    hipError_t e = hipLaunchCooperativeKernel((const void*)mk_fwd, dim3(grid), dim3(NTHR), kargs, LDS_BYTES, stream);
    if (e != hipSuccess) fprintf(stderr, "kernel_launch: cooperative launch failed: %s (grid %d)\n", hipGetErrorString(e), grid);
#else
    for (int p = 0; p < 11; ++p) { a.ph_lo = p; a.ph_hi = p + 1; hipLaunchKernelGGL(mk_fwd, dim3(grid), dim3(NTHR), LDS_BYTES, stream, a); }
#endif
}
```

```cpp
#include <hip/hip_runtime.h>
#include <hip/hip_cooperative_groups.h>
#include <cstdio>
#include <cstdint>
namespace cg = cooperative_groups;

#ifndef MK_CUT
#define MK_CUT 11
#endif
#ifndef MK_N_LAUNCHES
#define MK_N_LAUNCHES 1
#endif

namespace pg8 {
#define PG8_LAS __attribute__((address_space(3)))
typedef unsigned short bf16_t;
typedef short bf16x8 __attribute__((ext_vector_type(8)));
typedef float f32x4 __attribute__((ext_vector_type(4)));
typedef unsigned u32x4 __attribute__((ext_vector_type(4)));
constexpr int BM = 256, BK = 64, HALF = 128, HTB = HALF * BK * 2, STAGE_BYTES = 8 * HTB, NXCD = 8, WGM = 8;

__host__ __device__ __forceinline__ int lds_byte(int r, int c) { const int st = (r >> 4) * 2 + (c >> 5), rr = r & 15, cc = c & 31, ob = rr * 64 + cc * 2; return st * 1024 + (ob ^ (((ob >> 9) & 1) << 5)); }
__host__ __device__ __forceinline__ void stage_rc(int b, int& R, int& C) { const int st = b / 1024, sb = b % 1024, swz = sb ^ (((sb >> 9) & 1) << 5); R = (st >> 1) * 16 + swz / 64; C = (st & 1) * 32 + (swz % 64) / 2; }
__host__ __device__ __forceinline__ int perm32(int rho) { const int n = rho >> 4, i = rho & 15; return 8 * (i >> 2) + 4 * n + (i & 3); }

struct Unit { int pm, pn, seg; };
struct Gemm { const bf16_t* A0; const bf16_t* B0; const bf16_t* A1; const bf16_t* B1; int M, N, K; };

struct StaticOrder {
    int nM, nN, nwg, G, c, nseg;
    __device__ void init(int M, int N, int G_, int c_, int nseg_ = 1) { nM = M / BM; nN = N / BM; nwg = nM * nN; G = G_; c = c_; nseg = nseg_; }
    __device__ bool next(int i, Unit& u) const {
        const int j = (nseg == 2) ? (i >> 1) : i; u.seg = (nseg == 2) ? (i & 1) : 0;
        const long L = (long)j * G + c; if (L >= nwg) return false;
        int wgid = (int)L; { const int q = nwg / NXCD, r = nwg % NXCD, xcd = wgid % NXCD, off = wgid / NXCD; wgid = (xcd < r ? xcd * (q + 1) : r * (q + 1) + (xcd - r) * q) + off; }
        const int nig = WGM * nN, gid = wgid / nig, fm = gid * WGM, gsz = (nM - fm) < WGM ? (nM - fm) : WGM;
        u.pm = fm + ((wgid % nig) % gsz); u.pn = (wgid % nig) / gsz; return true;
    }
};

typedef __bf16 bf16x2_t __attribute__((ext_vector_type(2)));
typedef float f32x2_t __attribute__((ext_vector_type(2)));
struct ListOrder {
    int first, count, nN, nseg;
    __device__ bool next(int i, Unit& u) const { const int j = (nseg == 2) ? (i >> 1) : i; u.seg = (nseg == 2) ? (i & 1) : 0; if (j >= count) return false; const int L = first + j; u.pm = L / nN; u.pn = L % nN; return true; }
};
struct PanelOrder {
    int c;
    __device__ bool next(int i, Unit& u) const { u.seg = 0; if (i >= 2) return false; const int q = c >> 3; u.pm = i * 32 + (c & 7) * 4 + (q >> 3); u.pn = q & 7; return true; }
};
__device__ __forceinline__ unsigned cvt_pk_bf16(float lo, float hi) { const f32x2_t v = {lo, hi}; const bf16x2_t r = __builtin_convertvector(v, bf16x2_t); return __builtin_bit_cast(unsigned, r); }
__device__ __forceinline__ u32x4 pack8(const f32x4 a, const f32x4 b) { u32x4 w; w.x = cvt_pk_bf16(a[0], a[1]); w.y = cvt_pk_bf16(a[2], a[3]); w.z = cvt_pk_bf16(b[0], b[1]); w.w = cvt_pk_bf16(b[2], b[3]); return w; }
__device__ __forceinline__ void unpack8(const u32x4 w, f32x4& a, f32x4& b) {
    a[0] = __uint_as_float(w.x << 16); a[1] = __uint_as_float(w.x & 0xffff0000u); a[2] = __uint_as_float(w.y << 16); a[3] = __uint_as_float(w.y & 0xffff0000u);
    b[0] = __uint_as_float(w.z << 16); b[1] = __uint_as_float(w.z & 0xffff0000u); b[2] = __uint_as_float(w.w << 16); b[3] = __uint_as_float(w.w & 0xffff0000u); }
__device__ __forceinline__ f32x4 sigmoid4(const f32x4 v) { f32x4 o;
#pragma unroll
    for (int i = 0; i < 4; ++i) o[i] = __builtin_amdgcn_rcpf(1.0f + __expf(-v[i]));
    return o; }

typedef f32x4 Acc[2][2][4][2];

struct EpiBf16 {
    static constexpr bool PERM = true, KEEP_ACC = false;
    bf16_t* O; int ldc;
    __device__ __forceinline__ void operator()(Acc& acc, const Unit& u, int wr, int wc, int fr, int fq) const {
        const int row0 = u.pm * BM + wr * 64 + fr, col0 = u.pn * BM + wc * 32 + 8 * fq;
#pragma unroll
        for (int ai = 0; ai < 2; ++ai)
#pragma unroll
            for (int m = 0; m < 4; ++m) { bf16_t* rowp = O + (size_t)(row0 + ai * HALF + m * 16) * ldc + col0;
#pragma unroll
                for (int bj = 0; bj < 2; ++bj) *(u32x4*)(rowp + bj * HALF) = pack8(acc[ai][bj][m][0], acc[ai][bj][m][1]); }
    }
};
struct EpiIn {
    static constexpr bool PERM = true, KEEP_ACC = false;
    bf16_t* ZA; bf16_t* ZG; const float* cosT; const float* sinT; const float* bgate; float qscale; const float* rs1;
    __device__ __forceinline__ void operator()(Acc& acc, const Unit& u, int wr, int wc, int fr, int fq) const {
        const int row0 = u.pm * BM + wr * 64 + fr;
#pragma unroll
        for (int ai = 0; ai < 2; ++ai)
#pragma unroll
            for (int m = 0; m < 4; ++m) { const float rs = rs1[row0 + ai * HALF + m * 16];
#pragma unroll
                for (int bj = 0; bj < 2; ++bj) { acc[ai][bj][m][0] = acc[ai][bj][m][0] * rs; acc[ai][bj][m][1] = acc[ai][bj][m][1] * rs; } }
        if (u.pn < 5) {
            const int p = wc * 32 + 8 * fq, hb = p >> 6, j0 = p & 63, c1 = u.pn * 256 + hb * 128 + j0;
            const float sc = u.pn < 4 ? qscale : 1.0f;
#pragma unroll
            for (int ai = 0; ai < 2; ++ai)
#pragma unroll
                for (int m = 0; m < 4; ++m) { const int row = row0 + ai * HALF + m * 16, pos = row & 2047;
                    const f32x4 ca = *(const f32x4*)(cosT + pos * 64 + j0), cb = *(const f32x4*)(cosT + pos * 64 + j0 + 4);
                    const f32x4 sa = *(const f32x4*)(sinT + pos * 64 + j0), sb = *(const f32x4*)(sinT + pos * 64 + j0 + 4);
                    const f32x4 t1a = acc[ai][0][m][0], t1b = acc[ai][0][m][1], t2a = acc[ai][1][m][0], t2b = acc[ai][1][m][1];
                    const f32x4 o1a = (t1a * ca - t2a * sa) * sc, o1b = (t1b * cb - t2b * sb) * sc, o2a = (t2a * ca + t1a * sa) * sc, o2b = (t2b * cb + t1b * sb) * sc;
                    bf16_t* rp = ZA + (size_t)row * 4608 + c1;
                    __builtin_nontemporal_store(pack8(o1a, o1b), (u32x4*)(rp)); __builtin_nontemporal_store(pack8(o2a, o2b), (u32x4*)(rp + 64)); }
        } else if (u.pn == 5 || u.pn >= 14 && u.pn < 18) {
            const int col0 = (u.pn == 5 ? 1280 : 2560 + (u.pn - 14) * BM) + wc * 32 + 8 * fq;
#pragma unroll
            for (int ai = 0; ai < 2; ++ai)
#pragma unroll
                for (int m = 0; m < 4; ++m) { bf16_t* rowp = ZA + (size_t)(row0 + ai * HALF + m * 16) * 4608 + col0;
#pragma unroll
                    for (int bj = 0; bj < 2; ++bj) __builtin_nontemporal_store(pack8(acc[ai][bj][m][0], acc[ai][bj][m][1]), (u32x4*)(rowp + bj * HALF)); }
        } else if (u.pn < 14) {
            const int col0 = 1536 + (u.pn - 6) * HALF + wc * 32 + 8 * fq;
#pragma unroll
            for (int ai = 0; ai < 2; ++ai)
#pragma unroll
                for (int m = 0; m < 4; ++m) __builtin_nontemporal_store(pack8(acc[ai][0][m][0] * acc[ai][1][m][0], acc[ai][0][m][1] * acc[ai][1][m][1]), (u32x4*)(ZA + (size_t)(row0 + ai * HALF + m * 16) * 4608 + col0));
        } else {
            const int ch0 = (u.pn - 18) * HALF + wc * 32 + 8 * fq;
            const f32x4 ba0 = *(const f32x4*)(bgate + ch0), ba1 = *(const f32x4*)(bgate + ch0 + 4), bc0 = *(const f32x4*)(bgate + 2048 + ch0), bc1 = *(const f32x4*)(bgate + 2048 + ch0 + 4);
#pragma unroll
            for (int ai = 0; ai < 2; ++ai)
#pragma unroll
                for (int m = 0; m < 4; ++m) { bf16_t* rowp = ZG + (size_t)(row0 + ai * HALF + m * 16) * 4096 + ch0;
                    const f32x4 a0 = acc[ai][0][m][0] + ba0, a1 = acc[ai][0][m][1] + ba1, c0 = acc[ai][1][m][0] + bc0, c1 = acc[ai][1][m][1] + bc1;
                    f32x4 r0, r1, g0, g1;
#pragma unroll
                    for (int i = 0; i < 4; ++i) { const float ec0 = 1.0f + __expf(-c0[i]), ec1 = 1.0f + __expf(-c1[i]), ea0 = 1.0f + __expf(-a0[i]), ea1 = 1.0f + __expf(-a1[i]);
                        const float q0 = __builtin_amdgcn_rcpf(ea0 * ec0), q1 = __builtin_amdgcn_rcpf(ea1 * ec1);
                        g0[i] = ea0 * q0; g1[i] = ea1 * q1; r0[i] = ec0 * ec0 * q0; r1[i] = ec1 * ec1 * q1; }
                    __builtin_nontemporal_store(pack8(r0, r1), (u32x4*)(rowp)); __builtin_nontemporal_store(pack8(g0, g1), (u32x4*)(rowp + 2048)); }
        }
    }
};
struct EpiAcc2 {
    static constexpr bool PERM = true, KEEP_ACC = true;
    bf16_t* O; int ldc;
    __device__ __forceinline__ void operator()(Acc& acc, const Unit& u, int wr, int wc, int fr, int fq) const {
        if (u.seg == 0) return;
        const int row0 = u.pm * BM + wr * 64 + fr, col0 = u.pn * BM + wc * 32 + 8 * fq;
#pragma unroll
        for (int ai = 0; ai < 2; ++ai)
#pragma unroll
            for (int m = 0; m < 4; ++m) { bf16_t* rowp = O + (size_t)(row0 + ai * HALF + m * 16) * ldc + col0;
#pragma unroll
                for (int bj = 0; bj < 2; ++bj) *(u32x4*)(rowp + bj * HALF) = pack8(acc[ai][bj][m][0], acc[ai][bj][m][1]); }
    }
};
struct EpiMerge {
    static constexpr bool PERM = true, KEEP_ACC = true;
    const bf16_t* ZG; bf16_t* O;
    __device__ __forceinline__ void operator()(Acc& acc, const Unit& u, int wr, int wc, int fr, int fq) const {
        const int row0 = u.pm * BM + wr * 64 + fr, col0 = u.pn * BM + wc * 32 + 8 * fq;
#pragma unroll
        for (int ai = 0; ai < 2; ++ai)
#pragma unroll
            for (int m = 0; m < 4; ++m) { const int row = row0 + ai * HALF + m * 16;
#pragma unroll
                for (int bj = 0; bj < 2; ++bj) { const bf16_t* gp = ZG + (size_t)row * 4096 + col0 + bj * HALF;
                    if (u.seg == 0) { f32x4 a0, a1; unpack8(*(const u32x4*)gp, a0, a1); acc[ai][bj][m][0] = acc[ai][bj][m][0] * a0; acc[ai][bj][m][1] = acc[ai][bj][m][1] * a1; }
                    else { f32x4 c0, c1; unpack8(*(const u32x4*)(gp + 2048), c0, c1); *(u32x4*)(O + (size_t)row * 2048 + col0 + bj * HALF) = pack8(acc[ai][bj][m][0] * c0, acc[ai][bj][m][1] * c1); } } }
    }
};
struct EpiRes {
    static constexpr bool PERM = true, KEEP_ACC = false;
    const float* base; float* out; bf16_t* outb; float* part; PG8_LAS float* xch;
    __device__ __forceinline__ void operator()(Acc& acc, const Unit& u, int wr, int wc, int fr, int fq) const {
        const int row0 = u.pm * BM + wr * 64 + fr, col0 = u.pn * BM + wc * 32 + 8 * fq;
#pragma unroll
        for (int ai = 0; ai < 2; ++ai)
#pragma unroll
            for (int m = 0; m < 4; ++m) { const int row = row0 + ai * HALF + m * 16; float ss = 0.f;
#pragma unroll
                for (int bj = 0; bj < 2; ++bj) { const size_t off = (size_t)row * 2048 + col0 + bj * HALF;
                    const f32x4 o0 = *(const f32x4*)(base + off) + acc[ai][bj][m][0], o1 = *(const f32x4*)(base + off + 4) + acc[ai][bj][m][1];
                    *(f32x4*)(out + off) = o0; *(f32x4*)(out + off + 4) = o1;
                    if (outb) *(u32x4*)(outb + off) = pack8(o0, o1);
                    ss += (o0[0] * o0[0] + o0[1] * o0[1]) + (o0[2] * o0[2] + o0[3] * o0[3]) + (o1[0] * o1[0] + o1[1] * o1[1]) + (o1[2] * o1[2] + o1[3] * o1[3]); }
                ss += __shfl_xor(ss, 16); ss += __shfl_xor(ss, 32);
                if (fq == 0) xch[(ai * HALF + wr * 64 + m * 16 + fr) * 4 + wc] = ss; }
        asm volatile("s_waitcnt lgkmcnt(0)" ::: "memory"); __builtin_amdgcn_s_barrier(); asm volatile("" ::: "memory");
        { const int t = threadIdx.x; if (t < 256) { const f32x4 v = *(const PG8_LAS f32x4*)(xch + t * 4); part[(size_t)(u.pm * BM + t) * 8 + u.pn] = (v[0] + v[1]) + (v[2] + v[3]); } }
        asm volatile("s_waitcnt lgkmcnt(0)" ::: "memory"); __builtin_amdgcn_s_barrier(); asm volatile("" ::: "memory");
    }
};
struct EpiResB {
    static constexpr bool PERM = true, KEEP_ACC = false;
    const bf16_t* base; bf16_t* outb; float* part; PG8_LAS float* xch;
    __device__ __forceinline__ void operator()(Acc& acc, const Unit& u, int wr, int wc, int fr, int fq) const {
        const int row0 = u.pm * BM + wr * 64 + fr, col0 = u.pn * BM + wc * 32 + 8 * fq;
#pragma unroll
        for (int ai = 0; ai < 2; ++ai)
#pragma unroll
            for (int m = 0; m < 4; ++m) { const int row = row0 + ai * HALF + m * 16; float ss = 0.f;
#pragma unroll
                for (int bj = 0; bj < 2; ++bj) { const size_t off = (size_t)row * 2048 + col0 + bj * HALF;
                    f32x4 b0, b1; unpack8(*(const u32x4*)(base + off), b0, b1);
                    const f32x4 o0 = b0 + acc[ai][bj][m][0], o1 = b1 + acc[ai][bj][m][1];
                    *(u32x4*)(outb + off) = pack8(o0, o1);
                    ss += (o0[0] * o0[0] + o0[1] * o0[1]) + (o0[2] * o0[2] + o0[3] * o0[3]) + (o1[0] * o1[0] + o1[1] * o1[1]) + (o1[2] * o1[2] + o1[3] * o1[3]); }
                ss += __shfl_xor(ss, 16); ss += __shfl_xor(ss, 32);
                if (fq == 0) xch[(ai * HALF + wr * 64 + m * 16 + fr) * 4 + wc] = ss; }
        asm volatile("s_waitcnt lgkmcnt(0)" ::: "memory"); __builtin_amdgcn_s_barrier(); asm volatile("" ::: "memory");
        { const int t = threadIdx.x; if (t < 256) { const f32x4 v = *(const PG8_LAS f32x4*)(xch + t * 4); part[(size_t)(u.pm * BM + t) * 8 + u.pn] = (v[0] + v[1]) + (v[2] + v[3]); } }
        asm volatile("s_waitcnt lgkmcnt(0)" ::: "memory"); __builtin_amdgcn_s_barrier(); asm volatile("" ::: "memory");
    }
};
struct EpiFinal {
    static constexpr bool PERM = true, KEEP_ACC = false;
    const bf16_t* base; float* out; const float* gfin; float* part; unsigned* cnt; PG8_LAS float* xch;
    __device__ __forceinline__ void operator()(Acc& acc, const Unit& u, int wr, int wc, int fr, int fq) const {
        const int row0 = u.pm * BM + wr * 64 + fr, col0 = u.pn * BM + wc * 32 + 8 * fq;
        const int tid = threadIdx.x, wid = __builtin_amdgcn_readfirstlane(tid >> 6), lane = tid & 63;
        PG8_LAS float* S = xch + 1024; PG8_LAS unsigned* flag = (PG8_LAS unsigned*)(xch + 1024 + 256);
#pragma unroll
        for (int ai = 0; ai < 2; ++ai)
#pragma unroll
            for (int m = 0; m < 4; ++m) { const int row = row0 + ai * HALF + m * 16; float ss = 0.f;
#pragma unroll
                for (int bj = 0; bj < 2; ++bj) { f32x4 b0, b1; unpack8(*(const u32x4*)(base + (size_t)row * 2048 + col0 + bj * HALF), b0, b1);
                    const f32x4 o0 = b0 + acc[ai][bj][m][0], o1 = b1 + acc[ai][bj][m][1]; acc[ai][bj][m][0] = o0; acc[ai][bj][m][1] = o1;
                    ss += (o0[0] * o0[0] + o0[1] * o0[1]) + (o0[2] * o0[2] + o0[3] * o0[3]) + (o1[0] * o1[0] + o1[1] * o1[1]) + (o1[2] * o1[2] + o1[3] * o1[3]); }
                ss += __shfl_xor(ss, 16); ss += __shfl_xor(ss, 32);
                if (fq == 0) xch[(ai * HALF + wr * 64 + m * 16 + fr) * 4 + wc] = ss; }
        asm volatile("s_waitcnt lgkmcnt(0)" ::: "memory"); __builtin_amdgcn_s_barrier(); asm volatile("" ::: "memory");
        if (tid < 256) { const f32x4 v = *(const PG8_LAS f32x4*)(xch + tid * 4);
            __hip_atomic_store(part + (size_t)(u.pm * BM + tid) * 8 + u.pn, (v[0] + v[1]) + (v[2] + v[3]), __ATOMIC_RELAXED, __HIP_MEMORY_SCOPE_AGENT);
            asm volatile("s_waitcnt vmcnt(0)" ::: "memory");
            if (lane == 0) __hip_atomic_fetch_add(cnt + 64 * u.pm, 1u, __ATOMIC_RELAXED, __HIP_MEMORY_SCOPE_AGENT); }
        if (wid == 0) { unsigned dead = 0u, sp = 0u;
            while ((unsigned)__builtin_amdgcn_readfirstlane(__hip_atomic_load(cnt + 64 * u.pm, __ATOMIC_RELAXED, __HIP_MEMORY_SCOPE_AGENT)) < 32u) { __builtin_amdgcn_s_sleep(2); if (++sp > (1u << 20)) { dead = 1u; break; } }
            __builtin_amdgcn_fence(__ATOMIC_ACQUIRE, "agent");
            if (lane == 0) flag[0] = dead; }
        asm volatile("s_waitcnt vmcnt(0) lgkmcnt(0)" ::: "memory"); __builtin_amdgcn_s_barrier(); asm volatile("" ::: "memory");
        if (tid < 256) { const float* p = part + (size_t)(u.pm * BM + tid) * 8; float t = 0.f;
#pragma unroll
            for (int j = 0; j < 8; ++j) t += __hip_atomic_load(p + j, __ATOMIC_RELAXED, __HIP_MEMORY_SCOPE_AGENT);
            S[tid] = (flag[0] != 0u) ? __builtin_nanf("") : __builtin_amdgcn_rsqf(t * (1.0f / 2048.0f) + 1e-6f); }
        asm volatile("s_waitcnt vmcnt(0) lgkmcnt(0)" ::: "memory"); __builtin_amdgcn_s_barrier(); asm volatile("" ::: "memory");
        f32x4 gv[2][2];
#pragma unroll
        for (int bj = 0; bj < 2; ++bj) { gv[bj][0] = *(const f32x4*)(gfin + col0 + bj * HALF); gv[bj][1] = *(const f32x4*)(gfin + col0 + bj * HALF + 4); }
#pragma unroll
        for (int ai = 0; ai < 2; ++ai)
#pragma unroll
            for (int m = 0; m < 4; ++m) { const int rl = ai * HALF + wr * 64 + m * 16 + fr; const float rs = S[rl]; float* orow = out + (size_t)(u.pm * BM + rl) * 2048 + col0;
#pragma unroll
                for (int bj = 0; bj < 2; ++bj) { *(f32x4*)(orow + bj * HALF) = acc[ai][bj][m][0] * rs * gv[bj][0]; *(f32x4*)(orow + bj * HALF + 4) = acc[ai][bj][m][1] * rs * gv[bj][1]; } }
        asm volatile("s_waitcnt lgkmcnt(0)" ::: "memory"); __builtin_amdgcn_s_barrier(); asm volatile("" ::: "memory");
    }
};
__device__ __forceinline__ float row_rs(const float* part, int row) { const f32x4 a = *(const f32x4*)(part + (size_t)row * 8), b = *(const f32x4*)(part + (size_t)row * 8 + 4);
    return __builtin_amdgcn_rsqf((((a[0] + a[1]) + (a[2] + a[3])) + ((b[0] + b[1]) + (b[2] + b[3]))) * (1.0f / 2048.0f) + 1e-6f); }
struct EpiRowScale {
    static constexpr bool PERM = true, KEEP_ACC = false;
    bf16_t* O; int ldc; const float* ssq; float scale;
    __device__ __forceinline__ void operator()(Acc& acc, const Unit& u, int wr, int wc, int fr, int fq) const {
        const int row0 = u.pm * BM + wr * 64 + fr, col0 = u.pn * BM + wc * 32 + 8 * fq;
#pragma unroll
        for (int ai = 0; ai < 2; ++ai)
#pragma unroll
            for (int m = 0; m < 4; ++m) { const int row = row0 + ai * HALF + m * 16; const float rs = row_rs(ssq, row) * scale;
                bf16_t* rowp = O + (size_t)row * ldc + col0;
#pragma unroll
                for (int bj = 0; bj < 2; ++bj) *(u32x4*)(rowp + bj * HALF) = pack8(acc[ai][bj][m][0] * rs, acc[ai][bj][m][1] * rs); }
    }
};
struct EpiSwiGLU {
    static constexpr bool PERM = true, KEEP_ACC = false;
    bf16_t* O; const float* ssq;
    __device__ __forceinline__ void operator()(Acc& acc, const Unit& u, int wr, int wc, int fr, int fq) const {
        const int row0 = u.pm * BM + wr * 64 + fr, col0 = u.pn * HALF + wc * 32 + 8 * fq;
#pragma unroll
        for (int ai = 0; ai < 2; ++ai)
#pragma unroll
            for (int m = 0; m < 4; ++m) { const int row = row0 + ai * HALF + m * 16; const float rs = row_rs(ssq, row);
                const f32x4 g0 = acc[ai][0][m][0] * rs, g1 = acc[ai][0][m][1] * rs, u0 = acc[ai][1][m][0] * rs, u1 = acc[ai][1][m][1] * rs;
                __builtin_nontemporal_store(pack8(g0 * sigmoid4(g0) * u0, g1 * sigmoid4(g1) * u1), (u32x4*)(O + (size_t)row * 5632 + col0)); }
    }
};

template <class Epi, class Sched, bool ALIGN_EPI = true>
__device__ __forceinline__ void gemm_phase(PG8_LAS unsigned char* lds, const Gemm g, const Sched& S, const Epi& E) {
    const int tid = threadIdx.x, wid = __builtin_amdgcn_readfirstlane(tid >> 6), lane = tid & 63, wr = wid >> 2, wc = wid & 3, fr = lane & 15, fq = lane >> 4;
    const int K = g.K, nt = K / BK;
    unsigned voffA[2], voffB[2];
#pragma unroll
    for (int i = 0; i < 2; ++i) { int R, C; stage_rc(tid * 16 + i * 8192, R, C); const int Rb = Epi::PERM ? ((R & ~31) + perm32(R & 31)) : R;
        voffA[i] = (unsigned)(R * K + C) * 2u; voffB[i] = (unsigned)(Rb * K + C) * 2u; }
    const size_t kstep = (size_t)(BK * 2);
    const size_t hstep = (size_t)HALF * K * 2;
    const size_t tstep = 2 * hstep;
    const unsigned ldsw = (unsigned)wid * 1024u;
    const int aoff = lds_byte(wr * 64 + fr, fq * 8), boff = lds_byte(wc * 32 + fr, fq * 8);
#define PG8_SA(b, h) (((b) * 2 + (h)) * HTB)
#define PG8_SB(b, h) ((4 + (b) * 2 + (h)) * HTB)
#define PG8_STAGE(bufoff, gbase, voff) do { _Pragma("unroll") for (int _i = 0; _i < 2; ++_i) \
        __builtin_amdgcn_global_load_lds((const unsigned*)((const char*)(gbase) + (voff)[_i]), (PG8_LAS unsigned*)(lds + (bufoff) + ldsw + _i * 8192), 16, 0, 0); } while (0)
#define PG8_LDA(dst, b, h) do { _Pragma("unroll") for (int m = 0; m < 4; ++m) _Pragma("unroll") for (int k = 0; k < 2; ++k) dst[m][k] = *(const PG8_LAS bf16x8*)(lds + PG8_SA(b, h) + aoff + m * 2048 + k * 1024); } while (0)
#define PG8_LDB(dst, b, h) do { _Pragma("unroll") for (int n = 0; n < 2; ++n) _Pragma("unroll") for (int k = 0; k < 2; ++k) dst[n][k] = *(const PG8_LAS bf16x8*)(lds + PG8_SB(b, h) + boff + n * 2048 + k * 1024); } while (0)
#define PG8_MMA(ai, bj, At, Bt) do { __builtin_amdgcn_s_setprio(1); _Pragma("unroll") for (int m = 0; m < 4; ++m) _Pragma("unroll") for (int n = 0; n < 2; ++n) _Pragma("unroll") for (int k = 0; k < 2; ++k) \
        acc[ai][bj][m][n] = __builtin_amdgcn_mfma_f32_16x16x32_bf16(Bt[n][k], At[m][k], acc[ai][bj][m][n], 0, 0, 0); __builtin_amdgcn_s_setprio(0); } while (0)
#define PG8_WAIT_V(n) asm volatile("s_waitcnt vmcnt(" #n ")" ::: "memory")
#define PG8_WAIT_L(n) asm volatile("s_waitcnt lgkmcnt(" #n ")" ::: "memory")
#define PG8_BAR __builtin_amdgcn_s_barrier()
#define PG8_SCHED __builtin_amdgcn_sched_barrier(0)
#define PG8_UA(u) ((const char*)((u).seg ? g.A1 : g.A0) + (size_t)(u).pm * tstep)
#define PG8_UB(u) ((const char*)((u).seg ? g.B1 : g.B0) + (size_t)(u).pn * tstep)
    Unit cur, nxt; int ui = 0;
    if (!S.next(0, cur)) return;
    Acc acc;
#pragma unroll
    for (int a = 0; a < 2; ++a)
#pragma unroll
        for (int b = 0; b < 2; ++b)
#pragma unroll
            for (int m = 0; m < 4; ++m)
#pragma unroll
                for (int n = 0; n < 2; ++n) acc[a][b][m][n] = (f32x4){0.f, 0.f, 0.f, 0.f};
    bf16x8 At[4][2], B0[2][2], B1[2][2];
    const char* cA = PG8_UA(cur); const char* cB = PG8_UB(cur);
    PG8_STAGE(PG8_SB(0, 0), cB, voffB); PG8_STAGE(PG8_SB(0, 1), cB + hstep, voffB); PG8_STAGE(PG8_SA(0, 0), cA, voffA); PG8_STAGE(PG8_SA(0, 1), cA + hstep, voffA);
    if (wr == 1) PG8_BAR;
    PG8_WAIT_V(2); PG8_BAR;
    PG8_STAGE(PG8_SB(1, 0), cB + kstep, voffB); PG8_STAGE(PG8_SA(1, 0), cA + kstep, voffA); PG8_STAGE(PG8_SB(1, 1), cB + hstep + kstep, voffB);
    PG8_WAIT_V(6); PG8_BAR;
    for (;;) {
        const bool has_next = S.next(ui + 1, nxt);
        const char* nA = has_next ? PG8_UA(nxt) : cA; const char* nB = has_next ? PG8_UB(nxt) : cB;
        for (int t = 0; t < nt; t += 2) {
            const bool last = (t == nt - 2);
            const char* a1 = cA + (size_t)(t + 1) * kstep;
            const char* a2 = last ? nA : cA + (size_t)(t + 2) * kstep; const char* b2 = last ? nB : cB + (size_t)(t + 2) * kstep;
            const char* a3 = a2 + kstep; const char* b3 = b2 + kstep;
            PG8_LDB(B0, 0, 0); PG8_LDB(B1, 0, 1); PG8_SCHED; PG8_LDA(At, 0, 0); PG8_STAGE(PG8_SA(1, 1), a1 + hstep, voffA);
            PG8_WAIT_V(8); PG8_WAIT_L(0); PG8_BAR; PG8_MMA(0, 0, At, B0); PG8_MMA(0, 1, At, B1); PG8_BAR; PG8_SCHED;
            PG8_LDA(At, 0, 1); PG8_STAGE(PG8_SB(0, 0), b2, voffB); PG8_STAGE(PG8_SB(0, 1), b2 + hstep, voffB); PG8_STAGE(PG8_SA(0, 0), a2, voffA);
            PG8_WAIT_V(8); PG8_WAIT_L(0); PG8_BAR; PG8_MMA(1, 0, At, B0); PG8_MMA(1, 1, At, B1); PG8_BAR; PG8_SCHED;
            PG8_LDB(B0, 1, 0); PG8_LDB(B1, 1, 1); PG8_SCHED; PG8_LDA(At, 1, 0); PG8_STAGE(PG8_SA(0, 1), a2 + hstep, voffA);
            PG8_WAIT_V(8); PG8_WAIT_L(0); PG8_BAR; PG8_MMA(0, 0, At, B0); PG8_MMA(0, 1, At, B1); PG8_BAR; PG8_SCHED;
            PG8_LDA(At, 1, 1); PG8_STAGE(PG8_SB(1, 0), b3, voffB); PG8_STAGE(PG8_SB(1, 1), b3 + hstep, voffB); PG8_STAGE(PG8_SA(1, 0), a3, voffA);
            PG8_WAIT_V(8); PG8_WAIT_L(0); PG8_BAR; PG8_MMA(1, 0, At, B0); PG8_MMA(1, 1, At, B1); PG8_BAR; PG8_SCHED;
        }
        if constexpr (ALIGN_EPI) { if (wr == 0) PG8_BAR; }
        E(acc, cur, wr, wc, fr, fq);
        if (!has_next) break;
        if (!(Epi::KEEP_ACC && cur.seg == 0)) {
#pragma unroll
        for (int a = 0; a < 2; ++a)
#pragma unroll
            for (int b = 0; b < 2; ++b)
#pragma unroll
                for (int m = 0; m < 4; ++m)
#pragma unroll
                    for (int n = 0; n < 2; ++n) acc[a][b][m][n] = (f32x4){0.f, 0.f, 0.f, 0.f};
        }
        cur = nxt; cA = nA; cB = nB; ++ui;
        if constexpr (ALIGN_EPI) { if (wr == 1) PG8_BAR; }
    }
    PG8_WAIT_V(0);
    if constexpr (!ALIGN_EPI) { if (wr == 0) PG8_BAR; }
    PG8_BAR;
#undef PG8_SA
#undef PG8_SB
#undef PG8_STAGE
#undef PG8_LDA
#undef PG8_LDB
#undef PG8_MMA
#undef PG8_WAIT_V
#undef PG8_WAIT_L
#undef PG8_BAR
#undef PG8_SCHED
#undef PG8_UA
#undef PG8_UB
}
}

constexpr int NWAVES = 8, NTHR = NWAVES * 64;
constexpr int DM = 2048, BATCH = 8, SEQ = 2048, M = BATCH * SEQ;
constexpr int INW = 8704, ZAW = 4608, ZGW = 4096;
constexpr int NMEM = 256, MROWS = BATCH * NMEM;
constexpr int DFF = 5632;
constexpr float RMS_EPS = 1e-6f;

constexpr size_t MiB = 1u << 20;
constexpr size_t WS_BAR = 256 * 1024, WS_BAR_BYTES = 128 * 1024, WS_PCNT = WS_BAR + 64 * 1024;
constexpr size_t WS_RS1 = 0;
constexpr size_t WS_SSQ = 506 * MiB;
constexpr size_t WS_ROPE = 1 * MiB;
constexpr size_t WS_WIN = 2 * MiB;
constexpr size_t WS_WA = 36 * MiB;
constexpr size_t WS_WC = 40 * MiB;
constexpr size_t WS_WO = 44 * MiB;
constexpr size_t WS_WCQ = 52 * MiB;
constexpr size_t WS_WCKV = 54 * MiB;
constexpr size_t WS_WCO = 58 * MiB;
constexpr size_t WS_WGU = 60 * MiB;
constexpr size_t WS_WDN = 104 * MiB;
constexpr size_t WS_MEMN = 126 * MiB;
constexpr size_t WS_MEMKV = 134 * MiB;
constexpr size_t WS_ZA = 138 * MiB;
constexpr size_t WS_ZG = 282 * MiB;
constexpr size_t WS_AO = 2 * MiB;
constexpr size_t WS_CV = 410 * MiB;
constexpr size_t WS_WOB = 410 * MiB;
constexpr size_t WS_XB = 442 * MiB;
constexpr size_t WS_WOQ = 508 * MiB;
constexpr size_t WS_END = 510 * MiB;
constexpr size_t WS_MG = WS_ZA;
constexpr size_t WS_X1B = WS_ZG + 32 * MiB;
constexpr size_t WS_X3B = WS_XB;
constexpr size_t WS_QC = WS_ZG;
constexpr size_t WS_CO = WS_ZG + 16 * MiB;
constexpr size_t WS_X2B = WS_ZA;
constexpr size_t WS_ACT = WS_ZA + 64 * MiB;
static_assert(WS_ACT + (size_t)M * DFF * 2 <= WS_CV, "ACT overlay");

constexpr int LDS_BYTES = 147456;

#define GAS __attribute__((address_space(1)))
#define LAS __attribute__((address_space(3)))
typedef unsigned short bf16;
typedef unsigned v4u __attribute__((ext_vector_type(4)));
typedef float f32x4 __attribute__((ext_vector_type(4)));
#define LDS_WAIT() asm volatile("s_waitcnt lgkmcnt(0)" ::: "memory")
__device__ __forceinline__ unsigned f2bf(float f) { unsigned u = __builtin_bit_cast(unsigned, f); return (u + 0x7fffu + ((u >> 16) & 1u)) >> 16; }
__device__ __forceinline__ unsigned pk2(float lo, float hi) { return f2bf(lo) | (f2bf(hi) << 16); }
__device__ __forceinline__ float bflo(unsigned w) { return __uint_as_float(w << 16); }
__device__ __forceinline__ float bfhi(unsigned w) { return __uint_as_float(w & 0xffff0000u); }
__device__ __forceinline__ float wave_sum(float v) {
#pragma unroll
    for (int o = 1; o < 64; o <<= 1) v += __shfl_xor(v, o);
    return v;
}
__device__ __forceinline__ float wave_max(float v) {
#pragma unroll
    for (int o = 1; o < 64; o <<= 1) v = fmaxf(v, __shfl_xor(v, o));
    return v;
}

__device__ __forceinline__ int dest_row(int n0, int mode) {
    if (mode == 1) return (n0 >> 7) * 256 + (n0 & 127);
    if (mode == 2) return (n0 >> 7) * 256 + 128 + (n0 & 127);
    if (mode == 3 && n0 < 1280) return (n0 >> 8) * 256 + ((n0 >> 6) & 1) * 128 + ((n0 >> 7) & 1) * 64 + (n0 & 63);
    if (mode == 3 && n0 >= 1536 && n0 < 2560) { const int ch = n0 - 1536; return 1536 + (ch >> 7) * 256 + (ch & 127); }
    if (mode == 3 && n0 >= 3584 && n0 < 4608) { const int ch = n0 - 3584; return 1536 + (ch >> 7) * 256 + 128 + (ch & 127); }
    if (mode == 3 && n0 >= 2560 && n0 < 3584) return n0 + 1024;
    if (mode == 3 && n0 >= 4608) { const int g = n0 - 4608, br = g >> 11, ch = g & 2047; return 4608 + (ch >> 7) * 256 + br * 128 + (ch & 127); }
    return n0;
}
struct TItem { const float* W; bf16* WT; const float* gk; int K, N, mode, item; };
__device__ __forceinline__ void p0_t_load(const TItem& t, f32x4 (&v)[8], int lane) {
    const int nblk = t.N / 32, kb = t.item / nblk, nb = t.item % nblk, k0 = 64 * kb, n0 = 32 * nb, kr2 = lane >> 3, nq = lane & 7;
#pragma unroll
    for (int i = 0; i < 4; ++i) { const float* p = t.W + (size_t)(k0 + 16 * i + 2 * kr2) * t.N + n0 + 4 * nq; v[2 * i] = __builtin_nontemporal_load((const f32x4*)p); v[2 * i + 1] = __builtin_nontemporal_load((const f32x4*)(p + t.N)); }
}
__device__ __forceinline__ void p0_t_store(const TItem& t, const f32x4 (&v)[8], LAS float* scrf, int lane) {
    LAS unsigned* scr = (LAS unsigned*)scrf;
    const int nblk = t.N / 32, kb = t.item / nblk, nb = t.item % nblk, k0 = 64 * kb, n0 = 32 * nb, kr2 = lane >> 3, nq = lane & 7;
#pragma unroll
    for (int i = 0; i < 4; ++i) { float g0 = 1.0f, g1 = 1.0f; if (t.gk) { g0 = t.gk[k0 + 16 * i + 2 * kr2]; g1 = t.gk[k0 + 16 * i + 2 * kr2 + 1]; }
        LAS unsigned* p = scr + (4 * nq) * 36 + 8 * i + kr2;
        p[0 * 36] = pk2(v[2 * i].x * g0, v[2 * i + 1].x * g1); p[1 * 36] = pk2(v[2 * i].y * g0, v[2 * i + 1].y * g1);
        p[2 * 36] = pk2(v[2 * i].z * g0, v[2 * i + 1].z * g1); p[3 * 36] = pk2(v[2 * i].w * g0, v[2 * i + 1].w * g1); }
    LDS_WAIT(); asm volatile("" ::: "memory");
    const int c = lane & 7, r0 = dest_row(n0, t.mode);
#pragma unroll
    for (int j = 0; j < 4; ++j) { const int n = (lane >> 3) + 8 * j; *(v4u*)(t.WT + (size_t)(r0 + n) * t.K + k0 + 8 * c) = *(const LAS v4u*)(scr + n * 36 + 4 * c); }
    LDS_WAIT(); asm volatile("" ::: "memory");
}
__device__ __forceinline__ void row_to_bf16_rs(const float* xrow, bf16* orow, float* rs_out, int lane) {
    const f32x4* xr = (const f32x4*)xrow + lane;
    f32x4 v[8]; float s = 0.f;
#pragma unroll
    for (int j = 0; j < 8; ++j) { v[j] = xr[64 * j]; s += (v[j].x * v[j].x + v[j].y * v[j].y) + (v[j].z * v[j].z + v[j].w * v[j].w); }
    const float rs = 1.0f / sqrtf(wave_sum(s) * (1.0f / DM) + RMS_EPS);
    if (lane == 0) *rs_out = rs;
    unsigned long long* o8 = (unsigned long long*)orow + lane;
#pragma unroll
    for (int j = 0; j < 8; ++j) o8[64 * j] = (unsigned long long)pk2(v[j].x, v[j].y) | ((unsigned long long)pk2(v[j].z, v[j].w) << 32);
}
__device__ __forceinline__ void rms_row_to_bf16(const float* xrow, const float* g, bf16* orow, int lane) {
    const f32x4* xr = (const f32x4*)xrow + lane; const f32x4* gr = (const f32x4*)g + lane;
    f32x4 v[8]; float s = 0.f;
#pragma unroll
    for (int j = 0; j < 8; ++j) { v[j] = xr[64 * j]; s += (v[j].x * v[j].x + v[j].y * v[j].y) + (v[j].z * v[j].z + v[j].w * v[j].w); }
    const float rs = 1.0f / sqrtf(wave_sum(s) * (1.0f / DM) + RMS_EPS);
    unsigned long long* o8 = (unsigned long long*)orow + lane;
#pragma unroll
    for (int j = 0; j < 8; ++j) { const f32x4 gg = gr[64 * j];
        o8[64 * j] = (unsigned long long)pk2(v[j].x * rs * gg.x, v[j].y * rs * gg.y) | ((unsigned long long)pk2(v[j].z * rs * gg.z, v[j].w * rs * gg.w) << 32); }
}

typedef float f32x16 __attribute__((ext_vector_type(16)));
typedef short s16x8 __attribute__((ext_vector_type(8)));
typedef short s16x4 __attribute__((ext_vector_type(4)));
constexpr int ATT_KP = 272, ATT_VP = 264, ATT_V_OFF = 128 * ATT_KP, ATT_LDS = ATT_V_OFF + 128 * ATT_VP;
constexpr float LOG2E = 1.4426950408889634f;
template <bool WINDOW>
__device__ __forceinline__ void attn_unit(LAS unsigned char* lds, const bf16* qw, int qpitch, const bf16* kg, const bf16* vg, int kvpitch, int nblk,
                                          int qpos, int kpos, float m_init, float l_init, float qs, bf16* ow, int opitch, int tid, int lane) {
    const int r = lane & 31, h = lane >> 5;
    s16x8 qf[8];
#pragma unroll
    for (int kk = 0; kk < 8; ++kk) qf[kk] = *(const s16x8*)(qw + (size_t)r * qpitch + 16 * kk + 8 * h);
    f32x16 o[4];
#pragma unroll
    for (int dt = 0; dt < 4; ++dt)
#pragma unroll
        for (int i = 0; i < 16; ++i) o[dt][i] = 0.f;
    float m = m_init, l = (h == 0) ? l_init : 0.f;
    const int kkey = tid >> 4, kc = tid & 15, vkey = tid & 127, vcg = tid >> 7;
    for (int blk = 0; blk < nblk; ++blk) {
        v4u kreg[4], vreg[4];
#pragma unroll
        for (int it = 0; it < 4; ++it) { kreg[it] = *(const v4u*)(kg + (size_t)(blk * 128 + kkey + 32 * it) * kvpitch + kc * 8); vreg[it] = *(const v4u*)(vg + (size_t)(blk * 128 + vkey) * kvpitch + (vcg * 4 + it) * 8); }
        __syncthreads();
#pragma unroll
        for (int it = 0; it < 4; ++it) { *(LAS v4u*)(lds + (kkey + 32 * it) * ATT_KP + kc * 16) = kreg[it];
            LAS unsigned short* vt = (LAS unsigned short*)(lds + ATT_V_OFF) + (size_t)((vcg * 4 + it) * 8) * (ATT_VP / 2) + vkey;
            const v4u w = vreg[it];
            vt[0 * (ATT_VP / 2)] = (unsigned short)(w.x & 0xffffu); vt[1 * (ATT_VP / 2)] = (unsigned short)(w.x >> 16); vt[2 * (ATT_VP / 2)] = (unsigned short)(w.y & 0xffffu); vt[3 * (ATT_VP / 2)] = (unsigned short)(w.y >> 16);
            vt[4 * (ATT_VP / 2)] = (unsigned short)(w.z & 0xffffu); vt[5 * (ATT_VP / 2)] = (unsigned short)(w.z >> 16); vt[6 * (ATT_VP / 2)] = (unsigned short)(w.w & 0xffffu); vt[7 * (ATT_VP / 2)] = (unsigned short)(w.w >> 16); }
        __syncthreads();
#pragma unroll 1
        for (int hf = 0; hf < 2; ++hf) {
        const int thr0 = WINDOW ? (qpos - (kpos + blk * 128 + 64 * hf)) : 0;
        if (WINDOW && (thr0 - 63 > 128 || thr0 + 31 < -128)) continue;
        const bool need_mask = WINDOW && (thr0 + 31 > 128 || thr0 - 63 < -128);
        const int thr = thr0 + r - 4 * h;
        f32x16 sc[2];
#pragma unroll
        for (int kt = 0; kt < 2; ++kt) {
#pragma unroll
            for (int i = 0; i < 16; ++i) sc[kt][i] = 0.f;
#pragma unroll
            for (int kk = 0; kk < 8; ++kk) { const s16x8 kf = *(const LAS s16x8*)(lds + (64 * hf + 32 * kt + r) * ATT_KP + (16 * kk + 8 * h) * 2); sc[kt] = __builtin_amdgcn_mfma_f32_32x32x16_bf16(kf, qf[kk], sc[kt], 0, 0, 0); }
        }
        float mb = -1e30f;
#pragma unroll
        for (int kt = 0; kt < 2; ++kt)
#pragma unroll
            for (int i = 0; i < 16; ++i) {
                if (!WINDOW) sc[kt][i] *= qs;
                if (WINDOW) { if (need_mask && (unsigned)((32 * kt + (i & 3) + 8 * (i >> 2)) - thr + 128) > 256u) sc[kt][i] = -1e30f; }
                mb = fmaxf(mb, sc[kt][i]); }
        mb = fmaxf(mb, __shfl_xor(mb, 32));
        const float mn = fmaxf(m, mb), alpha = __builtin_amdgcn_exp2f((m - mn) * LOG2E), mo = mn * LOG2E;
        m = mn; l *= alpha;
#pragma unroll
        for (int dt = 0; dt < 4; ++dt) o[dt] = o[dt] * alpha;
        float ls = 0.f;
#pragma unroll
        for (int kt = 0; kt < 2; ++kt)
#pragma unroll
            for (int i = 0; i < 16; ++i) { const float p = __builtin_amdgcn_exp2f(sc[kt][i] * LOG2E - mo); sc[kt][i] = p; ls += p; }
        l += ls;
#pragma unroll
        for (int kt = 0; kt < 2; ++kt)
#pragma unroll
            for (int st = 0; st < 2; ++st) {
                v4u pw; pw.x = pg8::cvt_pk_bf16(sc[kt][8 * st + 0], sc[kt][8 * st + 1]); pw.y = pg8::cvt_pk_bf16(sc[kt][8 * st + 2], sc[kt][8 * st + 3]);
                pw.z = pg8::cvt_pk_bf16(sc[kt][8 * st + 4], sc[kt][8 * st + 5]); pw.w = pg8::cvt_pk_bf16(sc[kt][8 * st + 6], sc[kt][8 * st + 7]);
                const s16x8 pf = __builtin_bit_cast(s16x8, pw);
#pragma unroll
                for (int dt = 0; dt < 4; ++dt) { const LAS unsigned char* vp = lds + ATT_V_OFF + (32 * dt + r) * ATT_VP + (64 * hf + 32 * kt + 16 * st + 4 * h) * 2;
                    const s16x4 lo = *(const LAS s16x4*)vp, hi = *(const LAS s16x4*)(vp + 16);
                    const s16x8 vf = __builtin_shufflevector(lo, hi, 0, 1, 2, 3, 4, 5, 6, 7);
                    o[dt] = __builtin_amdgcn_mfma_f32_32x32x16_bf16(vf, pf, o[dt], 0, 0, 0); }
            }
        }
    }
    l += __shfl_xor(l, 32);
    const float inv = 1.0f / l;
    bf16* orow = ow + (size_t)r * opitch + 4 * h;
#pragma unroll
    for (int dt = 0; dt < 4; ++dt)
#pragma unroll
        for (int g = 0; g < 4; ++g) { unsigned long long w = (unsigned long long)pg8::cvt_pk_bf16(o[dt][4 * g] * inv, o[dt][4 * g + 1] * inv) | ((unsigned long long)pg8::cvt_pk_bf16(o[dt][4 * g + 2] * inv, o[dt][4 * g + 3] * inv) << 32);
            *(unsigned long long*)(orow + 32 * dt + 8 * g) = w; }
}

#define RLX_AGENT __ATOMIC_RELAXED, __HIP_MEMORY_SCOPE_AGENT
#define XB_TMO      128
#define XB_XCNT(j)  (256  + 64 * (j))
#define XB_XSUB(j)  (1280 + 64 * (j))
#define XB_XGEN(j)  (2304 + 64 * (j))
#define XB_TOP      3328
#define XB_TOPGEN   3392
#define XCD_BAR_WORDS 3456
#define XB_SPIN_CAP (1u << 18)

__device__ __forceinline__ unsigned xb_ld(unsigned* p)              { return __hip_atomic_load(p, __ATOMIC_RELAXED, __HIP_MEMORY_SCOPE_AGENT); }
__device__ __forceinline__ unsigned xb_add(unsigned* p, unsigned v) { return __hip_atomic_fetch_add(p, v, __ATOMIC_RELAXED, __HIP_MEMORY_SCOPE_AGENT); }
__device__ __forceinline__ unsigned xb_xcc_id() { return (unsigned)__builtin_amdgcn_s_getreg((3 << 11) | 20) & 0xFu; }
#define XB_SPIN(cond, bar) do { unsigned _sp = 0; while (cond) { __builtin_amdgcn_s_sleep(1); \
    if ((++_sp & 255u) == 0u) { if (xb_ld(&(bar)[XB_TMO])) break; if (_sp > XB_SPIN_CAP) { atomicAdd(&(bar)[XB_TMO], 1u); break; } } } } while (0)

struct XcdBarrier {
    unsigned* bar; unsigned x;
    volatile LAS unsigned* st;
};

__device__ __forceinline__ XcdBarrier xcd_barrier_post(unsigned* bar, volatile LAS unsigned* st) {
    XcdBarrier b; b.bar = bar; b.x = xb_xcc_id(); b.st = st;
    if (threadIdx.x == 0) (void)xb_add(&bar[XB_XCNT(b.x)], 1u);
    return b;
}
__device__ __forceinline__ void xcd_barrier_complete(unsigned* bar, unsigned x, unsigned& nloc, unsigned& nx) {
    const unsigned G = gridDim.x * gridDim.y * gridDim.z;
    unsigned sum, cnt, mine, sp = 0u;
    for (;;) {
        sum = 0u; cnt = 0u; mine = 0u;
#pragma unroll
        for (unsigned j = 0; j < 16; ++j) { const unsigned c = xb_ld(&bar[XB_XCNT(j)]); sum += c; cnt += (c > 0u) ? 1u : 0u; mine = (j == x) ? c : mine; }
        if (sum == G) break;
        __builtin_amdgcn_s_sleep(1);
        if ((++sp & 255u) == 0u) { if (xb_ld(&bar[XB_TMO])) break; if (sp > XB_SPIN_CAP) { atomicAdd(&bar[XB_TMO], 1u); break; } }
    }
    nloc = mine > 0u ? mine : 1u; nx = cnt > 0u ? cnt : 1u;
}

__device__ __forceinline__ void xcd_barrier(const XcdBarrier& b) {
    asm volatile("s_waitcnt vmcnt(0)" ::: "memory");
    __syncthreads();
    if (threadIdx.x == 0) {
        unsigned* bar = b.bar;
        __builtin_amdgcn_s_waitcnt(0);
        unsigned nloc = b.st[0], nx = b.st[1];
        if (nloc == 0u) { xcd_barrier_complete(bar, b.x, nloc, nx); b.st[0] = nloc; b.st[1] = nx; }
        const unsigned old = xb_add(&bar[XB_XSUB(b.x)], 1u);
        const unsigned gen = old / nloc;
        if (old + 1u == (gen + 1u) * nloc) {
            __builtin_amdgcn_fence(__ATOMIC_RELEASE, "agent");
            asm volatile("s_waitcnt vmcnt(0)" ::: "memory");
            const unsigned og = xb_add(&bar[XB_TOP], 1u);
            const unsigned tg = og / nx;
            if (og + 1u == (tg + 1u) * nx) xb_add(&bar[XB_TOPGEN], 1u);
            else XB_SPIN(xb_ld(&bar[XB_TOPGEN]) == tg, bar);
            __builtin_amdgcn_fence(__ATOMIC_ACQUIRE, "agent");
            xb_add(&bar[XB_XGEN(b.x)], 1u);
            asm volatile("s_waitcnt vmcnt(0)" ::: "memory");
        } else {
            XB_SPIN(xb_ld(&bar[XB_XGEN(b.x)]) == gen, bar);
            __builtin_amdgcn_fence(__ATOMIC_ACQUIRE, "agent");
            asm volatile("s_waitcnt vmcnt(0)" ::: "memory");
        }
    }
    __syncthreads();
}

struct Args { const float* in[20]; float* out; unsigned char* ws; int ph_lo, ph_hi, li, pad; };

__global__ void __launch_bounds__(NTHR, 2) mk_fwd(Args args) {
    extern __shared__ __attribute__((aligned(16))) unsigned char lds_raw[];
    LAS unsigned char* lds = (LAS unsigned char*)lds_raw;
    const int tid = threadIdx.x, lane = tid & 63, wave = __builtin_amdgcn_readfirstlane(tid >> 6);
    const int G = gridDim.x, bx = blockIdx.x;
    const int gw = bx * NWAVES + wave, NGW = G * NWAVES;
    unsigned char* ws = args.ws;
    const float* x = args.in[0]; const float* mem = args.in[1]; const float* g_mix = args.in[2]; const float* w_in = args.in[3]; const float* sink = args.in[4];
    const float* conv_w = args.in[5]; const float* b_gate = args.in[6]; const float* w_attn_out = args.in[7]; const float* w_conv_out = args.in[8]; const float* w_o = args.in[9];
    const float* g_cross = args.in[10]; const float* g_mem = args.in[11]; const float* w_cq = args.in[12]; const float* w_ckv = args.in[13]; const float* w_co = args.in[14];
    const float* g_ffn = args.in[15]; const float* w_gate = args.in[16]; const float* w_up = args.in[17]; const float* w_down = args.in[18]; const float* g_final = args.in[19];
    float* out = args.out;
    float* ssq2 = (float*)(ws + WS_SSQ); float* ssq3 = ssq2 + M * 8; float* ssq4 = ssq3 + M * 8;
    PG8_LAS float* xch = (PG8_LAS float*)(lds + pg8::STAGE_BYTES);
    float* cosT = (float*)(ws + WS_ROPE); float* sinT = cosT + SEQ * 64;
    bf16* Wt_in = (bf16*)(ws + WS_WIN); bf16* Wt_a = (bf16*)(ws + WS_WA); bf16* Wt_c = (bf16*)(ws + WS_WC); bf16* Wt_o = (bf16*)(ws + WS_WO);
    bf16* Wt_cq = (bf16*)(ws + WS_WCQ); bf16* Wt_ckv = (bf16*)(ws + WS_WCKV); bf16* Wt_co = (bf16*)(ws + WS_WCO); bf16* Wt_gu = (bf16*)(ws + WS_WGU); bf16* Wt_dn = (bf16*)(ws + WS_WDN);
    bf16* MEMN = (bf16*)(ws + WS_MEMN); bf16* MEMKV = (bf16*)(ws + WS_MEMKV);
    bf16* ZA = (bf16*)(ws + WS_ZA); bf16* ZG = (bf16*)(ws + WS_ZG); bf16* AO = (bf16*)(ws + WS_AO); bf16* CV = (bf16*)(ws + WS_CV);
    bf16* MG = (bf16*)(ws + WS_MG); bf16* X1B = (bf16*)(ws + WS_X1B); bf16* X3B = (bf16*)(ws + WS_X3B); bf16* XB = (bf16*)(ws + WS_XB); bf16* WOB = (bf16*)(ws + WS_WOB); bf16* WOQ = (bf16*)(ws + WS_WOQ); float* rs1 = (float*)(ws + WS_RS1); bf16* QC = (bf16*)(ws + WS_QC); bf16* CO = (bf16*)(ws + WS_CO);
    bf16* X2B = (bf16*)(ws + WS_X2B); bf16* ACT = (bf16*)(ws + WS_ACT);
    cg::grid_group grid = cg::this_grid();
    const int lo = args.ph_lo, hi = args.ph_hi;
#define IN(k) (lo <= (k) && (k) < hi)
#define SEAM(k) do { if (IN(k) && IN((k) + 1)) { if (args.ph_hi > 1000) { asm volatile("s_waitcnt vmcnt(0) lgkmcnt(0)" ::: "memory"); __syncthreads(); grid.sync(); } else xcd_barrier(xbar); } } while (0)
    if (tid < 4) ((LAS unsigned*)(lds + pg8::STAGE_BYTES + 8192))[tid] = 0u;
    __syncthreads();
    const XcdBarrier xbar = xcd_barrier_post((unsigned*)(ws + WS_BAR) + args.li * 4096, (volatile LAS unsigned*)(lds + pg8::STAGE_BYTES + 8192));

    if (IN(0)) {
        LAS float* scr = (LAS float*)(lds + wave * 16384);
        constexpr int I_IN = (DM / 64) * (INW / 32), I_A = (1024 / 64) * (DM / 32), I_O = (DM / 64) * (DM / 32), I_CQ = (DM / 64) * (512 / 32), I_CKV = (DM / 64) * (1024 / 32),
                      I_CO = (512 / 64) * (DM / 32), I_G = (DM / 64) * (DFF / 32), I_D = (DFF / 64) * (DM / 32);
        constexpr int NITEMS = I_IN + 2 * I_A + I_O + I_CQ + I_CKV + I_CO;
#define P0_PICK(t, itx) do { int r = (itx); \
            if (r < I_IN) { t = TItem{w_in, Wt_in, g_mix, DM, INW, 3, r}; break; } r -= I_IN; \
            if (r < I_A) { t = TItem{w_attn_out, Wt_a, nullptr, 1024, DM, 0, r}; break; } r -= I_A; \
            if (r < I_A) { t = TItem{w_conv_out, Wt_c, nullptr, 1024, DM, 0, r}; break; } r -= I_A; \
            if (r < I_O) { t = TItem{w_o, Wt_o, nullptr, DM, DM, 0, r}; break; } r -= I_O; \
            if (r < I_CQ) { t = TItem{w_cq, Wt_cq, g_cross, DM, 512, 0, r}; break; } r -= I_CQ; \
            if (r < I_CKV) { t = TItem{w_ckv, Wt_ckv, nullptr, DM, 1024, 0, r}; break; } r -= I_CKV; \
            t = TItem{w_co, Wt_co, nullptr, 512, DM, 0, r}; } while (0)
        for (int it = gw; it < NITEMS; it += 2 * NGW) {
            TItem t0, t1; f32x4 v0[8], v1[8]; const bool two = it + NGW < NITEMS;
            P0_PICK(t0, it); p0_t_load(t0, v0, lane);
            if (two) { P0_PICK(t1, it + NGW); p0_t_load(t1, v1, lane); }
            p0_t_store(t0, v0, scr, lane);
            if (two) p0_t_store(t1, v1, scr, lane);
        }
#undef P0_PICK
        for (int m = gw * 2; m < M; m += NGW * 2) {
            f32x4 va[8], vb[8]; const f32x4* xa = (const f32x4*)(x + (size_t)m * DM) + lane; const f32x4* xb2 = xa + DM / 4;
#pragma unroll
            for (int j = 0; j < 8; ++j) { va[j] = __builtin_nontemporal_load(xa + 64 * j); vb[j] = __builtin_nontemporal_load(xb2 + 64 * j); }
            float sa = 0.f, sb = 0.f;
#pragma unroll
            for (int j = 0; j < 8; ++j) { sa += (va[j].x * va[j].x + va[j].y * va[j].y) + (va[j].z * va[j].z + va[j].w * va[j].w); sb += (vb[j].x * vb[j].x + vb[j].y * vb[j].y) + (vb[j].z * vb[j].z + vb[j].w * vb[j].w); }
            sa = wave_sum(sa); sb = wave_sum(sb);
            if (lane == 0) { rs1[m] = 1.0f / sqrtf(sa * (1.0f / DM) + RMS_EPS); rs1[m + 1] = 1.0f / sqrtf(sb * (1.0f / DM) + RMS_EPS); }
            unsigned long long* oa = (unsigned long long*)(XB + (size_t)m * DM) + lane; unsigned long long* ob = oa + DM / 4;
#pragma unroll
            for (int j = 0; j < 8; ++j) { oa[64 * j] = (unsigned long long)pk2(va[j].x, va[j].y) | ((unsigned long long)pk2(va[j].z, va[j].w) << 32);
                ob[64 * j] = (unsigned long long)pk2(vb[j].x, vb[j].y) | ((unsigned long long)pk2(vb[j].z, vb[j].w) << 32); }
        }
        for (int i = bx * NTHR + tid; i < DM * DM / 8; i += G * NTHR) { const f32x4 a = *(const f32x4*)(w_o + (size_t)i * 8), b = *(const f32x4*)(w_o + (size_t)i * 8 + 4); *(v4u*)(WOB + (size_t)i * 8) = pg8::pack8(a, b); }
        for (int m = gw; m < MROWS; m += NGW) rms_row_to_bf16(mem + (size_t)m * DM, g_mem, MEMN + (size_t)m * DM, lane);
        for (int i = bx * NTHR + tid; i < SEQ * 64; i += G * NTHR) { const int pos = i >> 6, j = i & 63;
            const float inv = exp2f(-(float)j * (13.287712379549449f / 64.0f)); const float ang = (float)pos * inv;
            cosT[i] = cosf(ang); sinT[i] = sinf(ang); }
    }
    SEAM(0);

    if (IN(1)) {
        { pg8::Gemm g{XB, Wt_in, nullptr, nullptr, M, INW, DM}; pg8::StaticOrder S; S.init(M, INW, G, bx);
          pg8::EpiIn E{ZA, ZG, cosT, sinT, b_gate, 0.08838834764831845f, rs1};
          pg8::gemm_phase<pg8::EpiIn, pg8::StaticOrder>(lds, g, S, E); }
        { pg8::Gemm g{MEMN, Wt_ckv, nullptr, nullptr, MROWS, 1024, DM}; pg8::StaticOrder S; S.init(MROWS, 1024, G, (bx + G / 2) % G);
          pg8::EpiBf16 E{MEMKV, 1024};
          pg8::gemm_phase<pg8::EpiBf16, pg8::StaticOrder>(lds, g, S, E); }
        { pg8::Gemm g{Wt_cq, WOB, nullptr, nullptr, 512, DM, DM}; pg8::StaticOrder S; S.init(512, DM, G, (bx + G / 2 - 32 + G) % G);
          pg8::EpiBf16 E{WOQ, DM};
          pg8::gemm_phase<pg8::EpiBf16, pg8::StaticOrder>(lds, g, S, E); }
        if (G == 256 ? bx >= 176 : true) {
            __syncthreads();
            LAS float* scr = (LAS float*)(lds + wave * 16384);
            constexpr int I_G = (DM / 64) * (DFF / 32), I_D = (DFF / 64) * (DM / 32), NF = 2 * I_G + I_D;
            const int fw = (G == 256 ? (bx - 176) : bx) * NWAVES + wave, NFW = (G == 256 ? 80 : G) * NWAVES;
#define P1_PICK(t, itx) do { int r = (itx); \
            if (r < I_G) { t = TItem{w_gate, Wt_gu, g_ffn, DM, DFF, 1, r}; break; } r -= I_G; \
            if (r < I_G) { t = TItem{w_up, Wt_gu, g_ffn, DM, DFF, 2, r}; break; } r -= I_G; \
            t = TItem{w_down, Wt_dn, nullptr, DFF, DM, 0, r}; } while (0)
            for (int it = fw; it < NF; it += 4 * NFW) {
                TItem t0, t1, t2, t3; f32x4 v0[8], v1[8], v2[8], v3[8]; const bool h1 = it + NFW < NF, h2 = it + 2 * NFW < NF, h3 = it + 3 * NFW < NF;
                P1_PICK(t0, it); p0_t_load(t0, v0, lane);
                if (h1) { P1_PICK(t1, it + NFW); p0_t_load(t1, v1, lane); }
                if (h2) { P1_PICK(t2, it + 2 * NFW); p0_t_load(t2, v2, lane); }
                if (h3) { P1_PICK(t3, it + 3 * NFW); p0_t_load(t3, v3, lane); }
                p0_t_store(t0, v0, scr, lane);
                if (h1) p0_t_store(t1, v1, scr, lane);
                if (h2) p0_t_store(t2, v2, scr, lane);
                if (h3) p0_t_store(t3, v3, scr, lane);
            }
#undef P1_PICK
        }
    }
    SEAM(1);

    if (IN(2)) {
        const int vcu = (G % 8 == 0) ? (bx % 8) * (G / 8) + bx / 8 : bx;
        for (int it = 2 * vcu; it < 512; it += 2 * G)
            for (int hp = 0; hp < 2; ++hp) { const int kvh = it >> 1 & 1, nb = (it >> 2) & 15, b = it >> 6;
                const int hq = kvh * 4 + hp * 2 + (wave >> 2), t0 = b * SEQ + nb * 128 + (wave & 3) * 32;
                const int kb0 = nb > 0 ? nb - 1 : 0, kb1 = nb < 15 ? nb + 1 : 15; const size_t kt0 = (size_t)b * SEQ + kb0 * 128;
                attn_unit<true>(lds, ZA + (size_t)t0 * ZAW + hq * 128, ZAW, ZA + kt0 * ZAW + 1024 + kvh * 128, ZA + kt0 * ZAW + 1280 + kvh * 128, ZAW, kb1 - kb0 + 1,
                                nb * 128 + (wave & 3) * 32, kb0 * 128, sink[hq], 1.0f, 1.0f, AO + (size_t)t0 * 1024 + hq * 128, 1024, tid, lane); }
        __syncthreads();
        for (int idx = bx * NTHR + tid; idx < (M / 16) * 128; idx += G * NTHR) { const int run = idx >> 7, c8 = (idx & 127) * 8, t0 = run * 16, s0 = t0 & (SEQ - 1);
            const f32x4 w0a = *(const f32x4*)(conv_w + c8), w0b = *(const f32x4*)(conv_w + c8 + 4), w1a = *(const f32x4*)(conv_w + 1024 + c8), w1b = *(const f32x4*)(conv_w + 1024 + c8 + 4),
                        w2a = *(const f32x4*)(conv_w + 2048 + c8), w2b = *(const f32x4*)(conv_w + 2048 + c8 + 4);
            const bf16* zr = ZA + (size_t)t0 * ZAW + c8;
            f32x4 pa = {0.f, 0.f, 0.f, 0.f}, pb = pa, ca, cb;
            if (s0 > 0) pg8::unpack8(*(const v4u*)(zr - ZAW + 1536), pa, pb);
            pg8::unpack8(*(const v4u*)(zr + 1536), ca, cb);
#pragma unroll
            for (int i = 0; i < 16; ++i) { f32x4 na = {0.f, 0.f, 0.f, 0.f}, nbv = na, ga, gb;
                if (i < 15 || s0 + 16 < SEQ) pg8::unpack8(*(const v4u*)(zr + (size_t)(i + 1) * ZAW + 1536), na, nbv);
                pg8::unpack8(*(const v4u*)(zr + (size_t)i * ZAW + 2560), ga, gb);
                *(v4u*)(CV + (size_t)(t0 + i) * 1024 + c8) = pg8::pack8(ga * (w0a * pa + w1a * ca + w2a * na), gb * (w0b * pb + w1b * cb + w2b * nbv));
                pa = ca; pb = cb; ca = na; cb = nbv; }
        }
    }
    SEAM(2);

    if (IN(3)) {
        pg8::Gemm g{AO, Wt_a, CV, Wt_c, M, DM, 1024}; pg8::StaticOrder S; S.init(M, DM, G, bx, 2);
        pg8::EpiMerge E{ZG, MG};
        pg8::gemm_phase<pg8::EpiMerge, pg8::StaticOrder>(lds, g, S, E);
    }
    SEAM(3);

    if (IN(4)) {
        { pg8::Gemm g{MG, Wt_o, nullptr, nullptr, M, DM, DM}; pg8::ListOrder S{bx < 128 ? bx : 128 + (bx - 128) * 3, bx < 128 ? 1 : 3, 8, 1};
          pg8::EpiResB E{XB, X1B, ssq2, xch};
          pg8::gemm_phase<pg8::EpiResB, pg8::ListOrder>(lds, g, S, E); }
        { pg8::Gemm g{XB, Wt_cq, MG, WOQ, M, 512, DM}; pg8::ListOrder S{bx, bx < 128 ? 1 : 0, 2, 2};
          pg8::EpiAcc2 E{QC, 512};
          pg8::gemm_phase<pg8::EpiAcc2, pg8::ListOrder>(lds, g, S, E); }
    }
    SEAM(4);

    if (IN(6)) {
        const int vcu = (G % 8 == 0) ? (bx % 8) * (G / 8) + bx / 8 : bx;
        for (int it = vcu; it < 256; it += G) { const int rb = it & 7, hh = (it >> 3) & 3, b = it >> 5; const int t0 = b * SEQ + rb * 256 + wave * 32;
            attn_unit<false>(lds, QC + (size_t)t0 * 512 + hh * 128, 512, MEMKV + (size_t)(b * NMEM) * 1024 + hh * 128, MEMKV + (size_t)(b * NMEM) * 1024 + 512 + hh * 128, 1024, 2,
                             0, 0, -1e30f, 0.0f, pg8::row_rs(ssq2, t0 + (lane & 31)) * 0.08838834764831845f, CO + (size_t)t0 * 512 + hh * 128, 512, tid, lane); }
    }
    SEAM(6);

    if (IN(7)) {
        pg8::Gemm g{CO, Wt_co, nullptr, nullptr, M, DM, 512}; pg8::StaticOrder S; S.init(M, DM, G, bx);
        pg8::EpiResB E{X1B, X2B, ssq3, xch};
        pg8::gemm_phase<pg8::EpiResB, pg8::StaticOrder>(lds, g, S, E);
    }
    SEAM(7);

    if (IN(8)) {
        pg8::Gemm g{X2B, Wt_gu, nullptr, nullptr, M, 2 * DFF, DM}; pg8::StaticOrder S; S.init(M, 2 * DFF, G, bx);
        pg8::EpiSwiGLU E{ACT, ssq3};
        pg8::gemm_phase<pg8::EpiSwiGLU, pg8::StaticOrder>(lds, g, S, E);
    }
    SEAM(8);

    if (IN(9)) {
        pg8::Gemm g{ACT, Wt_dn, nullptr, nullptr, M, DM, DFF}; pg8::PanelOrder S{bx};
        pg8::EpiFinal E{X2B, out, g_final, ssq4, (unsigned*)(ws + WS_PCNT), xch};
        pg8::gemm_phase<pg8::EpiFinal, pg8::PanelOrder>(lds, g, S, E);
    }
#if defined(MK_DUMP_OFF)
    if (hi == MK_CUT && MK_CUT < 11) {
        asm volatile("s_waitcnt vmcnt(0) lgkmcnt(0)" ::: "memory"); __syncthreads(); grid.sync();
        const bf16* src = (const bf16*)(ws + (size_t)(MK_DUMP_OFF));
        for (size_t i = (size_t)bx * NTHR + tid; i < (size_t)M * 2048; i += (size_t)G * NTHR) { const size_t r = i >> 11, c = i & 2047; out[i] = __uint_as_float((unsigned)src[r * (MK_DUMP_LD) + (c % (MK_DUMP_W)) + (c / (MK_DUMP_W)) * (size_t)(MK_DUMP_OFF2)] << 16); }
    }
#endif
#undef IN
#undef SEAM
}

extern "C" void kernel_launch(void* const* d_in, const int* in_sizes, int n_in, void* d_out, int out_size, void* d_ws, size_t ws_size, hipStream_t stream) {
    static int grid = 0;
    if (grid == 0) {
        if (n_in != 20 || in_sizes[0] != M * DM || out_size != M * DM || ws_size < WS_END) { fprintf(stderr, "kernel_launch: unexpected shapes / workspace (n_in %d, ws %zu)\n", n_in, ws_size); grid = -1; return; }
        int dev = 0, cus = 0, per_cu = 0;
        if (hipGetDevice(&dev) != hipSuccess || hipDeviceGetAttribute(&cus, hipDeviceAttributeMultiprocessorCount, dev) != hipSuccess) { grid = -1; return; }
        if (hipFuncSetAttribute((const void*)mk_fwd, hipFuncAttributeMaxDynamicSharedMemorySize, LDS_BYTES) != hipSuccess) { fprintf(stderr, "kernel_launch: hipFuncSetAttribute failed\n"); grid = -1; return; }
        if (hipOccupancyMaxActiveBlocksPerMultiprocessor(&per_cu, (const void*)mk_fwd, NTHR, LDS_BYTES) != hipSuccess || per_cu < 1) { fprintf(stderr, "kernel_launch: occupancy query says %d\n", per_cu); (void)hipGetLastError(); grid = -1; return; }
        grid = cus;
    }
    if (grid < 0) return;
    Args a{};
    for (int i = 0; i < 20; ++i) a.in[i] = (const float*)d_in[i];
    a.out = (float*)d_out; a.ws = (unsigned char*)d_ws;
    if (hipMemsetAsync((char*)d_ws + WS_BAR, 0, WS_BAR_BYTES, stream) != hipSuccess) { fprintf(stderr, "kernel_launch: hipMemsetAsync of the barrier words failed\n"); return; }
#if defined(MK_PROBE_DUP)
    { void* kargs[] = {&a}; a.ph_lo = 0; a.ph_hi = MK_PROBE_DUP + 1; hipLaunchCooperativeKernel((const void*)mk_fwd, dim3(grid), dim3(NTHR), kargs, LDS_BYTES, stream);
      a.ph_lo = MK_PROBE_DUP; a.ph_hi = 11; a.li = 1; hipLaunchCooperativeKernel((const void*)mk_fwd, dim3(grid), dim3(NTHR), kargs, LDS_BYTES, stream); }
#elif MK_N_LAUNCHES == 1
    a.ph_lo = 0; a.ph_hi = MK_CUT;
    void* kargs[] = {&a};
    hipError_t e = hipLaunchCooperativeKernel((const void*)mk_fwd, dim3(grid), dim3(NTHR), kargs, LDS_BYTES, stream);
    if (e != hipSuccess) fprintf(stderr, "kernel_launch: cooperative launch failed: %s (grid %d)\n", hipGetErrorString(e), grid);
#else
    for (int p = 0; p < 11; ++p) { a.ph_lo = p; a.ph_hi = p + 1; hipLaunchKernelGGL(mk_fwd, dim3(grid), dim3(NTHR), LDS_BYTES, stream, a); }
#endif
}
```
